# Optimizing an MI355X kernel written in HIP

```python
import math
import jax, jax.numpy as jnp
from jax import lax
import numpy as np

D_MODEL = 4096
BATCH = 4
SEQ = 4096
DEPTH = 2

MIX_WIDTH = D_MODEL
LRU_WIDTH = D_MODEL // 4
LRU_HEADS = 8
LRU_HEAD_DIM = LRU_WIDTH // LRU_HEADS
CONV_WIDTH = 4
LRU_C = 8.0
LRU_A_MIN = 0.9
LRU_A_MAX = 0.999
HGRN_HEADS = 8
HGRN_DK = 128
HGRN_DV = 128
HGRN_KEY_WIDTH = HGRN_HEADS * HGRN_DK
HGRN_VAL_WIDTH = HGRN_HEADS * HGRN_DV
HGRN_CHUNK = 64
DIFF_WIDTH = D_MODEL // 2
DIFF_HEADS = 8
DIFF_HEAD_DIM = DIFF_WIDTH // (2 * DIFF_HEADS)
Q_BLOCK = 128
ROPE_THETA = 10000.0
D_FF = 4 * D_MODEL
NORM_EPS = 1e-6

OFF_A_GATE = 0
OFF_A_X = OFF_A_GATE + LRU_WIDTH
OFF_B_Q = OFF_A_X + LRU_WIDTH
OFF_B_F = OFF_B_Q + HGRN_KEY_WIDTH
OFF_B_I = OFF_B_F + HGRN_KEY_WIDTH
OFF_B_G = OFF_B_I + HGRN_VAL_WIDTH
OFF_C_Q = OFF_B_G + HGRN_VAL_WIDTH
OFF_C_K = OFF_C_Q + DIFF_WIDTH
OFF_C_V = OFF_C_K + DIFF_WIDTH
IN_WIDTH = OFF_C_V + DIFF_WIDTH

kernel_name = "hymba_rglru_hgrn2_diffattn_hybrid"

F32 = jnp.float32


def rms_norm(x, gain, eps=NORM_EPS):
    xf = x.astype(F32)
    y = xf * lax.rsqrt(jnp.mean(xf * xf, axis=-1, keepdims=True) + eps)
    return (y * gain.astype(F32)).astype(x.dtype)


def rotary_tables(seq, dim):
    inv = 1.0 / (ROPE_THETA ** (jnp.arange(0, dim, 2, dtype=F32) / dim))
    ang = jnp.arange(seq, dtype=F32)[:, None] * inv[None, :]
    ang = jnp.concatenate([ang, ang], axis=-1)
    return jnp.cos(ang), jnp.sin(ang)


def apply_rope(x, cos, sin):
    x1, x2 = jnp.split(x, 2, axis=-1)
    rot = jnp.concatenate([-x2, x1], axis=-1)
    c = cos[None, :, None, None, :]
    s = sin[None, :, None, None, :]
    return (x.astype(F32) * c + rot.astype(F32) * s).astype(x.dtype)


def causal_depthwise_conv(x, w, b):
    c = x.shape[-1]
    y = lax.conv_general_dilated(
        x, w[:, None, :].astype(x.dtype), window_strides=(1,),
        padding=[(CONV_WIDTH - 1, 0)], dimension_numbers=("NWC", "WIO", "NWC"),
        feature_group_count=c)
    return y + b.astype(x.dtype)


def rg_lru(x, w_r, b_r, w_i, b_i, lam):
    bsz, seq, width = x.shape
    xh = x.reshape(bsz, seq, LRU_HEADS, LRU_HEAD_DIM)
    r = jax.nn.sigmoid(jnp.einsum("bshi,hij->bshj", xh, w_r) + b_r).reshape(bsz, seq, width)
    i = jax.nn.sigmoid(jnp.einsum("bshi,hij->bshj", xh, w_i) + b_i).reshape(bsz, seq, width)
    log_a = -LRU_C * r.astype(F32) * jax.nn.softplus(-lam.astype(F32))
    a = jnp.exp(log_a)
    mult = jnp.sqrt(-jnp.expm1(2.0 * log_a))
    mult = jnp.where((jnp.arange(seq) == 0)[None, :, None], 1.0, mult)
    u = mult * (i * x).astype(F32)

    def combine(c1, c2):
        a1, b1 = c1
        a2, b2 = c2
        return a1 * a2, a2 * b1 + b2

    _, h = lax.associative_scan(combine, (a, u), axis=1)
    return h.astype(x.dtype)


def hgrn2_chunkwise(q, k, v, log_f):
    bsz, seq, heads, dk = q.shape
    dv = v.shape[-1]
    n = seq // HGRN_CHUNK

    def to_chunks(t):
        return t.astype(F32).reshape(bsz, n, HGRN_CHUNK, heads, t.shape[-1]).transpose(1, 0, 3, 2, 4)

    qc, kc, vc, gc = to_chunks(q), to_chunks(k), to_chunks(v), to_chunks(log_f)
    causal = jnp.tril(jnp.ones((HGRN_CHUNK, HGRN_CHUNK), dtype=bool))

    def step(state, inp):
        qb, kb, vb, gb = inp
        g_cum = jnp.cumsum(gb, axis=2)
        diff = g_cum[:, :, :, None, :] - g_cum[:, :, None, :, :]
        decay = jnp.exp(jnp.where(causal[None, None, :, :, None], diff, -jnp.inf))
        scores = jnp.einsum("bhtd,bhsd,bhtsd->bhts", qb, kb, decay)
        o = (jnp.einsum("bhts,bhsv->bhtv", scores, vb)
             + jnp.einsum("bhtd,bhdv->bhtv", qb * jnp.exp(g_cum), state))
        g_last = g_cum[:, :, -1, :]
        new_state = (jnp.exp(g_last)[..., None] * state
                     + jnp.einsum("bhsd,bhsv->bhdv", kb * jnp.exp(g_last[:, :, None, :] - g_cum), vb))
        return new_state, o

    state0 = jnp.zeros((bsz, heads, dk, dv), F32)
    _, o = lax.scan(step, state0, (qc, kc, vc, gc))
    return o.transpose(1, 0, 3, 2, 4).reshape(bsz, seq, heads, dv)


def diff_attention(q, k, v, lam):
    bsz, seq, heads, _, d = q.shape
    nb = seq // Q_BLOCK
    qb = q.astype(F32).reshape(bsz, nb, Q_BLOCK, heads, 2, d).transpose(1, 0, 2, 3, 4, 5)
    kf = k.astype(F32)
    vf = v.astype(F32)
    kpos = jnp.arange(seq)
    scale = d ** -0.5

    def block(args):
        qi, bi = args
        s = jnp.einsum("bqhcd,bkhcd->bhcqk", qi, kf) * scale
        qpos = bi * Q_BLOCK + jnp.arange(Q_BLOCK)
        mask = kpos[None, :] <= qpos[:, None]
        p = jax.nn.softmax(jnp.where(mask, s, -jnp.inf), axis=-1)
        w = p[:, :, 0] - lam * p[:, :, 1]
        return jnp.einsum("bhqk,bkhv->bqhv", w, vf)

    o = lax.map(block, (qb, jnp.arange(nb)))
    return o.transpose(1, 0, 2, 3, 4).reshape(bsz, seq, heads, 2 * d)


def setup_inputs(seed: int = 0) -> dict:
    key = jax.random.key(seed)
    ks = jax.random.split(key, 24)

    def normal(k, shape, scale):
        return jax.random.normal(k, shape, F32) * scale

    def gain(k, shape):
        return 1.0 + 0.02 * jax.random.normal(k, shape, F32)

    x = normal(ks[0], (BATCH, SEQ, D_MODEL), 1.0)
    ln1_gain = gain(ks[1], (DEPTH, D_MODEL))
    w_in = normal(ks[2], (DEPTH, D_MODEL, IN_WIDTH), D_MODEL ** -0.5)
    conv_w = normal(ks[3], (DEPTH, CONV_WIDTH, LRU_WIDTH), CONV_WIDTH ** -0.5)
    conv_b = normal(ks[4], (DEPTH, LRU_WIDTH), 0.01)
    lru_w_r = normal(ks[5], (DEPTH, LRU_HEADS, LRU_HEAD_DIM, LRU_HEAD_DIM), LRU_HEAD_DIM ** -0.5)
    lru_b_r = normal(ks[6], (DEPTH, LRU_HEADS, LRU_HEAD_DIM), 0.01)
    lru_w_i = normal(ks[7], (DEPTH, LRU_HEADS, LRU_HEAD_DIM, LRU_HEAD_DIM), LRU_HEAD_DIM ** -0.5)
    lru_b_i = normal(ks[8], (DEPTH, LRU_HEADS, LRU_HEAD_DIM), 0.01)
    a_pow_c = jax.random.uniform(ks[9], (DEPTH, LRU_WIDTH), F32, LRU_A_MIN, LRU_A_MAX)
    a0 = a_pow_c ** (1.0 / LRU_C)
    lru_lambda = jnp.log(a0) - jnp.log1p(-a0)
    lru_norm_gain = gain(ks[10], (DEPTH, LRU_WIDTH))
    hgrn_lower_bounds = normal(ks[11], (DEPTH, HGRN_KEY_WIDTH), 0.1)
    hgrn_norm_gain = gain(ks[12], (DEPTH, HGRN_DV))
    q_norm_gain = gain(ks[13], (DEPTH, DIFF_HEAD_DIM))
    k_norm_gain = gain(ks[14], (DEPTH, DIFF_HEAD_DIM))
    diff_lambda = normal(ks[15], (DEPTH, 4, DIFF_HEAD_DIM), 0.1)
    diff_subln_gain = gain(ks[16], (DEPTH, 2 * DIFF_HEAD_DIM))
    w_out = normal(ks[17], (DEPTH, MIX_WIDTH, D_MODEL), MIX_WIDTH ** -0.5)
    ln2_gain = gain(ks[18], (DEPTH, D_MODEL))
    w_ff1 = normal(ks[19], (DEPTH, D_MODEL, D_FF), D_MODEL ** -0.5)
    w_ff2 = normal(ks[20], (DEPTH, D_FF, D_MODEL), D_FF ** -0.5)
    return {
        "x": x, "ln1_gain": ln1_gain, "w_in": w_in, "conv_w": conv_w, "conv_b": conv_b,
        "lru_w_r": lru_w_r, "lru_b_r": lru_b_r, "lru_w_i": lru_w_i, "lru_b_i": lru_b_i,
        "lru_lambda": lru_lambda, "lru_norm_gain": lru_norm_gain,
        "hgrn_lower_bounds": hgrn_lower_bounds, "hgrn_norm_gain": hgrn_norm_gain,
        "q_norm_gain": q_norm_gain, "k_norm_gain": k_norm_gain, "diff_lambda": diff_lambda,
        "diff_subln_gain": diff_subln_gain, "w_out": w_out, "ln2_gain": ln2_gain,
        "w_ff1": w_ff1, "w_ff2": w_ff2,
    }


def reference(x, ln1_gain, w_in, conv_w, conv_b, lru_w_r, lru_b_r, lru_w_i, lru_b_i,
              lru_lambda, lru_norm_gain, hgrn_lower_bounds, hgrn_norm_gain, q_norm_gain,
              k_norm_gain, diff_lambda, diff_subln_gain, w_out, ln2_gain, w_ff1, w_ff2):
    bsz, seq, _ = x.shape
    dt = x.dtype
    cos, sin = rotary_tables(seq, DIFF_HEAD_DIM)
    lb_all = jnp.cumsum(jax.nn.softmax(hgrn_lower_bounds.astype(F32), axis=0), axis=0)
    lb_all = lb_all - lb_all[0:1]

    for l in range(DEPTH):
        h = rms_norm(x, ln1_gain[l])
        z = h @ w_in[l]

        gate_a = jax.nn.gelu(z[..., OFF_A_GATE:OFF_A_GATE + LRU_WIDTH])
        xa = causal_depthwise_conv(z[..., OFF_A_X:OFF_A_X + LRU_WIDTH], conv_w[l], conv_b[l])
        ya = rg_lru(xa, lru_w_r[l], lru_b_r[l], lru_w_i[l], lru_b_i[l], lru_lambda[l]) * gate_a
        ya = rms_norm(ya, lru_norm_gain[l]).astype(dt)

        qB = jax.nn.silu(z[..., OFF_B_Q:OFF_B_Q + HGRN_KEY_WIDTH].astype(F32))
        qB = qB.reshape(bsz, seq, HGRN_HEADS, HGRN_DK) * (HGRN_DK ** -0.5)
        zf = z[..., OFF_B_F:OFF_B_F + HGRN_KEY_WIDTH].astype(F32).reshape(bsz, seq, HGRN_HEADS, HGRN_DK)
        lb = lb_all[l].reshape(HGRN_HEADS, HGRN_DK)
        log_f = jnp.logaddexp(jnp.log(lb), jnp.log1p(-lb) + jax.nn.log_sigmoid(zf))
        kB = (1.0 - lb) * jax.nn.sigmoid(-zf)
        vB = z[..., OFF_B_I:OFF_B_I + HGRN_VAL_WIDTH].reshape(bsz, seq, HGRN_HEADS, HGRN_DV)
        gB = z[..., OFF_B_G:OFF_B_G + HGRN_VAL_WIDTH].reshape(bsz, seq, HGRN_HEADS, HGRN_DV)
        oB = hgrn2_chunkwise(qB, kB, vB, log_f)
        yb = rms_norm(oB, hgrn_norm_gain[l]) * jax.nn.silu(gB.astype(F32))
        yb = yb.reshape(bsz, seq, HGRN_VAL_WIDTH).astype(dt)

        qC = z[..., OFF_C_Q:OFF_C_Q + DIFF_WIDTH].reshape(bsz, seq, DIFF_HEADS, 2, DIFF_HEAD_DIM)
        kC = z[..., OFF_C_K:OFF_C_K + DIFF_WIDTH].reshape(bsz, seq, DIFF_HEADS, 2, DIFF_HEAD_DIM)
        vC = z[..., OFF_C_V:OFF_C_V + DIFF_WIDTH].reshape(bsz, seq, DIFF_HEADS, 2 * DIFF_HEAD_DIM)
        qC = apply_rope(rms_norm(qC, q_norm_gain[l]), cos, sin)
        kC = apply_rope(rms_norm(kC, k_norm_gain[l]), cos, sin)
        lam_init = 0.8 - 0.6 * math.exp(-0.3 * l)
        lp = diff_lambda[l].astype(F32)
        lam = jnp.exp(jnp.sum(lp[0] * lp[1])) - jnp.exp(jnp.sum(lp[2] * lp[3])) + lam_init
        oC = diff_attention(qC, kC, vC, lam)
        yc = rms_norm(oC, diff_subln_gain[l]) * (1.0 - lam_init)
        yc = yc.reshape(bsz, seq, DIFF_WIDTH).astype(dt)

        y = jnp.concatenate([ya, yb, yc], axis=-1) @ w_out[l]
        x = x + y.astype(dt)

        h2 = rms_norm(x, ln2_gain[l])
        x = x + (jnp.square(jax.nn.relu(h2 @ w_ff1[l])) @ w_ff2[l]).astype(dt)
    return x
```

```cpp
#include <hip/hip_runtime.h>
#include <hip/hip_bf16.h>
#include <cstdio>
#include <cstdint>
__device__ __forceinline__ int tid_opaque() { int t = threadIdx.x; asm volatile("" : "+v"(t)); return t; }
typedef __bf16 hw_bf16x2 __attribute__((ext_vector_type(2)));
typedef float hw_f32x2 __attribute__((ext_vector_type(2)));
__device__ __forceinline__ unsigned pk_bf16_builtin(float lo, float hi) { hw_f32x2 f = {lo, hi}; hw_bf16x2 r = __builtin_convertvector(f, hw_bf16x2); return __builtin_bit_cast(unsigned, r); }
namespace pg8 {
#define PG8_LAS __attribute__((address_space(3)))
typedef unsigned short bf16_t;
typedef short bf16x8 __attribute__((ext_vector_type(8)));
typedef float f32x4 __attribute__((ext_vector_type(4)));
typedef unsigned u32x4 __attribute__((ext_vector_type(4)));
constexpr int BM = 256, BK = 64, HALF = 128, HTB = HALF * BK * 2  , STAGE_BYTES = 8 * HTB, NXCD = 8, WGM = 8;

__host__ __device__ __forceinline__ int lds_byte(int r, int c) { const int st = (r >> 4) * 2 + (c >> 5), rr = r & 15, cc = c & 31, ob = rr * 64 + cc * 2; return st * 1024 + (ob ^ (((ob >> 9) & 1) << 5)); }
__host__ __device__ __forceinline__ void stage_rc(int b, int& R, int& C) { const int st = b / 1024, sb = b % 1024, swz = sb ^ (((sb >> 9) & 1) << 5); R = (st >> 1) * 16 + swz / 64; C = (st & 1) * 32 + (swz % 64) / 2; }
__host__ __device__ __forceinline__ int perm32(int rho) { const int n = rho >> 4, i = rho & 15; return 8 * (i >> 2) + 4 * n + (i & 3); }

struct Unit { int pm, pn; };
struct Gemm { const bf16_t* A; const bf16_t* Bt; int M, N, K; };

struct StaticOrder {
    int nM, nN, nwg, G, c;
    __host__ __device__ void init(int M, int N, int G_, int c_) { nM = M / BM; nN = N / BM; nwg = nM * nN; G = G_; c = c_; }
    __host__ __device__ bool next(int i, Unit& u) const {
        const long L = (long)i * G + c; if (L >= nwg) return false;
        int wgid = (int)L; { const int q = nwg / NXCD, r = nwg % NXCD, xcd = wgid % NXCD, off = wgid / NXCD; wgid = (xcd < r ? xcd * (q + 1) : r * (q + 1) + (xcd - r) * q) + off; }
        const int nig = WGM * nN, gid = wgid / nig, fm = gid * WGM, gsz = (nM - fm) < WGM ? (nM - fm) : WGM;
        u.pm = fm + ((wgid % nig) % gsz); u.pn = (wgid % nig) / gsz; return true;
    }
    __device__ __forceinline__ void a_ready(const Unit&) const {}
    __device__ __forceinline__ void done(const Unit&) const {}
};

__device__ __forceinline__ unsigned cvt_pk_bf16(float lo, float hi) { return pk_bf16_builtin(lo, hi); }
typedef float f32x2 __attribute__((ext_vector_type(2)));
__device__ __forceinline__ f32x2 gelu_pk(f32x2 v) {
    const f32x2 av = __builtin_elementwise_abs(v), d = av * 0.2316418882f + 1.0f;
    f32x2 t; t.x = __builtin_amdgcn_rcpf(d.x); t.y = __builtin_amdgcn_rcpf(d.y);
    f32x2 q = t * 0.5307027145f + (-0.7265760135f); q = q * t + 0.7107068705f; q = q * t + (-0.142248368f); q = q * t + 0.127414796f; q = q * t;
    const f32x2 s = (v * v) * (-0.72134752044f);
    f32x2 e; e.x = __builtin_amdgcn_exp2f(s.x); e.y = __builtin_amdgcn_exp2f(s.y);
    const f32x2 m = v * (q * e), r = v - m;
    f32x2 o; o.x = v.x < 0.f ? m.x : r.x; o.y = v.y < 0.f ? m.y : r.y; return o;
}

template <int ACT> struct EpiBf16X {
    static constexpr bool PERM = true, AFTER_DRAIN = false;
    bf16_t* O; int ldc; const float* bias0; const float* bias1; int bias_split;
    __device__ __forceinline__ void operator()(const f32x4 (&acc)[2][2][4][2], const Unit& u, int wr, int wc, int fr, int fq) const {
        const int row0 = u.pm * BM + wr * 64 + fr; const int colt = u.pn * BM;
        const int col0 = colt + wc * 32 + 8 * fq;
        f32x4 bv[2][2];
#pragma unroll
        for (int bj = 0; bj < 2; ++bj)
#pragma unroll
            for (int n = 0; n < 2; ++n) {
                if (ACT == 1) { const float* bp = (colt < bias_split) ? (bias0 + col0) : (bias1 + (col0 - bias_split)); bv[bj][n] = *(const f32x4*)(bp + bj * HALF + 4 * n); }
                else bv[bj][n] = (f32x4){0.f, 0.f, 0.f, 0.f};
            }
#pragma unroll
        for (int ai = 0; ai < 2; ++ai)
#pragma unroll
            for (int m = 0; m < 4; ++m) { bf16_t* rowp = O + (size_t)(row0 + ai * HALF + m * 16) * ldc + col0;
#pragma unroll
                for (int bj = 0; bj < 2; ++bj) { f32x4 v0 = acc[ai][bj][m][0] + bv[bj][0], v1 = acc[ai][bj][m][1] + bv[bj][1];
                    if (ACT == 1) {
#pragma unroll
                        for (int j = 0; j < 4; ++j) { v0[j] = __builtin_amdgcn_rcpf(1.0f + __builtin_amdgcn_exp2f(-1.4426950408889634f * v0[j])); v1[j] = __builtin_amdgcn_rcpf(1.0f + __builtin_amdgcn_exp2f(-1.4426950408889634f * v1[j])); } }
                    if (ACT == 2) {
#pragma unroll
                        for (int j = 0; j < 4; ++j) { const float a = fmaxf(v0[j], 0.f), b = fmaxf(v1[j], 0.f); v0[j] = a * a; v1[j] = b * b; } }
                    u32x4 w; w.x = cvt_pk_bf16(v0[0], v0[1]); w.y = cvt_pk_bf16(v0[2], v0[3]); w.z = cvt_pk_bf16(v1[0], v1[1]); w.w = cvt_pk_bf16(v1[2], v1[3]);
                    *(u32x4*)(rowp + bj * HALF) = w; } }
    }
};
struct EpiResF32 {
    static constexpr bool PERM = false, AFTER_DRAIN = false;
    const float* base; float* out; int ldc;
    __device__ __forceinline__ void operator()(const f32x4 (&acc)[2][2][4][2], const Unit& u, int wr, int wc, int fr, int fq) const {
        const int row0 = u.pm * BM + wr * 64 + fr, col0 = u.pn * BM + wc * 32 + 4 * fq;
#pragma unroll
        for (int ai = 0; ai < 2; ++ai)
#pragma unroll
            for (int m = 0; m < 4; ++m) { const size_t off = (size_t)(row0 + ai * HALF + m * 16) * ldc + col0;
#pragma unroll
                for (int bj = 0; bj < 2; ++bj)
#pragma unroll
                    for (int n = 0; n < 2; ++n) { const f32x4 bs = *(const f32x4*)(base + off + bj * HALF + n * 16); *(f32x4*)(out + off + bj * HALF + n * 16) = bs + acc[ai][bj][m][n]; }
                asm volatile("" ::: "memory"); }
    }
};
template <class Epi, class Sched, bool ALIGN_EPI = false, bool SP2 = false>
__device__ __forceinline__ void gemm_phase(PG8_LAS unsigned char* lds, const Gemm g, const Sched& S, const Epi& E) {
    const int tid = tid_opaque(), wid = __builtin_amdgcn_readfirstlane(tid >> 6), lane = tid & 63, wr = wid >> 2, wc = wid & 3, fr = lane & 15, fq = lane >> 4;
    const int K = g.K, nt = K / BK;
    unsigned voffA[2], voffB[2];
#pragma unroll
    for (int i = 0; i < 2; ++i) { int R, C; stage_rc(tid * 16 + i * 8192, R, C); const int Rb = Epi::PERM ? ((R & ~31) + perm32(R & 31)) : R;
        voffA[i] = (unsigned)(R * K + C) * 2u; voffB[i] = (unsigned)(Rb * K + C) * 2u; }
    const size_t kstep = (size_t)(BK * 2);
    const size_t hstep = (size_t)HALF * K * 2;
    const size_t tstep = 2 * hstep;
    const unsigned ldsw = (unsigned)wid * 1024u;
    const int aoff = lds_byte(wr * 64 + fr, fq * 8), boff = lds_byte(wc * 32 + fr, fq * 8);
#define PG8_SA(b, h) (((b) * 2 + (h)) * HTB)
#define PG8_SB(b, h) ((4 + (b) * 2 + (h)) * HTB)
#define PG8_STAGE(bufoff, gbase, voff) do { _Pragma("unroll") for (int _i = 0; _i < 2; ++_i) \
        __builtin_amdgcn_global_load_lds((const unsigned*)((const char*)(gbase) + (voff)[_i]), (PG8_LAS unsigned*)(lds + (bufoff) + ldsw + _i * 8192), 16, 0, 0); } while (0)
#define PG8_LDA(dst, b, h) do { _Pragma("unroll") for (int m = 0; m < 4; ++m) _Pragma("unroll") for (int k = 0; k < 2; ++k) dst[m][k] = *(const PG8_LAS bf16x8*)(lds + PG8_SA(b, h) + aoff + m * 2048 + k * 1024); } while (0)
#define PG8_LDB(dst, b, h) do { _Pragma("unroll") for (int n = 0; n < 2; ++n) _Pragma("unroll") for (int k = 0; k < 2; ++k) dst[n][k] = *(const PG8_LAS bf16x8*)(lds + PG8_SB(b, h) + boff + n * 2048 + k * 1024); } while (0)
#define PG8_MMA(ai, bj, At, Bt) do { __builtin_amdgcn_s_setprio(1); _Pragma("unroll") for (int m = 0; m < 4; ++m) _Pragma("unroll") for (int n = 0; n < 2; ++n) _Pragma("unroll") for (int k = 0; k < 2; ++k) \
        acc[ai][bj][m][n] = __builtin_amdgcn_mfma_f32_16x16x32_bf16(Bt[n][k], At[m][k], acc[ai][bj][m][n], 0, 0, 0); __builtin_amdgcn_s_setprio(0); } while (0)
#define PG8_WAIT_V(n) asm volatile("s_waitcnt vmcnt(" #n ")" ::: "memory")
#define PG8_WAIT_L(n) asm volatile("s_waitcnt lgkmcnt(" #n ")" ::: "memory")
#define PG8_BAR __builtin_amdgcn_s_barrier()
#define PG8_SCHED __builtin_amdgcn_sched_barrier(0)
    Unit cur, nxt; int ui = 0;
    if (!S.next(0, cur)) return;
    f32x4 acc[2][2][4][2];
#pragma unroll
    for (int a = 0; a < 2; ++a)
#pragma unroll
        for (int b = 0; b < 2; ++b)
#pragma unroll
            for (int m = 0; m < 4; ++m)
#pragma unroll
                for (int n = 0; n < 2; ++n) acc[a][b][m][n] = (f32x4){0.f, 0.f, 0.f, 0.f};
    bf16x8 At[4][2], B0[2][2], B1[2][2];
    const char* cA = (const char*)g.A + (size_t)cur.pm * tstep; const char* cB = (const char*)g.Bt + (size_t)cur.pn * tstep;
    S.a_ready(cur);
    if constexpr (SP2) {
        PG8_STAGE(PG8_SB(0, 0), cB, voffB); PG8_STAGE(PG8_SB(0, 1), cB + hstep, voffB); PG8_STAGE(PG8_SA(0, 0), cA, voffA); PG8_STAGE(PG8_SA(0, 1), cA + hstep, voffA);
        if (wr == 1) PG8_BAR;
        PG8_WAIT_V(2); PG8_BAR;
        PG8_STAGE(PG8_SB(1, 0), cB + kstep, voffB); PG8_STAGE(PG8_SA(1, 0), cA + kstep, voffA); PG8_STAGE(PG8_SB(1, 1), cB + hstep + kstep, voffB);
        PG8_WAIT_V(6); PG8_BAR;
    } else {
        PG8_STAGE(PG8_SB(0, 0), cB, voffB); PG8_STAGE(PG8_SA(0, 0), cA, voffA); PG8_STAGE(PG8_SB(0, 1), cB + hstep, voffB); PG8_STAGE(PG8_SA(0, 1), cA + hstep, voffA);
        if (wr == 1) PG8_BAR;
        PG8_WAIT_V(4); PG8_BAR;
        PG8_STAGE(PG8_SB(1, 0), cB + kstep, voffB); PG8_STAGE(PG8_SA(1, 0), cA + kstep, voffA); PG8_STAGE(PG8_SB(1, 1), cB + hstep + kstep, voffB);
        PG8_WAIT_V(6); PG8_BAR;
    }
    for (;;) {
        const bool has_next = S.next(ui + 1, nxt);
        const char* nA = has_next ? (const char*)g.A + (size_t)nxt.pm * tstep : cA; const char* nB = has_next ? (const char*)g.Bt + (size_t)nxt.pn * tstep : cB;
        for (int t = 0; t < nt; t += 2) {
            const bool last = (t == nt - 2);
            const char* a1 = cA + (size_t)(t + 1) * kstep;
            const char* a2 = last ? nA : cA + (size_t)(t + 2) * kstep; const char* b2 = last ? nB : cB + (size_t)(t + 2) * kstep;
            const char* a3 = a2 + kstep; const char* b3 = b2 + kstep;
            if (last && has_next) S.a_ready(nxt);
            if constexpr (SP2) {
            PG8_LDB(B0, 0, 0); PG8_LDB(B1, 0, 1); PG8_SCHED; PG8_LDA(At, 0, 0); PG8_STAGE(PG8_SA(1, 1), a1 + hstep, voffA);
            PG8_WAIT_V(8); PG8_WAIT_L(0); PG8_BAR; PG8_MMA(0, 0, At, B0); PG8_MMA(0, 1, At, B1); PG8_BAR; PG8_SCHED;
            PG8_LDA(At, 0, 1); PG8_STAGE(PG8_SB(0, 0), b2, voffB); PG8_STAGE(PG8_SB(0, 1), b2 + hstep, voffB); PG8_STAGE(PG8_SA(0, 0), a2, voffA);
            PG8_WAIT_V(8); PG8_WAIT_L(0); PG8_BAR; PG8_MMA(1, 0, At, B0); PG8_MMA(1, 1, At, B1); PG8_BAR; PG8_SCHED;
            PG8_LDB(B0, 1, 0); PG8_LDB(B1, 1, 1); PG8_SCHED; PG8_LDA(At, 1, 0); PG8_STAGE(PG8_SA(0, 1), a2 + hstep, voffA);
            PG8_WAIT_V(8); PG8_WAIT_L(0); PG8_BAR; PG8_MMA(0, 0, At, B0); PG8_MMA(0, 1, At, B1); PG8_BAR; PG8_SCHED;
            PG8_LDA(At, 1, 1); PG8_STAGE(PG8_SB(1, 0), b3, voffB); PG8_STAGE(PG8_SB(1, 1), b3 + hstep, voffB); PG8_STAGE(PG8_SA(1, 0), a3, voffA);
            PG8_WAIT_V(8); PG8_WAIT_L(0); PG8_BAR; PG8_MMA(1, 0, At, B0); PG8_MMA(1, 1, At, B1); PG8_BAR; PG8_SCHED;
            } else {
            PG8_LDB(B0, 0, 0); PG8_SCHED; PG8_LDA(At, 0, 0); PG8_STAGE(PG8_SA(1, 1), a1 + hstep, voffA);
            PG8_WAIT_L(8); PG8_BAR; PG8_WAIT_L(0); PG8_MMA(0, 0, At, B0); PG8_BAR; PG8_SCHED;
            PG8_LDB(B1, 0, 1); PG8_STAGE(PG8_SB(0, 0), b2, voffB);
            PG8_BAR; PG8_WAIT_L(0); PG8_MMA(0, 1, At, B1); PG8_BAR;
            PG8_LDA(At, 0, 1); PG8_STAGE(PG8_SA(0, 0), a2, voffA);
            PG8_BAR; PG8_WAIT_L(0); PG8_MMA(1, 0, At, B0); PG8_BAR; PG8_SCHED;
            PG8_STAGE(PG8_SB(0, 1), b2 + hstep, voffB);
            PG8_WAIT_V(6); PG8_BAR; PG8_MMA(1, 1, At, B1); PG8_BAR;
            PG8_LDB(B0, 1, 0); PG8_SCHED; PG8_LDA(At, 1, 0); PG8_STAGE(PG8_SA(0, 1), a2 + hstep, voffA);
            PG8_WAIT_L(8); PG8_BAR; PG8_WAIT_L(0); PG8_MMA(0, 0, At, B0); PG8_BAR; PG8_SCHED;
            PG8_LDB(B1, 1, 1); PG8_STAGE(PG8_SB(1, 0), b3, voffB);
            PG8_BAR; PG8_WAIT_L(0); PG8_MMA(0, 1, At, B1); PG8_BAR;
            PG8_LDA(At, 1, 1); PG8_STAGE(PG8_SA(1, 0), a3, voffA);
            PG8_BAR; PG8_WAIT_L(0); PG8_MMA(1, 0, At, B0); PG8_BAR; PG8_SCHED;
            PG8_STAGE(PG8_SB(1, 1), b3 + hstep, voffB);
            PG8_WAIT_V(6); PG8_BAR; PG8_MMA(1, 1, At, B1); PG8_BAR;
            }
        }
        if constexpr (ALIGN_EPI) { if (wr == 0) PG8_BAR; }
        if constexpr (!Epi::AFTER_DRAIN) { E(acc, cur, wr, wc, fr, fq); S.done(cur); }
        if (!has_next) break;
#pragma unroll
        for (int a = 0; a < 2; ++a)
#pragma unroll
            for (int b = 0; b < 2; ++b)
#pragma unroll
                for (int m = 0; m < 4; ++m)
#pragma unroll
                    for (int n = 0; n < 2; ++n) acc[a][b][m][n] = (f32x4){0.f, 0.f, 0.f, 0.f};
        cur = nxt; cA = nA; cB = nB; ++ui;
        if constexpr (ALIGN_EPI) { if (wr == 1) PG8_BAR; }
    }
    PG8_WAIT_V(0);
    if constexpr (!ALIGN_EPI) { if (wr == 0) PG8_BAR; }
    PG8_BAR;
    if constexpr (Epi::AFTER_DRAIN) { E.fused(acc, cur, wr, wc, fr, fq, lds, wid, lane); S.done(cur); }
#undef PG8_SA
#undef PG8_SB
#undef PG8_STAGE
#undef PG8_LDA
#undef PG8_LDB
#undef PG8_MMA
#undef PG8_WAIT_V
#undef PG8_WAIT_L
#undef PG8_BAR
#undef PG8_SCHED
}
}

namespace ab {
enum { ORDER_NATURAL = 0, ORDER_REVERSED = 1, ORDER_PAIRED = 2, ORDER_XCD = 4 };
using TIN = __hip_bfloat16; using TOUT = __hip_bfloat16;
constexpr int B = 4, H = 32, HKV = 32, SQ = 4096, SKV = 4096, D = 128;
constexpr int QOFF = 0; constexpr int WINDOW = SKV; constexpr float THR = 8.f; constexpr int ORDER = ORDER_PAIRED; constexpr int GRID_WGS = 0; constexpr bool WSKIP = false;
constexpr float SCALE = 0.08838834764831845f;
constexpr int NW = 8, QBLK = 32, KVBLK = 64, QB = NW * QBLK;
constexpr int SHM_V = KVBLK * D * 2, SHM_K = KVBLK * D * 2;
constexpr int LDS_BYTES = 2 * SHM_V + 2 * SHM_K + NW * 64 * 4;
using bf16 = __hip_bfloat16;
typedef short bf16x8 __attribute__((ext_vector_type(8)));
typedef short s16x4 __attribute__((ext_vector_type(4)));
typedef float f32x16 __attribute__((ext_vector_type(16)));
typedef float f32x4 __attribute__((ext_vector_type(4)));
typedef unsigned u32x4 __attribute__((ext_vector_type(4)));
template <class A, class Bt> struct same_t { static constexpr bool v = false; };
template <class A> struct same_t<A, A> { static constexpr bool v = true; };

#define KSWZ(row, colB) ((row) * 256 + ((colB) ^ (((row) & 7) << 4)))
#define SBAR() __builtin_amdgcn_sched_barrier(0)
__device__ __forceinline__ int v_st(int k, int c) { const int kk = (k & ~0xC) | ((k & 4) << 1) | ((k & 8) >> 1); return ((kk >> 3) * 4 + (c >> 5)) * 512 + ((kk & 7) * 32 + (c & 31)) * 2; }
__device__ __forceinline__ int v_rd_base(int lane) { return ((lane & 3) << 3) | (((lane >> 2) & 3) << 6) | (((lane >> 4) & 1) << 5) | (((lane >> 5) & 1) << 8); }
constexpr int v_rd_off(int d0, int ks, int half) { return d0 * 512 + ks * 4096 + half * 2048; }
__device__ __forceinline__ int crow(int r, int hi) { return (r & 3) + 8 * (r >> 2) + 4 * hi; }
__device__ __forceinline__ unsigned cvtpk(float lo, float hi) {
    return pk_bf16_builtin(lo, hi);
}
__device__ __forceinline__ bf16x8 pack8(f32x4 a, f32x4 b) {
    u32x4 w = {cvtpk(a[0], a[1]), cvtpk(a[2], a[3]), cvtpk(b[0], b[1]), cvtpk(b[2], b[3])};
    return *reinterpret_cast<bf16x8*>(&w);
}
template <class T> __device__ __forceinline__ bf16x8 load8(const T* p) {
    if constexpr (same_t<T, float>::v) { return pack8(*(const f32x4*)p, *(const f32x4*)(p + 4)); }
    else { return *reinterpret_cast<const bf16x8*>(p); }
}
__device__ __forceinline__ void mask_tile(f32x16& p0, f32x16& p1, int dq, unsigned W) {
    const float NEG = -__builtin_inff();
#pragma unroll
    for (int r = 0; r < 16; ++r) {
        const int c = (r & 3) + 8 * (r >> 2);
        if ((unsigned)(dq - c) >= W) p0[r] = NEG;
        if ((unsigned)(dq - c - 32) >= W) p1[r] = NEG;
    }
}
__device__ __forceinline__ void partialSM(f32x16& p0, f32x16& p1, float& m_reg, float& mn, float& alpha) {
    float pmax = p0[0]; for (int r = 1; r < 16; ++r) pmax = fmaxf(pmax, p0[r]); for (int r = 0; r < 16; ++r) pmax = fmaxf(pmax, p1[r]);
    { auto rr = __builtin_amdgcn_permlane32_swap(__float_as_uint(pmax), __float_as_uint(pmax), false, false);
      pmax = fmaxf(__uint_as_float(rr[0]), __uint_as_float(rr[1])); }
    constexpr float C2 = 1.4426950408889634f * SCALE;
    if (__builtin_expect(__all((pmax - m_reg) * SCALE <= THR), 1)) { mn = m_reg; alpha = 1.f; }
    else { mn = fmaxf(m_reg, pmax); alpha = __builtin_amdgcn_exp2f((m_reg - mn) * C2); m_reg = mn; }
    const float mnL = -mn * C2;
    for (int r = 0; r < 16; ++r) p0[r] = fmaf(p0[r], C2, mnL); for (int r = 0; r < 16; ++r) p1[r] = fmaf(p1[r], C2, mnL);
    for (int r = 0; r < 16; ++r) p0[r] = __builtin_amdgcn_exp2f(p0[r]);
}
__device__ __forceinline__ void finishSM(f32x16& p0, f32x16& p1, float alpha, float& l_reg, bf16x8& pa0, bf16x8& pa1, bf16x8& pa2, bf16x8& pa3) {
    for (int r = 0; r < 16; ++r) p1[r] = __builtin_amdgcn_exp2f(p1[r]);
    float ps = 0; for (int r = 0; r < 16; ++r) ps += p0[r]; for (int r = 0; r < 16; ++r) ps += p1[r];
    { auto rr = __builtin_amdgcn_permlane32_swap(__float_as_uint(ps), __float_as_uint(ps), false, false);
      ps = __uint_as_float(rr[0]) + __uint_as_float(rr[1]); }
    l_reg = l_reg * alpha + ps;
#define PK4(P, B_, OUT) do { unsigned a0 = cvtpk(P[B_+0], P[B_+1]), a1 = cvtpk(P[B_+2], P[B_+3]);                          \
        unsigned b0 = cvtpk(P[B_+4], P[B_+5]), b1 = cvtpk(P[B_+6], P[B_+7]);                                             \
        auto r0 = __builtin_amdgcn_permlane32_swap(a0, b0, false, false); auto r1 = __builtin_amdgcn_permlane32_swap(a1, b1, false, false); \
        u32x4 w = {r0[0], r1[0], r0[1], r1[1]}; OUT = *reinterpret_cast<bf16x8*>(&w); } while (0)
    PK4(p0, 0, pa0); PK4(p0, 8, pa1); PK4(p1, 0, pa2); PK4(p1, 8, pa3);
#undef PK4
}
template <int KB, bool SK>
__device__ __forceinline__ void qkt(f32x16& p0, f32x16& p1, const char* K_lds, int r32, int hi, const bf16x8* qr, bool act) {
    if (SK && !act) { const float NEG = -__builtin_inff();
#pragma unroll
        for (int r = 0; r < 16; ++r) { p0[r] = NEG; p1[r] = NEG; } return; }
    p0 = f32x16{}; p1 = f32x16{};
    const char* kb[4];
#pragma unroll
    for (int dd = 0; dd < 4; ++dd) kb[dd] = K_lds + KB * SHM_K + KSWZ(r32, (dd * 16 + hi * 8) * 2);
#pragma unroll
    for (int d0 = 0; d0 < 8; ++d0) { const char* a = kb[d0 & 3] + (d0 >> 2) * 128;
        bf16x8 b0 = *reinterpret_cast<const bf16x8*>(a);
        bf16x8 b1 = *reinterpret_cast<const bf16x8*>(a + 32 * 256);
        p0 = __builtin_amdgcn_mfma_f32_32x32x16_bf16(b0, qr[d0], p0, 0, 0, 0);
        p1 = __builtin_amdgcn_mfma_f32_32x32x16_bf16(b1, qr[d0], p1, 0, 0, 0); }
}
template <int VB, bool SK>
__device__ __forceinline__ void pv_tile(f32x16* o, int vb0, bf16x8 pa0, bf16x8 pa1, bf16x8 pa2, bf16x8 pa3, bool act) {
    if (SK && !act) return;
#define TRRD(dst, off) asm volatile("ds_read_b64_tr_b16 %0, %1 offset:%2" : "=&v"(dst) : "v"(vb0), "i"(off) : "memory")
#define PV_D0(d0) do { s16x4 l0, l1, l2, l3, h0, h1, h2, h3; constexpr int b_ = VB * SHM_V + v_rd_off(d0, 0, 0);     \
        TRRD(l0, b_); TRRD(h0, b_ + 2048); TRRD(l1, b_ + 4096); TRRD(h1, b_ + 6144); TRRD(l2, b_ + 8192); TRRD(h2, b_ + 10240); TRRD(l3, b_ + 12288); TRRD(h3, b_ + 14336); \
        asm volatile("s_waitcnt lgkmcnt(0)" ::: "memory"); SBAR();                 \
        o[d0] = __builtin_amdgcn_mfma_f32_32x32x16_bf16(pa0, (bf16x8){l0[0], l0[1], l0[2], l0[3], h0[0], h0[1], h0[2], h0[3]}, o[d0], 0, 0, 0);   \
        o[d0] = __builtin_amdgcn_mfma_f32_32x32x16_bf16(pa1, (bf16x8){l1[0], l1[1], l1[2], l1[3], h1[0], h1[1], h1[2], h1[3]}, o[d0], 0, 0, 0);   \
        o[d0] = __builtin_amdgcn_mfma_f32_32x32x16_bf16(pa2, (bf16x8){l2[0], l2[1], l2[2], l2[3], h2[0], h2[1], h2[2], h2[3]}, o[d0], 0, 0, 0);   \
        o[d0] = __builtin_amdgcn_mfma_f32_32x32x16_bf16(pa3, (bf16x8){l3[0], l3[1], l3[2], l3[3], h3[0], h3[1], h3[2], h3[3]}, o[d0], 0, 0, 0); } while (0)
    PV_D0(0); PV_D0(1); PV_D0(2); PV_D0(3);
#undef PV_D0
#undef TRRD
}

template <class TIn, class TOut> struct BlockRef { const TIn* Q; const TIn* K; const TIn* V; TOut* O; int P0; };
template <class TIn> struct Seam {
    bf16x8 qr[8];
    bf16x8 st_v0, st_v1, st_k0, st_k1; f32x4 sf0, sf1, sf2, sf3;
    f32x4 tq[16];
};
__device__ __forceinline__ int swa_jlo(int P0, int W) { const int lowk = P0 - W + 1; return lowk > 0 ? lowk / KVBLK : 0; }
#define ROW(p, k0, rr) ((p) + (size_t)((k0) + (rr)) * D + sc)
#define VMW() asm volatile("s_waitcnt vmcnt(0)" ::: "memory")
#define VMWN(n) asm volatile("s_waitcnt vmcnt(%0)" :: "i"(n) : "memory")
#define SLOAD_H(Kp, Vp, k0) do { S.st_v0 = load8<TIn>(ROW(Vp, k0, sr)); S.st_v1 = load8<TIn>(ROW(Vp, k0, 32 + sr));              \
                         S.st_k0 = load8<TIn>(ROW(Kp, k0, sr)); S.st_k1 = load8<TIn>(ROW(Kp, k0, 32 + sr)); } while (0)
#define SWRITE_HK(bf) do { *(bf16x8*)(K_lds + (bf) * SHM_K + kws) = S.st_k0; *(bf16x8*)(K_lds + (bf) * SHM_K + kws + 32 * 256) = S.st_k1; } while (0)
#define SWRITE_HV(bf) do { *(bf16x8*)(V_lds + (bf) * SHM_V + vst0) = S.st_v0; *(bf16x8*)(V_lds + (bf) * SHM_V + vst1) = S.st_v1; } while (0)
#define SWRITE_H(bf) do { SWRITE_HV(bf); SWRITE_HK(bf); } while (0)
#define SLOAD_F(p, k0) do { S.sf0 = *(const f32x4*)ROW(p, k0, sr); S.sf1 = *(const f32x4*)(ROW(p, k0, sr) + 4);                \
                            S.sf2 = *(const f32x4*)ROW(p, k0, 32 + sr); S.sf3 = *(const f32x4*)(ROW(p, k0, 32 + sr) + 4); } while (0)
#define SWRITE_KF(bf) do { *(bf16x8*)(K_lds + (bf) * SHM_K + kws) = pack8(S.sf0, S.sf1); *(bf16x8*)(K_lds + (bf) * SHM_K + kws + 32 * 256) = pack8(S.sf2, S.sf3); } while (0)
#define SWRITE_VF(bf) do { *(bf16x8*)(V_lds + (bf) * SHM_V + vst0) = pack8(S.sf0, S.sf1); *(bf16x8*)(V_lds + (bf) * SHM_V + vst1) = pack8(S.sf2, S.sf3); } while (0)
template <class TIn, class TOut>
__device__ __forceinline__ void causal_swa_prime(const BlockRef<TIn, TOut>& cur, int W, char* lds, Seam<TIn>& S) {
    constexpr bool F32 = same_t<TIn, float>::v;
    const int tid = tid_opaque(), wid = __builtin_amdgcn_readfirstlane(tid >> 6), lane = tid & 63, r32 = lane & 31, hi = lane >> 5;
    const int sr = tid >> 4, sc = (tid & 15) * 8, kws = KSWZ(sr, sc * 2); char* K_lds = lds + 2 * SHM_V;
    const int kb0 = swa_jlo(cur.P0, W) * KVBLK;
    for (int d0 = 0; d0 < 8; ++d0) S.qr[d0] = load8<TIn>(cur.Q + (size_t)(wid * QBLK + r32) * D + d0 * 16 + hi * 8);
    if constexpr (F32) { SLOAD_F((const float*)cur.K, kb0); VMW(); SWRITE_KF(0); SBAR(); SLOAD_F((const float*)cur.V, kb0); }
    else { SLOAD_H(cur.K, cur.V, kb0); VMW(); SWRITE_HK(0); }
    __syncthreads();
}
template <class TIn, class TOut>
__device__ __forceinline__ void causal_swa_block(const BlockRef<TIn, TOut>& cur, const BlockRef<TIn, TOut>& nxt, int skv, int W, char* lds, Seam<TIn>& S) {
    constexpr bool F32 = same_t<TIn, float>::v;
    const int tid = tid_opaque(), wid = __builtin_amdgcn_readfirstlane(tid >> 6), lane = tid & 63, r32 = lane & 31, hi = lane >> 5;
    const int j_lo = swa_jlo(cur.P0, W);
    int j_hi = (cur.P0 + QB - 1) / KVBLK + 1; if (j_hi > skv / KVBLK) j_hi = skv / KVBLK;
    const int NT = j_hi - j_lo;
    const int kbn = swa_jlo(nxt.P0, W) * KVBLK;
    const int qlo = cur.P0 + wid * QBLK, qm = qlo + r32 - 4 * hi;
    char* V_lds = lds; char* K_lds = lds + 2 * SHM_V;
    float* ws = (float*)(lds + 2 * SHM_V + 2 * SHM_K) + wid * 64; float* li_l = ws, * al_l = ws + 32;
    float m_reg = -1e30f, l_reg = 0; f32x16 o[4] = {};
    const int sr = tid >> 4, sc = (tid & 15) * 8, vst0 = v_st(sr, sc), vst1 = v_st(32 + sr, sc), kws = KSWZ(sr, sc * 2);
    const int vb0 = (int)(uintptr_t)V_lds + v_rd_base(lane);
    const TIn* Kh = cur.K; const TIn* Vh = cur.V;
#define RESC(a) do { if (__any((a) < 1.f)) { if (hi == 0) al_l[r32] = (a); asm volatile("s_waitcnt lgkmcnt(0)" ::: "memory");              \
                     for (int d_ = 0; d_ < 4; ++d_) for (int r = 0; r < 16; ++r) o[d_][r] *= al_l[crow(r, hi)]; } } while (0)
#define KBASE(t) ((j_lo + (t)) * KVBLK)
#define ACT(t) (KBASE(t) <= qlo + QBLK - 1 && KBASE(t) + KVBLK - 1 >= qlo - W + 1)
#define MASKT(P0_, P1_, t) do { const int kb_ = KBASE(t); if ((!SK || ACT(t)) && (kb_ + KVBLK - 1 > qlo || kb_ <= qlo + QBLK - 1 - W)) mask_tile(P0_, P1_, qm - kb_, (unsigned)W); } while (0)
    constexpr int NQL = F32 ? 16 : 8;
    constexpr bool SK = WSKIP && !F32;
#define SEAM_K0() do { VMWN(NQL); if constexpr (F32) { SWRITE_KF(0); SBAR(); SLOAD_F((const float*)nxt.V, kbn); } else { SWRITE_HK(0); } SBAR(); } while (0)
    f32x16 pA0, pA1, pB0, pB1; float mnA, mnB, alA, alB; bf16x8 pa0, pa1, pa2, pa3;
    if constexpr (F32) { VMW(); SWRITE_VF(0); SBAR(); } else { SWRITE_HV(0); SBAR(); }
    if (NT > 1) { if constexpr (F32) SLOAD_F((const float*)Kh, KBASE(1)); else SLOAD_H(Kh, Vh, KBASE(1)); }
    SBAR(); qkt<0, SK>(pA0, pA1, K_lds, r32, hi, S.qr, ACT(0));
    if constexpr (F32) { if (NT > 1) { VMW(); SWRITE_KF(1); SBAR(); SLOAD_F((const float*)Vh, KBASE(1)); } }
    MASKT(pA0, pA1, 0); partialSM(pA0, pA1, m_reg, mnA, alA);
    if (NT > 1) { VMW(); if constexpr (F32) { SWRITE_VF(1); SBAR(); if (NT > 2) SLOAD_F((const float*)Kh, KBASE(2)); } else SWRITE_H(1); }
    __syncthreads();
#define HALF_STEP(PX0, PX1, mnX, alX, PY0, PY1, alY, t, KB, VB, SB) do {                                                      \
        SBAR(); qkt<KB, SK>(PX0, PX1, K_lds, r32, hi, S.qr, ACT(t));                                             \
        finishSM(PY0, PY1, alY, l_reg, pa0, pa1, pa2, pa3); SBAR();                                                           \
        if ((t) + 1 < NT) { if constexpr (F32) { VMW(); SWRITE_KF(SB); SBAR(); SLOAD_F((const float*)Vh, KBASE((t) + 1)); }  \
                            else { SLOAD_H(Kh, Vh, KBASE((t) + 1)); } SBAR(); }                                               \
        pv_tile<VB, SK>(o, vb0, pa0, pa1, pa2, pa3, ACT((t) - 1)); MASKT(PX0, PX1, (t)); partialSM(PX0, PX1, m_reg, mnX, alX);                                        \
        __syncthreads();                                                                                                      \
        if ((t) + 1 < NT) { VMW(); if constexpr (F32) { SWRITE_VF(SB); SBAR(); if ((t) + 2 < NT) SLOAD_F((const float*)Kh, KBASE((t) + 2)); } \
                            else { SWRITE_H(SB); } }                                                                          \
        RESC(alX); __syncthreads(); } while (0)
    for (int t = 1; t + 1 < NT; t += 2) {
        HALF_STEP(pB0, pB1, mnB, alB, pA0, pA1, alA, t, 1, 0, 0);
        HALF_STEP(pA0, pA1, mnA, alA, pB0, pB1, alB, t + 1, 0, 1, 1);
    }
    const bool even = (NT & 1) == 0;
    if (even) { SBAR(); qkt<1, SK>(pB0, pB1, K_lds, r32, hi, S.qr, ACT(NT - 1)); SBAR(); }
#define QROW(e) (nxt.Q + (size_t)(wid * QBLK + r32) * D + ((e) >> 1) * 16 + hi * 8 + ((e) & 1) * 4)
    if constexpr (F32) { SLOAD_F((const float*)nxt.K, kbn); SBAR();
#pragma unroll
        for (int e = 0; e < 8; ++e) S.tq[e] = *(const f32x4*)QROW(e); }
    else { SLOAD_H(nxt.K, nxt.V, kbn); SBAR();
#pragma unroll
        for (int d0 = 0; d0 < 8; ++d0) S.qr[d0] = load8<TIn>(nxt.Q + (size_t)(wid * QBLK + r32) * D + d0 * 16 + hi * 8); }
    SBAR();
    finishSM(pA0, pA1, alA, l_reg, pa0, pa1, pa2, pa3); SBAR();
    if constexpr (F32) {
#pragma unroll
        for (int e = 8; e < 16; ++e) S.tq[e] = *(const f32x4*)QROW(e); SBAR(); }
#undef QROW
    pv_tile<0, SK>(o, vb0, pa0, pa1, pa2, pa3, ACT(even ? NT - 2 : NT - 1));
    if (even) { MASKT(pB0, pB1, NT - 1); partialSM(pB0, pB1, m_reg, mnB, alB); __syncthreads(); RESC(alB);
        finishSM(pB0, pB1, alB, l_reg, pa0, pa1, pa2, pa3); SBAR(); pv_tile<1, SK>(o, vb0, pa0, pa1, pa2, pa3, ACT(NT - 1)); }
    SBAR(); SEAM_K0();
    if (hi == 0) li_l[r32] = l_reg; asm volatile("s_waitcnt lgkmcnt(0)" ::: "memory");
    float rli[16];
#pragma unroll
    for (int r = 0; r < 16; ++r) rli[r] = __builtin_amdgcn_rcpf(li_l[crow(r, hi)]);
    TOut* Ow = cur.O + (size_t)(wid * QBLK) * D;
#pragma unroll
    for (int r = 0; r < 16; ++r) { const int orow = crow(r, hi);
#pragma unroll
        for (int d0 = 0; d0 < 4; ++d0) { const float v = o[d0][r] * rli[r];
            if constexpr (same_t<TOut, float>::v) { Ow[(size_t)orow * D + d0 * 32 + r32] = v; }
            else { const float vn = __shfl_xor(v, 1);
                   if ((r32 & 1) == 0) *(unsigned*)(Ow + (size_t)orow * D + d0 * 32 + r32) = cvtpk(v, vn); } } }
    if constexpr (F32) {
#pragma unroll
        for (int d0 = 0; d0 < 8; ++d0) S.qr[d0] = pack8(S.tq[2 * d0], S.tq[2 * d0 + 1]); }
    __syncthreads();
#undef RESC
#undef KBASE
#undef ACT
#undef MASKT
#undef SEAM_K0
#undef HALF_STEP
}
#undef ROW
#undef VMW
#undef VMWN
#undef SLOAD_H
#undef SWRITE_HK
#undef SWRITE_HV
#undef SWRITE_H
#undef SLOAD_F
#undef SWRITE_KF
#undef SWRITE_VF

}

#define XB_TMO      128
#define XB_XCNT(j)  (256  + 64 * (j))
#define XB_XSUB(j)  (1280 + 64 * (j))
#define XB_XGEN(j)  (2304 + 64 * (j))
#define XB_TOP      3328
#define XB_TOPGEN   3392
#define XCD_BAR_WORDS 3456
#define XB_SPIN_CAP (1u << 18)
#define LAS __attribute__((address_space(3)))

__device__ __forceinline__ unsigned xb_ld(unsigned* p)              { return __hip_atomic_load(p, __ATOMIC_RELAXED, __HIP_MEMORY_SCOPE_AGENT); }
__device__ __forceinline__ unsigned xb_add(unsigned* p, unsigned v) { return __hip_atomic_fetch_add(p, v, __ATOMIC_RELAXED, __HIP_MEMORY_SCOPE_AGENT); }
__device__ __forceinline__ unsigned xb_xcc_id() { return (unsigned)__builtin_amdgcn_s_getreg((3 << 11) | 20) & 0xFu; }
#define XB_SPIN(cond, bar) do { unsigned _sp = 0; while (cond) { __builtin_amdgcn_s_sleep(1); \
    if ((++_sp & 255u) == 0u) { if (xb_ld(&(bar)[XB_TMO])) break; if (_sp > XB_SPIN_CAP) { atomicAdd(&(bar)[XB_TMO], 1u); break; } } } } while (0)

struct XcdBarrier {
    unsigned* bar; unsigned x;
    volatile LAS unsigned* st;
};

__device__ __forceinline__ XcdBarrier xcd_barrier_post(unsigned* bar, volatile LAS unsigned* st) {
    XcdBarrier b; b.bar = bar; b.x = xb_xcc_id(); b.st = st;
    if (threadIdx.x == 0) (void)xb_add(&bar[XB_XCNT(b.x)], 1u);
    return b;
}
__device__ __forceinline__ void xcd_barrier_complete(unsigned* bar, unsigned x, unsigned& nloc, unsigned& nx) {
    const unsigned G = gridDim.x * gridDim.y * gridDim.z;
    unsigned sum, cnt, mine, sp = 0u;
    for (;;) {
        sum = 0u; cnt = 0u; mine = 0u;
#pragma unroll
        for (unsigned j = 0; j < 16; ++j) { const unsigned c = xb_ld(&bar[XB_XCNT(j)]); sum += c; cnt += (c > 0u) ? 1u : 0u; mine = (j == x) ? c : mine; }
        if (sum == G) break;
        __builtin_amdgcn_s_sleep(1);
        if ((++sp & 255u) == 0u) { if (xb_ld(&bar[XB_TMO])) break; if (sp > XB_SPIN_CAP) { atomicAdd(&bar[XB_TMO], 1u); break; } }
    }
    nloc = mine > 0u ? mine : 1u; nx = cnt > 0u ? cnt : 1u;
}

__device__ __forceinline__ void xcd_barrier(const XcdBarrier& b) {
    asm volatile("s_waitcnt vmcnt(0)" ::: "memory");
    __syncthreads();
    if (threadIdx.x == 0) {
        unsigned* bar = b.bar;
        __builtin_amdgcn_s_waitcnt(0);
        unsigned nloc = b.st[0], nx = b.st[1];
        if (nloc == 0u) { xcd_barrier_complete(bar, b.x, nloc, nx); b.st[0] = nloc; b.st[1] = nx; }
        const unsigned old = xb_add(&bar[XB_XSUB(b.x)], 1u);
        const unsigned gen = old / nloc;
        if (old + 1u == (gen + 1u) * nloc) {
            __builtin_amdgcn_fence(__ATOMIC_RELEASE, "agent");
            asm volatile("s_waitcnt vmcnt(0)" ::: "memory");
            const unsigned og = xb_add(&bar[XB_TOP], 1u);
            const unsigned tg = og / nx;
            if (og + 1u == (tg + 1u) * nx) xb_add(&bar[XB_TOPGEN], 1u);
            else XB_SPIN(xb_ld(&bar[XB_TOPGEN]) == tg, bar);
            __builtin_amdgcn_fence(__ATOMIC_ACQUIRE, "agent");
            xb_add(&bar[XB_XGEN(b.x)], 1u);
            asm volatile("s_waitcnt vmcnt(0)" ::: "memory");
        } else {
            XB_SPIN(xb_ld(&bar[XB_XGEN(b.x)]) == gen, bar);
            __builtin_amdgcn_fence(__ATOMIC_ACQUIRE, "agent");
            asm volatile("s_waitcnt vmcnt(0)" ::: "memory");
        }
    }
    __syncthreads();
}

constexpr int D_MODEL = 4096, BATCH = 4, SEQ = 4096, DEPTH = 2, M_TOK = BATCH * SEQ;
constexpr int IN_WIDTH = 12288, D_FF = 16384, LRU_W = 1024, HG_W = 1024, DIFF_W = 2048;
constexpr int OFF_A_GATE = 0, OFF_A_X = 1024, OFF_B_Q = 2048, OFF_B_F = 3072, OFF_B_I = 4096, OFF_B_G = 5120, OFF_C_Q = 6144, OFF_C_K = 8192, OFF_C_V = 10240;
constexpr float NORM_EPS = 1e-6f;
constexpr int NWAVES = 8, NTHREADS = NWAVES * 64;
constexpr int N_INPUTS = 21;
enum { I_X = 0, I_LN1, I_WIN, I_CONVW, I_CONVB, I_WR, I_BR, I_WI, I_BI, I_LAM, I_LRUG, I_HLB, I_HNG, I_QNG, I_KNG, I_DLAM, I_SUBLN, I_WOUT, I_LN2, I_WFF1, I_WFF2 };

constexpr size_t MiB = (size_t)1 << 20;
constexpr size_t WS_CTL = 0, CTL_ZERO_BYTES = 1 * MiB;
constexpr size_t WS_LB = 1 * MiB;
constexpr size_t WS_ROPE = 2 * MiB;
constexpr size_t WS_WGATE = 4 * MiB;
constexpr size_t WS_WIN = 16 * MiB;
constexpr size_t WS_WOUT = 208 * MiB;
constexpr size_t WS_WFF1 = 272 * MiB;
constexpr size_t WS_WFF2 = 528 * MiB;
constexpr size_t WS_H = 784 * MiB;
constexpr size_t WS_YCAT = 912 * MiB;
constexpr size_t WS_Z = 1040 * MiB;
constexpr size_t WS_XA = 1424 * MiB;
constexpr size_t WS_RI = 1456 * MiB;
constexpr size_t WS_QT = 1520 * MiB;
constexpr size_t WS_KK = 1552 * MiB;
constexpr size_t WS_QH = 1584 * MiB, WS_KH = 1648 * MiB, WS_VH = 1712 * MiB;
constexpr size_t WS_OATT = 1776 * MiB;
constexpr size_t WS_YAPRE = 1904 * MiB;
constexpr size_t WS_OBPRE = 1968 * MiB;
constexpr size_t WS_LSUM = 2032 * MiB;
constexpr size_t WS_HID = 1040 * MiB;
constexpr size_t WS_END = 2034 * MiB;
constexpr int CW_BAR = 4096;

constexpr int RING_BYTES = 131072, MISC_OFF = RING_BYTES + 320, LDS_BYTES = 147456;

#define GAS __attribute__((address_space(1)))
typedef unsigned short bf16r;
typedef unsigned v4u __attribute__((ext_vector_type(4)));
typedef unsigned v2u __attribute__((ext_vector_type(2)));
typedef float f32x4 __attribute__((ext_vector_type(4)));
typedef float f32x2 __attribute__((ext_vector_type(2)));
#define LDS_WAIT() asm volatile("s_waitcnt lgkmcnt(0)" ::: "memory")
__device__ __forceinline__ float bflo(unsigned w) { return __uint_as_float(w << 16); }
__device__ __forceinline__ float bfhi(unsigned w) { return __uint_as_float(w & 0xffff0000u); }
__device__ __forceinline__ float bf1(bf16r b) { return __uint_as_float((unsigned)b << 16); }
__device__ __forceinline__ unsigned pk2(float lo, float hi) { return pk_bf16_builtin(lo, hi); }
__device__ __forceinline__ float wave_sum(float v) {
#pragma unroll
    for (int o = 1; o < 64; o <<= 1) v += __shfl_xor(v, o);
    return v;
}
__device__ __forceinline__ float fast_exp(float x) { return __builtin_amdgcn_exp2f(x * 1.4426950408889634f); }
__device__ __forceinline__ float sigmoidf_(float x) { return __builtin_amdgcn_rcpf(1.0f + fast_exp(-x)); }

__device__ __forceinline__ void p0_transpose_item(const float* W, int K, int N, bf16r* WT, LAS float* scr, int item, int lane) {
    const int nblk = N / 32, kb = item / nblk, nb = item % nblk, k0 = 64 * kb, n0 = 32 * nb;
#pragma unroll 8
    for (int i = 0; i < 32; ++i) { const int kk = 2 * i + (lane >> 5); scr[kk * 33 + (lane & 31)] = W[(size_t)(k0 + kk) * N + n0 + (lane & 31)]; }
    LDS_WAIT(); asm volatile("" ::: "memory");
    const int c = lane & 7;
#pragma unroll
    for (int j = 0; j < 4; ++j) { const int n = (lane >> 3) + 8 * j; const LAS float* s = scr + (8 * c) * 33 + n;
        v4u o; o.x = pk2(s[0 * 33], s[1 * 33]); o.y = pk2(s[2 * 33], s[3 * 33]); o.z = pk2(s[4 * 33], s[5 * 33]); o.w = pk2(s[6 * 33], s[7 * 33]);
        *(v4u*)(WT + (size_t)(n0 + n) * K + k0 + 8 * c) = o; }
    LDS_WAIT(); asm volatile("" ::: "memory");
}

struct Args { const float* in[N_INPUTS]; float* out; unsigned char* ws; int ph_lo, ph_hi; };

constexpr int PH_PER_LAYER = 13, N_PHASES = 1 + DEPTH * PH_PER_LAYER;

__device__ __forceinline__ float neg_expm1(float x) {
    if (x > -0.3f) { float p = 1.0f + x * (1.0f / 7.0f); p = 1.0f + x * (1.0f / 6.0f) * p; p = 1.0f + x * 0.2f * p; p = 1.0f + x * 0.25f * p; p = 1.0f + x * (1.0f / 3.0f) * p; p = 1.0f + x * 0.5f * p; return -x * p; }
    return 1.0f - fast_exp(x);
}
__device__ __forceinline__ void lru_step(float r, float ig, float x, float sp8, bool first, float& h, float& A) {
    const float la = -r * sp8; const float a = fast_exp(la);
    const float mult = first ? 1.0f : sqrtf(neg_expm1(2.0f * la));
    h = a * h + mult * (ig * x); A += la;
}
__device__ __forceinline__ float gelu_tanh(float x) { const float y = 1.5957691216057308f * (x + 0.044715f * x * x * x); return x * __builtin_amdgcn_rcpf(1.0f + fast_exp(-y)); }

typedef const __attribute__((address_space(4))) unsigned char* kargp_t;
__device__ __forceinline__ kargp_t karg_base() { kargp_t kp = (kargp_t)__builtin_amdgcn_kernarg_segment_ptr(); asm volatile("" : "+s"(kp)); return kp; }
__device__ __forceinline__ const float* karg_in(int i) { return *(const float* const __attribute__((address_space(4)))*)(karg_base() + 8 * i); }
__device__ __forceinline__ float* karg_out() { return *(float* const __attribute__((address_space(4)))*)(karg_base() + 8 * N_INPUTS); }
__device__ __forceinline__ unsigned char* karg_ws() { return *(unsigned char* const __attribute__((address_space(4)))*)(karg_base() + 8 * N_INPUTS + 8); }
__device__ __forceinline__ int karg_int(int i) { return *(const int __attribute__((address_space(4)))*)(karg_base() + 8 * N_INPUTS + 16 + 4 * i); }
#define WSP(T, off) ((T*)(karg_ws() + (off)))
#define PHASE_IDS const int tid = tid_opaque(), lane = tid & 63, wave = __builtin_amdgcn_readfirstlane(tid >> 6), gw = vcu * NWAVES + wave; (void)tid; (void)lane; (void)wave; (void)gw

__device__ __forceinline__ ab::BlockRef<__hip_bfloat16, __hip_bfloat16> attn_ref(const __hip_bfloat16* Qp, const __hip_bfloat16* Kp, const __hip_bfloat16* Vp, __hip_bfloat16* Op, int L, int pass) {
    const int bh = L >> 3, x = L & 7, qb = pass ? 15 - x : x;
    const int b = bh >> 5, hq = bh & 31, h = hq >> 2, c = (hq >> 1) & 1, vh = hq & 1;
    ab::BlockRef<__hip_bfloat16, __hip_bfloat16> r;
    r.Q = Qp + ((size_t)(b * 16 + h * 2 + c) * SEQ + (size_t)qb * 256) * 128;
    r.K = Kp + (size_t)(b * 16 + h * 2 + c) * SEQ * 128;
    r.V = Vp + (size_t)(b * 16 + h * 2 + vh) * SEQ * 128;
    r.O = Op + ((size_t)(b * 32 + hq) * SEQ + (size_t)qb * 256) * 128;
    r.P0 = qb * 256;
    return r;
}

__global__ void __launch_bounds__(NTHREADS, 2) hymba_fwd(Args args) {
    extern __shared__ __attribute__((aligned(16))) unsigned char lds[];
    LAS unsigned char* ldsl = (LAS unsigned char*)lds;
    const int G = gridDim.x;
    const int bx = blockIdx.x;
    const int vcu = (G % 8 == 0) ? (bx % 8) * (G / 8) + bx / 8 : bx;
    const int ngw = G * NWAVES;
    volatile LAS unsigned* MISC = (volatile LAS unsigned*)(ldsl + MISC_OFF);
    for (int u = threadIdx.x; u < (LDS_BYTES - RING_BYTES) / 4; u += NTHREADS) ((LAS unsigned*)(ldsl + RING_BYTES))[u] = 0u;
    __syncthreads();
    const int lo = karg_int(0), hi = karg_int(1);
    const bool multi = (hi - lo) > 1;
    XcdBarrier bar; bar.bar = WSP(unsigned, WS_CTL) + CW_BAR; bar.x = 0; bar.st = nullptr;
    if (multi) bar = xcd_barrier_post(WSP(unsigned, WS_CTL) + CW_BAR, MISC + 8);
#ifndef EN_MASK
#define EN_MASK 0xFFFF
#endif
#define ENK(j) (((EN_MASK) >> (j)) & 1)
#define IN(k) (lo <= (k) && (k) < hi)
#define SEAM(k) do { if (IN((k) + 1)) xcd_barrier(bar); } while (0)

    if (ENK(15) && IN(0)) {
        PHASE_IDS;
        bf16r* const W_IN = WSP(bf16r, WS_WIN);
        bf16r* const W_OUT = WSP(bf16r, WS_WOUT);
        bf16r* const W_FF1 = WSP(bf16r, WS_WFF1);
        bf16r* const W_FF2 = WSP(bf16r, WS_WFF2);
        bf16r* const W_GATE = WSP(bf16r, WS_WGATE);
        float* const LB = WSP(float, WS_LB);
        float* const ROPE_COS = WSP(float, WS_ROPE); float* const ROPE_SIN = ROPE_COS + SEQ * 64;
        LAS float* scr = (LAS float*)(ldsl + wave * 16384);
        constexpr int I_IN = (D_MODEL / 64) * (IN_WIDTH / 32), I_OUT = (D_MODEL / 64) * (D_MODEL / 32), I_F1 = (D_MODEL / 64) * (D_FF / 32), I_F2 = (D_FF / 64) * (D_MODEL / 32);
        constexpr int I_LAYER = I_IN + I_OUT + I_F1 + I_F2;
        for (int it = gw; it < DEPTH * I_LAYER; it += ngw) {
            const int l = it / I_LAYER; int r = it - l * I_LAYER;
            if (r < I_IN) { p0_transpose_item(karg_in(I_WIN) + (size_t)l * D_MODEL * IN_WIDTH, D_MODEL, IN_WIDTH, W_IN + (size_t)l * IN_WIDTH * D_MODEL, scr, r, lane); continue; } r -= I_IN;
            if (r < I_OUT) { p0_transpose_item(karg_in(I_WOUT) + (size_t)l * D_MODEL * D_MODEL, D_MODEL, D_MODEL, W_OUT + (size_t)l * D_MODEL * D_MODEL, scr, r, lane); continue; } r -= I_OUT;
            if (r < I_F1) { p0_transpose_item(karg_in(I_WFF1) + (size_t)l * D_MODEL * D_FF, D_MODEL, D_FF, W_FF1 + (size_t)l * D_FF * D_MODEL, scr, r, lane); continue; } r -= I_F1;
            p0_transpose_item(karg_in(I_WFF2) + (size_t)l * D_FF * D_MODEL, D_FF, D_MODEL, W_FF2 + (size_t)l * D_MODEL * D_FF, scr, r, lane);
        }
        for (int idx = gw * 64 + lane; idx < DEPTH * 2048 * 128; idx += ngw * 64) {
            const int l = idx / (2048 * 128), n = (idx / 128) % 2048, k0 = (idx % 128) * 8;
            const int g = n >> 10, nn = n & 1023, h = nn >> 7, j = nn & 127;
            v4u o = {0u, 0u, 0u, 0u};
            if ((k0 >> 7) == h) { const float* w = karg_in(g ? I_WI : I_WR) + (((size_t)l * 8 + h) * 128 + (k0 & 127)) * 128 + j;
                o.x = pk2(w[0 * 128], w[1 * 128]); o.y = pk2(w[2 * 128], w[3 * 128]); o.z = pk2(w[4 * 128], w[5 * 128]); o.w = pk2(w[6 * 128], w[7 * 128]); }
            *(v4u*)(W_GATE + ((size_t)l * 2048 + n) * 1024 + k0) = o;
        }
        for (int c = gw * 64 + lane; c < HG_W; c += ngw * 64) {
            const float b0 = karg_in(I_HLB)[c], b1 = karg_in(I_HLB)[HG_W + c]; const float mx = fmaxf(b0, b1);
            const float e0 = __expf(b0 - mx), e1 = __expf(b1 - mx);
            LB[c] = 0.f; LB[HG_W + c] = e1 / (e0 + e1);
        }
        for (int idx = gw * 64 + lane; idx < SEQ * 64; idx += ngw * 64) {
            const int t = idx >> 6, j = idx & 63;
            const float inv = exp2f(-(float)(2 * j) * (1.0f / 128.0f) * 13.287712379549449f);
            const float angf = (float)t * inv;
            double rev = (double)angf * 0.15915494309189535; rev -= floor(rev);
            const float rf = (float)rev;
            ROPE_COS[idx] = __builtin_amdgcn_cosf(rf); ROPE_SIN[idx] = __builtin_amdgcn_sinf(rf);
        }
        SEAM(0);
    }

#pragma unroll 1
    for (int l = 0; l < DEPTH; ++l) {
        const int pb = 1 + l * PH_PER_LAYER;

        if (ENK(0) && IN(pb + 0)) {
            PHASE_IDS;
            const float* const xin = (l == 0) ? karg_in(I_X) : (const float*)karg_out();
            bf16r* const HB = WSP(bf16r, WS_H);
            const float* gain = karg_in(I_LN1) + l * D_MODEL;
            for (int m = gw; m < M_TOK; m += ngw) {
                const f32x4* xr = (const f32x4*)(xin + (size_t)m * D_MODEL) + lane;
                f32x4 v[16]; float ss = 0.f;
#pragma unroll
                for (int j = 0; j < 16; ++j) { v[j] = xr[64 * j]; ss += (v[j].x * v[j].x + v[j].y * v[j].y) + (v[j].z * v[j].z + v[j].w * v[j].w); }
                ss = wave_sum(ss);
                const float rs = 1.0f / sqrtf(ss * (1.0f / D_MODEL) + NORM_EPS);
                const f32x4* gr = (const f32x4*)gain + lane; v2u* o = (v2u*)(HB + (size_t)m * D_MODEL) + lane;
#pragma unroll
                for (int j = 0; j < 16; ++j) { const f32x4 g = gr[64 * j]; v2u w; w.x = pk2(v[j].x * rs * g.x, v[j].y * rs * g.y); w.y = pk2(v[j].z * rs * g.z, v[j].w * rs * g.w); o[64 * j] = w; }
            }
            SEAM(pb + 0);
        }

        if (ENK(1) && IN(pb + 1)) {
            PHASE_IDS;
            bf16r* const HB = WSP(bf16r, WS_H);
            bf16r* const W_IN = WSP(bf16r, WS_WIN);
            bf16r* const Z = WSP(bf16r, WS_Z);
            pg8::Gemm g{HB, W_IN + (size_t)l * IN_WIDTH * D_MODEL, M_TOK, IN_WIDTH, D_MODEL}; pg8::StaticOrder S; S.init(M_TOK, IN_WIDTH, G, bx);
            pg8::EpiBf16X<0> E{Z, IN_WIDTH, nullptr, nullptr, 0};
            pg8::gemm_phase<pg8::EpiBf16X<0>, pg8::StaticOrder, true, true>(ldsl, g, S, E);
            SEAM(pb + 1);
        }

        if (ENK(2) && IN(pb + 2)) {
            PHASE_IDS;
            bf16r* const Z = WSP(bf16r, WS_Z);
            bf16r* const XA = WSP(bf16r, WS_XA);
            bf16r* const QT = WSP(bf16r, WS_QT);
            bf16r* const KK = WSP(bf16r, WS_KK);
            bf16r* const QH = WSP(bf16r, WS_QH);
            bf16r* const KH = WSP(bf16r, WS_KH);
            bf16r* const VH = WSP(bf16r, WS_VH);
            float* const LB = WSP(float, WS_LB);
            float* const ROPE_COS = WSP(float, WS_ROPE); float* const ROPE_SIN = ROPE_COS + SEQ * 64;
            const float* convw = karg_in(I_CONVW) + l * 4 * LRU_W; const float* convb = karg_in(I_CONVB) + l * LRU_W;
            const float* lbl = LB + l * HG_W;
            const float* qg = karg_in(I_QNG) + l * 128; const float* kg = karg_in(I_KNG) + l * 128;
            for (int m = gw; m < M_TOK; m += ngw) {
                const int t = m & (SEQ - 1), b = m >> 12;
                const bf16r* zr = Z + (size_t)m * IN_WIDTH;
#pragma unroll
                for (int it = 0; it < 2; ++it) {
                    const int c0 = it * 512 + lane * 8;
                    const f32x4 b0 = *(const f32x4*)(convb + c0), b1 = *(const f32x4*)(convb + c0 + 4);
                    float a0 = b0.x, a1 = b0.y, a2 = b0.z, a3 = b0.w, a4 = b1.x, a5 = b1.y, a6 = b1.z, a7 = b1.w;
#pragma unroll
                    for (int j = 0; j < 4; ++j) {
                        if (t - 3 + j >= 0) {
                            const v4u xv = *(const v4u*)(zr - (ptrdiff_t)(3 - j) * IN_WIDTH + OFF_A_X + c0);
                            const f32x4 w0 = *(const f32x4*)(convw + j * LRU_W + c0), w1 = *(const f32x4*)(convw + j * LRU_W + c0 + 4);
                            a0 += bflo(xv.x) * w0.x; a1 += bfhi(xv.x) * w0.y; a2 += bflo(xv.y) * w0.z; a3 += bfhi(xv.y) * w0.w;
                            a4 += bflo(xv.z) * w1.x; a5 += bfhi(xv.z) * w1.y; a6 += bflo(xv.w) * w1.z; a7 += bfhi(xv.w) * w1.w;
                        }
                    }
                    v4u o; o.x = pk2(a0, a1); o.y = pk2(a2, a3); o.z = pk2(a4, a5); o.w = pk2(a6, a7);
                    *(v4u*)(XA + (size_t)m * LRU_W + c0) = o;
                }
#pragma unroll
                for (int it = 0; it < 2; ++it) {
                    const int c0 = it * 512 + lane * 8;
                    const v4u qv = *(const v4u*)(zr + OFF_B_Q + c0), fv = *(const v4u*)(zr + OFF_B_F + c0);
                    const f32x4 l0 = *(const f32x4*)(lbl + c0), l1 = *(const f32x4*)(lbl + c0 + 4);
                    const float qs = 0.08838834764831845f;
#define SILU(x) ((x) * sigmoidf_(x) * qs)
#define KF(x, lbv) ((1.0f - (lbv)) * __builtin_amdgcn_rcpf(1.0f + fast_exp(x)))
                    v4u oq, ok;
                    oq.x = pk2(SILU(bflo(qv.x)), SILU(bfhi(qv.x))); oq.y = pk2(SILU(bflo(qv.y)), SILU(bfhi(qv.y))); oq.z = pk2(SILU(bflo(qv.z)), SILU(bfhi(qv.z))); oq.w = pk2(SILU(bflo(qv.w)), SILU(bfhi(qv.w)));
                    ok.x = pk2(KF(bflo(fv.x), l0.x), KF(bfhi(fv.x), l0.y)); ok.y = pk2(KF(bflo(fv.y), l0.z), KF(bfhi(fv.y), l0.w)); ok.z = pk2(KF(bflo(fv.z), l1.x), KF(bfhi(fv.z), l1.y)); ok.w = pk2(KF(bflo(fv.w), l1.z), KF(bfhi(fv.w), l1.w));
#undef SILU
#undef KF
                    *(v4u*)(QT + (size_t)m * HG_W + c0) = oq; *(v4u*)(KK + (size_t)m * HG_W + c0) = ok;
                }
#pragma unroll
                for (int it = 0; it < 4; ++it) {
                    const int isk = it >> 1, vi = (it & 1) * 8 + (lane >> 3), sub = lane & 7;
                    const bf16r* src = zr + (isk ? OFF_C_K : OFF_C_Q) + vi * 128 + sub * 8;
                    const v4u av = *(const v4u*)src, cv = *(const v4u*)(src + 64);
                    float x1[8] = {bflo(av.x), bfhi(av.x), bflo(av.y), bfhi(av.y), bflo(av.z), bfhi(av.z), bflo(av.w), bfhi(av.w)};
                    float x2[8] = {bflo(cv.x), bfhi(cv.x), bflo(cv.y), bfhi(cv.y), bflo(cv.z), bfhi(cv.z), bflo(cv.w), bfhi(cv.w)};
                    float ss = 0.f;
#pragma unroll
                    for (int e = 0; e < 8; ++e) ss += x1[e] * x1[e] + x2[e] * x2[e];
                    ss += __shfl_xor(ss, 1); ss += __shfl_xor(ss, 2); ss += __shfl_xor(ss, 4);
                    const float rs = 1.0f / sqrtf(ss * (1.0f / 128.0f) + NORM_EPS);
                    const float* gp = (isk ? kg : qg) + sub * 8;
                    const f32x4 g1a = *(const f32x4*)gp, g1b = *(const f32x4*)(gp + 4), g2a = *(const f32x4*)(gp + 64), g2b = *(const f32x4*)(gp + 68);
                    const f32x4 ca = *(const f32x4*)(ROPE_COS + t * 64 + sub * 8), cb = *(const f32x4*)(ROPE_COS + t * 64 + sub * 8 + 4);
                    const f32x4 sa = *(const f32x4*)(ROPE_SIN + t * 64 + sub * 8), sb = *(const f32x4*)(ROPE_SIN + t * 64 + sub * 8 + 4);
                    const float g1[8] = {g1a.x, g1a.y, g1a.z, g1a.w, g1b.x, g1b.y, g1b.z, g1b.w}, g2[8] = {g2a.x, g2a.y, g2a.z, g2a.w, g2b.x, g2b.y, g2b.z, g2b.w};
                    const float cc[8] = {ca.x, ca.y, ca.z, ca.w, cb.x, cb.y, cb.z, cb.w}, sn[8] = {sa.x, sa.y, sa.z, sa.w, sb.x, sb.y, sb.z, sb.w};
                    float o1[8], o2[8];
#pragma unroll
                    for (int e = 0; e < 8; ++e) { const float y1 = x1[e] * rs * g1[e], y2 = x2[e] * rs * g2[e]; o1[e] = y1 * cc[e] - y2 * sn[e]; o2[e] = y2 * cc[e] + y1 * sn[e]; }
                    bf16r* dst = (isk ? KH : QH) + ((size_t)(b * 16 + vi) * SEQ + t) * 128 + sub * 8;
                    v4u w1, w2; w1.x = pk2(o1[0], o1[1]); w1.y = pk2(o1[2], o1[3]); w1.z = pk2(o1[4], o1[5]); w1.w = pk2(o1[6], o1[7]);
                    w2.x = pk2(o2[0], o2[1]); w2.y = pk2(o2[2], o2[3]); w2.z = pk2(o2[4], o2[5]); w2.w = pk2(o2[6], o2[7]);
                    *(v4u*)dst = w1; *(v4u*)(dst + 64) = w2;
                }
#pragma unroll
                for (int it = 0; it < 4; ++it) {
                    const int e = it * 512 + lane * 8, vi = e >> 7, d = e & 127;
                    *(v4u*)(VH + ((size_t)(b * 16 + vi) * SEQ + t) * 128 + d) = *(const v4u*)(zr + OFF_C_V + e);
                }
            }
            SEAM(pb + 2);
        }

        if (ENK(3) && IN(pb + 3)) {
            PHASE_IDS;
            bf16r* const XA = WSP(bf16r, WS_XA);
            bf16r* const W_GATE = WSP(bf16r, WS_WGATE);
            bf16r* const RI = WSP(bf16r, WS_RI);
            pg8::Gemm g{XA, W_GATE + (size_t)l * 2048 * 1024, M_TOK, 2048, 1024}; pg8::StaticOrder S; S.init(M_TOK, 2048, G, bx);
            pg8::EpiBf16X<1> E{RI, 2048, karg_in(I_BR) + l * LRU_W, karg_in(I_BI) + l * LRU_W, 1024};
            pg8::gemm_phase<pg8::EpiBf16X<1>, pg8::StaticOrder, true, true>(ldsl, g, S, E);
            SEAM(pb + 3);
        }

        if ((ENK(4) || ENK(5)) && (IN(pb + 4) || IN(pb + 5))) {
            PHASE_IDS;
            bf16r* const XA = WSP(bf16r, WS_XA);
            bf16r* const RI = WSP(bf16r, WS_RI);
            float* const LSUM = WSP(float, WS_LSUM);
            bf16r* const Z = WSP(bf16r, WS_Z);
            float* const YAPRE = WSP(float, WS_YAPRE);
            const float* lam = karg_in(I_LAM) + l * LRU_W;
            const int c = tid * 2;
            const float sp0 = 8.0f * log1pf(__expf(-lam[c])), sp1 = 8.0f * log1pf(__expf(-lam[c + 1]));
            if (ENK(4) && IN(pb + 4)) {
                for (int u = bx; u < BATCH * 64; u += G) {
                    const int b = u >> 6, s = u & 63;
                    float h0 = 0.f, h1 = 0.f, A0 = 0.f, A1 = 0.f;
#pragma unroll 4
                    for (int t = 0; t < 64; ++t) {
                        const size_t m = (size_t)b * SEQ + s * 64 + t;
                        const unsigned rr = *(const unsigned*)(RI + m * 2048 + c), ii = *(const unsigned*)(RI + m * 2048 + 1024 + c), xx = *(const unsigned*)(XA + m * LRU_W + c);
                        const bool first = (s == 0 && t == 0);
                        lru_step(bflo(rr), bflo(ii), bflo(xx), sp0, first, h0, A0);
                        lru_step(bfhi(rr), bfhi(ii), bfhi(xx), sp1, first, h1, A1);
                    }
                    *(f32x4*)(LSUM + ((size_t)u * LRU_W + c) * 2) = (f32x4){A0, h0, A1, h1};
                }
                SEAM(pb + 4);
            }
            if (ENK(5) && IN(pb + 5)) {
                for (int u = bx; u < BATCH * 64; u += G) {
                    const int b = u >> 6, s = u & 63;
                    float h0 = 0.f, h1 = 0.f, A0 = 0.f, A1 = 0.f;
                    for (int sp = 0; sp < s; ++sp) {
                        const f32x4 v = *(const f32x4*)(LSUM + ((size_t)(b * 64 + sp) * LRU_W + c) * 2);
                        h0 = fast_exp(v.x) * h0 + v.y; h1 = fast_exp(v.z) * h1 + v.w;
                    }
#pragma unroll 4
                    for (int t = 0; t < 64; ++t) {
                        const size_t m = (size_t)b * SEQ + s * 64 + t;
                        const unsigned rr = *(const unsigned*)(RI + m * 2048 + c), ii = *(const unsigned*)(RI + m * 2048 + 1024 + c), xx = *(const unsigned*)(XA + m * LRU_W + c);
                        const unsigned gg = *(const unsigned*)(Z + m * IN_WIDTH + OFF_A_GATE + c);
                        const bool first = (s == 0 && t == 0);
                        lru_step(bflo(rr), bflo(ii), bflo(xx), sp0, first, h0, A0);
                        lru_step(bfhi(rr), bfhi(ii), bfhi(xx), sp1, first, h1, A1);
                        *(f32x2*)(YAPRE + m * LRU_W + c) = (f32x2){h0 * gelu_tanh(bflo(gg)), h1 * gelu_tanh(bfhi(gg))};
                    }
                }
                SEAM(pb + 5);
            }
        }

        if (ENK(6) && IN(pb + 6)) {
            PHASE_IDS;
            bf16r* const QT = WSP(bf16r, WS_QT);
            bf16r* const KK = WSP(bf16r, WS_KK);
            bf16r* const Z = WSP(bf16r, WS_Z);
            float* const OBPRE = WSP(float, WS_OBPRE);
            if (wave < 4) {
                for (int wg = vcu * 4 + wave; wg < BATCH * 8 * 32; wg += G * 4) {
                    const int bh = wg >> 5, vgrp = wg & 31, b = bh >> 3, h = bh & 7;
                    const int dg = lane & 15, v = vgrp * 4 + (lane >> 4);
                    float S0 = 0.f, S1 = 0.f, S2 = 0.f, S3 = 0.f, S4 = 0.f, S5 = 0.f, S6 = 0.f, S7 = 0.f;
                    const bf16r* qp = QT + (size_t)b * SEQ * HG_W + h * 128 + dg * 8;
                    const bf16r* kp = KK + (size_t)b * SEQ * HG_W + h * 128 + dg * 8;
                    const bf16r* vp = Z + (size_t)b * SEQ * IN_WIDTH + OFF_B_I + h * 128 + v;
                    float* op = OBPRE + ((size_t)wg * SEQ) * 4 + (lane >> 4);
#pragma unroll 4
                    for (int t = 0; t < SEQ; ++t) {
                        const v4u q = *(const v4u*)(qp + (size_t)t * HG_W), k = *(const v4u*)(kp + (size_t)t * HG_W);
                        const float vv = bf1(vp[(size_t)t * IN_WIDTH]);
                        float acc;
                        S0 += bflo(k.x) * (vv - S0); acc = S0 * bflo(q.x);
                        S1 += bfhi(k.x) * (vv - S1); acc += S1 * bfhi(q.x);
                        S2 += bflo(k.y) * (vv - S2); acc += S2 * bflo(q.y);
                        S3 += bfhi(k.y) * (vv - S3); acc += S3 * bfhi(q.y);
                        S4 += bflo(k.z) * (vv - S4); acc += S4 * bflo(q.z);
                        S5 += bfhi(k.z) * (vv - S5); acc += S5 * bfhi(q.z);
                        S6 += bflo(k.w) * (vv - S6); acc += S6 * bflo(q.w);
                        S7 += bfhi(k.w) * (vv - S7); acc += S7 * bfhi(q.w);
                        acc += __shfl_xor(acc, 1); acc += __shfl_xor(acc, 2); acc += __shfl_xor(acc, 4); acc += __shfl_xor(acc, 8);
                        if (dg == 0) op[(size_t)t * 4] = acc;
                    }
                }
            }
            SEAM(pb + 6);
        }

        if (ENK(7) && IN(pb + 7)) {
            PHASE_IDS;
            bf16r* const QH = WSP(bf16r, WS_QH);
            bf16r* const KH = WSP(bf16r, WS_KH);
            bf16r* const VH = WSP(bf16r, WS_VH);
            bf16r* const OATT = WSP(bf16r, WS_OATT);
            typedef __hip_bfloat16 abf;
            const abf* Qp = (const abf*)QH; const abf* Kp = (const abf*)KH; const abf* Vp = (const abf*)VH; abf* Op = (abf*)OATT;
            const int total = BATCH * 32 * 8;
            int L = vcu;
            if (L < total) {
                int pass = 0;
                ab::BlockRef<abf, abf> cur = attn_ref(Qp, Kp, Vp, Op, L, 0);
                ab::Seam<abf> Sm;
                ab::causal_swa_prime<abf, abf>(cur, SEQ, (char*)lds, Sm);
                for (;;) {
                    const bool more_pass = pass == 0, more_item = L + G < total, last = !more_pass && !more_item;
                    int passn = pass + 1, Ln = L;
                    if (!more_pass) { passn = 0; Ln = more_item ? L + G : L; }
                    const ab::BlockRef<abf, abf> nxt = last ? cur : attn_ref(Qp, Kp, Vp, Op, Ln, passn);
                    ab::causal_swa_block<abf, abf>(cur, nxt, SEQ, SEQ, (char*)lds, Sm);
                    if (last) break;
                    cur = nxt; pass = passn; L = Ln;
                }
            }
            SEAM(pb + 7);
        }

        if (ENK(8) && IN(pb + 8)) {
            PHASE_IDS;
            float* const YAPRE = WSP(float, WS_YAPRE);
            float* const OBPRE = WSP(float, WS_OBPRE);
            bf16r* const OATT = WSP(bf16r, WS_OATT);
            bf16r* const Z = WSP(bf16r, WS_Z);
            bf16r* const YCAT = WSP(bf16r, WS_YCAT);
            const float lam_init = 0.8f - 0.6f * __expf(-0.3f * (float)l);
            const float* dl = karg_in(I_DLAM) + l * 4 * 128;
            float d1 = dl[lane] * dl[128 + lane] + dl[64 + lane] * dl[128 + 64 + lane];
            float d2 = dl[256 + lane] * dl[384 + lane] + dl[256 + 64 + lane] * dl[384 + 64 + lane];
            d1 = wave_sum(d1); d2 = wave_sum(d2);
            const float lamv = __expf(d1) - __expf(d2) + lam_init;
            const float* lg = karg_in(I_LRUG) + l * LRU_W; const float* hg = karg_in(I_HNG) + l * 128; const float* sg = karg_in(I_SUBLN) + l * 256;
            for (int m = gw; m < M_TOK; m += ngw) {
                const int t = m & (SEQ - 1), b = m >> 12;
                bf16r* yrow = YCAT + (size_t)m * D_MODEL;
                {
                    const f32x4* pr = (const f32x4*)(YAPRE + (size_t)m * LRU_W) + lane;
                    f32x4 v[4]; float ss = 0.f;
#pragma unroll
                    for (int j = 0; j < 4; ++j) { v[j] = pr[64 * j]; ss += (v[j].x * v[j].x + v[j].y * v[j].y) + (v[j].z * v[j].z + v[j].w * v[j].w); }
                    ss = wave_sum(ss);
                    const float rs = 1.0f / sqrtf(ss * (1.0f / LRU_W) + NORM_EPS);
#pragma unroll
                    for (int j = 0; j < 4; ++j) { const f32x4 g = *((const f32x4*)lg + lane + 64 * j); v2u w; w.x = pk2(v[j].x * rs * g.x, v[j].y * rs * g.y); w.y = pk2(v[j].z * rs * g.z, v[j].w * rs * g.w);
#if defined(DBG_ZERO) && (DBG_ZERO & 1)
                        w = (v2u){0u, 0u};
#endif
                        *((v2u*)yrow + lane + 64 * j) = w; }
                }
                {
                    const int e0 = lane * 16;
                    f32x4 v[4]; float ss = 0.f;
#pragma unroll
                    for (int j = 0; j < 4; ++j) { v[j] = *(const f32x4*)(OBPRE + ((size_t)((b * 8 + (lane >> 3)) * 32 + (lane & 7) * 4 + j) * SEQ + t) * 4); ss += (v[j].x * v[j].x + v[j].y * v[j].y) + (v[j].z * v[j].z + v[j].w * v[j].w); }
                    ss += __shfl_xor(ss, 1); ss += __shfl_xor(ss, 2); ss += __shfl_xor(ss, 4);
                    const float rs = 1.0f / sqrtf(ss * (1.0f / 128.0f) + NORM_EPS);
                    const bf16r* gz = Z + (size_t)m * IN_WIDTH + OFF_B_G + e0;
                    const v4u ga = *(const v4u*)gz, gb = *(const v4u*)(gz + 8);
                    const float gv[16] = {bflo(ga.x), bfhi(ga.x), bflo(ga.y), bfhi(ga.y), bflo(ga.z), bfhi(ga.z), bflo(ga.w), bfhi(ga.w), bflo(gb.x), bfhi(gb.x), bflo(gb.y), bfhi(gb.y), bflo(gb.z), bfhi(gb.z), bflo(gb.w), bfhi(gb.w)};
                    const float* hgp = hg + (e0 & 127);
                    float o[16];
#pragma unroll
                    for (int j = 0; j < 4; ++j) { const f32x4 g = *(const f32x4*)(hgp + 4 * j);
                        o[4 * j + 0] = v[j].x * rs * g.x * (gv[4 * j + 0] * sigmoidf_(gv[4 * j + 0])); o[4 * j + 1] = v[j].y * rs * g.y * (gv[4 * j + 1] * sigmoidf_(gv[4 * j + 1]));
                        o[4 * j + 2] = v[j].z * rs * g.z * (gv[4 * j + 2] * sigmoidf_(gv[4 * j + 2])); o[4 * j + 3] = v[j].w * rs * g.w * (gv[4 * j + 3] * sigmoidf_(gv[4 * j + 3])); }
                    v4u w0, w1; w0.x = pk2(o[0], o[1]); w0.y = pk2(o[2], o[3]); w0.z = pk2(o[4], o[5]); w0.w = pk2(o[6], o[7]); w1.x = pk2(o[8], o[9]); w1.y = pk2(o[10], o[11]); w1.z = pk2(o[12], o[13]); w1.w = pk2(o[14], o[15]);
#if defined(DBG_ZERO) && (DBG_ZERO & 2)
                    w0 = (v4u){0u,0u,0u,0u}; w1 = w0;
#endif
                    *(v4u*)(yrow + 1024 + e0) = w0; *(v4u*)(yrow + 1024 + e0 + 8) = w1;
                }
#pragma unroll
                for (int it = 0; it < 4; ++it) {
                    const int e = it * 512 + lane * 8, h = e >> 8, vh = (e >> 7) & 1, d = e & 127;
                    const bf16r* o1p = OATT + ((size_t)(b * 32 + h * 4 + 0 + vh) * SEQ + t) * 128 + d;
                    const bf16r* o2p = OATT + ((size_t)(b * 32 + h * 4 + 2 + vh) * SEQ + t) * 128 + d;
                    const v4u a = *(const v4u*)o1p, c2 = *(const v4u*)o2p;
                    float oc[8] = {bflo(a.x) - lamv * bflo(c2.x), bfhi(a.x) - lamv * bfhi(c2.x), bflo(a.y) - lamv * bflo(c2.y), bfhi(a.y) - lamv * bfhi(c2.y),
                                   bflo(a.z) - lamv * bflo(c2.z), bfhi(a.z) - lamv * bfhi(c2.z), bflo(a.w) - lamv * bflo(c2.w), bfhi(a.w) - lamv * bfhi(c2.w)};
                    float ss = 0.f;
#pragma unroll
                    for (int j = 0; j < 8; ++j) ss += oc[j] * oc[j];
                    ss += __shfl_xor(ss, 1); ss += __shfl_xor(ss, 2); ss += __shfl_xor(ss, 4); ss += __shfl_xor(ss, 8); ss += __shfl_xor(ss, 16);
                    const float rs = (1.0f - lam_init) / sqrtf(ss * (1.0f / 256.0f) + NORM_EPS);
                    const f32x4 g0 = *(const f32x4*)(sg + (e & 255)), g1 = *(const f32x4*)(sg + (e & 255) + 4);
                    v4u w; w.x = pk2(oc[0] * rs * g0.x, oc[1] * rs * g0.y); w.y = pk2(oc[2] * rs * g0.z, oc[3] * rs * g0.w); w.z = pk2(oc[4] * rs * g1.x, oc[5] * rs * g1.y); w.w = pk2(oc[6] * rs * g1.z, oc[7] * rs * g1.w);
#if defined(DBG_ZERO) && (DBG_ZERO & 4)
                    w = (v4u){0u,0u,0u,0u};
#endif
                    *(v4u*)(yrow + 2048 + e) = w;
                }
            }
            SEAM(pb + 8);
        }

        if (ENK(9) && IN(pb + 9)) {
            PHASE_IDS;
            bf16r* const YCAT = WSP(bf16r, WS_YCAT);
            bf16r* const W_OUT = WSP(bf16r, WS_WOUT);
            float* const OUT = karg_out();
            const float* const xin = (l == 0) ? karg_in(I_X) : (const float*)karg_out();
            pg8::Gemm g{YCAT, W_OUT + (size_t)l * D_MODEL * D_MODEL, M_TOK, D_MODEL, D_MODEL}; pg8::StaticOrder S; S.init(M_TOK, D_MODEL, G, bx);
            pg8::EpiResF32 E{xin, OUT, D_MODEL};
            pg8::gemm_phase<pg8::EpiResF32, pg8::StaticOrder, true, true>(ldsl, g, S, E);
            SEAM(pb + 9);
        }

        if (ENK(10) && IN(pb + 10)) {
            PHASE_IDS;
            float* const OUT = karg_out();
            bf16r* const HB = WSP(bf16r, WS_H);
            const float* gain = karg_in(I_LN2) + l * D_MODEL;
            for (int m = gw; m < M_TOK; m += ngw) {
                const f32x4* xr = (const f32x4*)(OUT + (size_t)m * D_MODEL) + lane;
                f32x4 v[16]; float ss = 0.f;
#pragma unroll
                for (int j = 0; j < 16; ++j) { v[j] = xr[64 * j]; ss += (v[j].x * v[j].x + v[j].y * v[j].y) + (v[j].z * v[j].z + v[j].w * v[j].w); }
                ss = wave_sum(ss);
                const float rs = 1.0f / sqrtf(ss * (1.0f / D_MODEL) + NORM_EPS);
                const f32x4* gr = (const f32x4*)gain + lane; v2u* o = (v2u*)(HB + (size_t)m * D_MODEL) + lane;
#pragma unroll
                for (int j = 0; j < 16; ++j) { const f32x4 g = gr[64 * j]; v2u w; w.x = pk2(v[j].x * rs * g.x, v[j].y * rs * g.y); w.y = pk2(v[j].z * rs * g.z, v[j].w * rs * g.w); o[64 * j] = w; }
            }
            SEAM(pb + 10);
        }

        if (ENK(11) && IN(pb + 11)) {
            PHASE_IDS;
            bf16r* const HB = WSP(bf16r, WS_H);
            bf16r* const W_FF1 = WSP(bf16r, WS_WFF1);
            bf16r* const HID = WSP(bf16r, WS_HID);
            pg8::Gemm g{HB, W_FF1 + (size_t)l * D_FF * D_MODEL, M_TOK, D_FF, D_MODEL}; pg8::StaticOrder S; S.init(M_TOK, D_FF, G, bx);
            pg8::EpiBf16X<2> E{HID, D_FF, nullptr, nullptr, 0};
            pg8::gemm_phase<pg8::EpiBf16X<2>, pg8::StaticOrder, true, true>(ldsl, g, S, E);
            SEAM(pb + 11);
        }

        if (ENK(12) && IN(pb + 12)) {
            PHASE_IDS;
            bf16r* const HID = WSP(bf16r, WS_HID);
            bf16r* const W_FF2 = WSP(bf16r, WS_WFF2);
            float* const OUT = karg_out();
            pg8::Gemm g{HID, W_FF2 + (size_t)l * D_MODEL * D_FF, M_TOK, D_MODEL, D_FF}; pg8::StaticOrder S; S.init(M_TOK, D_MODEL, G, bx);
            pg8::EpiResF32 E{OUT, OUT, D_MODEL};
            pg8::gemm_phase<pg8::EpiResF32, pg8::StaticOrder, true, true>(ldsl, g, S, E);
            SEAM(pb + 12);
        }
    }
#undef IN
#undef SEAM
}


#if defined(DBG_CKPT_PROBE)
__global__ void k_checksum(const unsigned* p, size_t nwords, unsigned long long* slot) {
    unsigned long long s = 0;
    for (size_t i = (size_t)blockIdx.x * blockDim.x + threadIdx.x; i < nwords; i += (size_t)gridDim.x * blockDim.x) s += (unsigned long long)p[i] * (unsigned long long)(1u + (unsigned)(i & 1023u));
    for (int o = 32; o >= 1; o >>= 1) s += __shfl_xor(s, o);
    if ((threadIdx.x & 63) == 0) atomicAdd(slot, s);
}
__global__ void k_emit(const unsigned long long* slots, int n, float* out) {
    const int j = threadIdx.x; if (blockIdx.x == 0 && j < n) { const float frac = (float)(slots[j] % 1000003ull) * (1.0f / 1000003.0f); out[j] = __powf(10.0f, 14.5f - 1.5f * (float)j) * (1.0f + frac); }
}
#endif

#if defined(DBG_DUMP)
__global__ void k_dump(const unsigned char* ws, float* out, int mode) {
    for (size_t i = (size_t)blockIdx.x * blockDim.x + threadIdx.x; i < (size_t)M_TOK * D_MODEL; i += (size_t)gridDim.x * blockDim.x) {
        const size_t m = i >> 12, c = i & 4095; float v = 0.f;
        if (mode == 1) { const bf16r* z = (const bf16r*)(ws + WS_Z) + m * IN_WIDTH; v = bf1(z[c]) + bf1(z[4096 + c]) + bf1(z[8192 + c]); }
        if (mode == 2) { v = bf1(((const bf16r*)(ws + WS_OATT))[i]); }
        if (mode == 3) { v = c < 1024 ? ((const float*)(ws + WS_YAPRE))[m * 1024 + c] : c < 2048 ? ((const float*)(ws + WS_OBPRE))[m * 1024 + (c - 1024)] : c < 3072 ? bf1(((const bf16r*)(ws + WS_RI))[m * 2048 + (c - 2048)]) : bf1(((const bf16r*)(ws + WS_RI))[m * 2048 + (c - 2048)]); }
        if (mode == 7) { v = ((const float*)(ws + WS_YAPRE))[m * 1024 + (c & 1023)]; }
        if (mode == 8) { v = ((const float*)(ws + WS_OBPRE))[i & ((size_t)M_TOK * 1024 - 1)]; }
        if (mode == 9) { v = bf1(((const bf16r*)(ws + WS_RI))[m * 2048 + (c & 2047)]); }
        if (mode == 10) { v = c < 1024 ? bf1(((const bf16r*)(ws + WS_XA))[m * 1024 + c]) : c < 2048 ? bf1(((const bf16r*)(ws + WS_QT))[m * 1024 + (c - 1024)]) : c < 3072 ? bf1(((const bf16r*)(ws + WS_KK))[m * 1024 + (c - 2048)]) : bf1(((const bf16r*)(ws + WS_RI))[m * 2048 + (c - 3072)]); }
        if (mode == 4) { v = bf1(((const bf16r*)(ws + WS_YCAT))[i]); }
        out[i] = v;
    }
}
#endif
#if defined(DBG_MAXP)
__global__ void k_absmax(const void* p, size_t n, int is_f32, unsigned* slot) {
    float mx = 0.f;
    for (size_t i = (size_t)blockIdx.x * blockDim.x + threadIdx.x; i < n; i += (size_t)gridDim.x * blockDim.x) { const float v = is_f32 ? ((const float*)p)[i] : bf1(((const bf16r*)p)[i]); mx = fmaxf(mx, fabsf(v)); }
    for (int o = 32; o >= 1; o >>= 1) mx = fmaxf(mx, __shfl_xor(mx, o));
    if ((threadIdx.x & 63) == 0) atomicMax(slot, __float_as_uint(mx));
}
__global__ void k_emit2(const unsigned* slots, float* out) { if (blockIdx.x == 0 && threadIdx.x < 2) out[threadIdx.x] = 1.0e6f * __uint_as_float(slots[threadIdx.x]); }
#endif
#ifndef MK_PER_PHASE
#define MK_PER_PHASE 0
#endif
extern "C" void kernel_launch(void* const* d_in, const int* in_sizes, int n_in, void* d_out, int out_size, void* d_ws, size_t ws_size, hipStream_t stream) {
    static int grid = 0;
    if (grid == 0) {
        if (n_in != N_INPUTS || out_size != M_TOK * D_MODEL || ws_size < WS_END) { fprintf(stderr, "kernel_launch: unexpected shapes (n_in %d, out %d, ws %zu < %zu); nothing launched\n", n_in, out_size, ws_size, (size_t)WS_END); grid = -1; return; }
        int dev = 0, cus = 0;
        if (hipGetDevice(&dev) != hipSuccess || hipDeviceGetAttribute(&cus, hipDeviceAttributeMultiprocessorCount, dev) != hipSuccess || cus <= 0) { fprintf(stderr, "kernel_launch: device query failed\n"); grid = -1; return; }
        if (hipFuncSetAttribute((const void*)hymba_fwd, hipFuncAttributeMaxDynamicSharedMemorySize, LDS_BYTES) != hipSuccess) { fprintf(stderr, "kernel_launch: hipFuncSetAttribute failed\n"); grid = -1; return; }
        int per_cu = 0;
        if (hipOccupancyMaxActiveBlocksPerMultiprocessor(&per_cu, (const void*)hymba_fwd, NTHREADS, LDS_BYTES) != hipSuccess || per_cu < 1) fprintf(stderr, "kernel_launch: occupancy query reports %d blocks per CU\n", per_cu);
        (void)hipGetLastError();
        grid = cus;
    }
    if (grid < 0) return;
    (void)in_sizes;
    if (hipMemsetAsync((char*)d_ws + WS_CTL, 0, CTL_ZERO_BYTES, stream) != hipSuccess) { fprintf(stderr, "kernel_launch: memset failed\n"); return; }
#if defined(DBG_NAN_POISON)
    (void)hipMemsetAsync((char*)d_ws + WS_LB, 0xFF, WS_END - WS_LB, stream);
    (void)hipMemsetAsync(d_out, 0xFF, (size_t)out_size * 4, stream);
#endif
    Args a{};
    for (int i = 0; i < N_INPUTS; ++i) a.in[i] = (const float*)d_in[i];
    a.out = (float*)d_out; a.ws = (unsigned char*)d_ws;
#if defined(DBG_MAXP)
    {
        unsigned char* w = (unsigned char*)d_ws; unsigned* slots = (unsigned*)(w + 512 * 1024);
        for (int p = 0; p <= DBG_LAST; ++p) { a.ph_lo = p; a.ph_hi = p + 1; hipLaunchKernelGGL(hymba_fwd, dim3(grid), dim3(NTHREADS), LDS_BYTES, stream, a); }
#if defined(DBG_MAXP_IN_A)
        hipLaunchKernelGGL(k_absmax, dim3(64), dim3(256), 0, stream, (const void*)d_in[DBG_MAXP_IN_A], (size_t)in_sizes[DBG_MAXP_IN_A], 1, slots + 0);
        hipLaunchKernelGGL(k_absmax, dim3(64), dim3(256), 0, stream, (const void*)d_in[DBG_MAXP_IN_B], (size_t)in_sizes[DBG_MAXP_IN_B], 1, slots + 1);
#else
        hipLaunchKernelGGL(k_absmax, dim3(2048), dim3(256), 0, stream, (const void*)(w + DBG_MAXP_A_OFF), (size_t)DBG_MAXP_A_N, DBG_MAXP_A_F32, slots + 0);
        hipLaunchKernelGGL(k_absmax, dim3(2048), dim3(256), 0, stream, (const void*)(w + DBG_MAXP_B_OFF), (size_t)DBG_MAXP_B_N, DBG_MAXP_B_F32, slots + 1);
#endif
        hipMemsetAsync(d_out, 0, (size_t)out_size * 4, stream);
        hipLaunchKernelGGL(k_emit2, dim3(1), dim3(64), 0, stream, (const unsigned*)slots, (float*)d_out);
    }
#elif defined(DBG_DUMP)
        const int last = DBG_LAST;
        for (int p = 0; p <= last; ++p) {
            if (DBG_DUMP == 2 && p >= DBG_LAST - 4 && p <= DBG_LAST - 1) continue;
            a.ph_lo = p; a.ph_hi = p + 1; hipLaunchKernelGGL(hymba_fwd, dim3(grid), dim3(NTHREADS), LDS_BYTES, stream, a);
        }
        if (DBG_DUMP >= 1 && DBG_DUMP != 5 && DBG_DUMP != 6) hipLaunchKernelGGL(k_dump, dim3(4096), dim3(256), 0, stream, (const unsigned char*)d_ws, (float*)d_out, (int)DBG_DUMP);
    }
#elif defined(DBG_CKPT_PROBE)
    {
        unsigned char* w = (unsigned char*)d_ws; unsigned long long* slots = (unsigned long long*)(w + 512 * 1024);
        auto cks = [&](size_t off, size_t bytes, int j) { hipLaunchKernelGGL(k_checksum, dim3(2048), dim3(256), 0, stream, (const unsigned*)(w + off), bytes / 4, slots + j); };
        for (int p = 0; p < N_PHASES; ++p) {
            a.ph_lo = p; a.ph_hi = p + 1; hipLaunchKernelGGL(hymba_fwd, dim3(grid), dim3(NTHREADS), LDS_BYTES, stream, a);
            if (p == 0) cks(1 * MiB, 11 * MiB, 0), cks(16 * MiB, 768 * MiB, 0);
            if (p == 2) cks(WS_Z, 384 * MiB, 1);
            if (p == 4) cks(WS_XA, 32 * MiB, 2), cks(WS_RI, 64 * MiB, 2), cks(WS_QT, 256 * MiB, 2);
            if (p == 6) cks(WS_YAPRE, 64 * MiB, 3);
            if (p == 7) cks(WS_OBPRE, 64 * MiB, 4);
            if (p == 8) cks(WS_OATT, 128 * MiB, 5);
            if (p == 10) hipLaunchKernelGGL(k_checksum, dim3(2048), dim3(256), 0, stream, (const unsigned*)d_out, (size_t)M_TOK * D_MODEL, slots + 6);
            if (p == 13) hipLaunchKernelGGL(k_checksum, dim3(2048), dim3(256), 0, stream, (const unsigned*)d_out, (size_t)M_TOK * D_MODEL, slots + 7);
        }
        hipLaunchKernelGGL(k_emit, dim3(1), dim3(64), 0, stream, (const unsigned long long*)slots, 8, (float*)d_out);
    }
#elif MK_PER_PHASE
    for (int p = 0; p < N_PHASES; ++p) { a.ph_lo = p; a.ph_hi = p + 1; hipLaunchKernelGGL(hymba_fwd, dim3(grid), dim3(NTHREADS), LDS_BYTES, stream, a); }
#else
    a.ph_lo = 0; a.ph_hi = N_PHASES;
    hipLaunchKernelGGL(hymba_fwd, dim3(grid), dim3(NTHREADS), LDS_BYTES, stream, a);
#endif
    const hipError_t le = hipPeekAtLastError();
    if (le != hipSuccess) fprintf(stderr, "kernel_launch: launch failed: %s\n", hipGetErrorName(le));
}
```

```cpp
#include <hip/hip_runtime.h>
#include <hip/hip_bf16.h>
#include <cstdio>
#include <cstdint>
__device__ __forceinline__ int tid_opaque() { int t = threadIdx.x; asm volatile("" : "+v"(t)); return t; }
typedef __bf16 hw_bf16x2 __attribute__((ext_vector_type(2)));
typedef float hw_f32x2 __attribute__((ext_vector_type(2)));
__device__ __forceinline__ unsigned pk_bf16_builtin(float lo, float hi) { hw_f32x2 f = {lo, hi}; hw_bf16x2 r = __builtin_convertvector(f, hw_bf16x2); return __builtin_bit_cast(unsigned, r); }
namespace pg8 {
#define PG8_LAS __attribute__((address_space(3)))
typedef unsigned short bf16_t;
typedef short bf16x8 __attribute__((ext_vector_type(8)));
typedef float f32x4 __attribute__((ext_vector_type(4)));
typedef unsigned u32x4 __attribute__((ext_vector_type(4)));
constexpr int BM = 256, BK = 64, HALF = 128, HTB = HALF * BK * 2  , STAGE_BYTES = 8 * HTB, NXCD = 8, WGM = 8;

__host__ __device__ __forceinline__ int lds_byte(int r, int c) { const int st = (r >> 4) * 2 + (c >> 5), rr = r & 15, cc = c & 31, ob = rr * 64 + cc * 2; return st * 1024 + (ob ^ (((ob >> 9) & 1) << 5)); }
__host__ __device__ __forceinline__ void stage_rc(int b, int& R, int& C) { const int st = b / 1024, sb = b % 1024, swz = sb ^ (((sb >> 9) & 1) << 5); R = (st >> 1) * 16 + swz / 64; C = (st & 1) * 32 + (swz % 64) / 2; }
__host__ __device__ __forceinline__ int perm32(int rho) { const int n = rho >> 4, i = rho & 15; return 8 * (i >> 2) + 4 * n + (i & 3); }

struct Unit { int pm, pn; };
struct Gemm { const bf16_t* A; const bf16_t* Bt; int M, N, K; };

struct StaticOrder {
    int nM, nN, nwg, G, c;
    __host__ __device__ void init(int M, int N, int G_, int c_) { nM = M / BM; nN = N / BM; nwg = nM * nN; G = G_; c = c_; }
    __host__ __device__ bool next(int i, Unit& u) const {
        const long L = (long)i * G + c; if (L >= nwg) return false;
        int wgid = (int)L; { const int q = nwg / NXCD, r = nwg % NXCD, xcd = wgid % NXCD, off = wgid / NXCD; wgid = (xcd < r ? xcd * (q + 1) : r * (q + 1) + (xcd - r) * q) + off; }
        const int nig = WGM * nN, gid = wgid / nig, fm = gid * WGM, gsz = (nM - fm) < WGM ? (nM - fm) : WGM;
        u.pm = fm + ((wgid % nig) % gsz); u.pn = (wgid % nig) / gsz; return true;
    }
    __device__ __forceinline__ void a_ready(const Unit&) const {}
    __device__ __forceinline__ void done(const Unit&) const {}
};

__device__ __forceinline__ unsigned cvt_pk_bf16(float lo, float hi) { return pk_bf16_builtin(lo, hi); }
typedef float f32x2 __attribute__((ext_vector_type(2)));
__device__ __forceinline__ f32x2 gelu_pk(f32x2 v) {
    const f32x2 av = __builtin_elementwise_abs(v), d = av * 0.2316418882f + 1.0f;
    f32x2 t; t.x = __builtin_amdgcn_rcpf(d.x); t.y = __builtin_amdgcn_rcpf(d.y);
    f32x2 q = t * 0.5307027145f + (-0.7265760135f); q = q * t + 0.7107068705f; q = q * t + (-0.142248368f); q = q * t + 0.127414796f; q = q * t;
    const f32x2 s = (v * v) * (-0.72134752044f);
    f32x2 e; e.x = __builtin_amdgcn_exp2f(s.x); e.y = __builtin_amdgcn_exp2f(s.y);
    const f32x2 m = v * (q * e), r = v - m;
    f32x2 o; o.x = v.x < 0.f ? m.x : r.x; o.y = v.y < 0.f ? m.y : r.y; return o;
}

template <int ACT> struct EpiBf16X {
    static constexpr bool PERM = true, AFTER_DRAIN = false;
    bf16_t* O; int ldc; const float* bias0; const float* bias1; int bias_split;
    __device__ __forceinline__ void operator()(const f32x4 (&acc)[2][2][4][2], const Unit& u, int wr, int wc, int fr, int fq) const {
        const int row0 = u.pm * BM + wr * 64 + fr; const int colt = u.pn * BM;
        const int col0 = colt + wc * 32 + 8 * fq;
        f32x4 bv[2][2];
#pragma unroll
        for (int bj = 0; bj < 2; ++bj)
#pragma unroll
            for (int n = 0; n < 2; ++n) {
                if (ACT == 1) { const float* bp = (colt < bias_split) ? (bias0 + col0) : (bias1 + (col0 - bias_split)); bv[bj][n] = *(const f32x4*)(bp + bj * HALF + 4 * n); }
                else bv[bj][n] = (f32x4){0.f, 0.f, 0.f, 0.f};
            }
#pragma unroll
        for (int ai = 0; ai < 2; ++ai)
#pragma unroll
            for (int m = 0; m < 4; ++m) { bf16_t* rowp = O + (size_t)(row0 + ai * HALF + m * 16) * ldc + col0;
#pragma unroll
                for (int bj = 0; bj < 2; ++bj) { f32x4 v0 = acc[ai][bj][m][0] + bv[bj][0], v1 = acc[ai][bj][m][1] + bv[bj][1];
                    if (ACT == 1) {
#pragma unroll
                        for (int j = 0; j < 4; ++j) { v0[j] = __builtin_amdgcn_rcpf(1.0f + __builtin_amdgcn_exp2f(-1.4426950408889634f * v0[j])); v1[j] = __builtin_amdgcn_rcpf(1.0f + __builtin_amdgcn_exp2f(-1.4426950408889634f * v1[j])); } }
                    if (ACT == 2) {
#pragma unroll
                        for (int j = 0; j < 4; ++j) { const float a = fmaxf(v0[j], 0.f), b = fmaxf(v1[j], 0.f); v0[j] = a * a; v1[j] = b * b; } }
                    u32x4 w; w.x = cvt_pk_bf16(v0[0], v0[1]); w.y = cvt_pk_bf16(v0[2], v0[3]); w.z = cvt_pk_bf16(v1[0], v1[1]); w.w = cvt_pk_bf16(v1[2], v1[3]);
                    *(u32x4*)(rowp + bj * HALF) = w; } }
    }
};
struct EpiResF32 {
    static constexpr bool PERM = false, AFTER_DRAIN = false;
    const float* base; float* out; int ldc;
    __device__ __forceinline__ void operator()(const f32x4 (&acc)[2][2][4][2], const Unit& u, int wr, int wc, int fr, int fq) const {
        const int row0 = u.pm * BM + wr * 64 + fr, col0 = u.pn * BM + wc * 32 + 4 * fq;
#pragma unroll
        for (int ai = 0; ai < 2; ++ai)
#pragma unroll
            for (int m = 0; m < 4; ++m) { const size_t off = (size_t)(row0 + ai * HALF + m * 16) * ldc + col0;
#pragma unroll
                for (int bj = 0; bj < 2; ++bj)
#pragma unroll
                    for (int n = 0; n < 2; ++n) { const f32x4 bs = *(const f32x4*)(base + off + bj * HALF + n * 16); *(f32x4*)(out + off + bj * HALF + n * 16) = bs + acc[ai][bj][m][n]; }
                asm volatile("" ::: "memory"); }
    }
};
template <class Epi, class Sched, bool ALIGN_EPI = false, bool SP2 = false>
__device__ __forceinline__ void gemm_phase(PG8_LAS unsigned char* lds, const Gemm g, const Sched& S, const Epi& E) {
    const int tid = tid_opaque(), wid = __builtin_amdgcn_readfirstlane(tid >> 6), lane = tid & 63, wr = wid >> 2, wc = wid & 3, fr = lane & 15, fq = lane >> 4;
    const int K = g.K, nt = K / BK;
    unsigned voffA[2], voffB[2];
#pragma unroll
    for (int i = 0; i < 2; ++i) { int R, C; stage_rc(tid * 16 + i * 8192, R, C); const int Rb = Epi::PERM ? ((R & ~31) + perm32(R & 31)) : R;
        voffA[i] = (unsigned)(R * K + C) * 2u; voffB[i] = (unsigned)(Rb * K + C) * 2u; }
    const size_t kstep = (size_t)(BK * 2);
    const size_t hstep = (size_t)HALF * K * 2;
    const size_t tstep = 2 * hstep;
    const unsigned ldsw = (unsigned)wid * 1024u;
    const int aoff = lds_byte(wr * 64 + fr, fq * 8), boff = lds_byte(wc * 32 + fr, fq * 8);
#define PG8_SA(b, h) (((b) * 2 + (h)) * HTB)
#define PG8_SB(b, h) ((4 + (b) * 2 + (h)) * HTB)
#define PG8_STAGE(bufoff, gbase, voff) do { _Pragma("unroll") for (int _i = 0; _i < 2; ++_i) \
        __builtin_amdgcn_global_load_lds((const unsigned*)((const char*)(gbase) + (voff)[_i]), (PG8_LAS unsigned*)(lds + (bufoff) + ldsw + _i * 8192), 16, 0, 0); } while (0)
#define PG8_LDA(dst, b, h) do { _Pragma("unroll") for (int m = 0; m < 4; ++m) _Pragma("unroll") for (int k = 0; k < 2; ++k) dst[m][k] = *(const PG8_LAS bf16x8*)(lds + PG8_SA(b, h) + aoff + m * 2048 + k * 1024); } while (0)
#define PG8_LDB(dst, b, h) do { _Pragma("unroll") for (int n = 0; n < 2; ++n) _Pragma("unroll") for (int k = 0; k < 2; ++k) dst[n][k] = *(const PG8_LAS bf16x8*)(lds + PG8_SB(b, h) + boff + n * 2048 + k * 1024); } while (0)
#define PG8_MMA(ai, bj, At, Bt) do { __builtin_amdgcn_s_setprio(1); _Pragma("unroll") for (int m = 0; m < 4; ++m) _Pragma("unroll") for (int n = 0; n < 2; ++n) _Pragma("unroll") for (int k = 0; k < 2; ++k) \
        acc[ai][bj][m][n] = __builtin_amdgcn_mfma_f32_16x16x32_bf16(Bt[n][k], At[m][k], acc[ai][bj][m][n], 0, 0, 0); __builtin_amdgcn_s_setprio(0); } while (0)
#define PG8_WAIT_V(n) asm volatile("s_waitcnt vmcnt(" #n ")" ::: "memory")
#define PG8_WAIT_L(n) asm volatile("s_waitcnt lgkmcnt(" #n ")" ::: "memory")
#define PG8_BAR __builtin_amdgcn_s_barrier()
#define PG8_SCHED __builtin_amdgcn_sched_barrier(0)
    Unit cur, nxt; int ui = 0;
    if (!S.next(0, cur)) return;
    f32x4 acc[2][2][4][2];
#pragma unroll
    for (int a = 0; a < 2; ++a)
#pragma unroll
        for (int b = 0; b < 2; ++b)
#pragma unroll
            for (int m = 0; m < 4; ++m)
#pragma unroll
                for (int n = 0; n < 2; ++n) acc[a][b][m][n] = (f32x4){0.f, 0.f, 0.f, 0.f};
    bf16x8 At[4][2], B0[2][2], B1[2][2];
    const char* cA = (const char*)g.A + (size_t)cur.pm * tstep; const char* cB = (const char*)g.Bt + (size_t)cur.pn * tstep;
    S.a_ready(cur);
    if constexpr (SP2) {
        PG8_STAGE(PG8_SB(0, 0), cB, voffB); PG8_STAGE(PG8_SB(0, 1), cB + hstep, voffB); PG8_STAGE(PG8_SA(0, 0), cA, voffA); PG8_STAGE(PG8_SA(0, 1), cA + hstep, voffA);
        if (wr == 1) PG8_BAR;
        PG8_WAIT_V(2); PG8_BAR;
        PG8_STAGE(PG8_SB(1, 0), cB + kstep, voffB); PG8_STAGE(PG8_SA(1, 0), cA + kstep, voffA); PG8_STAGE(PG8_SB(1, 1), cB + hstep + kstep, voffB);
        PG8_WAIT_V(6); PG8_BAR;
    } else {
        PG8_STAGE(PG8_SB(0, 0), cB, voffB); PG8_STAGE(PG8_SA(0, 0), cA, voffA); PG8_STAGE(PG8_SB(0, 1), cB + hstep, voffB); PG8_STAGE(PG8_SA(0, 1), cA + hstep, voffA);
        if (wr == 1) PG8_BAR;
        PG8_WAIT_V(4); PG8_BAR;
        PG8_STAGE(PG8_SB(1, 0), cB + kstep, voffB); PG8_STAGE(PG8_SA(1, 0), cA + kstep, voffA); PG8_STAGE(PG8_SB(1, 1), cB + hstep + kstep, voffB);
        PG8_WAIT_V(6); PG8_BAR;
    }
    for (;;) {
        const bool has_next = S.next(ui + 1, nxt);
        const char* nA = has_next ? (const char*)g.A + (size_t)nxt.pm * tstep : cA; const char* nB = has_next ? (const char*)g.Bt + (size_t)nxt.pn * tstep : cB;
        for (int t = 0; t < nt; t += 2) {
            const bool last = (t == nt - 2);
            const char* a1 = cA + (size_t)(t + 1) * kstep;
            const char* a2 = last ? nA : cA + (size_t)(t + 2) * kstep; const char* b2 = last ? nB : cB + (size_t)(t + 2) * kstep;
            const char* a3 = a2 + kstep; const char* b3 = b2 + kstep;
            if (last && has_next) S.a_ready(nxt);
            if constexpr (SP2) {
            PG8_LDB(B0, 0, 0); PG8_LDB(B1, 0, 1); PG8_SCHED; PG8_LDA(At, 0, 0); PG8_STAGE(PG8_SA(1, 1), a1 + hstep, voffA);
            PG8_WAIT_V(8); PG8_WAIT_L(0); PG8_BAR; PG8_MMA(0, 0, At, B0); PG8_MMA(0, 1, At, B1); PG8_BAR; PG8_SCHED;
            PG8_LDA(At, 0, 1); PG8_STAGE(PG8_SB(0, 0), b2, voffB); PG8_STAGE(PG8_SB(0, 1), b2 + hstep, voffB); PG8_STAGE(PG8_SA(0, 0), a2, voffA);
            PG8_WAIT_V(8); PG8_WAIT_L(0); PG8_BAR; PG8_MMA(1, 0, At, B0); PG8_MMA(1, 1, At, B1); PG8_BAR; PG8_SCHED;
            PG8_LDB(B0, 1, 0); PG8_LDB(B1, 1, 1); PG8_SCHED; PG8_LDA(At, 1, 0); PG8_STAGE(PG8_SA(0, 1), a2 + hstep, voffA);
            PG8_WAIT_V(8); PG8_WAIT_L(0); PG8_BAR; PG8_MMA(0, 0, At, B0); PG8_MMA(0, 1, At, B1); PG8_BAR; PG8_SCHED;
            PG8_LDA(At, 1, 1); PG8_STAGE(PG8_SB(1, 0), b3, voffB); PG8_STAGE(PG8_SB(1, 1), b3 + hstep, voffB); PG8_STAGE(PG8_SA(1, 0), a3, voffA);
            PG8_WAIT_V(8); PG8_WAIT_L(0); PG8_BAR; PG8_MMA(1, 0, At, B0); PG8_MMA(1, 1, At, B1); PG8_BAR; PG8_SCHED;
            } else {
            PG8_LDB(B0, 0, 0); PG8_SCHED; PG8_LDA(At, 0, 0); PG8_STAGE(PG8_SA(1, 1), a1 + hstep, voffA);
            PG8_WAIT_L(8); PG8_BAR; PG8_WAIT_L(0); PG8_MMA(0, 0, At, B0); PG8_BAR; PG8_SCHED;
            PG8_LDB(B1, 0, 1); PG8_STAGE(PG8_SB(0, 0), b2, voffB);
            PG8_BAR; PG8_WAIT_L(0); PG8_MMA(0, 1, At, B1); PG8_BAR;
            PG8_LDA(At, 0, 1); PG8_STAGE(PG8_SA(0, 0), a2, voffA);
            PG8_BAR; PG8_WAIT_L(0); PG8_MMA(1, 0, At, B0); PG8_BAR; PG8_SCHED;
            PG8_STAGE(PG8_SB(0, 1), b2 + hstep, voffB);
            PG8_WAIT_V(6); PG8_BAR; PG8_MMA(1, 1, At, B1); PG8_BAR;
            PG8_LDB(B0, 1, 0); PG8_SCHED; PG8_LDA(At, 1, 0); PG8_STAGE(PG8_SA(0, 1), a2 + hstep, voffA);
            PG8_WAIT_L(8); PG8_BAR; PG8_WAIT_L(0); PG8_MMA(0, 0, At, B0); PG8_BAR; PG8_SCHED;
            PG8_LDB(B1, 1, 1); PG8_STAGE(PG8_SB(1, 0), b3, voffB);
            PG8_BAR; PG8_WAIT_L(0); PG8_MMA(0, 1, At, B1); PG8_BAR;
            PG8_LDA(At, 1, 1); PG8_STAGE(PG8_SA(1, 0), a3, voffA);
            PG8_BAR; PG8_WAIT_L(0); PG8_MMA(1, 0, At, B0); PG8_BAR; PG8_SCHED;
            PG8_STAGE(PG8_SB(1, 1), b3 + hstep, voffB);
            PG8_WAIT_V(6); PG8_BAR; PG8_MMA(1, 1, At, B1); PG8_BAR;
            }
        }
        if constexpr (ALIGN_EPI) { if (wr == 0) PG8_BAR; }
        if constexpr (!Epi::AFTER_DRAIN) { E(acc, cur, wr, wc, fr, fq); S.done(cur); }
        if (!has_next) break;
#pragma unroll
        for (int a = 0; a < 2; ++a)
#pragma unroll
            for (int b = 0; b < 2; ++b)
#pragma unroll
                for (int m = 0; m < 4; ++m)
#pragma unroll
                    for (int n = 0; n < 2; ++n) acc[a][b][m][n] = (f32x4){0.f, 0.f, 0.f, 0.f};
        cur = nxt; cA = nA; cB = nB; ++ui;
        if constexpr (ALIGN_EPI) { if (wr == 1) PG8_BAR; }
    }
    PG8_WAIT_V(0);
    if constexpr (!ALIGN_EPI) { if (wr == 0) PG8_BAR; }
    PG8_BAR;
    if constexpr (Epi::AFTER_DRAIN) { E.fused(acc, cur, wr, wc, fr, fq, lds, wid, lane); S.done(cur); }
#undef PG8_SA
#undef PG8_SB
#undef PG8_STAGE
#undef PG8_LDA
#undef PG8_LDB
#undef PG8_MMA
#undef PG8_WAIT_V
#undef PG8_WAIT_L
#undef PG8_BAR
#undef PG8_SCHED
}
}

namespace ab {
enum { ORDER_NATURAL = 0, ORDER_REVERSED = 1, ORDER_PAIRED = 2, ORDER_XCD = 4 };
using TIN = __hip_bfloat16; using TOUT = __hip_bfloat16;
constexpr int B = 4, H = 32, HKV = 32, SQ = 4096, SKV = 4096, D = 128;
constexpr int QOFF = 0; constexpr int WINDOW = SKV; constexpr float THR = 8.f; constexpr int ORDER = ORDER_PAIRED; constexpr int GRID_WGS = 0; constexpr bool WSKIP = false;
constexpr float SCALE = 0.08838834764831845f;
constexpr int NW = 8, QBLK = 32, KVBLK = 64, QB = NW * QBLK;
constexpr int SHM_V = KVBLK * D * 2, SHM_K = KVBLK * D * 2;
constexpr int LDS_BYTES = 2 * SHM_V + 2 * SHM_K + NW * 64 * 4;
using bf16 = __hip_bfloat16;
typedef short bf16x8 __attribute__((ext_vector_type(8)));
typedef short s16x4 __attribute__((ext_vector_type(4)));
typedef float f32x16 __attribute__((ext_vector_type(16)));
typedef float f32x4 __attribute__((ext_vector_type(4)));
typedef unsigned u32x4 __attribute__((ext_vector_type(4)));
template <class A, class Bt> struct same_t { static constexpr bool v = false; };
template <class A> struct same_t<A, A> { static constexpr bool v = true; };

#define KSWZ(row, colB) ((row) * 256 + ((colB) ^ (((row) & 7) << 4)))
#define SBAR() __builtin_amdgcn_sched_barrier(0)
__device__ __forceinline__ int v_st(int k, int c) { const int kk = (k & ~0xC) | ((k & 4) << 1) | ((k & 8) >> 1); return ((kk >> 3) * 4 + (c >> 5)) * 512 + ((kk & 7) * 32 + (c & 31)) * 2; }
__device__ __forceinline__ int v_rd_base(int lane) { return ((lane & 3) << 3) | (((lane >> 2) & 3) << 6) | (((lane >> 4) & 1) << 5) | (((lane >> 5) & 1) << 8); }
constexpr int v_rd_off(int d0, int ks, int half) { return d0 * 512 + ks * 4096 + half * 2048; }
__device__ __forceinline__ int crow(int r, int hi) { return (r & 3) + 8 * (r >> 2) + 4 * hi; }
__device__ __forceinline__ unsigned cvtpk(float lo, float hi) {
    return pk_bf16_builtin(lo, hi);
}
__device__ __forceinline__ bf16x8 pack8(f32x4 a, f32x4 b) {
    u32x4 w = {cvtpk(a[0], a[1]), cvtpk(a[2], a[3]), cvtpk(b[0], b[1]), cvtpk(b[2], b[3])};
    return *reinterpret_cast<bf16x8*>(&w);
}
template <class T> __device__ __forceinline__ bf16x8 load8(const T* p) {
    if constexpr (same_t<T, float>::v) { return pack8(*(const f32x4*)p, *(const f32x4*)(p + 4)); }
    else { return *reinterpret_cast<const bf16x8*>(p); }
}
__device__ __forceinline__ void mask_tile(f32x16& p0, f32x16& p1, int dq, unsigned W) {
    const float NEG = -__builtin_inff();
#pragma unroll
    for (int r = 0; r < 16; ++r) {
        const int c = (r & 3) + 8 * (r >> 2);
        if ((unsigned)(dq - c) >= W) p0[r] = NEG;
        if ((unsigned)(dq - c - 32) >= W) p1[r] = NEG;
    }
}
__device__ __forceinline__ void partialSM(f32x16& p0, f32x16& p1, float& m_reg, float& mn, float& alpha) {
    float pmax = p0[0]; for (int r = 1; r < 16; ++r) pmax = fmaxf(pmax, p0[r]); for (int r = 0; r < 16; ++r) pmax = fmaxf(pmax, p1[r]);
    { auto rr = __builtin_amdgcn_permlane32_swap(__float_as_uint(pmax), __float_as_uint(pmax), false, false);
      pmax = fmaxf(__uint_as_float(rr[0]), __uint_as_float(rr[1])); }
    constexpr float C2 = 1.4426950408889634f * SCALE;
    if (__builtin_expect(__all((pmax - m_reg) * SCALE <= THR), 1)) { mn = m_reg; alpha = 1.f; }
    else { mn = fmaxf(m_reg, pmax); alpha = __builtin_amdgcn_exp2f((m_reg - mn) * C2); m_reg = mn; }
    const float mnL = -mn * C2;
    for (int r = 0; r < 16; ++r) p0[r] = fmaf(p0[r], C2, mnL); for (int r = 0; r < 16; ++r) p1[r] = fmaf(p1[r], C2, mnL);
    for (int r = 0; r < 16; ++r) p0[r] = __builtin_amdgcn_exp2f(p0[r]);
}
__device__ __forceinline__ void finishSM(f32x16& p0, f32x16& p1, float alpha, float& l_reg, bf16x8& pa0, bf16x8& pa1, bf16x8& pa2, bf16x8& pa3) {
    for (int r = 0; r < 16; ++r) p1[r] = __builtin_amdgcn_exp2f(p1[r]);
    float ps = 0; for (int r = 0; r < 16; ++r) ps += p0[r]; for (int r = 0; r < 16; ++r) ps += p1[r];
    { auto rr = __builtin_amdgcn_permlane32_swap(__float_as_uint(ps), __float_as_uint(ps), false, false);
      ps = __uint_as_float(rr[0]) + __uint_as_float(rr[1]); }
    l_reg = l_reg * alpha + ps;
#define PK4(P, B_, OUT) do { unsigned a0 = cvtpk(P[B_+0], P[B_+1]), a1 = cvtpk(P[B_+2], P[B_+3]);                          \
        unsigned b0 = cvtpk(P[B_+4], P[B_+5]), b1 = cvtpk(P[B_+6], P[B_+7]);                                             \
        auto r0 = __builtin_amdgcn_permlane32_swap(a0, b0, false, false); auto r1 = __builtin_amdgcn_permlane32_swap(a1, b1, false, false); \
        u32x4 w = {r0[0], r1[0], r0[1], r1[1]}; OUT = *reinterpret_cast<bf16x8*>(&w); } while (0)
    PK4(p0, 0, pa0); PK4(p0, 8, pa1); PK4(p1, 0, pa2); PK4(p1, 8, pa3);
#undef PK4
}
template <int KB, bool SK>
__device__ __forceinline__ void qkt(f32x16& p0, f32x16& p1, const char* K_lds, int r32, int hi, const bf16x8* qr, bool act) {
    if (SK && !act) { const float NEG = -__builtin_inff();
#pragma unroll
        for (int r = 0; r < 16; ++r) { p0[r] = NEG; p1[r] = NEG; } return; }
    p0 = f32x16{}; p1 = f32x16{};
    const char* kb[4];
#pragma unroll
    for (int dd = 0; dd < 4; ++dd) kb[dd] = K_lds + KB * SHM_K + KSWZ(r32, (dd * 16 + hi * 8) * 2);
#pragma unroll
    for (int d0 = 0; d0 < 8; ++d0) { const char* a = kb[d0 & 3] + (d0 >> 2) * 128;
        bf16x8 b0 = *reinterpret_cast<const bf16x8*>(a);
        bf16x8 b1 = *reinterpret_cast<const bf16x8*>(a + 32 * 256);
        p0 = __builtin_amdgcn_mfma_f32_32x32x16_bf16(b0, qr[d0], p0, 0, 0, 0);
        p1 = __builtin_amdgcn_mfma_f32_32x32x16_bf16(b1, qr[d0], p1, 0, 0, 0); }
}
template <int VB, bool SK>
__device__ __forceinline__ void pv_tile(f32x16* o, int vb0, bf16x8 pa0, bf16x8 pa1, bf16x8 pa2, bf16x8 pa3, bool act) {
    if (SK && !act) return;
#define TRRD(dst, off) asm volatile("ds_read_b64_tr_b16 %0, %1 offset:%2" : "=&v"(dst) : "v"(vb0), "i"(off) : "memory")
#define PV_D0(d0) do { s16x4 l0, l1, l2, l3, h0, h1, h2, h3; constexpr int b_ = VB * SHM_V + v_rd_off(d0, 0, 0);     \
        TRRD(l0, b_); TRRD(h0, b_ + 2048); TRRD(l1, b_ + 4096); TRRD(h1, b_ + 6144); TRRD(l2, b_ + 8192); TRRD(h2, b_ + 10240); TRRD(l3, b_ + 12288); TRRD(h3, b_ + 14336); \
        asm volatile("s_waitcnt lgkmcnt(0)" ::: "memory"); SBAR();                 \
        o[d0] = __builtin_amdgcn_mfma_f32_32x32x16_bf16(pa0, (bf16x8){l0[0], l0[1], l0[2], l0[3], h0[0], h0[1], h0[2], h0[3]}, o[d0], 0, 0, 0);   \
        o[d0] = __builtin_amdgcn_mfma_f32_32x32x16_bf16(pa1, (bf16x8){l1[0], l1[1], l1[2], l1[3], h1[0], h1[1], h1[2], h1[3]}, o[d0], 0, 0, 0);   \
        o[d0] = __builtin_amdgcn_mfma_f32_32x32x16_bf16(pa2, (bf16x8){l2[0], l2[1], l2[2], l2[3], h2[0], h2[1], h2[2], h2[3]}, o[d0], 0, 0, 0);   \
        o[d0] = __builtin_amdgcn_mfma_f32_32x32x16_bf16(pa3, (bf16x8){l3[0], l3[1], l3[2], l3[3], h3[0], h3[1], h3[2], h3[3]}, o[d0], 0, 0, 0); } while (0)
    PV_D0(0); PV_D0(1); PV_D0(2); PV_D0(3);
#undef PV_D0
#undef TRRD
}

template <class TIn, class TOut> struct BlockRef { const TIn* Q; const TIn* K; const TIn* V; TOut* O; int P0; };
template <class TIn> struct Seam {
    bf16x8 qr[8];
    bf16x8 st_v0, st_v1, st_k0, st_k1; f32x4 sf0, sf1, sf2, sf3;
    f32x4 tq[16];
};
__device__ __forceinline__ int swa_jlo(int P0, int W) { const int lowk = P0 - W + 1; return lowk > 0 ? lowk / KVBLK : 0; }
#define ROW(p, k0, rr) ((p) + (size_t)((k0) + (rr)) * D + sc)
#define VMW() asm volatile("s_waitcnt vmcnt(0)" ::: "memory")
#define VMWN(n) asm volatile("s_waitcnt vmcnt(%0)" :: "i"(n) : "memory")
#define SLOAD_H(Kp, Vp, k0) do { S.st_v0 = load8<TIn>(ROW(Vp, k0, sr)); S.st_v1 = load8<TIn>(ROW(Vp, k0, 32 + sr));              \
                         S.st_k0 = load8<TIn>(ROW(Kp, k0, sr)); S.st_k1 = load8<TIn>(ROW(Kp, k0, 32 + sr)); } while (0)
#define SWRITE_HK(bf) do { *(bf16x8*)(K_lds + (bf) * SHM_K + kws) = S.st_k0; *(bf16x8*)(K_lds + (bf) * SHM_K + kws + 32 * 256) = S.st_k1; } while (0)
#define SWRITE_HV(bf) do { *(bf16x8*)(V_lds + (bf) * SHM_V + vst0) = S.st_v0; *(bf16x8*)(V_lds + (bf) * SHM_V + vst1) = S.st_v1; } while (0)
#define SWRITE_H(bf) do { SWRITE_HV(bf); SWRITE_HK(bf); } while (0)
#define SLOAD_F(p, k0) do { S.sf0 = *(const f32x4*)ROW(p, k0, sr); S.sf1 = *(const f32x4*)(ROW(p, k0, sr) + 4);                \
                            S.sf2 = *(const f32x4*)ROW(p, k0, 32 + sr); S.sf3 = *(const f32x4*)(ROW(p, k0, 32 + sr) + 4); } while (0)
#define SWRITE_KF(bf) do { *(bf16x8*)(K_lds + (bf) * SHM_K + kws) = pack8(S.sf0, S.sf1); *(bf16x8*)(K_lds + (bf) * SHM_K + kws + 32 * 256) = pack8(S.sf2, S.sf3); } while (0)
#define SWRITE_VF(bf) do { *(bf16x8*)(V_lds + (bf) * SHM_V + vst0) = pack8(S.sf0, S.sf1); *(bf16x8*)(V_lds + (bf) * SHM_V + vst1) = pack8(S.sf2, S.sf3); } while (0)
template <class TIn, class TOut>
__device__ __forceinline__ void causal_swa_prime(const BlockRef<TIn, TOut>& cur, int W, char* lds, Seam<TIn>& S) {
    constexpr bool F32 = same_t<TIn, float>::v;
    const int tid = tid_opaque(), wid = __builtin_amdgcn_readfirstlane(tid >> 6), lane = tid & 63, r32 = lane & 31, hi = lane >> 5;
    const int sr = tid >> 4, sc = (tid & 15) * 8, kws = KSWZ(sr, sc * 2); char* K_lds = lds + 2 * SHM_V;
    const int kb0 = swa_jlo(cur.P0, W) * KVBLK;
    for (int d0 = 0; d0 < 8; ++d0) S.qr[d0] = load8<TIn>(cur.Q + (size_t)(wid * QBLK + r32) * D + d0 * 16 + hi * 8);
    if constexpr (F32) { SLOAD_F((const float*)cur.K, kb0); VMW(); SWRITE_KF(0); SBAR(); SLOAD_F((const float*)cur.V, kb0); }
    else { SLOAD_H(cur.K, cur.V, kb0); VMW(); SWRITE_HK(0); }
    __syncthreads();
}
template <class TIn, class TOut>
__device__ __forceinline__ void causal_swa_block(const BlockRef<TIn, TOut>& cur, const BlockRef<TIn, TOut>& nxt, int skv, int W, char* lds, Seam<TIn>& S) {
    constexpr bool F32 = same_t<TIn, float>::v;
    const int tid = tid_opaque(), wid = __builtin_amdgcn_readfirstlane(tid >> 6), lane = tid & 63, r32 = lane & 31, hi = lane >> 5;
    const int j_lo = swa_jlo(cur.P0, W);
    int j_hi = (cur.P0 + QB - 1) / KVBLK + 1; if (j_hi > skv / KVBLK) j_hi = skv / KVBLK;
    const int NT = j_hi - j_lo;
    const int kbn = swa_jlo(nxt.P0, W) * KVBLK;
    const int qlo = cur.P0 + wid * QBLK, qm = qlo + r32 - 4 * hi;
    char* V_lds = lds; char* K_lds = lds + 2 * SHM_V;
    float* ws = (float*)(lds + 2 * SHM_V + 2 * SHM_K) + wid * 64; float* li_l = ws, * al_l = ws + 32;
    float m_reg = -1e30f, l_reg = 0; f32x16 o[4] = {};
    const int sr = tid >> 4, sc = (tid & 15) * 8, vst0 = v_st(sr, sc), vst1 = v_st(32 + sr, sc), kws = KSWZ(sr, sc * 2);
    const int vb0 = (int)(uintptr_t)V_lds + v_rd_base(lane);
    const TIn* Kh = cur.K; const TIn* Vh = cur.V;
#define RESC(a) do { if (__any((a) < 1.f)) { if (hi == 0) al_l[r32] = (a); asm volatile("s_waitcnt lgkmcnt(0)" ::: "memory");              \
                     for (int d_ = 0; d_ < 4; ++d_) for (int r = 0; r < 16; ++r) o[d_][r] *= al_l[crow(r, hi)]; } } while (0)
#define KBASE(t) ((j_lo + (t)) * KVBLK)
#define ACT(t) (KBASE(t) <= qlo + QBLK - 1 && KBASE(t) + KVBLK - 1 >= qlo - W + 1)
#define MASKT(P0_, P1_, t) do { const int kb_ = KBASE(t); if ((!SK || ACT(t)) && (kb_ + KVBLK - 1 > qlo || kb_ <= qlo + QBLK - 1 - W)) mask_tile(P0_, P1_, qm - kb_, (unsigned)W); } while (0)
    constexpr int NQL = F32 ? 16 : 8;
    constexpr bool SK = WSKIP && !F32;
#define SEAM_K0() do { VMWN(NQL); if constexpr (F32) { SWRITE_KF(0); SBAR(); SLOAD_F((const float*)nxt.V, kbn); } else { SWRITE_HK(0); } SBAR(); } while (0)
    f32x16 pA0, pA1, pB0, pB1; float mnA, mnB, alA, alB; bf16x8 pa0, pa1, pa2, pa3;
    if constexpr (F32) { VMW(); SWRITE_VF(0); SBAR(); } else { SWRITE_HV(0); SBAR(); }
    if (NT > 1) { if constexpr (F32) SLOAD_F((const float*)Kh, KBASE(1)); else SLOAD_H(Kh, Vh, KBASE(1)); }
    SBAR(); qkt<0, SK>(pA0, pA1, K_lds, r32, hi, S.qr, ACT(0));
    if constexpr (F32) { if (NT > 1) { VMW(); SWRITE_KF(1); SBAR(); SLOAD_F((const float*)Vh, KBASE(1)); } }
    MASKT(pA0, pA1, 0); partialSM(pA0, pA1, m_reg, mnA, alA);
    if (NT > 1) { VMW(); if constexpr (F32) { SWRITE_VF(1); SBAR(); if (NT > 2) SLOAD_F((const float*)Kh, KBASE(2)); } else SWRITE_H(1); }
    __syncthreads();
#define HALF_STEP(PX0, PX1, mnX, alX, PY0, PY1, alY, t, KB, VB, SB) do {                                                      \
        SBAR(); qkt<KB, SK>(PX0, PX1, K_lds, r32, hi, S.qr, ACT(t));                                             \
        finishSM(PY0, PY1, alY, l_reg, pa0, pa1, pa2, pa3); SBAR();                                                           \
        if ((t) + 1 < NT) { if constexpr (F32) { VMW(); SWRITE_KF(SB); SBAR(); SLOAD_F((const float*)Vh, KBASE((t) + 1)); }  \
                            else { SLOAD_H(Kh, Vh, KBASE((t) + 1)); } SBAR(); }                                               \
        pv_tile<VB, SK>(o, vb0, pa0, pa1, pa2, pa3, ACT((t) - 1)); MASKT(PX0, PX1, (t)); partialSM(PX0, PX1, m_reg, mnX, alX);                                        \
        __syncthreads();                                                                                                      \
        if ((t) + 1 < NT) { VMW(); if constexpr (F32) { SWRITE_VF(SB); SBAR(); if ((t) + 2 < NT) SLOAD_F((const float*)Kh, KBASE((t) + 2)); } \
                            else { SWRITE_H(SB); } }                                                                          \
        RESC(alX); __syncthreads(); } while (0)
    for (int t = 1; t + 1 < NT; t += 2) {
        HALF_STEP(pB0, pB1, mnB, alB, pA0, pA1, alA, t, 1, 0, 0);
        HALF_STEP(pA0, pA1, mnA, alA, pB0, pB1, alB, t + 1, 0, 1, 1);
    }
    const bool even = (NT & 1) == 0;
    if (even) { SBAR(); qkt<1, SK>(pB0, pB1, K_lds, r32, hi, S.qr, ACT(NT - 1)); SBAR(); }
#define QROW(e) (nxt.Q + (size_t)(wid * QBLK + r32) * D + ((e) >> 1) * 16 + hi * 8 + ((e) & 1) * 4)
    if constexpr (F32) { SLOAD_F((const float*)nxt.K, kbn); SBAR();
#pragma unroll
        for (int e = 0; e < 8; ++e) S.tq[e] = *(const f32x4*)QROW(e); }
    else { SLOAD_H(nxt.K, nxt.V, kbn); SBAR();
#pragma unroll
        for (int d0 = 0; d0 < 8; ++d0) S.qr[d0] = load8<TIn>(nxt.Q + (size_t)(wid * QBLK + r32) * D + d0 * 16 + hi * 8); }
    SBAR();
    finishSM(pA0, pA1, alA, l_reg, pa0, pa1, pa2, pa3); SBAR();
    if constexpr (F32) {
#pragma unroll
        for (int e = 8; e < 16; ++e) S.tq[e] = *(const f32x4*)QROW(e); SBAR(); }
#undef QROW
    pv_tile<0, SK>(o, vb0, pa0, pa1, pa2, pa3, ACT(even ? NT - 2 : NT - 1));
    if (even) { MASKT(pB0, pB1, NT - 1); partialSM(pB0, pB1, m_reg, mnB, alB); __syncthreads(); RESC(alB);
        finishSM(pB0, pB1, alB, l_reg, pa0, pa1, pa2, pa3); SBAR(); pv_tile<1, SK>(o, vb0, pa0, pa1, pa2, pa3, ACT(NT - 1)); }
    SBAR(); SEAM_K0();
    if (hi == 0) li_l[r32] = l_reg; asm volatile("s_waitcnt lgkmcnt(0)" ::: "memory");
    float rli[16];
#pragma unroll
    for (int r = 0; r < 16; ++r) rli[r] = __builtin_amdgcn_rcpf(li_l[crow(r, hi)]);
    TOut* Ow = cur.O + (size_t)(wid * QBLK) * D;
#pragma unroll
    for (int r = 0; r < 16; ++r) { const int orow = crow(r, hi);
#pragma unroll
        for (int d0 = 0; d0 < 4; ++d0) { const float v = o[d0][r] * rli[r];
            if constexpr (same_t<TOut, float>::v) { Ow[(size_t)orow * D + d0 * 32 + r32] = v; }
            else { const float vn = __shfl_xor(v, 1);
                   if ((r32 & 1) == 0) *(unsigned*)(Ow + (size_t)orow * D + d0 * 32 + r32) = cvtpk(v, vn); } } }
    if constexpr (F32) {
#pragma unroll
        for (int d0 = 0; d0 < 8; ++d0) S.qr[d0] = pack8(S.tq[2 * d0], S.tq[2 * d0 + 1]); }
    __syncthreads();
#undef RESC
#undef KBASE
#undef ACT
#undef MASKT
#undef SEAM_K0
#undef HALF_STEP
}
#undef ROW
#undef VMW
#undef VMWN
#undef SLOAD_H
#undef SWRITE_HK
#undef SWRITE_HV
#undef SWRITE_H
#undef SLOAD_F
#undef SWRITE_KF
#undef SWRITE_VF

}

#define XB_TMO      128
#define XB_XCNT(j)  (256  + 64 * (j))
#define XB_XSUB(j)  (1280 + 64 * (j))
#define XB_XGEN(j)  (2304 + 64 * (j))
#define XB_TOP      3328
#define XB_TOPGEN   3392
#define XCD_BAR_WORDS 3456
#define XB_SPIN_CAP (1u << 18)
#define LAS __attribute__((address_space(3)))

__device__ __forceinline__ unsigned xb_ld(unsigned* p)              { return __hip_atomic_load(p, __ATOMIC_RELAXED, __HIP_MEMORY_SCOPE_AGENT); }
__device__ __forceinline__ unsigned xb_add(unsigned* p, unsigned v) { return __hip_atomic_fetch_add(p, v, __ATOMIC_RELAXED, __HIP_MEMORY_SCOPE_AGENT); }
__device__ __forceinline__ unsigned xb_xcc_id() { return (unsigned)__builtin_amdgcn_s_getreg((3 << 11) | 20) & 0xFu; }
#define XB_SPIN(cond, bar) do { unsigned _sp = 0; while (cond) { __builtin_amdgcn_s_sleep(1); \
    if ((++_sp & 255u) == 0u) { if (xb_ld(&(bar)[XB_TMO])) break; if (_sp > XB_SPIN_CAP) { atomicAdd(&(bar)[XB_TMO], 1u); break; } } } } while (0)

struct XcdBarrier {
    unsigned* bar; unsigned x;
    volatile LAS unsigned* st;
};

__device__ __forceinline__ XcdBarrier xcd_barrier_post(unsigned* bar, volatile LAS unsigned* st) {
    XcdBarrier b; b.bar = bar; b.x = xb_xcc_id(); b.st = st;
    if (threadIdx.x == 0) (void)xb_add(&bar[XB_XCNT(b.x)], 1u);
    return b;
}
__device__ __forceinline__ void xcd_barrier_complete(unsigned* bar, unsigned x, unsigned& nloc, unsigned& nx) {
    const unsigned G = gridDim.x * gridDim.y * gridDim.z;
    unsigned sum, cnt, mine, sp = 0u;
    for (;;) {
        sum = 0u; cnt = 0u; mine = 0u;
#pragma unroll
        for (unsigned j = 0; j < 16; ++j) { const unsigned c = xb_ld(&bar[XB_XCNT(j)]); sum += c; cnt += (c > 0u) ? 1u : 0u; mine = (j == x) ? c : mine; }
        if (sum == G) break;
        __builtin_amdgcn_s_sleep(1);
        if ((++sp & 255u) == 0u) { if (xb_ld(&bar[XB_TMO])) break; if (sp > XB_SPIN_CAP) { atomicAdd(&bar[XB_TMO], 1u); break; } }
    }
    nloc = mine > 0u ? mine : 1u; nx = cnt > 0u ? cnt : 1u;
}

__device__ __forceinline__ void xcd_barrier(const XcdBarrier& b) {
    asm volatile("s_waitcnt vmcnt(0)" ::: "memory");
    __syncthreads();
    if (threadIdx.x == 0) {
        unsigned* bar = b.bar;
        __builtin_amdgcn_s_waitcnt(0);
        unsigned nloc = b.st[0], nx = b.st[1];
        if (nloc == 0u) { xcd_barrier_complete(bar, b.x, nloc, nx); b.st[0] = nloc; b.st[1] = nx; }
        const unsigned old = xb_add(&bar[XB_XSUB(b.x)], 1u);
        const unsigned gen = old / nloc;
        if (old + 1u == (gen + 1u) * nloc) {
            __builtin_amdgcn_fence(__ATOMIC_RELEASE, "agent");
            asm volatile("s_waitcnt vmcnt(0)" ::: "memory");
            const unsigned og = xb_add(&bar[XB_TOP], 1u);
            const unsigned tg = og / nx;
            if (og + 1u == (tg + 1u) * nx) xb_add(&bar[XB_TOPGEN], 1u);
            else XB_SPIN(xb_ld(&bar[XB_TOPGEN]) == tg, bar);
            __builtin_amdgcn_fence(__ATOMIC_ACQUIRE, "agent");
            xb_add(&bar[XB_XGEN(b.x)], 1u);
            asm volatile("s_waitcnt vmcnt(0)" ::: "memory");
        } else {
            XB_SPIN(xb_ld(&bar[XB_XGEN(b.x)]) == gen, bar);
            __builtin_amdgcn_fence(__ATOMIC_ACQUIRE, "agent");
            asm volatile("s_waitcnt vmcnt(0)" ::: "memory");
        }
    }
    __syncthreads();
}

constexpr int D_MODEL = 4096, BATCH = 4, SEQ = 4096, DEPTH = 2, M_TOK = BATCH * SEQ;
constexpr int IN_WIDTH = 12288, D_FF = 16384, LRU_W = 1024, HG_W = 1024, DIFF_W = 2048;
constexpr int OFF_A_GATE = 0, OFF_A_X = 1024, OFF_B_Q = 2048, OFF_B_F = 3072, OFF_B_I = 4096, OFF_B_G = 5120, OFF_C_Q = 6144, OFF_C_K = 8192, OFF_C_V = 10240;
constexpr float NORM_EPS = 1e-6f;
constexpr int NWAVES = 8, NTHREADS = NWAVES * 64;
constexpr int N_INPUTS = 21;
enum { I_X = 0, I_LN1, I_WIN, I_CONVW, I_CONVB, I_WR, I_BR, I_WI, I_BI, I_LAM, I_LRUG, I_HLB, I_HNG, I_QNG, I_KNG, I_DLAM, I_SUBLN, I_WOUT, I_LN2, I_WFF1, I_WFF2 };

constexpr size_t MiB = (size_t)1 << 20;
constexpr size_t WS_CTL = 0, CTL_ZERO_BYTES = 1 * MiB;
constexpr size_t WS_LB = 1 * MiB;
constexpr size_t WS_ROPE = 2 * MiB;
constexpr size_t WS_WGATE = 4 * MiB;
constexpr size_t WS_WIN = 16 * MiB;
constexpr size_t WS_WOUT = 208 * MiB;
constexpr size_t WS_WFF1 = 272 * MiB;
constexpr size_t WS_WFF2 = 528 * MiB;
constexpr size_t WS_H = 784 * MiB;
constexpr size_t WS_YCAT = 912 * MiB;
constexpr size_t WS_Z = 1040 * MiB;
constexpr size_t WS_XA = 1424 * MiB;
constexpr size_t WS_RI = 1456 * MiB;
constexpr size_t WS_QT = 1520 * MiB;
constexpr size_t WS_KK = 1552 * MiB;
constexpr size_t WS_QH = 1584 * MiB, WS_KH = 1648 * MiB, WS_VH = 1712 * MiB;
constexpr size_t WS_OATT = 1776 * MiB;
constexpr size_t WS_YAPRE = 1904 * MiB;
constexpr size_t WS_OBPRE = 1968 * MiB;
constexpr size_t WS_LSUM = 2032 * MiB;
constexpr size_t WS_HID = 1040 * MiB;
constexpr size_t WS_END = 2034 * MiB;
constexpr int CW_BAR = 4096;

constexpr int RING_BYTES = 131072, MISC_OFF = RING_BYTES + 320, LDS_BYTES = 147456;

#define GAS __attribute__((address_space(1)))
typedef unsigned short bf16r;
typedef unsigned v4u __attribute__((ext_vector_type(4)));
typedef unsigned v2u __attribute__((ext_vector_type(2)));
typedef float f32x4 __attribute__((ext_vector_type(4)));
typedef float f32x2 __attribute__((ext_vector_type(2)));
#define LDS_WAIT() asm volatile("s_waitcnt lgkmcnt(0)" ::: "memory")
__device__ __forceinline__ float bflo(unsigned w) { return __uint_as_float(w << 16); }
__device__ __forceinline__ float bfhi(unsigned w) { return __uint_as_float(w & 0xffff0000u); }
__device__ __forceinline__ float bf1(bf16r b) { return __uint_as_float((unsigned)b << 16); }
__device__ __forceinline__ unsigned pk2(float lo, float hi) { return pk_bf16_builtin(lo, hi); }
__device__ __forceinline__ float wave_sum(float v) {
#pragma unroll
    for (int o = 1; o < 64; o <<= 1) v += __shfl_xor(v, o);
    return v;
}
__device__ __forceinline__ float fast_exp(float x) { return __builtin_amdgcn_exp2f(x * 1.4426950408889634f); }
__device__ __forceinline__ float sigmoidf_(float x) { return __builtin_amdgcn_rcpf(1.0f + fast_exp(-x)); }

__device__ __forceinline__ void p0_transpose_item(const float* W, int K, int N, bf16r* WT, LAS float* scr, int item, int lane) {
    const int nblk = N / 32, kb = item / nblk, nb = item % nblk, k0 = 64 * kb, n0 = 32 * nb;
#pragma unroll 8
    for (int i = 0; i < 32; ++i) { const int kk = 2 * i + (lane >> 5); scr[kk * 33 + (lane & 31)] = W[(size_t)(k0 + kk) * N + n0 + (lane & 31)]; }
    LDS_WAIT(); asm volatile("" ::: "memory");
    const int c = lane & 7;
#pragma unroll
    for (int j = 0; j < 4; ++j) { const int n = (lane >> 3) + 8 * j; const LAS float* s = scr + (8 * c) * 33 + n;
        v4u o; o.x = pk2(s[0 * 33], s[1 * 33]); o.y = pk2(s[2 * 33], s[3 * 33]); o.z = pk2(s[4 * 33], s[5 * 33]); o.w = pk2(s[6 * 33], s[7 * 33]);
        *(v4u*)(WT + (size_t)(n0 + n) * K + k0 + 8 * c) = o; }
    LDS_WAIT(); asm volatile("" ::: "memory");
}

struct Args { const float* in[N_INPUTS]; float* out; unsigned char* ws; int ph_lo, ph_hi; };

constexpr int PH_PER_LAYER = 13, N_PHASES = 1 + DEPTH * PH_PER_LAYER;

__device__ __forceinline__ float neg_expm1(float x) {
    if (x > -0.3f) { float p = 1.0f + x * (1.0f / 7.0f); p = 1.0f + x * (1.0f / 6.0f) * p; p = 1.0f + x * 0.2f * p; p = 1.0f + x * 0.25f * p; p = 1.0f + x * (1.0f / 3.0f) * p; p = 1.0f + x * 0.5f * p; return -x * p; }
    return 1.0f - fast_exp(x);
}
__device__ __forceinline__ void lru_step(float r, float ig, float x, float sp8, bool first, float& h, float& A) {
    const float la = -r * sp8; const float a = fast_exp(la);
    const float mult = first ? 1.0f : sqrtf(neg_expm1(2.0f * la));
    h = a * h + mult * (ig * x); A += la;
}
__device__ __forceinline__ float gelu_tanh(float x) { const float y = 1.5957691216057308f * (x + 0.044715f * x * x * x); return x * __builtin_amdgcn_rcpf(1.0f + fast_exp(-y)); }

typedef const __attribute__((address_space(4))) unsigned char* kargp_t;
__device__ __forceinline__ kargp_t karg_base() { kargp_t kp = (kargp_t)__builtin_amdgcn_kernarg_segment_ptr(); asm volatile("" : "+s"(kp)); return kp; }
__device__ __forceinline__ const float* karg_in(int i) { return *(const float* const __attribute__((address_space(4)))*)(karg_base() + 8 * i); }
__device__ __forceinline__ float* karg_out() { return *(float* const __attribute__((address_space(4)))*)(karg_base() + 8 * N_INPUTS); }
__device__ __forceinline__ unsigned char* karg_ws() { return *(unsigned char* const __attribute__((address_space(4)))*)(karg_base() + 8 * N_INPUTS + 8); }
__device__ __forceinline__ int karg_int(int i) { return *(const int __attribute__((address_space(4)))*)(karg_base() + 8 * N_INPUTS + 16 + 4 * i); }
#define WSP(T, off) ((T*)(karg_ws() + (off)))
#define PHASE_IDS const int tid = tid_opaque(), lane = tid & 63, wave = __builtin_amdgcn_readfirstlane(tid >> 6), gw = vcu * NWAVES + wave; (void)tid; (void)lane; (void)wave; (void)gw

typedef short hg_bf16x8 __attribute__((ext_vector_type(8)));
#define HG_MFMA(a, b, c) __builtin_amdgcn_mfma_f32_16x16x32_bf16((a), (b), (c), 0, 0, 0)
#if defined(DBG_HG_NOPREFETCH)
#define HG_BAR() __syncthreads()
#else
#define HG_BAR() do { asm volatile("s_waitcnt vmcnt(0) lgkmcnt(0)" ::: "memory"); __builtin_amdgcn_s_barrier(); asm volatile("" ::: "memory"); } while (0)
#endif
#if defined(DBG_HG_NOPREFETCH)
#define HG_BARL() HG_BAR()
#else
#define HG_BARL() do { asm volatile("s_waitcnt lgkmcnt(0)" ::: "memory"); __builtin_amdgcn_s_barrier(); asm volatile("" ::: "memory"); } while (0)
#endif
__device__ __forceinline__ void hgrn_chunked(LAS unsigned char* L, const bf16r* QT, const bf16r* KK, const bf16r* Z, float* OBPRE, int b, int h, int tid, bool check, unsigned* flag, void* dbgbuf) {
    constexpr int QS = 0, KS = 17408, KT = 34816, VT = 53248, STO = 71680, PS = 106496, SP = 115712, DM = 123904, DH = 124416;
    constexpr int RS = 272, TS = 144;
    const int lane = tid & 63, wave = __builtin_amdgcn_readfirstlane(tid >> 6), lr = lane & 15, lq = lane >> 4;
    const int u = tid & 255, j8 = (u & 15) * 8, seg = u >> 4;
    const bool scaler = wave < 4;
    const bool backward = wave < 2;
    const size_t tok0 = (size_t)b * SEQ;
    f32x4 stm[8];
#pragma unroll
    for (int n = 0; n < 8; ++n) stm[n] = (f32x4){0.f, 0.f, 0.f, 0.f};
    v4u ldA[4], ldB[4];
#define HG_ISSUE(c) do { const size_t m_ = tok0 + (size_t)(c) * 64 + 4 * seg; \
        if (scaler) { _Pragma("unroll") for (int r = 0; r < 4; ++r) { ldA[r] = *(const v4u*)(KK + (m_ + r) * HG_W + h * 128 + j8); ldB[r] = *(const v4u*)(QT + (m_ + r) * HG_W + h * 128 + j8); } } \
        else { _Pragma("unroll") for (int r = 0; r < 4; ++r) ldA[r] = *(const v4u*)(Z + (m_ + r) * IN_WIDTH + OFF_B_I + h * 128 + j8); } } while (0)
    HG_ISSUE(0);
#pragma unroll 1
    for (int c = 0; c < SEQ / 64; ++c) {
#if defined(DBG_HG_NOPREFETCH)
        if (c > 0) HG_ISSUE(c);
#endif
        float loc[4][8], Lp[8];
        if (scaler) {
            asm volatile("s_waitcnt vmcnt(0)" ::: "memory");
            const unsigned kw0[4] = {ldA[0].x, ldA[0].y, ldA[0].z, ldA[0].w}, kw1[4] = {ldA[1].x, ldA[1].y, ldA[1].z, ldA[1].w}, kw2[4] = {ldA[2].x, ldA[2].y, ldA[2].z, ldA[2].w}, kw3[4] = {ldA[3].x, ldA[3].y, ldA[3].z, ldA[3].w};
#pragma unroll
            for (int e = 0; e < 8; ++e) {
                const float f0 = 1.0f - ((e & 1) ? bfhi(kw0[e >> 1]) : bflo(kw0[e >> 1])), f1 = 1.0f - ((e & 1) ? bfhi(kw1[e >> 1]) : bflo(kw1[e >> 1]));
                const float f2 = 1.0f - ((e & 1) ? bfhi(kw2[e >> 1]) : bflo(kw2[e >> 1])), f3 = 1.0f - ((e & 1) ? bfhi(kw3[e >> 1]) : bflo(kw3[e >> 1]));
                if (backward) { loc[3][e] = 1.0f; loc[2][e] = f3; loc[1][e] = f3 * f2; loc[0][e] = f3 * f2 * f1; Lp[e] = loc[0][e] * f0; }
                else { loc[0][e] = f0; loc[1][e] = f0 * f1; loc[2][e] = loc[1][e] * f2; loc[3][e] = loc[2][e] * f3; Lp[e] = loc[3][e]; }
            }
            *(LAS f32x4*)(L + SP + (seg * 128 + j8) * 4) = (f32x4){Lp[0], Lp[1], Lp[2], Lp[3]};
            *(LAS f32x4*)(L + SP + (seg * 128 + j8) * 4 + 16) = (f32x4){Lp[4], Lp[5], Lp[6], Lp[7]};
        }
        HG_BAR();
        if (scaler) {
            float X[8];
#pragma unroll
            for (int e = 0; e < 8; ++e) X[e] = 1.0f;
#pragma unroll
            for (int k = 0; k < 7; ++k) {
                const int sp = backward ? (1 + k) : (8 + k);
                const bool use = backward ? (sp > seg) : (sp < seg);
                const f32x4 a = *(const LAS f32x4*)(L + SP + (sp * 128 + j8) * 4), b4 = *(const LAS f32x4*)(L + SP + (sp * 128 + j8) * 4 + 16);
                X[0] *= use ? a.x : 1.0f; X[1] *= use ? a.y : 1.0f; X[2] *= use ? a.z : 1.0f; X[3] *= use ? a.w : 1.0f;
                X[4] *= use ? b4.x : 1.0f; X[5] *= use ? b4.y : 1.0f; X[6] *= use ? b4.z : 1.0f; X[7] *= use ? b4.w : 1.0f;
            }
            if (seg == 0) { *(LAS f32x4*)(L + DM + j8 * 4) = (f32x4){Lp[0] * X[0], Lp[1] * X[1], Lp[2] * X[2], Lp[3] * X[3]}; *(LAS f32x4*)(L + DM + j8 * 4 + 16) = (f32x4){Lp[4] * X[4], Lp[5] * X[5], Lp[6] * X[6], Lp[7] * X[7]}; }
            if (seg == 15) { *(LAS f32x4*)(L + DH + j8 * 4) = (f32x4){Lp[0] * X[0], Lp[1] * X[1], Lp[2] * X[2], Lp[3] * X[3]}; *(LAS f32x4*)(L + DH + j8 * 4 + 16) = (f32x4){Lp[4] * X[4], Lp[5] * X[5], Lp[6] * X[6], Lp[7] * X[7]}; }
            unsigned kt[8][2];
#pragma unroll
            for (int r = 0; r < 4; ++r) {
                float qs[8], ks[8];
                const unsigned kwr[4] = {ldA[r].x, ldA[r].y, ldA[r].z, ldA[r].w}, qwr[4] = {ldB[r].x, ldB[r].y, ldB[r].z, ldB[r].w};
#pragma unroll
                for (int e = 0; e < 8; ++e) {
                    float E, IE;
                    if (backward) { IE = fmaxf(loc[r][e] * X[e], 1.0e-30f); E = __builtin_amdgcn_rcpf(IE); }
                    else { E = fmaxf(loc[r][e] * X[e], 1.0e-30f); IE = __builtin_amdgcn_rcpf(E); }
#if defined(DBG_HG_NOSCALE)
                    E = 1.0f; IE = 1.0f;
#endif
                    qs[e] = ((e & 1) ? bfhi(qwr[e >> 1]) : bflo(qwr[e >> 1])) * E; ks[e] = ((e & 1) ? bfhi(kwr[e >> 1]) : bflo(kwr[e >> 1])) * IE;
                }
                v4u wq, wk; wq.x = pk2(qs[0], qs[1]); wq.y = pk2(qs[2], qs[3]); wq.z = pk2(qs[4], qs[5]); wq.w = pk2(qs[6], qs[7]);
                wk.x = pk2(ks[0], ks[1]); wk.y = pk2(ks[2], ks[3]); wk.z = pk2(ks[4], ks[5]); wk.w = pk2(ks[6], ks[7]);
                *(LAS v4u*)(L + QS + (4 * seg + r) * RS + j8 * 2) = wq; *(LAS v4u*)(L + KS + (4 * seg + r) * RS + j8 * 2) = wk;
                const unsigned kw[4] = {wk.x, wk.y, wk.z, wk.w};
#pragma unroll
                for (int e = 0; e < 8; ++e) { const unsigned hv = (e & 1) ? (kw[e >> 1] >> 16) : (kw[e >> 1] & 0xffffu);
                    if (r == 0) kt[e][0] = hv; else if (r == 1) kt[e][0] |= hv << 16; else if (r == 2) kt[e][1] = hv; else kt[e][1] |= hv << 16; }
            }
#pragma unroll
            for (int e = 0; e < 8; ++e) *(LAS v2u*)(L + KT + (j8 + e) * TS + (4 * seg) * 2) = (v2u){kt[e][0], kt[e][1]};
        } else {
            asm volatile("s_waitcnt vmcnt(0)" ::: "memory");
            const unsigned vw[4][4] = {{ldA[0].x, ldA[0].y, ldA[0].z, ldA[0].w}, {ldA[1].x, ldA[1].y, ldA[1].z, ldA[1].w}, {ldA[2].x, ldA[2].y, ldA[2].z, ldA[2].w}, {ldA[3].x, ldA[3].y, ldA[3].z, ldA[3].w}};
#pragma unroll
            for (int e = 0; e < 8; ++e) {
                unsigned h0, h1, h2, h3;
                if (e & 1) { h0 = vw[0][e >> 1] >> 16; h1 = vw[1][e >> 1] >> 16; h2 = vw[2][e >> 1] >> 16; h3 = vw[3][e >> 1] >> 16; }
                else { h0 = vw[0][e >> 1] & 0xffffu; h1 = vw[1][e >> 1] & 0xffffu; h2 = vw[2][e >> 1] & 0xffffu; h3 = vw[3][e >> 1] & 0xffffu; }
                *(LAS v2u*)(L + VT + (j8 + e) * TS + (4 * seg) * 2) = (v2u){h0 | (h1 << 16), h2 | (h3 << 16)};
            }
        }
        HG_BARL();
#pragma unroll
        for (int n = 0; n < 8; ++n) {
            const f32x4 dm = *(const LAS f32x4*)(L + DM + (16 * n + 4 * lq) * 4); const f32x4 sv = stm[n] * dm;
            *(LAS v2u*)(L + STO + (16 * wave + lr) * RS + (16 * n + 4 * lq) * 2) = (v2u){pk2(sv.x, sv.y), pk2(sv.z, sv.w)};
        }
        {
            const int ti = wave >> 1;
#pragma unroll
            for (int jj = 0; jj < 2; ++jj) {
                const int sj = 2 * (wave & 1) + jj;
                f32x4 acc = (f32x4){0.f, 0.f, 0.f, 0.f};
#pragma unroll
                for (int ks = 0; ks < 4; ++ks) {
                    const hg_bf16x8 a = *(const LAS hg_bf16x8*)(L + KS + (16 * sj + lr) * RS + (ks * 32 + 8 * lq) * 2);
                    const hg_bf16x8 bq = *(const LAS hg_bf16x8*)(L + QS + (16 * ti + lr) * RS + (ks * 32 + 8 * lq) * 2);
                    acc = HG_MFMA(a, bq, acc);
                }
                {
                    const int s0 = 16 * sj + 4 * lq, tt = 16 * ti + lr;
                    acc.x = (s0 + 0 <= tt) ? acc.x : 0.f; acc.y = (s0 + 1 <= tt) ? acc.y : 0.f; acc.z = (s0 + 2 <= tt) ? acc.z : 0.f; acc.w = (s0 + 3 <= tt) ? acc.w : 0.f;
                }
                *(LAS v2u*)(L + PS + (16 * ti + lr) * TS + (16 * sj + 4 * lq) * 2) = (v2u){pk2(acc.x, acc.y), pk2(acc.z, acc.w)};
            }
        }
#if !defined(DBG_HG_NOPREFETCH)
        if (c + 1 < SEQ / 64) HG_ISSUE(c + 1);
#endif
        HG_BARL();
        f32x4 o[4];
        {
#pragma unroll
            for (int i = 0; i < 4; ++i) o[i] = (f32x4){0.f, 0.f, 0.f, 0.f};
            hg_bf16x8 bs[4];
#pragma unroll
            for (int ks = 0; ks < 4; ++ks) bs[ks] = *(const LAS hg_bf16x8*)(L + STO + (16 * wave + lr) * RS + (ks * 32 + 8 * lq) * 2);
#pragma unroll
            for (int i = 0; i < 4; ++i)
#pragma unroll
                for (int ks = 0; ks < 4; ++ks) { const hg_bf16x8 a = *(const LAS hg_bf16x8*)(L + QS + (16 * i + lr) * RS + (ks * 32 + 8 * lq) * 2); o[i] = HG_MFMA(a, bs[ks], o[i]); }
            hg_bf16x8 bv[2];
#pragma unroll
            for (int ks = 0; ks < 2; ++ks) bv[ks] = *(const LAS hg_bf16x8*)(L + VT + (16 * wave + lr) * TS + (ks * 32 + 8 * lq) * 2);
#pragma unroll
            for (int i = 0; i < 4; ++i)
#pragma unroll
                for (int ks = 0; ks < 2; ++ks) { if (ks == 1 && i < 2) continue; const hg_bf16x8 a = *(const LAS hg_bf16x8*)(L + PS + (16 * i + lr) * TS + (ks * 32 + 8 * lq) * 2); o[i] = HG_MFMA(a, bv[ks], o[i]); }
#pragma unroll
            for (int n = 0; n < 8; ++n) {
                f32x4 U = (f32x4){0.f, 0.f, 0.f, 0.f};
#pragma unroll
                for (int ks = 0; ks < 2; ++ks) { const hg_bf16x8 a = *(const LAS hg_bf16x8*)(L + KT + (16 * n + lr) * TS + (ks * 32 + 8 * lq) * 2); U = HG_MFMA(a, bv[ks], U); }
                const f32x4 dm = *(const LAS f32x4*)(L + DM + (16 * n + 4 * lq) * 4), dh = *(const LAS f32x4*)(L + DH + (16 * n + 4 * lq) * 4);
#if defined(DBG_HG_NOSTATE)
                (void)U; (void)dm; (void)dh;
#else
                stm[n] = stm[n] * (dm * dh) + dh * U;
#endif
            }
        }
#if defined(DBG_HG_COPY)
#pragma unroll
        for (int i = 0; i < 4; ++i) {
            const int cc = 16 * wave + lr;
#if DBG_HG_COPY == 1
            o[i].x = bf1(*(const LAS bf16r*)(L + QS + (16 * i + 4 * lq + 0) * RS + cc * 2)); o[i].y = bf1(*(const LAS bf16r*)(L + QS + (16 * i + 4 * lq + 1) * RS + cc * 2));
            o[i].z = bf1(*(const LAS bf16r*)(L + QS + (16 * i + 4 * lq + 2) * RS + cc * 2)); o[i].w = bf1(*(const LAS bf16r*)(L + QS + (16 * i + 4 * lq + 3) * RS + cc * 2));
#elif DBG_HG_COPY == 2
            o[i].x = bf1(*(const LAS bf16r*)(L + VT + cc * TS + (16 * i + 4 * lq + 0) * 2)); o[i].y = bf1(*(const LAS bf16r*)(L + VT + cc * TS + (16 * i + 4 * lq + 1) * 2));
            o[i].z = bf1(*(const LAS bf16r*)(L + VT + cc * TS + (16 * i + 4 * lq + 2) * 2)); o[i].w = bf1(*(const LAS bf16r*)(L + VT + cc * TS + (16 * i + 4 * lq + 3) * 2));
#else
            o[i].x = bf1(*(const LAS bf16r*)(L + PS + (16 * i + 4 * lq + 0) * TS + (cc & 63) * 2)); o[i].y = bf1(*(const LAS bf16r*)(L + PS + (16 * i + 4 * lq + 1) * TS + (cc & 63) * 2));
            o[i].z = bf1(*(const LAS bf16r*)(L + PS + (16 * i + 4 * lq + 2) * TS + (cc & 63) * 2)); o[i].w = bf1(*(const LAS bf16r*)(L + PS + (16 * i + 4 * lq + 3) * TS + (cc & 63) * 2));
#endif
        }
#endif
        HG_BARL();
#pragma unroll
        for (int i = 0; i < 4; ++i) {
            *(LAS float*)(L + (16 * i + 4 * lq + 0) * 528 + (16 * wave + lr) * 4) = o[i].x; *(LAS float*)(L + (16 * i + 4 * lq + 1) * 528 + (16 * wave + lr) * 4) = o[i].y;
            *(LAS float*)(L + (16 * i + 4 * lq + 2) * 528 + (16 * wave + lr) * 4) = o[i].z; *(LAS float*)(L + (16 * i + 4 * lq + 3) * 528 + (16 * wave + lr) * 4) = o[i].w;
        }
        HG_BARL();
        if (!check) {
#pragma unroll
            for (int k = 0; k < 4; ++k) { const int pc = tid + 512 * k, row = pc >> 5, col = (pc & 31) * 4;
                *(f32x4*)(OBPRE + (tok0 + (size_t)c * 64 + row) * HG_W + h * 128 + col) = *(const LAS f32x4*)(L + row * 528 + col * 4); }
        }
    }
#undef HG_ISSUE
}

__device__ __forceinline__ ab::BlockRef<__hip_bfloat16, __hip_bfloat16> attn_ref(const __hip_bfloat16* Qp, const __hip_bfloat16* Kp, const __hip_bfloat16* Vp, __hip_bfloat16* Op, int L, int pass) {
    const int bh = L >> 3, x = L & 7, qb = pass ? 15 - x : x;
    const int b = bh >> 5, hq = bh & 31, h = hq >> 2, c = (hq >> 1) & 1, vh = hq & 1;
    ab::BlockRef<__hip_bfloat16, __hip_bfloat16> r;
    r.Q = Qp + ((size_t)(b * 16 + h * 2 + c) * SEQ + (size_t)qb * 256) * 128;
    r.K = Kp + (size_t)(b * 16 + h * 2 + c) * SEQ * 128;
    r.V = Vp + (size_t)(b * 16 + h * 2 + vh) * SEQ * 128;
    r.O = Op + ((size_t)(b * 32 + hq) * SEQ + (size_t)qb * 256) * 128;
    r.P0 = qb * 256;
    return r;
}

__global__ void __launch_bounds__(NTHREADS, 2) hymba_fwd(Args args) {
    extern __shared__ __attribute__((aligned(16))) unsigned char lds[];
    LAS unsigned char* ldsl = (LAS unsigned char*)lds;
    const int G = gridDim.x;
    const int bx = blockIdx.x;
    const int vcu = (G % 8 == 0) ? (bx % 8) * (G / 8) + bx / 8 : bx;
    const int ngw = G * NWAVES;
    volatile LAS unsigned* MISC = (volatile LAS unsigned*)(ldsl + MISC_OFF);
    for (int u = threadIdx.x; u < (LDS_BYTES - RING_BYTES) / 4; u += NTHREADS) ((LAS unsigned*)(ldsl + RING_BYTES))[u] = 0u;
    __syncthreads();
    const int lo = karg_int(0), hi = karg_int(1);
    const bool multi = (hi - lo) > 1;
    XcdBarrier bar; bar.bar = WSP(unsigned, WS_CTL) + CW_BAR; bar.x = 0; bar.st = nullptr;
    if (multi) bar = xcd_barrier_post(WSP(unsigned, WS_CTL) + CW_BAR, MISC + 8);
#ifndef EN_MASK
#define EN_MASK 0xFFFF
#endif
#define ENK(j) (((EN_MASK) >> (j)) & 1)
#ifndef DBG_TWICE_MASK
#define DBG_TWICE_MASK 0
#endif
#define REPS(j) ((((DBG_TWICE_MASK) >> (j)) & 1) ? 2 : 1)
#define IN(k) (lo <= (k) && (k) < hi)
#define SEAM(k) do { if (IN((k) + 1)) xcd_barrier(bar); } while (0)

    if (ENK(15) && IN(0)) {
        PHASE_IDS;
        for (int rep_ = 0; rep_ < REPS(15); ++rep_) {
        bf16r* const W_IN = WSP(bf16r, WS_WIN);
        bf16r* const W_OUT = WSP(bf16r, WS_WOUT);
        bf16r* const W_FF1 = WSP(bf16r, WS_WFF1);
        bf16r* const W_FF2 = WSP(bf16r, WS_WFF2);
        bf16r* const W_GATE = WSP(bf16r, WS_WGATE);
        float* const LB = WSP(float, WS_LB);
        float* const ROPE_COS = WSP(float, WS_ROPE); float* const ROPE_SIN = ROPE_COS + SEQ * 64;
        LAS float* scr = (LAS float*)(ldsl + wave * 16384);
        constexpr int I_IN = (D_MODEL / 64) * (IN_WIDTH / 32), I_OUT = (D_MODEL / 64) * (D_MODEL / 32), I_F1 = (D_MODEL / 64) * (D_FF / 32), I_F2 = (D_FF / 64) * (D_MODEL / 32);
        constexpr int I_LAYER = I_IN + I_OUT + I_F1 + I_F2;
        for (int it = gw; it < DEPTH * I_LAYER; it += ngw) {
            const int l = it / I_LAYER; int r = it - l * I_LAYER;
            if (r < I_IN) { p0_transpose_item(karg_in(I_WIN) + (size_t)l * D_MODEL * IN_WIDTH, D_MODEL, IN_WIDTH, W_IN + (size_t)l * IN_WIDTH * D_MODEL, scr, r, lane); continue; } r -= I_IN;
            if (r < I_OUT) { p0_transpose_item(karg_in(I_WOUT) + (size_t)l * D_MODEL * D_MODEL, D_MODEL, D_MODEL, W_OUT + (size_t)l * D_MODEL * D_MODEL, scr, r, lane); continue; } r -= I_OUT;
            if (r < I_F1) { p0_transpose_item(karg_in(I_WFF1) + (size_t)l * D_MODEL * D_FF, D_MODEL, D_FF, W_FF1 + (size_t)l * D_FF * D_MODEL, scr, r, lane); continue; } r -= I_F1;
            p0_transpose_item(karg_in(I_WFF2) + (size_t)l * D_FF * D_MODEL, D_FF, D_MODEL, W_FF2 + (size_t)l * D_MODEL * D_FF, scr, r, lane);
        }
        for (int idx = gw * 64 + lane; idx < DEPTH * 2048 * 128; idx += ngw * 64) {
            const int l = idx / (2048 * 128), n = (idx / 128) % 2048, k0 = (idx % 128) * 8;
            const int g = n >> 10, nn = n & 1023, h = nn >> 7, j = nn & 127;
            v4u o = {0u, 0u, 0u, 0u};
            if ((k0 >> 7) == h) { const float* w = karg_in(g ? I_WI : I_WR) + (((size_t)l * 8 + h) * 128 + (k0 & 127)) * 128 + j;
                o.x = pk2(w[0 * 128], w[1 * 128]); o.y = pk2(w[2 * 128], w[3 * 128]); o.z = pk2(w[4 * 128], w[5 * 128]); o.w = pk2(w[6 * 128], w[7 * 128]); }
            *(v4u*)(W_GATE + ((size_t)l * 2048 + n) * 1024 + k0) = o;
        }
        for (int c = gw * 64 + lane; c < HG_W; c += ngw * 64) {
            const float b0 = karg_in(I_HLB)[c], b1 = karg_in(I_HLB)[HG_W + c]; const float mx = fmaxf(b0, b1);
            const float e0 = __expf(b0 - mx), e1 = __expf(b1 - mx);
            LB[c] = 0.f; LB[HG_W + c] = e1 / (e0 + e1);
        }
        for (int idx = gw * 64 + lane; idx < SEQ * 64; idx += ngw * 64) {
            const int t = idx >> 6, j = idx & 63;
            const float inv = exp2f(-(float)(2 * j) * (1.0f / 128.0f) * 13.287712379549449f);
            const float angf = (float)t * inv;
            double rev = (double)angf * 0.15915494309189535; rev -= floor(rev);
            const float rf = (float)rev;
            ROPE_COS[idx] = __builtin_amdgcn_cosf(rf); ROPE_SIN[idx] = __builtin_amdgcn_sinf(rf);
        }
        }
        SEAM(0);
    }

#pragma unroll 1
    for (int l = 0; l < DEPTH; ++l) {
        const int pb = 1 + l * PH_PER_LAYER;

        if (ENK(0) && IN(pb + 0)) {
            PHASE_IDS;
            for (int rep_ = 0; rep_ < REPS(0); ++rep_) {
            const float* const xin = (l == 0) ? karg_in(I_X) : (const float*)karg_out();
            bf16r* const HB = WSP(bf16r, WS_H);
            const float* gain = karg_in(I_LN1) + l * D_MODEL;
            for (int m = gw; m < M_TOK; m += ngw) {
                const f32x4* xr = (const f32x4*)(xin + (size_t)m * D_MODEL) + lane;
                f32x4 v[16]; float ss = 0.f;
#pragma unroll
                for (int j = 0; j < 16; ++j) { v[j] = xr[64 * j]; ss += (v[j].x * v[j].x + v[j].y * v[j].y) + (v[j].z * v[j].z + v[j].w * v[j].w); }
                ss = wave_sum(ss);
                const float rs = 1.0f / sqrtf(ss * (1.0f / D_MODEL) + NORM_EPS);
                const f32x4* gr = (const f32x4*)gain + lane; v2u* o = (v2u*)(HB + (size_t)m * D_MODEL) + lane;
#pragma unroll
                for (int j = 0; j < 16; ++j) { const f32x4 g = gr[64 * j]; v2u w; w.x = pk2(v[j].x * rs * g.x, v[j].y * rs * g.y); w.y = pk2(v[j].z * rs * g.z, v[j].w * rs * g.w); o[64 * j] = w; }
            }
            }
            SEAM(pb + 0);
        }

        if (ENK(1) && IN(pb + 1)) {
            PHASE_IDS;
            for (int rep_ = 0; rep_ < REPS(1); ++rep_) {
            bf16r* const HB = WSP(bf16r, WS_H);
            bf16r* const W_IN = WSP(bf16r, WS_WIN);
            bf16r* const Z = WSP(bf16r, WS_Z);
            pg8::Gemm g{HB, W_IN + (size_t)l * IN_WIDTH * D_MODEL, M_TOK, IN_WIDTH, D_MODEL}; pg8::StaticOrder S; S.init(M_TOK, IN_WIDTH, G, bx);
            pg8::EpiBf16X<0> E{Z, IN_WIDTH, nullptr, nullptr, 0};
            pg8::gemm_phase<pg8::EpiBf16X<0>, pg8::StaticOrder, true, true>(ldsl, g, S, E);
            }
            SEAM(pb + 1);
        }

        if (ENK(2) && IN(pb + 2)) {
            PHASE_IDS;
            for (int rep_ = 0; rep_ < REPS(2); ++rep_) {
            bf16r* const Z = WSP(bf16r, WS_Z);
            bf16r* const XA = WSP(bf16r, WS_XA);
            bf16r* const QT = WSP(bf16r, WS_QT);
            bf16r* const KK = WSP(bf16r, WS_KK);
            bf16r* const QH = WSP(bf16r, WS_QH);
            bf16r* const KH = WSP(bf16r, WS_KH);
            bf16r* const VH = WSP(bf16r, WS_VH);
            float* const LB = WSP(float, WS_LB);
            float* const ROPE_COS = WSP(float, WS_ROPE); float* const ROPE_SIN = ROPE_COS + SEQ * 64;
            const float* convw = karg_in(I_CONVW) + l * 4 * LRU_W; const float* convb = karg_in(I_CONVB) + l * LRU_W;
            const float* lbl = LB + l * HG_W;
            const float* qg = karg_in(I_QNG) + l * 128; const float* kg = karg_in(I_KNG) + l * 128;
            for (int m = gw; m < M_TOK; m += ngw) {
                const int t = m & (SEQ - 1), b = m >> 12;
                const bf16r* zr = Z + (size_t)m * IN_WIDTH;
#pragma unroll
                for (int it = 0; it < 2; ++it) {
                    const int c0 = it * 512 + lane * 8;
                    const f32x4 b0 = *(const f32x4*)(convb + c0), b1 = *(const f32x4*)(convb + c0 + 4);
                    float a0 = b0.x, a1 = b0.y, a2 = b0.z, a3 = b0.w, a4 = b1.x, a5 = b1.y, a6 = b1.z, a7 = b1.w;
#pragma unroll
                    for (int j = 0; j < 4; ++j) {
                        if (t - 3 + j >= 0) {
                            const v4u xv = *(const v4u*)(zr - (ptrdiff_t)(3 - j) * IN_WIDTH + OFF_A_X + c0);
                            const f32x4 w0 = *(const f32x4*)(convw + j * LRU_W + c0), w1 = *(const f32x4*)(convw + j * LRU_W + c0 + 4);
                            a0 += bflo(xv.x) * w0.x; a1 += bfhi(xv.x) * w0.y; a2 += bflo(xv.y) * w0.z; a3 += bfhi(xv.y) * w0.w;
                            a4 += bflo(xv.z) * w1.x; a5 += bfhi(xv.z) * w1.y; a6 += bflo(xv.w) * w1.z; a7 += bfhi(xv.w) * w1.w;
                        }
                    }
                    v4u o; o.x = pk2(a0, a1); o.y = pk2(a2, a3); o.z = pk2(a4, a5); o.w = pk2(a6, a7);
                    *(v4u*)(XA + (size_t)m * LRU_W + c0) = o;
                }
#pragma unroll
                for (int it = 0; it < 2; ++it) {
                    const int c0 = it * 512 + lane * 8;
                    const v4u qv = *(const v4u*)(zr + OFF_B_Q + c0), fv = *(const v4u*)(zr + OFF_B_F + c0);
                    const f32x4 l0 = *(const f32x4*)(lbl + c0), l1 = *(const f32x4*)(lbl + c0 + 4);
                    const float qs = 0.08838834764831845f;
#define SILU(x) ((x) * sigmoidf_(x) * qs)
#define KF(x, lbv) ((1.0f - (lbv)) * __builtin_amdgcn_rcpf(1.0f + fast_exp(x)))
                    v4u oq, ok;
                    oq.x = pk2(SILU(bflo(qv.x)), SILU(bfhi(qv.x))); oq.y = pk2(SILU(bflo(qv.y)), SILU(bfhi(qv.y))); oq.z = pk2(SILU(bflo(qv.z)), SILU(bfhi(qv.z))); oq.w = pk2(SILU(bflo(qv.w)), SILU(bfhi(qv.w)));
                    ok.x = pk2(KF(bflo(fv.x), l0.x), KF(bfhi(fv.x), l0.y)); ok.y = pk2(KF(bflo(fv.y), l0.z), KF(bfhi(fv.y), l0.w)); ok.z = pk2(KF(bflo(fv.z), l1.x), KF(bfhi(fv.z), l1.y)); ok.w = pk2(KF(bflo(fv.w), l1.z), KF(bfhi(fv.w), l1.w));
#undef SILU
#undef KF
                    *(v4u*)(QT + (size_t)m * HG_W + c0) = oq; *(v4u*)(KK + (size_t)m * HG_W + c0) = ok;
                }
#pragma unroll
                for (int it = 0; it < 4; ++it) {
                    const int isk = it >> 1, vi = (it & 1) * 8 + (lane >> 3), sub = lane & 7;
                    const bf16r* src = zr + (isk ? OFF_C_K : OFF_C_Q) + vi * 128 + sub * 8;
                    const v4u av = *(const v4u*)src, cv = *(const v4u*)(src + 64);
                    float x1[8] = {bflo(av.x), bfhi(av.x), bflo(av.y), bfhi(av.y), bflo(av.z), bfhi(av.z), bflo(av.w), bfhi(av.w)};
                    float x2[8] = {bflo(cv.x), bfhi(cv.x), bflo(cv.y), bfhi(cv.y), bflo(cv.z), bfhi(cv.z), bflo(cv.w), bfhi(cv.w)};
                    float ss = 0.f;
#pragma unroll
                    for (int e = 0; e < 8; ++e) ss += x1[e] * x1[e] + x2[e] * x2[e];
                    ss += __shfl_xor(ss, 1); ss += __shfl_xor(ss, 2); ss += __shfl_xor(ss, 4);
                    const float rs = 1.0f / sqrtf(ss * (1.0f / 128.0f) + NORM_EPS);
                    const float* gp = (isk ? kg : qg) + sub * 8;
                    const f32x4 g1a = *(const f32x4*)gp, g1b = *(const f32x4*)(gp + 4), g2a = *(const f32x4*)(gp + 64), g2b = *(const f32x4*)(gp + 68);
                    const f32x4 ca = *(const f32x4*)(ROPE_COS + t * 64 + sub * 8), cb = *(const f32x4*)(ROPE_COS + t * 64 + sub * 8 + 4);
                    const f32x4 sa = *(const f32x4*)(ROPE_SIN + t * 64 + sub * 8), sb = *(const f32x4*)(ROPE_SIN + t * 64 + sub * 8 + 4);
                    const float g1[8] = {g1a.x, g1a.y, g1a.z, g1a.w, g1b.x, g1b.y, g1b.z, g1b.w}, g2[8] = {g2a.x, g2a.y, g2a.z, g2a.w, g2b.x, g2b.y, g2b.z, g2b.w};
                    const float cc[8] = {ca.x, ca.y, ca.z, ca.w, cb.x, cb.y, cb.z, cb.w}, sn[8] = {sa.x, sa.y, sa.z, sa.w, sb.x, sb.y, sb.z, sb.w};
                    float o1[8], o2[8];
#pragma unroll
                    for (int e = 0; e < 8; ++e) { const float y1 = x1[e] * rs * g1[e], y2 = x2[e] * rs * g2[e]; o1[e] = y1 * cc[e] - y2 * sn[e]; o2[e] = y2 * cc[e] + y1 * sn[e]; }
                    bf16r* dst = (isk ? KH : QH) + ((size_t)(b * 16 + vi) * SEQ + t) * 128 + sub * 8;
                    v4u w1, w2; w1.x = pk2(o1[0], o1[1]); w1.y = pk2(o1[2], o1[3]); w1.z = pk2(o1[4], o1[5]); w1.w = pk2(o1[6], o1[7]);
                    w2.x = pk2(o2[0], o2[1]); w2.y = pk2(o2[2], o2[3]); w2.z = pk2(o2[4], o2[5]); w2.w = pk2(o2[6], o2[7]);
                    *(v4u*)dst = w1; *(v4u*)(dst + 64) = w2;
                }
#pragma unroll
                for (int it = 0; it < 4; ++it) {
                    const int e = it * 512 + lane * 8, vi = e >> 7, d = e & 127;
                    *(v4u*)(VH + ((size_t)(b * 16 + vi) * SEQ + t) * 128 + d) = *(const v4u*)(zr + OFF_C_V + e);
                }
            }
            }
            SEAM(pb + 2);
        }

        if (ENK(3) && IN(pb + 3)) {
            PHASE_IDS;
            for (int rep_ = 0; rep_ < REPS(3); ++rep_) {
            bf16r* const XA = WSP(bf16r, WS_XA);
            bf16r* const W_GATE = WSP(bf16r, WS_WGATE);
            bf16r* const RI = WSP(bf16r, WS_RI);
            pg8::Gemm g{XA, W_GATE + (size_t)l * 2048 * 1024, M_TOK, 2048, 1024}; pg8::StaticOrder S; S.init(M_TOK, 2048, G, bx);
            pg8::EpiBf16X<1> E{RI, 2048, karg_in(I_BR) + l * LRU_W, karg_in(I_BI) + l * LRU_W, 1024};
            pg8::gemm_phase<pg8::EpiBf16X<1>, pg8::StaticOrder, true, true>(ldsl, g, S, E);
            }
            SEAM(pb + 3);
        }

        if ((ENK(4) || ENK(5)) && (IN(pb + 4) || IN(pb + 5))) {
            PHASE_IDS;
            bf16r* const XA = WSP(bf16r, WS_XA);
            bf16r* const RI = WSP(bf16r, WS_RI);
            float* const LSUM = WSP(float, WS_LSUM);
            bf16r* const Z = WSP(bf16r, WS_Z);
            float* const YAPRE = WSP(float, WS_YAPRE);
            const float* lam = karg_in(I_LAM) + l * LRU_W;
            const int c = tid * 2;
            const float sp0 = 8.0f * log1pf(__expf(-lam[c])), sp1 = 8.0f * log1pf(__expf(-lam[c + 1]));
            if (ENK(4) && IN(pb + 4)) {
                for (int u = bx; u < BATCH * 64; u += G) {
                    const int b = u >> 6, s = u & 63;
                    float h0 = 0.f, h1 = 0.f, A0 = 0.f, A1 = 0.f;
#pragma unroll 4
                    for (int t = 0; t < 64; ++t) {
                        const size_t m = (size_t)b * SEQ + s * 64 + t;
                        const unsigned rr = *(const unsigned*)(RI + m * 2048 + c), ii = *(const unsigned*)(RI + m * 2048 + 1024 + c), xx = *(const unsigned*)(XA + m * LRU_W + c);
                        const bool first = (s == 0 && t == 0);
                        lru_step(bflo(rr), bflo(ii), bflo(xx), sp0, first, h0, A0);
                        lru_step(bfhi(rr), bfhi(ii), bfhi(xx), sp1, first, h1, A1);
                    }
                    *(f32x4*)(LSUM + ((size_t)u * LRU_W + c) * 2) = (f32x4){A0, h0, A1, h1};
                }
                SEAM(pb + 4);
            }
            if (ENK(5) && IN(pb + 5)) {
                for (int u = bx; u < BATCH * 64; u += G) {
                    const int b = u >> 6, s = u & 63;
                    float h0 = 0.f, h1 = 0.f, A0 = 0.f, A1 = 0.f;
                    for (int sp = 0; sp < s; ++sp) {
                        const f32x4 v = *(const f32x4*)(LSUM + ((size_t)(b * 64 + sp) * LRU_W + c) * 2);
                        h0 = fast_exp(v.x) * h0 + v.y; h1 = fast_exp(v.z) * h1 + v.w;
                    }
#pragma unroll 4
                    for (int t = 0; t < 64; ++t) {
                        const size_t m = (size_t)b * SEQ + s * 64 + t;
                        const unsigned rr = *(const unsigned*)(RI + m * 2048 + c), ii = *(const unsigned*)(RI + m * 2048 + 1024 + c), xx = *(const unsigned*)(XA + m * LRU_W + c);
                        const unsigned gg = *(const unsigned*)(Z + m * IN_WIDTH + OFF_A_GATE + c);
                        const bool first = (s == 0 && t == 0);
                        lru_step(bflo(rr), bflo(ii), bflo(xx), sp0, first, h0, A0);
                        lru_step(bfhi(rr), bfhi(ii), bfhi(xx), sp1, first, h1, A1);
                        *(f32x2*)(YAPRE + m * LRU_W + c) = (f32x2){h0 * gelu_tanh(bflo(gg)), h1 * gelu_tanh(bfhi(gg))};
                    }
                }
                SEAM(pb + 5);
            }
        }

        if (ENK(6) && IN(pb + 6)) {
            PHASE_IDS;
            for (int rep_ = 0; rep_ < REPS(6); ++rep_) {
            bf16r* const QT = WSP(bf16r, WS_QT);
            bf16r* const KK = WSP(bf16r, WS_KK);
            bf16r* const Z = WSP(bf16r, WS_Z);
            float* const OBPRE = WSP(float, WS_OBPRE);
            for (int ubh = vcu; ubh < BATCH * 8; ubh += G) hgrn_chunked(ldsl, QT, KK, Z, OBPRE, ubh >> 3, ubh & 7, tid, rep_ == 1, WSP(unsigned, WS_CTL) + 2048, WSP(void, WS_OATT));
            }
            SEAM(pb + 6);
        }

        if (ENK(7) && IN(pb + 7)) {
            PHASE_IDS;
            for (int rep_ = 0; rep_ < REPS(7); ++rep_) {
            bf16r* const QH = WSP(bf16r, WS_QH);
            bf16r* const KH = WSP(bf16r, WS_KH);
            bf16r* const VH = WSP(bf16r, WS_VH);
            bf16r* const OATT = WSP(bf16r, WS_OATT);
            typedef __hip_bfloat16 abf;
            const abf* Qp = (const abf*)QH; const abf* Kp = (const abf*)KH; const abf* Vp = (const abf*)VH; abf* Op = (abf*)OATT;
            const int total = BATCH * 32 * 8;
            int L = vcu;
            if (L < total) {
                int pass = 0;
                ab::BlockRef<abf, abf> cur = attn_ref(Qp, Kp, Vp, Op, L, 0);
                ab::Seam<abf> Sm;
                ab::causal_swa_prime<abf, abf>(cur, SEQ, (char*)lds, Sm);
                for (;;) {
                    const bool more_pass = pass == 0, more_item = L + G < total, last = !more_pass && !more_item;
                    int passn = pass + 1, Ln = L;
                    if (!more_pass) { passn = 0; Ln = more_item ? L + G : L; }
                    const ab::BlockRef<abf, abf> nxt = last ? cur : attn_ref(Qp, Kp, Vp, Op, Ln, passn);
                    ab::causal_swa_block<abf, abf>(cur, nxt, SEQ, SEQ, (char*)lds, Sm);
                    if (last) break;
                    cur = nxt; pass = passn; L = Ln;
                }
            }
            }
            SEAM(pb + 7);
        }

        if (ENK(8) && IN(pb + 8)) {
            PHASE_IDS;
            for (int rep_ = 0; rep_ < REPS(8); ++rep_) {
            float* const YAPRE = WSP(float, WS_YAPRE);
            float* const OBPRE = WSP(float, WS_OBPRE);
            bf16r* const OATT = WSP(bf16r, WS_OATT);
            bf16r* const Z = WSP(bf16r, WS_Z);
            bf16r* const YCAT = WSP(bf16r, WS_YCAT);
            const float lam_init = 0.8f - 0.6f * __expf(-0.3f * (float)l);
            const float* dl = karg_in(I_DLAM) + l * 4 * 128;
            float d1 = dl[lane] * dl[128 + lane] + dl[64 + lane] * dl[128 + 64 + lane];
            float d2 = dl[256 + lane] * dl[384 + lane] + dl[256 + 64 + lane] * dl[384 + 64 + lane];
            d1 = wave_sum(d1); d2 = wave_sum(d2);
            const float lamv = __expf(d1) - __expf(d2) + lam_init;
            const float* lg = karg_in(I_LRUG) + l * LRU_W; const float* hg = karg_in(I_HNG) + l * 128; const float* sg = karg_in(I_SUBLN) + l * 256;
            const bool hg_bad = WSP(unsigned, WS_CTL)[2048] != 0u;
            for (int m = gw; m < M_TOK; m += ngw) {
                const int t = m & (SEQ - 1), b = m >> 12;
                bf16r* yrow = YCAT + (size_t)m * D_MODEL;
                {
                    const f32x4* pr = (const f32x4*)(YAPRE + (size_t)m * LRU_W) + lane;
                    f32x4 v[4]; float ss = 0.f;
#pragma unroll
                    for (int j = 0; j < 4; ++j) { v[j] = pr[64 * j]; ss += (v[j].x * v[j].x + v[j].y * v[j].y) + (v[j].z * v[j].z + v[j].w * v[j].w); }
                    ss = wave_sum(ss);
                    const float rs = 1.0f / sqrtf(ss * (1.0f / LRU_W) + NORM_EPS);
#pragma unroll
                    for (int j = 0; j < 4; ++j) { const f32x4 g = *((const f32x4*)lg + lane + 64 * j); v2u w; w.x = pk2(v[j].x * rs * g.x, v[j].y * rs * g.y); w.y = pk2(v[j].z * rs * g.z, v[j].w * rs * g.w);
#if defined(DBG_ZERO) && (DBG_ZERO & 1)
                        w = (v2u){0u, 0u};
#endif
                        *((v2u*)yrow + lane + 64 * j) = w; }
                }
                {
                    const int e0 = lane * 16;
                    f32x4 v[4]; float ss = 0.f;
#pragma unroll
                    for (int j = 0; j < 4; ++j) { v[j] = *(const f32x4*)(OBPRE + (size_t)m * HG_W + e0 + 4 * j); ss += (v[j].x * v[j].x + v[j].y * v[j].y) + (v[j].z * v[j].z + v[j].w * v[j].w); }
                    ss += __shfl_xor(ss, 1); ss += __shfl_xor(ss, 2); ss += __shfl_xor(ss, 4);
                    const float rs = 1.0f / sqrtf(ss * (1.0f / 128.0f) + NORM_EPS);
                    const bf16r* gz = Z + (size_t)m * IN_WIDTH + OFF_B_G + e0;
                    const v4u ga = *(const v4u*)gz, gb = *(const v4u*)(gz + 8);
                    const float gv[16] = {bflo(ga.x), bfhi(ga.x), bflo(ga.y), bfhi(ga.y), bflo(ga.z), bfhi(ga.z), bflo(ga.w), bfhi(ga.w), bflo(gb.x), bfhi(gb.x), bflo(gb.y), bfhi(gb.y), bflo(gb.z), bfhi(gb.z), bflo(gb.w), bfhi(gb.w)};
                    const float* hgp = hg + (e0 & 127);
                    float o[16];
#pragma unroll
                    for (int j = 0; j < 4; ++j) { const f32x4 g = *(const f32x4*)(hgp + 4 * j);
                        o[4 * j + 0] = v[j].x * rs * g.x * (gv[4 * j + 0] * sigmoidf_(gv[4 * j + 0])); o[4 * j + 1] = v[j].y * rs * g.y * (gv[4 * j + 1] * sigmoidf_(gv[4 * j + 1]));
                        o[4 * j + 2] = v[j].z * rs * g.z * (gv[4 * j + 2] * sigmoidf_(gv[4 * j + 2])); o[4 * j + 3] = v[j].w * rs * g.w * (gv[4 * j + 3] * sigmoidf_(gv[4 * j + 3])); }
                    v4u w0, w1; w0.x = pk2(o[0], o[1]); w0.y = pk2(o[2], o[3]); w0.z = pk2(o[4], o[5]); w0.w = pk2(o[6], o[7]); w1.x = pk2(o[8], o[9]); w1.y = pk2(o[10], o[11]); w1.z = pk2(o[12], o[13]); w1.w = pk2(o[14], o[15]);
#if defined(DBG_ZERO) && (DBG_ZERO & 2)
                    w0 = (v4u){0u,0u,0u,0u}; w1 = w0;
#endif
                    *(v4u*)(yrow + 1024 + e0) = w0; *(v4u*)(yrow + 1024 + e0 + 8) = w1;
                }
#pragma unroll
                for (int it = 0; it < 4; ++it) {
                    const int e = it * 512 + lane * 8, h = e >> 8, vh = (e >> 7) & 1, d = e & 127;
                    const bf16r* o1p = OATT + ((size_t)(b * 32 + h * 4 + 0 + vh) * SEQ + t) * 128 + d;
                    const bf16r* o2p = OATT + ((size_t)(b * 32 + h * 4 + 2 + vh) * SEQ + t) * 128 + d;
                    const v4u a = *(const v4u*)o1p, c2 = *(const v4u*)o2p;
                    float oc[8] = {bflo(a.x) - lamv * bflo(c2.x), bfhi(a.x) - lamv * bfhi(c2.x), bflo(a.y) - lamv * bflo(c2.y), bfhi(a.y) - lamv * bfhi(c2.y),
                                   bflo(a.z) - lamv * bflo(c2.z), bfhi(a.z) - lamv * bfhi(c2.z), bflo(a.w) - lamv * bflo(c2.w), bfhi(a.w) - lamv * bfhi(c2.w)};
                    float ss = 0.f;
#pragma unroll
                    for (int j = 0; j < 8; ++j) ss += oc[j] * oc[j];
                    ss += __shfl_xor(ss, 1); ss += __shfl_xor(ss, 2); ss += __shfl_xor(ss, 4); ss += __shfl_xor(ss, 8); ss += __shfl_xor(ss, 16);
                    const float rs = (1.0f - lam_init) / sqrtf(ss * (1.0f / 256.0f) + NORM_EPS);
                    const f32x4 g0 = *(const f32x4*)(sg + (e & 255)), g1 = *(const f32x4*)(sg + (e & 255) + 4);
                    v4u w; w.x = pk2(oc[0] * rs * g0.x, oc[1] * rs * g0.y); w.y = pk2(oc[2] * rs * g0.z, oc[3] * rs * g0.w); w.z = pk2(oc[4] * rs * g1.x, oc[5] * rs * g1.y); w.w = pk2(oc[6] * rs * g1.z, oc[7] * rs * g1.w);
#if defined(DBG_ZERO) && (DBG_ZERO & 4)
                    w = (v4u){0u,0u,0u,0u};
#endif
                    *(v4u*)(yrow + 2048 + e) = w;
                }
            }
            }
            SEAM(pb + 8);
        }

        if (ENK(9) && IN(pb + 9)) {
            PHASE_IDS;
            for (int rep_ = 0; rep_ < REPS(9); ++rep_) {
            bf16r* const YCAT = WSP(bf16r, WS_YCAT);
            bf16r* const W_OUT = WSP(bf16r, WS_WOUT);
            float* const OUT = karg_out();
            const float* const xin = (l == 0) ? karg_in(I_X) : (const float*)karg_out();
            pg8::Gemm g{YCAT, W_OUT + (size_t)l * D_MODEL * D_MODEL, M_TOK, D_MODEL, D_MODEL}; pg8::StaticOrder S; S.init(M_TOK, D_MODEL, G, bx);
            pg8::EpiResF32 E{xin, OUT, D_MODEL};
            pg8::gemm_phase<pg8::EpiResF32, pg8::StaticOrder, true, true>(ldsl, g, S, E);
            }
            SEAM(pb + 9);
        }

        if (ENK(10) && IN(pb + 10)) {
            PHASE_IDS;
            for (int rep_ = 0; rep_ < REPS(10); ++rep_) {
            float* const OUT = karg_out();
            bf16r* const HB = WSP(bf16r, WS_H);
            const float* gain = karg_in(I_LN2) + l * D_MODEL;
            for (int m = gw; m < M_TOK; m += ngw) {
                const f32x4* xr = (const f32x4*)(OUT + (size_t)m * D_MODEL) + lane;
                f32x4 v[16]; float ss = 0.f;
#pragma unroll
                for (int j = 0; j < 16; ++j) { v[j] = xr[64 * j]; ss += (v[j].x * v[j].x + v[j].y * v[j].y) + (v[j].z * v[j].z + v[j].w * v[j].w); }
                ss = wave_sum(ss);
                const float rs = 1.0f / sqrtf(ss * (1.0f / D_MODEL) + NORM_EPS);
                const f32x4* gr = (const f32x4*)gain + lane; v2u* o = (v2u*)(HB + (size_t)m * D_MODEL) + lane;
#pragma unroll
                for (int j = 0; j < 16; ++j) { const f32x4 g = gr[64 * j]; v2u w; w.x = pk2(v[j].x * rs * g.x, v[j].y * rs * g.y); w.y = pk2(v[j].z * rs * g.z, v[j].w * rs * g.w); o[64 * j] = w; }
            }
            }
            SEAM(pb + 10);
        }

        if (ENK(11) && IN(pb + 11)) {
            PHASE_IDS;
            for (int rep_ = 0; rep_ < REPS(11); ++rep_) {
            bf16r* const HB = WSP(bf16r, WS_H);
            bf16r* const W_FF1 = WSP(bf16r, WS_WFF1);
            bf16r* const HID = WSP(bf16r, WS_HID);
            pg8::Gemm g{HB, W_FF1 + (size_t)l * D_FF * D_MODEL, M_TOK, D_FF, D_MODEL}; pg8::StaticOrder S; S.init(M_TOK, D_FF, G, bx);
            pg8::EpiBf16X<2> E{HID, D_FF, nullptr, nullptr, 0};
            pg8::gemm_phase<pg8::EpiBf16X<2>, pg8::StaticOrder, true, true>(ldsl, g, S, E);
            }
            SEAM(pb + 11);
        }

        if (ENK(12) && IN(pb + 12)) {
            PHASE_IDS;
            for (int rep_ = 0; rep_ < REPS(12); ++rep_) {
            bf16r* const HID = WSP(bf16r, WS_HID);
            bf16r* const W_FF2 = WSP(bf16r, WS_WFF2);
            float* const OUT = karg_out();
            pg8::Gemm g{HID, W_FF2 + (size_t)l * D_MODEL * D_FF, M_TOK, D_MODEL, D_FF}; pg8::StaticOrder S; S.init(M_TOK, D_MODEL, G, bx);
            pg8::EpiResF32 E{OUT, OUT, D_MODEL};
            pg8::gemm_phase<pg8::EpiResF32, pg8::StaticOrder, true, true>(ldsl, g, S, E);
            }
            SEAM(pb + 12);
        }
    }
#undef IN
#undef SEAM
}


#if defined(DBG_CKPT_PROBE)
__global__ void k_checksum(const unsigned* p, size_t nwords, unsigned long long* slot) {
    unsigned long long s = 0;
    for (size_t i = (size_t)blockIdx.x * blockDim.x + threadIdx.x; i < nwords; i += (size_t)gridDim.x * blockDim.x) s += (unsigned long long)p[i] * (unsigned long long)(1u + (unsigned)(i & 1023u));
    for (int o = 32; o >= 1; o >>= 1) s += __shfl_xor(s, o);
    if ((threadIdx.x & 63) == 0) atomicAdd(slot, s);
}
__global__ void k_emit(const unsigned long long* slots, int n, float* out) {
    const int j = threadIdx.x; if (blockIdx.x == 0 && j < n) { const float frac = (float)(slots[j] % 1000003ull) * (1.0f / 1000003.0f); out[j] = __powf(10.0f, 14.5f - 1.5f * (float)j) * (1.0f + frac); }
}
#endif

#if defined(DBG_DUMP)
__global__ void k_dump(const unsigned char* ws, float* out, int mode) {
    for (size_t i = (size_t)blockIdx.x * blockDim.x + threadIdx.x; i < (size_t)M_TOK * D_MODEL; i += (size_t)gridDim.x * blockDim.x) {
        const size_t m = i >> 12, c = i & 4095; float v = 0.f;
        if (mode == 1) { const bf16r* z = (const bf16r*)(ws + WS_Z) + m * IN_WIDTH; v = bf1(z[c]) + bf1(z[4096 + c]) + bf1(z[8192 + c]); }
        if (mode == 2) { v = bf1(((const bf16r*)(ws + WS_OATT))[i]); }
        if (mode == 3) { v = c < 1024 ? ((const float*)(ws + WS_YAPRE))[m * 1024 + c] : c < 2048 ? ((const float*)(ws + WS_OBPRE))[m * 1024 + (c - 1024)] : c < 3072 ? bf1(((const bf16r*)(ws + WS_RI))[m * 2048 + (c - 2048)]) : bf1(((const bf16r*)(ws + WS_RI))[m * 2048 + (c - 2048)]); }
        if (mode == 7) { v = ((const float*)(ws + WS_YAPRE))[m * 1024 + (c & 1023)]; }
        if (mode == 8) { v = ((const float*)(ws + WS_OBPRE))[i & ((size_t)M_TOK * 1024 - 1)]; }
        if (mode == 9) { v = bf1(((const bf16r*)(ws + WS_RI))[m * 2048 + (c & 2047)]); }
        if (mode == 10) { v = c < 1024 ? bf1(((const bf16r*)(ws + WS_XA))[m * 1024 + c]) : c < 2048 ? bf1(((const bf16r*)(ws + WS_QT))[m * 1024 + (c - 1024)]) : c < 3072 ? bf1(((const bf16r*)(ws + WS_KK))[m * 1024 + (c - 2048)]) : bf1(((const bf16r*)(ws + WS_RI))[m * 2048 + (c - 3072)]); }
        if (mode == 4) { v = bf1(((const bf16r*)(ws + WS_YCAT))[i]); }
        out[i] = v;
    }
}
#endif
#if defined(DBG_MAXP)
__global__ void k_absmax(const void* p, size_t n, int is_f32, unsigned* slot) {
    float mx = 0.f;
    for (size_t i = (size_t)blockIdx.x * blockDim.x + threadIdx.x; i < n; i += (size_t)gridDim.x * blockDim.x) { const float v = is_f32 ? ((const float*)p)[i] : bf1(((const bf16r*)p)[i]); mx = fmaxf(mx, fabsf(v)); }
    for (int o = 32; o >= 1; o >>= 1) mx = fmaxf(mx, __shfl_xor(mx, o));
    if ((threadIdx.x & 63) == 0) atomicMax(slot, __float_as_uint(mx));
}
__global__ void k_emit2(const unsigned* slots, float* out) { if (blockIdx.x == 0 && threadIdx.x < 2) out[threadIdx.x] = 1.0e6f * __uint_as_float(slots[threadIdx.x]); }
#endif
#if defined(DBG_HG_LDSCMP)
__global__ void k_emit_flag(const unsigned* flag, float* out) { if (blockIdx.x == 0 && threadIdx.x == 0) { const unsigned m = *flag; out[0] = 1.0e6f * (float)(1u + (m & 15u)); out[1] = 1.0e6f * (float)(1u + ((m >> 4) & 31u)); } }
#endif
#ifndef MK_PER_PHASE
#define MK_PER_PHASE 0
#endif
extern "C" void kernel_launch(void* const* d_in, const int* in_sizes, int n_in, void* d_out, int out_size, void* d_ws, size_t ws_size, hipStream_t stream) {
    static int grid = 0;
    if (grid == 0) {
        if (n_in != N_INPUTS || out_size != M_TOK * D_MODEL || ws_size < WS_END) { fprintf(stderr, "kernel_launch: unexpected shapes (n_in %d, out %d, ws %zu < %zu); nothing launched\n", n_in, out_size, ws_size, (size_t)WS_END); grid = -1; return; }
        int dev = 0, cus = 0;
        if (hipGetDevice(&dev) != hipSuccess || hipDeviceGetAttribute(&cus, hipDeviceAttributeMultiprocessorCount, dev) != hipSuccess || cus <= 0) { fprintf(stderr, "kernel_launch: device query failed\n"); grid = -1; return; }
        if (hipFuncSetAttribute((const void*)hymba_fwd, hipFuncAttributeMaxDynamicSharedMemorySize, LDS_BYTES) != hipSuccess) { fprintf(stderr, "kernel_launch: hipFuncSetAttribute failed\n"); grid = -1; return; }
        int per_cu = 0;
        if (hipOccupancyMaxActiveBlocksPerMultiprocessor(&per_cu, (const void*)hymba_fwd, NTHREADS, LDS_BYTES) != hipSuccess || per_cu < 1) fprintf(stderr, "kernel_launch: occupancy query reports %d blocks per CU\n", per_cu);
        (void)hipGetLastError();
        grid = cus;
    }
    if (grid < 0) return;
    (void)in_sizes;
    if (hipMemsetAsync((char*)d_ws + WS_CTL, 0, CTL_ZERO_BYTES, stream) != hipSuccess) { fprintf(stderr, "kernel_launch: memset failed\n"); return; }
#if defined(DBG_NAN_POISON)
    (void)hipMemsetAsync((char*)d_ws + WS_LB, 0xFF, WS_END - WS_LB, stream);
    (void)hipMemsetAsync(d_out, 0xFF, (size_t)out_size * 4, stream);
#endif
    Args a{};
    for (int i = 0; i < N_INPUTS; ++i) a.in[i] = (const float*)d_in[i];
    a.out = (float*)d_out; a.ws = (unsigned char*)d_ws;
#if defined(DBG_HG_LDSCMP)
    {
        for (int p = 0; p <= 7; ++p) { a.ph_lo = p; a.ph_hi = p + 1; hipLaunchKernelGGL(hymba_fwd, dim3(grid), dim3(NTHREADS), LDS_BYTES, stream, a); }
        (void)hipMemsetAsync(d_out, 0, (size_t)out_size * 4, stream);
        hipLaunchKernelGGL(k_emit_flag, dim3(1), dim3(64), 0, stream, (const unsigned*)((unsigned char*)d_ws + 8192), (float*)d_out);
    }
#elif defined(DBG_MAXP)
        unsigned char* w = (unsigned char*)d_ws; unsigned* slots = (unsigned*)(w + 512 * 1024);
        for (int p = 0; p <= DBG_LAST; ++p) { a.ph_lo = p; a.ph_hi = p + 1; hipLaunchKernelGGL(hymba_fwd, dim3(grid), dim3(NTHREADS), LDS_BYTES, stream, a); }
#if defined(DBG_MAXP_IN_A)
        hipLaunchKernelGGL(k_absmax, dim3(64), dim3(256), 0, stream, (const void*)d_in[DBG_MAXP_IN_A], (size_t)in_sizes[DBG_MAXP_IN_A], 1, slots + 0);
        hipLaunchKernelGGL(k_absmax, dim3(64), dim3(256), 0, stream, (const void*)d_in[DBG_MAXP_IN_B], (size_t)in_sizes[DBG_MAXP_IN_B], 1, slots + 1);
#else
        hipLaunchKernelGGL(k_absmax, dim3(2048), dim3(256), 0, stream, (const void*)(w + DBG_MAXP_A_OFF), (size_t)DBG_MAXP_A_N, DBG_MAXP_A_F32, slots + 0);
        hipLaunchKernelGGL(k_absmax, dim3(2048), dim3(256), 0, stream, (const void*)(w + DBG_MAXP_B_OFF), (size_t)DBG_MAXP_B_N, DBG_MAXP_B_F32, slots + 1);
#endif
        hipMemsetAsync(d_out, 0, (size_t)out_size * 4, stream);
        hipLaunchKernelGGL(k_emit2, dim3(1), dim3(64), 0, stream, (const unsigned*)slots, (float*)d_out);
    }
#elif defined(DBG_DUMP)
        const int last = DBG_LAST;
        for (int p = 0; p <= last; ++p) {
            if (DBG_DUMP == 2 && p >= DBG_LAST - 4 && p <= DBG_LAST - 1) continue;
            a.ph_lo = p; a.ph_hi = p + 1; hipLaunchKernelGGL(hymba_fwd, dim3(grid), dim3(NTHREADS), LDS_BYTES, stream, a);
        }
        if (DBG_DUMP >= 1 && DBG_DUMP != 5 && DBG_DUMP != 6) hipLaunchKernelGGL(k_dump, dim3(4096), dim3(256), 0, stream, (const unsigned char*)d_ws, (float*)d_out, (int)DBG_DUMP);
    }
#elif defined(DBG_CKPT_PROBE)
    {
        unsigned char* w = (unsigned char*)d_ws; unsigned long long* slots = (unsigned long long*)(w + 512 * 1024);
        auto cks = [&](size_t off, size_t bytes, int j) { hipLaunchKernelGGL(k_checksum, dim3(2048), dim3(256), 0, stream, (const unsigned*)(w + off), bytes / 4, slots + j); };
        for (int p = 0; p < N_PHASES; ++p) {
            a.ph_lo = p; a.ph_hi = p + 1; hipLaunchKernelGGL(hymba_fwd, dim3(grid), dim3(NTHREADS), LDS_BYTES, stream, a);
            if (p == 0) cks(1 * MiB, 11 * MiB, 0), cks(16 * MiB, 768 * MiB, 0);
            if (p == 2) cks(WS_Z, 384 * MiB, 1);
            if (p == 4) cks(WS_XA, 32 * MiB, 2), cks(WS_RI, 64 * MiB, 2), cks(WS_QT, 256 * MiB, 2);
            if (p == 6) cks(WS_YAPRE, 64 * MiB, 3);
            if (p == 7) cks(WS_OBPRE, 64 * MiB, 4);
            if (p == 8) cks(WS_OATT, 128 * MiB, 5);
            if (p == 10) hipLaunchKernelGGL(k_checksum, dim3(2048), dim3(256), 0, stream, (const unsigned*)d_out, (size_t)M_TOK * D_MODEL, slots + 6);
            if (p == 13) hipLaunchKernelGGL(k_checksum, dim3(2048), dim3(256), 0, stream, (const unsigned*)d_out, (size_t)M_TOK * D_MODEL, slots + 7);
        }
        hipLaunchKernelGGL(k_emit, dim3(1), dim3(64), 0, stream, (const unsigned long long*)slots, 8, (float*)d_out);
    }
#elif MK_PER_PHASE
    for (int p = 0; p < N_PHASES; ++p) { a.ph_lo = p; a.ph_hi = p + 1; hipLaunchKernelGGL(hymba_fwd, dim3(grid), dim3(NTHREADS), LDS_BYTES, stream, a); }
#else
    a.ph_lo = 0; a.ph_hi = N_PHASES;
    hipLaunchKernelGGL(hymba_fwd, dim3(grid), dim3(NTHREADS), LDS_BYTES, stream, a);
#endif
    const hipError_t le = hipPeekAtLastError();
    if (le != hipSuccess) fprintf(stderr, "kernel_launch: launch failed: %s\n", hipGetErrorName(le));
}
```

```cpp
#include <hip/hip_runtime.h>
#include <hip/hip_bf16.h>
#include <cstdio>
#include <cstdint>
__device__ __forceinline__ int tid_opaque() { int t = threadIdx.x; asm volatile("" : "+v"(t)); return t; }
typedef __bf16 hw_bf16x2 __attribute__((ext_vector_type(2)));
typedef float hw_f32x2 __attribute__((ext_vector_type(2)));
__device__ __forceinline__ unsigned pk_bf16_builtin(float lo, float hi) { hw_f32x2 f = {lo, hi}; hw_bf16x2 r = __builtin_convertvector(f, hw_bf16x2); return __builtin_bit_cast(unsigned, r); }
namespace pg8 {
#define PG8_LAS __attribute__((address_space(3)))
typedef unsigned short bf16_t;
typedef short bf16x8 __attribute__((ext_vector_type(8)));
typedef float f32x4 __attribute__((ext_vector_type(4)));
typedef unsigned u32x4 __attribute__((ext_vector_type(4)));
constexpr int BM = 256, BK = 64, HALF = 128, HTB = HALF * BK * 2  , STAGE_BYTES = 8 * HTB, NXCD = 8, WGM = 8;

__host__ __device__ __forceinline__ int lds_byte(int r, int c) { const int st = (r >> 4) * 2 + (c >> 5), rr = r & 15, cc = c & 31, ob = rr * 64 + cc * 2; return st * 1024 + (ob ^ (((ob >> 9) & 1) << 5)); }
__host__ __device__ __forceinline__ void stage_rc(int b, int& R, int& C) { const int st = b / 1024, sb = b % 1024, swz = sb ^ (((sb >> 9) & 1) << 5); R = (st >> 1) * 16 + swz / 64; C = (st & 1) * 32 + (swz % 64) / 2; }
__host__ __device__ __forceinline__ int perm32(int rho) { const int n = rho >> 4, i = rho & 15; return 8 * (i >> 2) + 4 * n + (i & 3); }

struct Unit { int pm, pn; };
struct Gemm { const bf16_t* A; const bf16_t* Bt; int M, N, K; };

struct StaticOrder {
    int nM, nN, nwg, G, c;
    __host__ __device__ void init(int M, int N, int G_, int c_) { nM = M / BM; nN = N / BM; nwg = nM * nN; G = G_; c = c_; }
    __host__ __device__ bool next(int i, Unit& u) const {
        const long L = (long)i * G + c; if (L >= nwg) return false;
        int wgid = (int)L; { const int q = nwg / NXCD, r = nwg % NXCD, xcd = wgid % NXCD, off = wgid / NXCD; wgid = (xcd < r ? xcd * (q + 1) : r * (q + 1) + (xcd - r) * q) + off; }
        const int nig = WGM * nN, gid = wgid / nig, fm = gid * WGM, gsz = (nM - fm) < WGM ? (nM - fm) : WGM;
        u.pm = fm + ((wgid % nig) % gsz); u.pn = (wgid % nig) / gsz; return true;
    }
    __device__ __forceinline__ void a_ready(const Unit&) const {}
    __device__ __forceinline__ void done(const Unit&) const {}
};

__device__ __forceinline__ unsigned cvt_pk_bf16(float lo, float hi) { return pk_bf16_builtin(lo, hi); }
typedef float f32x2 __attribute__((ext_vector_type(2)));
__device__ __forceinline__ f32x2 gelu_pk(f32x2 v) {
    const f32x2 av = __builtin_elementwise_abs(v), d = av * 0.2316418882f + 1.0f;
    f32x2 t; t.x = __builtin_amdgcn_rcpf(d.x); t.y = __builtin_amdgcn_rcpf(d.y);
    f32x2 q = t * 0.5307027145f + (-0.7265760135f); q = q * t + 0.7107068705f; q = q * t + (-0.142248368f); q = q * t + 0.127414796f; q = q * t;
    const f32x2 s = (v * v) * (-0.72134752044f);
    f32x2 e; e.x = __builtin_amdgcn_exp2f(s.x); e.y = __builtin_amdgcn_exp2f(s.y);
    const f32x2 m = v * (q * e), r = v - m;
    f32x2 o; o.x = v.x < 0.f ? m.x : r.x; o.y = v.y < 0.f ? m.y : r.y; return o;
}

template <int ACT> struct EpiBf16X {
    static constexpr bool PERM = true, AFTER_DRAIN = false;
    bf16_t* O; int ldc; const float* bias0; const float* bias1; int bias_split;
    __device__ __forceinline__ void operator()(const f32x4 (&acc)[2][2][4][2], const Unit& u, int wr, int wc, int fr, int fq) const {
        const int row0 = u.pm * BM + wr * 64 + fr; const int colt = u.pn * BM;
        const int col0 = colt + wc * 32 + 8 * fq;
        f32x4 bv[2][2];
#pragma unroll
        for (int bj = 0; bj < 2; ++bj)
#pragma unroll
            for (int n = 0; n < 2; ++n) {
                if (ACT == 1) { const float* bp = (colt < bias_split) ? (bias0 + col0) : (bias1 + (col0 - bias_split)); bv[bj][n] = *(const f32x4*)(bp + bj * HALF + 4 * n); }
                else bv[bj][n] = (f32x4){0.f, 0.f, 0.f, 0.f};
            }
#pragma unroll
        for (int ai = 0; ai < 2; ++ai)
#pragma unroll
            for (int m = 0; m < 4; ++m) { bf16_t* rowp = O + (size_t)(row0 + ai * HALF + m * 16) * ldc + col0;
#pragma unroll
                for (int bj = 0; bj < 2; ++bj) { f32x4 v0 = acc[ai][bj][m][0] + bv[bj][0], v1 = acc[ai][bj][m][1] + bv[bj][1];
                    if (ACT == 1) {
#pragma unroll
                        for (int j = 0; j < 4; ++j) { v0[j] = __builtin_amdgcn_rcpf(1.0f + __builtin_amdgcn_exp2f(-1.4426950408889634f * v0[j])); v1[j] = __builtin_amdgcn_rcpf(1.0f + __builtin_amdgcn_exp2f(-1.4426950408889634f * v1[j])); } }
                    if (ACT == 2) {
#pragma unroll
                        for (int j = 0; j < 4; ++j) { const float a = fmaxf(v0[j], 0.f), b = fmaxf(v1[j], 0.f); v0[j] = a * a; v1[j] = b * b; } }
                    u32x4 w; w.x = cvt_pk_bf16(v0[0], v0[1]); w.y = cvt_pk_bf16(v0[2], v0[3]); w.z = cvt_pk_bf16(v1[0], v1[1]); w.w = cvt_pk_bf16(v1[2], v1[3]);
                    *(u32x4*)(rowp + bj * HALF) = w; } }
    }
};
struct EpiResF32 {
    static constexpr bool PERM = false, AFTER_DRAIN = false;
    const float* base; float* out; int ldc;
    __device__ __forceinline__ void operator()(const f32x4 (&acc)[2][2][4][2], const Unit& u, int wr, int wc, int fr, int fq) const {
        const int row0 = u.pm * BM + wr * 64 + fr, col0 = u.pn * BM + wc * 32 + 4 * fq;
#pragma unroll
        for (int ai = 0; ai < 2; ++ai)
#pragma unroll
            for (int m = 0; m < 4; ++m) { const size_t off = (size_t)(row0 + ai * HALF + m * 16) * ldc + col0;
#pragma unroll
                for (int bj = 0; bj < 2; ++bj)
#pragma unroll
                    for (int n = 0; n < 2; ++n) { const f32x4 bs = *(const f32x4*)(base + off + bj * HALF + n * 16); *(f32x4*)(out + off + bj * HALF + n * 16) = bs + acc[ai][bj][m][n]; }
                asm volatile("" ::: "memory"); }
    }
};
template <class Epi, class Sched, bool ALIGN_EPI = false, bool SP2 = false>
__device__ __forceinline__ void gemm_phase(PG8_LAS unsigned char* lds, const Gemm g, const Sched& S, const Epi& E) {
    const int tid = tid_opaque(), wid = __builtin_amdgcn_readfirstlane(tid >> 6), lane = tid & 63, wr = wid >> 2, wc = wid & 3, fr = lane & 15, fq = lane >> 4;
    const int K = g.K, nt = K / BK;
    unsigned voffA[2], voffB[2];
#pragma unroll
    for (int i = 0; i < 2; ++i) { int R, C; stage_rc(tid * 16 + i * 8192, R, C); const int Rb = Epi::PERM ? ((R & ~31) + perm32(R & 31)) : R;
        voffA[i] = (unsigned)(R * K + C) * 2u; voffB[i] = (unsigned)(Rb * K + C) * 2u; }
    const size_t kstep = (size_t)(BK * 2);
    const size_t hstep = (size_t)HALF * K * 2;
    const size_t tstep = 2 * hstep;
    const unsigned ldsw = (unsigned)wid * 1024u;
    const int aoff = lds_byte(wr * 64 + fr, fq * 8), boff = lds_byte(wc * 32 + fr, fq * 8);
#define PG8_SA(b, h) (((b) * 2 + (h)) * HTB)
#define PG8_SB(b, h) ((4 + (b) * 2 + (h)) * HTB)
#define PG8_STAGE(bufoff, gbase, voff) do { _Pragma("unroll") for (int _i = 0; _i < 2; ++_i) \
        __builtin_amdgcn_global_load_lds((const unsigned*)((const char*)(gbase) + (voff)[_i]), (PG8_LAS unsigned*)(lds + (bufoff) + ldsw + _i * 8192), 16, 0, 0); } while (0)
#define PG8_LDA(dst, b, h) do { _Pragma("unroll") for (int m = 0; m < 4; ++m) _Pragma("unroll") for (int k = 0; k < 2; ++k) dst[m][k] = *(const PG8_LAS bf16x8*)(lds + PG8_SA(b, h) + aoff + m * 2048 + k * 1024); } while (0)
#define PG8_LDB(dst, b, h) do { _Pragma("unroll") for (int n = 0; n < 2; ++n) _Pragma("unroll") for (int k = 0; k < 2; ++k) dst[n][k] = *(const PG8_LAS bf16x8*)(lds + PG8_SB(b, h) + boff + n * 2048 + k * 1024); } while (0)
#define PG8_MMA(ai, bj, At, Bt) do { __builtin_amdgcn_s_setprio(1); _Pragma("unroll") for (int m = 0; m < 4; ++m) _Pragma("unroll") for (int n = 0; n < 2; ++n) _Pragma("unroll") for (int k = 0; k < 2; ++k) \
        acc[ai][bj][m][n] = __builtin_amdgcn_mfma_f32_16x16x32_bf16(Bt[n][k], At[m][k], acc[ai][bj][m][n], 0, 0, 0); __builtin_amdgcn_s_setprio(0); } while (0)
#define PG8_WAIT_V(n) asm volatile("s_waitcnt vmcnt(" #n ")" ::: "memory")
#define PG8_WAIT_L(n) asm volatile("s_waitcnt lgkmcnt(" #n ")" ::: "memory")
#define PG8_BAR __builtin_amdgcn_s_barrier()
#define PG8_SCHED __builtin_amdgcn_sched_barrier(0)
    Unit cur, nxt; int ui = 0;
    if (!S.next(0, cur)) return;
    f32x4 acc[2][2][4][2];
#pragma unroll
    for (int a = 0; a < 2; ++a)
#pragma unroll
        for (int b = 0; b < 2; ++b)
#pragma unroll
            for (int m = 0; m < 4; ++m)
#pragma unroll
                for (int n = 0; n < 2; ++n) acc[a][b][m][n] = (f32x4){0.f, 0.f, 0.f, 0.f};
    bf16x8 At[4][2], B0[2][2], B1[2][2];
    const char* cA = (const char*)g.A + (size_t)cur.pm * tstep; const char* cB = (const char*)g.Bt + (size_t)cur.pn * tstep;
    S.a_ready(cur);
    if constexpr (SP2) {
        PG8_STAGE(PG8_SB(0, 0), cB, voffB); PG8_STAGE(PG8_SB(0, 1), cB + hstep, voffB); PG8_STAGE(PG8_SA(0, 0), cA, voffA); PG8_STAGE(PG8_SA(0, 1), cA + hstep, voffA);
        if (wr == 1) PG8_BAR;
        PG8_WAIT_V(2); PG8_BAR;
        PG8_STAGE(PG8_SB(1, 0), cB + kstep, voffB); PG8_STAGE(PG8_SA(1, 0), cA + kstep, voffA); PG8_STAGE(PG8_SB(1, 1), cB + hstep + kstep, voffB);
        PG8_WAIT_V(6); PG8_BAR;
    } else {
        PG8_STAGE(PG8_SB(0, 0), cB, voffB); PG8_STAGE(PG8_SA(0, 0), cA, voffA); PG8_STAGE(PG8_SB(0, 1), cB + hstep, voffB); PG8_STAGE(PG8_SA(0, 1), cA + hstep, voffA);
        if (wr == 1) PG8_BAR;
        PG8_WAIT_V(4); PG8_BAR;
        PG8_STAGE(PG8_SB(1, 0), cB + kstep, voffB); PG8_STAGE(PG8_SA(1, 0), cA + kstep, voffA); PG8_STAGE(PG8_SB(1, 1), cB + hstep + kstep, voffB);
        PG8_WAIT_V(6); PG8_BAR;
    }
    for (;;) {
        const bool has_next = S.next(ui + 1, nxt);
        const char* nA = has_next ? (const char*)g.A + (size_t)nxt.pm * tstep : cA; const char* nB = has_next ? (const char*)g.Bt + (size_t)nxt.pn * tstep : cB;
        for (int t = 0; t < nt; t += 2) {
            const bool last = (t == nt - 2);
            const char* a1 = cA + (size_t)(t + 1) * kstep;
            const char* a2 = last ? nA : cA + (size_t)(t + 2) * kstep; const char* b2 = last ? nB : cB + (size_t)(t + 2) * kstep;
            const char* a3 = a2 + kstep; const char* b3 = b2 + kstep;
            if (last && has_next) S.a_ready(nxt);
            if constexpr (SP2) {
            PG8_LDB(B0, 0, 0); PG8_LDB(B1, 0, 1); PG8_SCHED; PG8_LDA(At, 0, 0); PG8_STAGE(PG8_SA(1, 1), a1 + hstep, voffA);
            PG8_WAIT_V(8); PG8_WAIT_L(0); PG8_BAR; PG8_MMA(0, 0, At, B0); PG8_MMA(0, 1, At, B1); PG8_BAR; PG8_SCHED;
            PG8_LDA(At, 0, 1); PG8_STAGE(PG8_SB(0, 0), b2, voffB); PG8_STAGE(PG8_SB(0, 1), b2 + hstep, voffB); PG8_STAGE(PG8_SA(0, 0), a2, voffA);
            PG8_WAIT_V(8); PG8_WAIT_L(0); PG8_BAR; PG8_MMA(1, 0, At, B0); PG8_MMA(1, 1, At, B1); PG8_BAR; PG8_SCHED;
            PG8_LDB(B0, 1, 0); PG8_LDB(B1, 1, 1); PG8_SCHED; PG8_LDA(At, 1, 0); PG8_STAGE(PG8_SA(0, 1), a2 + hstep, voffA);
            PG8_WAIT_V(8); PG8_WAIT_L(0); PG8_BAR; PG8_MMA(0, 0, At, B0); PG8_MMA(0, 1, At, B1); PG8_BAR; PG8_SCHED;
            PG8_LDA(At, 1, 1); PG8_STAGE(PG8_SB(1, 0), b3, voffB); PG8_STAGE(PG8_SB(1, 1), b3 + hstep, voffB); PG8_STAGE(PG8_SA(1, 0), a3, voffA);
            PG8_WAIT_V(8); PG8_WAIT_L(0); PG8_BAR; PG8_MMA(1, 0, At, B0); PG8_MMA(1, 1, At, B1); PG8_BAR; PG8_SCHED;
            } else {
            PG8_LDB(B0, 0, 0); PG8_SCHED; PG8_LDA(At, 0, 0); PG8_STAGE(PG8_SA(1, 1), a1 + hstep, voffA);
            PG8_WAIT_L(8); PG8_BAR; PG8_WAIT_L(0); PG8_MMA(0, 0, At, B0); PG8_BAR; PG8_SCHED;
            PG8_LDB(B1, 0, 1); PG8_STAGE(PG8_SB(0, 0), b2, voffB);
            PG8_BAR; PG8_WAIT_L(0); PG8_MMA(0, 1, At, B1); PG8_BAR;
            PG8_LDA(At, 0, 1); PG8_STAGE(PG8_SA(0, 0), a2, voffA);
            PG8_BAR; PG8_WAIT_L(0); PG8_MMA(1, 0, At, B0); PG8_BAR; PG8_SCHED;
            PG8_STAGE(PG8_SB(0, 1), b2 + hstep, voffB);
            PG8_WAIT_V(6); PG8_BAR; PG8_MMA(1, 1, At, B1); PG8_BAR;
            PG8_LDB(B0, 1, 0); PG8_SCHED; PG8_LDA(At, 1, 0); PG8_STAGE(PG8_SA(0, 1), a2 + hstep, voffA);
            PG8_WAIT_L(8); PG8_BAR; PG8_WAIT_L(0); PG8_MMA(0, 0, At, B0); PG8_BAR; PG8_SCHED;
            PG8_LDB(B1, 1, 1); PG8_STAGE(PG8_SB(1, 0), b3, voffB);
            PG8_BAR; PG8_WAIT_L(0); PG8_MMA(0, 1, At, B1); PG8_BAR;
            PG8_LDA(At, 1, 1); PG8_STAGE(PG8_SA(1, 0), a3, voffA);
            PG8_BAR; PG8_WAIT_L(0); PG8_MMA(1, 0, At, B0); PG8_BAR; PG8_SCHED;
            PG8_STAGE(PG8_SB(1, 1), b3 + hstep, voffB);
            PG8_WAIT_V(6); PG8_BAR; PG8_MMA(1, 1, At, B1); PG8_BAR;
            }
        }
        if constexpr (ALIGN_EPI) { if (wr == 0) PG8_BAR; }
        if constexpr (!Epi::AFTER_DRAIN) { E(acc, cur, wr, wc, fr, fq); S.done(cur); }
        if (!has_next) break;
#pragma unroll
        for (int a = 0; a < 2; ++a)
#pragma unroll
            for (int b = 0; b < 2; ++b)
#pragma unroll
                for (int m = 0; m < 4; ++m)
#pragma unroll
                    for (int n = 0; n < 2; ++n) acc[a][b][m][n] = (f32x4){0.f, 0.f, 0.f, 0.f};
        cur = nxt; cA = nA; cB = nB; ++ui;
        if constexpr (ALIGN_EPI) { if (wr == 1) PG8_BAR; }
    }
    PG8_WAIT_V(0);
    if constexpr (!ALIGN_EPI) { if (wr == 0) PG8_BAR; }
    PG8_BAR;
    if constexpr (Epi::AFTER_DRAIN) { E.fused(acc, cur, wr, wc, fr, fq, lds, wid, lane); S.done(cur); }
#undef PG8_SA
#undef PG8_SB
#undef PG8_STAGE
#undef PG8_LDA
#undef PG8_LDB
#undef PG8_MMA
#undef PG8_WAIT_V
#undef PG8_WAIT_L
#undef PG8_BAR
#undef PG8_SCHED
}
}

namespace ab {
enum { ORDER_NATURAL = 0, ORDER_REVERSED = 1, ORDER_PAIRED = 2, ORDER_XCD = 4 };
using TIN = __hip_bfloat16; using TOUT = __hip_bfloat16;
constexpr int B = 4, H = 32, HKV = 32, SQ = 4096, SKV = 4096, D = 128;
constexpr int QOFF = 0; constexpr int WINDOW = SKV; constexpr float THR = 8.f; constexpr int ORDER = ORDER_PAIRED; constexpr int GRID_WGS = 0; constexpr bool WSKIP = false;
constexpr float SCALE = 0.08838834764831845f;
constexpr int NW = 8, QBLK = 32, KVBLK = 64, QB = NW * QBLK;
constexpr int SHM_V = KVBLK * D * 2, SHM_K = KVBLK * D * 2;
constexpr int LDS_BYTES = 2 * SHM_V + 2 * SHM_K + NW * 64 * 4;
using bf16 = __hip_bfloat16;
typedef short bf16x8 __attribute__((ext_vector_type(8)));
typedef short s16x4 __attribute__((ext_vector_type(4)));
typedef float f32x16 __attribute__((ext_vector_type(16)));
typedef float f32x4 __attribute__((ext_vector_type(4)));
typedef unsigned u32x4 __attribute__((ext_vector_type(4)));
template <class A, class Bt> struct same_t { static constexpr bool v = false; };
template <class A> struct same_t<A, A> { static constexpr bool v = true; };

#define KSWZ(row, colB) ((row) * 256 + ((colB) ^ (((row) & 7) << 4)))
#define SBAR() __builtin_amdgcn_sched_barrier(0)
__device__ __forceinline__ int v_st(int k, int c) { const int kk = (k & ~0xC) | ((k & 4) << 1) | ((k & 8) >> 1); return ((kk >> 3) * 4 + (c >> 5)) * 512 + ((kk & 7) * 32 + (c & 31)) * 2; }
__device__ __forceinline__ int v_rd_base(int lane) { return ((lane & 3) << 3) | (((lane >> 2) & 3) << 6) | (((lane >> 4) & 1) << 5) | (((lane >> 5) & 1) << 8); }
constexpr int v_rd_off(int d0, int ks, int half) { return d0 * 512 + ks * 4096 + half * 2048; }
__device__ __forceinline__ int crow(int r, int hi) { return (r & 3) + 8 * (r >> 2) + 4 * hi; }
__device__ __forceinline__ unsigned cvtpk(float lo, float hi) {
    return pk_bf16_builtin(lo, hi);
}
__device__ __forceinline__ bf16x8 pack8(f32x4 a, f32x4 b) {
    u32x4 w = {cvtpk(a[0], a[1]), cvtpk(a[2], a[3]), cvtpk(b[0], b[1]), cvtpk(b[2], b[3])};
    return *reinterpret_cast<bf16x8*>(&w);
}
template <class T> __device__ __forceinline__ bf16x8 load8(const T* p) {
    if constexpr (same_t<T, float>::v) { return pack8(*(const f32x4*)p, *(const f32x4*)(p + 4)); }
    else { return *reinterpret_cast<const bf16x8*>(p); }
}
__device__ __forceinline__ void mask_tile(f32x16& p0, f32x16& p1, int dq, unsigned W) {
    const float NEG = -__builtin_inff();
#pragma unroll
    for (int r = 0; r < 16; ++r) {
        const int c = (r & 3) + 8 * (r >> 2);
        if ((unsigned)(dq - c) >= W) p0[r] = NEG;
        if ((unsigned)(dq - c - 32) >= W) p1[r] = NEG;
    }
}
__device__ __forceinline__ void partialSM(f32x16& p0, f32x16& p1, float& m_reg, float& mn, float& alpha) {
    float pmax = p0[0]; for (int r = 1; r < 16; ++r) pmax = fmaxf(pmax, p0[r]); for (int r = 0; r < 16; ++r) pmax = fmaxf(pmax, p1[r]);
    { auto rr = __builtin_amdgcn_permlane32_swap(__float_as_uint(pmax), __float_as_uint(pmax), false, false);
      pmax = fmaxf(__uint_as_float(rr[0]), __uint_as_float(rr[1])); }
    constexpr float C2 = 1.4426950408889634f * SCALE;
    if (__builtin_expect(__all((pmax - m_reg) * SCALE <= THR), 1)) { mn = m_reg; alpha = 1.f; }
    else { mn = fmaxf(m_reg, pmax); alpha = __builtin_amdgcn_exp2f((m_reg - mn) * C2); m_reg = mn; }
    const float mnL = -mn * C2;
    for (int r = 0; r < 16; ++r) p0[r] = fmaf(p0[r], C2, mnL); for (int r = 0; r < 16; ++r) p1[r] = fmaf(p1[r], C2, mnL);
    for (int r = 0; r < 16; ++r) p0[r] = __builtin_amdgcn_exp2f(p0[r]);
}
__device__ __forceinline__ void finishSM(f32x16& p0, f32x16& p1, float alpha, float& l_reg, bf16x8& pa0, bf16x8& pa1, bf16x8& pa2, bf16x8& pa3) {
    for (int r = 0; r < 16; ++r) p1[r] = __builtin_amdgcn_exp2f(p1[r]);
    float ps = 0; for (int r = 0; r < 16; ++r) ps += p0[r]; for (int r = 0; r < 16; ++r) ps += p1[r];
    { auto rr = __builtin_amdgcn_permlane32_swap(__float_as_uint(ps), __float_as_uint(ps), false, false);
      ps = __uint_as_float(rr[0]) + __uint_as_float(rr[1]); }
    l_reg = l_reg * alpha + ps;
#define PK4(P, B_, OUT) do { unsigned a0 = cvtpk(P[B_+0], P[B_+1]), a1 = cvtpk(P[B_+2], P[B_+3]);                          \
        unsigned b0 = cvtpk(P[B_+4], P[B_+5]), b1 = cvtpk(P[B_+6], P[B_+7]);                                             \
        auto r0 = __builtin_amdgcn_permlane32_swap(a0, b0, false, false); auto r1 = __builtin_amdgcn_permlane32_swap(a1, b1, false, false); \
        u32x4 w = {r0[0], r1[0], r0[1], r1[1]}; OUT = *reinterpret_cast<bf16x8*>(&w); } while (0)
    PK4(p0, 0, pa0); PK4(p0, 8, pa1); PK4(p1, 0, pa2); PK4(p1, 8, pa3);
#undef PK4
}
template <int KB, bool SK>
__device__ __forceinline__ void qkt(f32x16& p0, f32x16& p1, const char* K_lds, int r32, int hi, const bf16x8* qr, bool act) {
    if (SK && !act) { const float NEG = -__builtin_inff();
#pragma unroll
        for (int r = 0; r < 16; ++r) { p0[r] = NEG; p1[r] = NEG; } return; }
    p0 = f32x16{}; p1 = f32x16{};
    const char* kb[4];
#pragma unroll
    for (int dd = 0; dd < 4; ++dd) kb[dd] = K_lds + KB * SHM_K + KSWZ(r32, (dd * 16 + hi * 8) * 2);
#pragma unroll
    for (int d0 = 0; d0 < 8; ++d0) { const char* a = kb[d0 & 3] + (d0 >> 2) * 128;
        bf16x8 b0 = *reinterpret_cast<const bf16x8*>(a);
        bf16x8 b1 = *reinterpret_cast<const bf16x8*>(a + 32 * 256);
        p0 = __builtin_amdgcn_mfma_f32_32x32x16_bf16(b0, qr[d0], p0, 0, 0, 0);
        p1 = __builtin_amdgcn_mfma_f32_32x32x16_bf16(b1, qr[d0], p1, 0, 0, 0); }
}
template <int VB, bool SK>
__device__ __forceinline__ void pv_tile(f32x16* o, int vb0, bf16x8 pa0, bf16x8 pa1, bf16x8 pa2, bf16x8 pa3, bool act) {
    if (SK && !act) return;
#define TRRD(dst, off) asm volatile("ds_read_b64_tr_b16 %0, %1 offset:%2" : "=&v"(dst) : "v"(vb0), "i"(off) : "memory")
#define PV_D0(d0) do { s16x4 l0, l1, l2, l3, h0, h1, h2, h3; constexpr int b_ = VB * SHM_V + v_rd_off(d0, 0, 0);     \
        TRRD(l0, b_); TRRD(h0, b_ + 2048); TRRD(l1, b_ + 4096); TRRD(h1, b_ + 6144); TRRD(l2, b_ + 8192); TRRD(h2, b_ + 10240); TRRD(l3, b_ + 12288); TRRD(h3, b_ + 14336); \
        asm volatile("s_waitcnt lgkmcnt(0)" ::: "memory"); SBAR();                 \
        o[d0] = __builtin_amdgcn_mfma_f32_32x32x16_bf16(pa0, (bf16x8){l0[0], l0[1], l0[2], l0[3], h0[0], h0[1], h0[2], h0[3]}, o[d0], 0, 0, 0);   \
        o[d0] = __builtin_amdgcn_mfma_f32_32x32x16_bf16(pa1, (bf16x8){l1[0], l1[1], l1[2], l1[3], h1[0], h1[1], h1[2], h1[3]}, o[d0], 0, 0, 0);   \
        o[d0] = __builtin_amdgcn_mfma_f32_32x32x16_bf16(pa2, (bf16x8){l2[0], l2[1], l2[2], l2[3], h2[0], h2[1], h2[2], h2[3]}, o[d0], 0, 0, 0);   \
        o[d0] = __builtin_amdgcn_mfma_f32_32x32x16_bf16(pa3, (bf16x8){l3[0], l3[1], l3[2], l3[3], h3[0], h3[1], h3[2], h3[3]}, o[d0], 0, 0, 0); } while (0)
    PV_D0(0); PV_D0(1); PV_D0(2); PV_D0(3);
#undef PV_D0
#undef TRRD
}

template <class TIn, class TOut> struct BlockRef { const TIn* Q; const TIn* K; const TIn* V; TOut* O; int P0; };
template <class TIn> struct Seam {
    bf16x8 qr[8];
    bf16x8 st_v0, st_v1, st_k0, st_k1; f32x4 sf0, sf1, sf2, sf3;
    f32x4 tq[16];
};
__device__ __forceinline__ int swa_jlo(int P0, int W) { const int lowk = P0 - W + 1; return lowk > 0 ? lowk / KVBLK : 0; }
#define ROW(p, k0, rr) ((p) + (size_t)((k0) + (rr)) * D + sc)
#define VMW() asm volatile("s_waitcnt vmcnt(0)" ::: "memory")
#define VMWN(n) asm volatile("s_waitcnt vmcnt(%0)" :: "i"(n) : "memory")
#define SLOAD_H(Kp, Vp, k0) do { S.st_v0 = load8<TIn>(ROW(Vp, k0, sr)); S.st_v1 = load8<TIn>(ROW(Vp, k0, 32 + sr));              \
                         S.st_k0 = load8<TIn>(ROW(Kp, k0, sr)); S.st_k1 = load8<TIn>(ROW(Kp, k0, 32 + sr)); } while (0)
#define SWRITE_HK(bf) do { *(bf16x8*)(K_lds + (bf) * SHM_K + kws) = S.st_k0; *(bf16x8*)(K_lds + (bf) * SHM_K + kws + 32 * 256) = S.st_k1; } while (0)
#define SWRITE_HV(bf) do { *(bf16x8*)(V_lds + (bf) * SHM_V + vst0) = S.st_v0; *(bf16x8*)(V_lds + (bf) * SHM_V + vst1) = S.st_v1; } while (0)
#define SWRITE_H(bf) do { SWRITE_HV(bf); SWRITE_HK(bf); } while (0)
#define SLOAD_F(p, k0) do { S.sf0 = *(const f32x4*)ROW(p, k0, sr); S.sf1 = *(const f32x4*)(ROW(p, k0, sr) + 4);                \
                            S.sf2 = *(const f32x4*)ROW(p, k0, 32 + sr); S.sf3 = *(const f32x4*)(ROW(p, k0, 32 + sr) + 4); } while (0)
#define SWRITE_KF(bf) do { *(bf16x8*)(K_lds + (bf) * SHM_K + kws) = pack8(S.sf0, S.sf1); *(bf16x8*)(K_lds + (bf) * SHM_K + kws + 32 * 256) = pack8(S.sf2, S.sf3); } while (0)
#define SWRITE_VF(bf) do { *(bf16x8*)(V_lds + (bf) * SHM_V + vst0) = pack8(S.sf0, S.sf1); *(bf16x8*)(V_lds + (bf) * SHM_V + vst1) = pack8(S.sf2, S.sf3); } while (0)
template <class TIn, class TOut>
__device__ __forceinline__ void causal_swa_prime(const BlockRef<TIn, TOut>& cur, int W, char* lds, Seam<TIn>& S) {
    constexpr bool F32 = same_t<TIn, float>::v;
    const int tid = tid_opaque(), wid = __builtin_amdgcn_readfirstlane(tid >> 6), lane = tid & 63, r32 = lane & 31, hi = lane >> 5;
    const int sr = tid >> 4, sc = (tid & 15) * 8, kws = KSWZ(sr, sc * 2); char* K_lds = lds + 2 * SHM_V;
    const int kb0 = swa_jlo(cur.P0, W) * KVBLK;
    for (int d0 = 0; d0 < 8; ++d0) S.qr[d0] = load8<TIn>(cur.Q + (size_t)(wid * QBLK + r32) * D + d0 * 16 + hi * 8);
    if constexpr (F32) { SLOAD_F((const float*)cur.K, kb0); VMW(); SWRITE_KF(0); SBAR(); SLOAD_F((const float*)cur.V, kb0); }
    else { SLOAD_H(cur.K, cur.V, kb0); VMW(); SWRITE_HK(0); }
    __syncthreads();
}
template <class TIn, class TOut>
__device__ __forceinline__ void causal_swa_block(const BlockRef<TIn, TOut>& cur, const BlockRef<TIn, TOut>& nxt, int skv, int W, char* lds, Seam<TIn>& S) {
    constexpr bool F32 = same_t<TIn, float>::v;
    const int tid = tid_opaque(), wid = __builtin_amdgcn_readfirstlane(tid >> 6), lane = tid & 63, r32 = lane & 31, hi = lane >> 5;
    const int j_lo = swa_jlo(cur.P0, W);
    int j_hi = (cur.P0 + QB - 1) / KVBLK + 1; if (j_hi > skv / KVBLK) j_hi = skv / KVBLK;
    const int NT = j_hi - j_lo;
    const int kbn = swa_jlo(nxt.P0, W) * KVBLK;
    const int qlo = cur.P0 + wid * QBLK, qm = qlo + r32 - 4 * hi;
    char* V_lds = lds; char* K_lds = lds + 2 * SHM_V;
    float* ws = (float*)(lds + 2 * SHM_V + 2 * SHM_K) + wid * 64; float* li_l = ws, * al_l = ws + 32;
    float m_reg = -1e30f, l_reg = 0; f32x16 o[4] = {};
    const int sr = tid >> 4, sc = (tid & 15) * 8, vst0 = v_st(sr, sc), vst1 = v_st(32 + sr, sc), kws = KSWZ(sr, sc * 2);
    const int vb0 = (int)(uintptr_t)V_lds + v_rd_base(lane);
    const TIn* Kh = cur.K; const TIn* Vh = cur.V;
#define RESC(a) do { if (__any((a) < 1.f)) { if (hi == 0) al_l[r32] = (a); asm volatile("s_waitcnt lgkmcnt(0)" ::: "memory");              \
                     for (int d_ = 0; d_ < 4; ++d_) for (int r = 0; r < 16; ++r) o[d_][r] *= al_l[crow(r, hi)]; } } while (0)
#define KBASE(t) ((j_lo + (t)) * KVBLK)
#define ACT(t) (KBASE(t) <= qlo + QBLK - 1 && KBASE(t) + KVBLK - 1 >= qlo - W + 1)
#define MASKT(P0_, P1_, t) do { const int kb_ = KBASE(t); if ((!SK || ACT(t)) && (kb_ + KVBLK - 1 > qlo || kb_ <= qlo + QBLK - 1 - W)) mask_tile(P0_, P1_, qm - kb_, (unsigned)W); } while (0)
    constexpr int NQL = F32 ? 16 : 8;
    constexpr bool SK = WSKIP && !F32;
#define SEAM_K0() do { VMWN(NQL); if constexpr (F32) { SWRITE_KF(0); SBAR(); SLOAD_F((const float*)nxt.V, kbn); } else { SWRITE_HK(0); } SBAR(); } while (0)
    f32x16 pA0, pA1, pB0, pB1; float mnA, mnB, alA, alB; bf16x8 pa0, pa1, pa2, pa3;
    if constexpr (F32) { VMW(); SWRITE_VF(0); SBAR(); } else { SWRITE_HV(0); SBAR(); }
    if (NT > 1) { if constexpr (F32) SLOAD_F((const float*)Kh, KBASE(1)); else SLOAD_H(Kh, Vh, KBASE(1)); }
    SBAR(); qkt<0, SK>(pA0, pA1, K_lds, r32, hi, S.qr, ACT(0));
    if constexpr (F32) { if (NT > 1) { VMW(); SWRITE_KF(1); SBAR(); SLOAD_F((const float*)Vh, KBASE(1)); } }
    MASKT(pA0, pA1, 0); partialSM(pA0, pA1, m_reg, mnA, alA);
    if (NT > 1) { VMW(); if constexpr (F32) { SWRITE_VF(1); SBAR(); if (NT > 2) SLOAD_F((const float*)Kh, KBASE(2)); } else SWRITE_H(1); }
    __syncthreads();
#define HALF_STEP(PX0, PX1, mnX, alX, PY0, PY1, alY, t, KB, VB, SB) do {                                                      \
        SBAR(); qkt<KB, SK>(PX0, PX1, K_lds, r32, hi, S.qr, ACT(t));                                             \
        finishSM(PY0, PY1, alY, l_reg, pa0, pa1, pa2, pa3); SBAR();                                                           \
        if ((t) + 1 < NT) { if constexpr (F32) { VMW(); SWRITE_KF(SB); SBAR(); SLOAD_F((const float*)Vh, KBASE((t) + 1)); }  \
                            else { SLOAD_H(Kh, Vh, KBASE((t) + 1)); } SBAR(); }                                               \
        pv_tile<VB, SK>(o, vb0, pa0, pa1, pa2, pa3, ACT((t) - 1)); MASKT(PX0, PX1, (t)); partialSM(PX0, PX1, m_reg, mnX, alX);                                        \
        __syncthreads();                                                                                                      \
        if ((t) + 1 < NT) { VMW(); if constexpr (F32) { SWRITE_VF(SB); SBAR(); if ((t) + 2 < NT) SLOAD_F((const float*)Kh, KBASE((t) + 2)); } \
                            else { SWRITE_H(SB); } }                                                                          \
        RESC(alX); __syncthreads(); } while (0)
    for (int t = 1; t + 1 < NT; t += 2) {
        HALF_STEP(pB0, pB1, mnB, alB, pA0, pA1, alA, t, 1, 0, 0);
        HALF_STEP(pA0, pA1, mnA, alA, pB0, pB1, alB, t + 1, 0, 1, 1);
    }
    const bool even = (NT & 1) == 0;
    if (even) { SBAR(); qkt<1, SK>(pB0, pB1, K_lds, r32, hi, S.qr, ACT(NT - 1)); SBAR(); }
#define QROW(e) (nxt.Q + (size_t)(wid * QBLK + r32) * D + ((e) >> 1) * 16 + hi * 8 + ((e) & 1) * 4)
    if constexpr (F32) { SLOAD_F((const float*)nxt.K, kbn); SBAR();
#pragma unroll
        for (int e = 0; e < 8; ++e) S.tq[e] = *(const f32x4*)QROW(e); }
    else { SLOAD_H(nxt.K, nxt.V, kbn); SBAR();
#pragma unroll
        for (int d0 = 0; d0 < 8; ++d0) S.qr[d0] = load8<TIn>(nxt.Q + (size_t)(wid * QBLK + r32) * D + d0 * 16 + hi * 8); }
    SBAR();
    finishSM(pA0, pA1, alA, l_reg, pa0, pa1, pa2, pa3); SBAR();
    if constexpr (F32) {
#pragma unroll
        for (int e = 8; e < 16; ++e) S.tq[e] = *(const f32x4*)QROW(e); SBAR(); }
#undef QROW
    pv_tile<0, SK>(o, vb0, pa0, pa1, pa2, pa3, ACT(even ? NT - 2 : NT - 1));
    if (even) { MASKT(pB0, pB1, NT - 1); partialSM(pB0, pB1, m_reg, mnB, alB); __syncthreads(); RESC(alB);
        finishSM(pB0, pB1, alB, l_reg, pa0, pa1, pa2, pa3); SBAR(); pv_tile<1, SK>(o, vb0, pa0, pa1, pa2, pa3, ACT(NT - 1)); }
    SBAR(); SEAM_K0();
    if (hi == 0) li_l[r32] = l_reg; asm volatile("s_waitcnt lgkmcnt(0)" ::: "memory");
    float rli[16];
#pragma unroll
    for (int r = 0; r < 16; ++r) rli[r] = __builtin_amdgcn_rcpf(li_l[crow(r, hi)]);
    TOut* Ow = cur.O + (size_t)(wid * QBLK) * D;
#pragma unroll
    for (int r = 0; r < 16; ++r) { const int orow = crow(r, hi);
#pragma unroll
        for (int d0 = 0; d0 < 4; ++d0) { const float v = o[d0][r] * rli[r];
            if constexpr (same_t<TOut, float>::v) { Ow[(size_t)orow * D + d0 * 32 + r32] = v; }
            else { const float vn = __shfl_xor(v, 1);
                   if ((r32 & 1) == 0) *(unsigned*)(Ow + (size_t)orow * D + d0 * 32 + r32) = cvtpk(v, vn); } } }
    if constexpr (F32) {
#pragma unroll
        for (int d0 = 0; d0 < 8; ++d0) S.qr[d0] = pack8(S.tq[2 * d0], S.tq[2 * d0 + 1]); }
    __syncthreads();
#undef RESC
#undef KBASE
#undef ACT
#undef MASKT
#undef SEAM_K0
#undef HALF_STEP
}
#undef ROW
#undef VMW
#undef VMWN
#undef SLOAD_H
#undef SWRITE_HK
#undef SWRITE_HV
#undef SWRITE_H
#undef SLOAD_F
#undef SWRITE_KF
#undef SWRITE_VF

}

#define XB_TMO      128
#define XB_XCNT(j)  (256  + 64 * (j))
#define XB_XSUB(j)  (1280 + 64 * (j))
#define XB_XGEN(j)  (2304 + 64 * (j))
#define XB_TOP      3328
#define XB_TOPGEN   3392
#define XCD_BAR_WORDS 3456
#define XB_SPIN_CAP (1u << 18)
#define LAS __attribute__((address_space(3)))

__device__ __forceinline__ unsigned xb_ld(unsigned* p)              { return __hip_atomic_load(p, __ATOMIC_RELAXED, __HIP_MEMORY_SCOPE_AGENT); }
__device__ __forceinline__ unsigned xb_add(unsigned* p, unsigned v) { return __hip_atomic_fetch_add(p, v, __ATOMIC_RELAXED, __HIP_MEMORY_SCOPE_AGENT); }
__device__ __forceinline__ unsigned xb_xcc_id() { return (unsigned)__builtin_amdgcn_s_getreg((3 << 11) | 20) & 0xFu; }
#define XB_SPIN(cond, bar) do { unsigned _sp = 0; while (cond) { __builtin_amdgcn_s_sleep(1); \
    if ((++_sp & 255u) == 0u) { if (xb_ld(&(bar)[XB_TMO])) break; if (_sp > XB_SPIN_CAP) { atomicAdd(&(bar)[XB_TMO], 1u); break; } } } } while (0)

struct XcdBarrier {
    unsigned* bar; unsigned x;
    volatile LAS unsigned* st;
};

__device__ __forceinline__ XcdBarrier xcd_barrier_post(unsigned* bar, volatile LAS unsigned* st) {
    XcdBarrier b; b.bar = bar; b.x = xb_xcc_id(); b.st = st;
    if (threadIdx.x == 0) (void)xb_add(&bar[XB_XCNT(b.x)], 1u);
    return b;
}
__device__ __forceinline__ void xcd_barrier_complete(unsigned* bar, unsigned x, unsigned& nloc, unsigned& nx) {
    const unsigned G = gridDim.x * gridDim.y * gridDim.z;
    unsigned sum, cnt, mine, sp = 0u;
    for (;;) {
        sum = 0u; cnt = 0u; mine = 0u;
#pragma unroll
        for (unsigned j = 0; j < 16; ++j) { const unsigned c = xb_ld(&bar[XB_XCNT(j)]); sum += c; cnt += (c > 0u) ? 1u : 0u; mine = (j == x) ? c : mine; }
        if (sum == G) break;
        __builtin_amdgcn_s_sleep(1);
        if ((++sp & 255u) == 0u) { if (xb_ld(&bar[XB_TMO])) break; if (sp > XB_SPIN_CAP) { atomicAdd(&bar[XB_TMO], 1u); break; } }
    }
    nloc = mine > 0u ? mine : 1u; nx = cnt > 0u ? cnt : 1u;
}

__device__ __forceinline__ void xcd_barrier(const XcdBarrier& b) {
    asm volatile("s_waitcnt vmcnt(0)" ::: "memory");
    __syncthreads();
    if (threadIdx.x == 0) {
        unsigned* bar = b.bar;
        __builtin_amdgcn_s_waitcnt(0);
        unsigned nloc = b.st[0], nx = b.st[1];
        if (nloc == 0u) { xcd_barrier_complete(bar, b.x, nloc, nx); b.st[0] = nloc; b.st[1] = nx; }
        const unsigned old = xb_add(&bar[XB_XSUB(b.x)], 1u);
        const unsigned gen = old / nloc;
        if (old + 1u == (gen + 1u) * nloc) {
            __builtin_amdgcn_fence(__ATOMIC_RELEASE, "agent");
            asm volatile("s_waitcnt vmcnt(0)" ::: "memory");
            const unsigned og = xb_add(&bar[XB_TOP], 1u);
            const unsigned tg = og / nx;
            if (og + 1u == (tg + 1u) * nx) xb_add(&bar[XB_TOPGEN], 1u);
            else XB_SPIN(xb_ld(&bar[XB_TOPGEN]) == tg, bar);
            __builtin_amdgcn_fence(__ATOMIC_ACQUIRE, "agent");
            xb_add(&bar[XB_XGEN(b.x)], 1u);
            asm volatile("s_waitcnt vmcnt(0)" ::: "memory");
        } else {
            XB_SPIN(xb_ld(&bar[XB_XGEN(b.x)]) == gen, bar);
            __builtin_amdgcn_fence(__ATOMIC_ACQUIRE, "agent");
            asm volatile("s_waitcnt vmcnt(0)" ::: "memory");
        }
    }
    __syncthreads();
}

constexpr int D_MODEL = 4096, BATCH = 4, SEQ = 4096, DEPTH = 2, M_TOK = BATCH * SEQ;
constexpr int IN_WIDTH = 12288, D_FF = 16384, LRU_W = 1024, HG_W = 1024, DIFF_W = 2048;
constexpr int OFF_A_GATE = 0, OFF_A_X = 1024, OFF_B_Q = 2048, OFF_B_F = 3072, OFF_B_I = 4096, OFF_B_G = 5120, OFF_C_Q = 6144, OFF_C_K = 8192, OFF_C_V = 10240;
constexpr float NORM_EPS = 1e-6f;
constexpr int NWAVES = 8, NTHREADS = NWAVES * 64;
constexpr int N_INPUTS = 21;
enum { I_X = 0, I_LN1, I_WIN, I_CONVW, I_CONVB, I_WR, I_BR, I_WI, I_BI, I_LAM, I_LRUG, I_HLB, I_HNG, I_QNG, I_KNG, I_DLAM, I_SUBLN, I_WOUT, I_LN2, I_WFF1, I_WFF2 };

constexpr size_t MiB = (size_t)1 << 20;
constexpr size_t WS_CTL = 0, CTL_ZERO_BYTES = 1 * MiB;
constexpr size_t WS_LB = 1 * MiB;
constexpr size_t WS_ROPE = 2 * MiB;
constexpr size_t WS_WGATE = 4 * MiB;
constexpr size_t WS_WIN = 16 * MiB;
constexpr size_t WS_WOUT = 208 * MiB;
constexpr size_t WS_WFF1 = 272 * MiB;
constexpr size_t WS_WFF2 = 528 * MiB;
constexpr size_t WS_H = 784 * MiB;
constexpr size_t WS_YCAT = 912 * MiB;
constexpr size_t WS_Z = 1040 * MiB;
constexpr size_t WS_XA = 1424 * MiB;
constexpr size_t WS_RI = 1456 * MiB;
constexpr size_t WS_QT = 1520 * MiB;
constexpr size_t WS_KK = 1552 * MiB;
constexpr size_t WS_QH = 1584 * MiB, WS_KH = 1648 * MiB, WS_VH = 1712 * MiB;
constexpr size_t WS_OATT = 1776 * MiB;
constexpr size_t WS_YAPRE = 1904 * MiB;
constexpr size_t WS_OBPRE = 1968 * MiB;
constexpr size_t WS_LSUM = 2032 * MiB;
constexpr size_t WS_HID = 1040 * MiB;
constexpr size_t WS_END = 2034 * MiB;
constexpr int CW_BAR = 4096;

constexpr int RING_BYTES = 131072, MISC_OFF = RING_BYTES + 320, LDS_BYTES = 147456;

#define GAS __attribute__((address_space(1)))
typedef unsigned short bf16r;
typedef unsigned v4u __attribute__((ext_vector_type(4)));
typedef unsigned v2u __attribute__((ext_vector_type(2)));
typedef float f32x4 __attribute__((ext_vector_type(4)));
typedef float f32x2 __attribute__((ext_vector_type(2)));
#define LDS_WAIT() asm volatile("s_waitcnt lgkmcnt(0)" ::: "memory")
__device__ __forceinline__ float bflo(unsigned w) { return __uint_as_float(w << 16); }
__device__ __forceinline__ float bfhi(unsigned w) { return __uint_as_float(w & 0xffff0000u); }
__device__ __forceinline__ float bf1(bf16r b) { return __uint_as_float((unsigned)b << 16); }
__device__ __forceinline__ unsigned pk2(float lo, float hi) { return pk_bf16_builtin(lo, hi); }
__device__ __forceinline__ float wave_sum(float v) {
#pragma unroll
    for (int o = 1; o < 64; o <<= 1) v += __shfl_xor(v, o);
    return v;
}
__device__ __forceinline__ float fast_exp(float x) { return __builtin_amdgcn_exp2f(x * 1.4426950408889634f); }
__device__ __forceinline__ float sigmoidf_(float x) { return __builtin_amdgcn_rcpf(1.0f + fast_exp(-x)); }

__device__ __forceinline__ void p0_transpose_item(const float* W, int K, int N, bf16r* WT, LAS float* scr, int item, int lane) {
    const int nblk = N / 32, kb = item / nblk, nb = item % nblk, k0 = 64 * kb, n0 = 32 * nb;
#pragma unroll 8
    for (int i = 0; i < 32; ++i) { const int kk = 2 * i + (lane >> 5); scr[kk * 33 + (lane & 31)] = W[(size_t)(k0 + kk) * N + n0 + (lane & 31)]; }
    LDS_WAIT(); asm volatile("" ::: "memory");
    const int c = lane & 7;
#pragma unroll
    for (int j = 0; j < 4; ++j) { const int n = (lane >> 3) + 8 * j; const LAS float* s = scr + (8 * c) * 33 + n;
        v4u o; o.x = pk2(s[0 * 33], s[1 * 33]); o.y = pk2(s[2 * 33], s[3 * 33]); o.z = pk2(s[4 * 33], s[5 * 33]); o.w = pk2(s[6 * 33], s[7 * 33]);
        *(v4u*)(WT + (size_t)(n0 + n) * K + k0 + 8 * c) = o; }
    LDS_WAIT(); asm volatile("" ::: "memory");
}

struct Args { const float* in[N_INPUTS]; float* out; unsigned char* ws; int ph_lo, ph_hi; };

constexpr int PH_PER_LAYER = 13, N_PHASES = 1 + DEPTH * PH_PER_LAYER;

__device__ __forceinline__ float neg_expm1(float x) {
    if (x > -0.3f) { float p = 1.0f + x * (1.0f / 7.0f); p = 1.0f + x * (1.0f / 6.0f) * p; p = 1.0f + x * 0.2f * p; p = 1.0f + x * 0.25f * p; p = 1.0f + x * (1.0f / 3.0f) * p; p = 1.0f + x * 0.5f * p; return -x * p; }
    return 1.0f - fast_exp(x);
}
__device__ __forceinline__ void lru_step(float r, float ig, float x, float sp8, bool first, float& h, float& A) {
    const float la = -r * sp8; const float a = fast_exp(la);
    const float mult = first ? 1.0f : sqrtf(neg_expm1(2.0f * la));
    h = a * h + mult * (ig * x); A += la;
}
__device__ __forceinline__ float gelu_tanh(float x) { const float y = 1.5957691216057308f * (x + 0.044715f * x * x * x); return x * __builtin_amdgcn_rcpf(1.0f + fast_exp(-y)); }

typedef const __attribute__((address_space(4))) unsigned char* kargp_t;
__device__ __forceinline__ kargp_t karg_base() { kargp_t kp = (kargp_t)__builtin_amdgcn_kernarg_segment_ptr(); asm volatile("" : "+s"(kp)); return kp; }
__device__ __forceinline__ const float* karg_in(int i) { return *(const float* const __attribute__((address_space(4)))*)(karg_base() + 8 * i); }
__device__ __forceinline__ float* karg_out() { return *(float* const __attribute__((address_space(4)))*)(karg_base() + 8 * N_INPUTS); }
__device__ __forceinline__ unsigned char* karg_ws() { return *(unsigned char* const __attribute__((address_space(4)))*)(karg_base() + 8 * N_INPUTS + 8); }
__device__ __forceinline__ int karg_int(int i) { return *(const int __attribute__((address_space(4)))*)(karg_base() + 8 * N_INPUTS + 16 + 4 * i); }
#define WSP(T, off) ((T*)(karg_ws() + (off)))
#define PHASE_IDS const int tid = tid_opaque(), lane = tid & 63, wave = __builtin_amdgcn_readfirstlane(tid >> 6), gw = vcu * NWAVES + wave; (void)tid; (void)lane; (void)wave; (void)gw

typedef short hg_bf16x8 __attribute__((ext_vector_type(8)));
#define HG_MFMA(a, b, c) __builtin_amdgcn_mfma_f32_16x16x32_bf16((a), (b), (c), 0, 0, 0)
#if defined(DBG_HG_NOPREFETCH)
#define HG_BAR() __syncthreads()
#else
#define HG_BAR() do { asm volatile("s_waitcnt vmcnt(0) lgkmcnt(0)" ::: "memory"); __builtin_amdgcn_s_barrier(); asm volatile("" ::: "memory"); } while (0)
#endif
#if defined(DBG_HG_NOPREFETCH)
#define HG_BARL() HG_BAR()
#else
#define HG_BARL() do { asm volatile("s_waitcnt lgkmcnt(0)" ::: "memory"); __builtin_amdgcn_s_barrier(); asm volatile("" ::: "memory"); } while (0)
#endif
__device__ __forceinline__ void hgrn_chunked(LAS unsigned char* L, const bf16r* QT, const bf16r* KK, const bf16r* Z, float* OBPRE, int b, int h, int tid) {
    constexpr int QS = 0, KS = 17408, KT = 34816, VT = 53248, STO = 71680, PS = 106496, SP = 115712, DM = 123904, DH = 124416;
    constexpr int RS = 272, TS = 144;
    const int lane = tid & 63, wave = __builtin_amdgcn_readfirstlane(tid >> 6), lr = lane & 15, lq = lane >> 4;
    const int u = tid & 255, j8 = (u & 15) * 8, seg = u >> 4;
    const bool scaler = wave < 4;
    const bool backward = wave < 2;
    const size_t tok0 = (size_t)b * SEQ;
    f32x4 stm[8];
#pragma unroll
    for (int n = 0; n < 8; ++n) stm[n] = (f32x4){0.f, 0.f, 0.f, 0.f};
    v4u ldA[4], ldB[4];
#define HG_ISSUE(c) do { const size_t m_ = tok0 + (size_t)(c) * 64 + 4 * seg; \
        if (scaler) { _Pragma("unroll") for (int r = 0; r < 4; ++r) { ldA[r] = *(const v4u*)(KK + (m_ + r) * HG_W + h * 128 + j8); ldB[r] = *(const v4u*)(QT + (m_ + r) * HG_W + h * 128 + j8); } } \
        else { _Pragma("unroll") for (int r = 0; r < 4; ++r) ldA[r] = *(const v4u*)(Z + (m_ + r) * IN_WIDTH + OFF_B_I + h * 128 + j8); } } while (0)
    HG_ISSUE(0);
#pragma unroll 1
    for (int c = 0; c < SEQ / 64; ++c) {
#if defined(DBG_HG_NOPREFETCH)
        if (c > 0) HG_ISSUE(c);
#endif
        float loc[4][8], Lp[8];
        if (scaler) {
            asm volatile("s_waitcnt vmcnt(0)" ::: "memory");
            const unsigned kw0[4] = {ldA[0].x, ldA[0].y, ldA[0].z, ldA[0].w}, kw1[4] = {ldA[1].x, ldA[1].y, ldA[1].z, ldA[1].w}, kw2[4] = {ldA[2].x, ldA[2].y, ldA[2].z, ldA[2].w}, kw3[4] = {ldA[3].x, ldA[3].y, ldA[3].z, ldA[3].w};
#pragma unroll
            for (int e = 0; e < 8; ++e) {
                const float f0 = 1.0f - ((e & 1) ? bfhi(kw0[e >> 1]) : bflo(kw0[e >> 1])), f1 = 1.0f - ((e & 1) ? bfhi(kw1[e >> 1]) : bflo(kw1[e >> 1]));
                const float f2 = 1.0f - ((e & 1) ? bfhi(kw2[e >> 1]) : bflo(kw2[e >> 1])), f3 = 1.0f - ((e & 1) ? bfhi(kw3[e >> 1]) : bflo(kw3[e >> 1]));
                if (backward) { loc[3][e] = 1.0f; loc[2][e] = f3; loc[1][e] = f3 * f2; loc[0][e] = f3 * f2 * f1; Lp[e] = loc[0][e] * f0; }
                else { loc[0][e] = f0; loc[1][e] = f0 * f1; loc[2][e] = loc[1][e] * f2; loc[3][e] = loc[2][e] * f3; Lp[e] = loc[3][e]; }
            }
            *(LAS f32x4*)(L + SP + (seg * 128 + j8) * 4) = (f32x4){Lp[0], Lp[1], Lp[2], Lp[3]};
            *(LAS f32x4*)(L + SP + (seg * 128 + j8) * 4 + 16) = (f32x4){Lp[4], Lp[5], Lp[6], Lp[7]};
        }
        HG_BAR();
        if (scaler) {
            float X[8];
#pragma unroll
            for (int e = 0; e < 8; ++e) X[e] = 1.0f;
#pragma unroll
            for (int k = 0; k < 7; ++k) {
                const int sp = backward ? (1 + k) : (8 + k);
                const bool use = backward ? (sp > seg) : (sp < seg);
                const f32x4 a = *(const LAS f32x4*)(L + SP + (sp * 128 + j8) * 4), b4 = *(const LAS f32x4*)(L + SP + (sp * 128 + j8) * 4 + 16);
                X[0] *= use ? a.x : 1.0f; X[1] *= use ? a.y : 1.0f; X[2] *= use ? a.z : 1.0f; X[3] *= use ? a.w : 1.0f;
                X[4] *= use ? b4.x : 1.0f; X[5] *= use ? b4.y : 1.0f; X[6] *= use ? b4.z : 1.0f; X[7] *= use ? b4.w : 1.0f;
            }
            if (seg == 0) { *(LAS f32x4*)(L + DM + j8 * 4) = (f32x4){Lp[0] * X[0], Lp[1] * X[1], Lp[2] * X[2], Lp[3] * X[3]}; *(LAS f32x4*)(L + DM + j8 * 4 + 16) = (f32x4){Lp[4] * X[4], Lp[5] * X[5], Lp[6] * X[6], Lp[7] * X[7]}; }
            if (seg == 15) { *(LAS f32x4*)(L + DH + j8 * 4) = (f32x4){Lp[0] * X[0], Lp[1] * X[1], Lp[2] * X[2], Lp[3] * X[3]}; *(LAS f32x4*)(L + DH + j8 * 4 + 16) = (f32x4){Lp[4] * X[4], Lp[5] * X[5], Lp[6] * X[6], Lp[7] * X[7]}; }
            unsigned kt[8][2];
#pragma unroll
            for (int r = 0; r < 4; ++r) {
                float qs[8], ks[8];
                const unsigned kwr[4] = {ldA[r].x, ldA[r].y, ldA[r].z, ldA[r].w}, qwr[4] = {ldB[r].x, ldB[r].y, ldB[r].z, ldB[r].w};
#pragma unroll
                for (int e = 0; e < 8; ++e) {
                    float E, IE;
                    if (backward) { IE = fmaxf(loc[r][e] * X[e], 1.0e-30f); E = __builtin_amdgcn_rcpf(IE); }
                    else { E = fmaxf(loc[r][e] * X[e], 1.0e-30f); IE = __builtin_amdgcn_rcpf(E); }
#if defined(DBG_HG_NOSCALE)
                    E = 1.0f; IE = 1.0f;
#endif
                    qs[e] = ((e & 1) ? bfhi(qwr[e >> 1]) : bflo(qwr[e >> 1])) * E; ks[e] = ((e & 1) ? bfhi(kwr[e >> 1]) : bflo(kwr[e >> 1])) * IE;
                }
                v4u wq, wk; wq.x = pk2(qs[0], qs[1]); wq.y = pk2(qs[2], qs[3]); wq.z = pk2(qs[4], qs[5]); wq.w = pk2(qs[6], qs[7]);
                wk.x = pk2(ks[0], ks[1]); wk.y = pk2(ks[2], ks[3]); wk.z = pk2(ks[4], ks[5]); wk.w = pk2(ks[6], ks[7]);
                *(LAS v4u*)(L + QS + (4 * seg + r) * RS + j8 * 2) = wq; *(LAS v4u*)(L + KS + (4 * seg + r) * RS + j8 * 2) = wk;
                const unsigned kw[4] = {wk.x, wk.y, wk.z, wk.w};
#pragma unroll
                for (int e = 0; e < 8; ++e) { const unsigned hv = (e & 1) ? (kw[e >> 1] >> 16) : (kw[e >> 1] & 0xffffu);
                    if (r == 0) kt[e][0] = hv; else if (r == 1) kt[e][0] |= hv << 16; else if (r == 2) kt[e][1] = hv; else kt[e][1] |= hv << 16; }
            }
#pragma unroll
            for (int e = 0; e < 8; ++e) *(LAS v2u*)(L + KT + (j8 + e) * TS + (4 * seg) * 2) = (v2u){kt[e][0], kt[e][1]};
        } else {
            asm volatile("s_waitcnt vmcnt(0)" ::: "memory");
            const unsigned vw[4][4] = {{ldA[0].x, ldA[0].y, ldA[0].z, ldA[0].w}, {ldA[1].x, ldA[1].y, ldA[1].z, ldA[1].w}, {ldA[2].x, ldA[2].y, ldA[2].z, ldA[2].w}, {ldA[3].x, ldA[3].y, ldA[3].z, ldA[3].w}};
#pragma unroll
            for (int e = 0; e < 8; ++e) {
                unsigned h0, h1, h2, h3;
                if (e & 1) { h0 = vw[0][e >> 1] >> 16; h1 = vw[1][e >> 1] >> 16; h2 = vw[2][e >> 1] >> 16; h3 = vw[3][e >> 1] >> 16; }
                else { h0 = vw[0][e >> 1] & 0xffffu; h1 = vw[1][e >> 1] & 0xffffu; h2 = vw[2][e >> 1] & 0xffffu; h3 = vw[3][e >> 1] & 0xffffu; }
                *(LAS v2u*)(L + VT + (j8 + e) * TS + (4 * seg) * 2) = (v2u){h0 | (h1 << 16), h2 | (h3 << 16)};
            }
        }
        HG_BARL();
#pragma unroll
        for (int n = 0; n < 8; ++n) {
            const f32x4 dm = *(const LAS f32x4*)(L + DM + (16 * n + 4 * lq) * 4); const f32x4 sv = stm[n] * dm;
            *(LAS v2u*)(L + STO + (16 * wave + lr) * RS + (16 * n + 4 * lq) * 2) = (v2u){pk2(sv.x, sv.y), pk2(sv.z, sv.w)};
        }
        {
            const int ti = wave >> 1;
#pragma unroll
            for (int jj = 0; jj < 2; ++jj) {
                const int sj = 2 * (wave & 1) + jj;
                f32x4 acc = (f32x4){0.f, 0.f, 0.f, 0.f};
#pragma unroll
                for (int ks = 0; ks < 4; ++ks) {
                    const hg_bf16x8 a = *(const LAS hg_bf16x8*)(L + KS + (16 * sj + lr) * RS + (ks * 32 + 8 * lq) * 2);
                    const hg_bf16x8 bq = *(const LAS hg_bf16x8*)(L + QS + (16 * ti + lr) * RS + (ks * 32 + 8 * lq) * 2);
                    acc = HG_MFMA(a, bq, acc);
                }
                {
                    const int s0 = 16 * sj + 4 * lq, tt = 16 * ti + lr;
                    acc.x = (s0 + 0 <= tt) ? acc.x : 0.f; acc.y = (s0 + 1 <= tt) ? acc.y : 0.f; acc.z = (s0 + 2 <= tt) ? acc.z : 0.f; acc.w = (s0 + 3 <= tt) ? acc.w : 0.f;
                }
                *(LAS v2u*)(L + PS + (16 * ti + lr) * TS + (16 * sj + 4 * lq) * 2) = (v2u){pk2(acc.x, acc.y), pk2(acc.z, acc.w)};
            }
        }
#if !defined(DBG_HG_NOPREFETCH)
        if (c + 1 < SEQ / 64) HG_ISSUE(c + 1);
#endif
        HG_BARL();
        f32x4 o[4];
        {
#pragma unroll
            for (int i = 0; i < 4; ++i) o[i] = (f32x4){0.f, 0.f, 0.f, 0.f};
            hg_bf16x8 bs[4];
#pragma unroll
            for (int ks = 0; ks < 4; ++ks) bs[ks] = *(const LAS hg_bf16x8*)(L + STO + (16 * wave + lr) * RS + (ks * 32 + 8 * lq) * 2);
#pragma unroll
            for (int i = 0; i < 4; ++i)
#pragma unroll
                for (int ks = 0; ks < 4; ++ks) { const hg_bf16x8 a = *(const LAS hg_bf16x8*)(L + QS + (16 * i + lr) * RS + (ks * 32 + 8 * lq) * 2); o[i] = HG_MFMA(a, bs[ks], o[i]); }
            hg_bf16x8 bv[2];
#pragma unroll
            for (int ks = 0; ks < 2; ++ks) bv[ks] = *(const LAS hg_bf16x8*)(L + VT + (16 * wave + lr) * TS + (ks * 32 + 8 * lq) * 2);
#pragma unroll
            for (int i = 0; i < 4; ++i)
#pragma unroll
                for (int ks = 0; ks < 2; ++ks) { if (ks == 1 && i < 2) continue; const hg_bf16x8 a = *(const LAS hg_bf16x8*)(L + PS + (16 * i + lr) * TS + (ks * 32 + 8 * lq) * 2); o[i] = HG_MFMA(a, bv[ks], o[i]); }
#pragma unroll
            for (int n = 0; n < 8; ++n) {
                f32x4 U = (f32x4){0.f, 0.f, 0.f, 0.f};
#pragma unroll
                for (int ks = 0; ks < 2; ++ks) { const hg_bf16x8 a = *(const LAS hg_bf16x8*)(L + KT + (16 * n + lr) * TS + (ks * 32 + 8 * lq) * 2); U = HG_MFMA(a, bv[ks], U); }
                const f32x4 dm = *(const LAS f32x4*)(L + DM + (16 * n + 4 * lq) * 4), dh = *(const LAS f32x4*)(L + DH + (16 * n + 4 * lq) * 4);
#if defined(DBG_HG_NOSTATE)
                (void)U; (void)dm; (void)dh;
#else
                stm[n] = stm[n] * (dm * dh) + dh * U;
#endif
            }
        }
#if defined(DBG_HG_COPY)
#pragma unroll
        for (int i = 0; i < 4; ++i) {
            const int cc = 16 * wave + lr;
#if DBG_HG_COPY == 1
            o[i].x = bf1(*(const LAS bf16r*)(L + QS + (16 * i + 4 * lq + 0) * RS + cc * 2)); o[i].y = bf1(*(const LAS bf16r*)(L + QS + (16 * i + 4 * lq + 1) * RS + cc * 2));
            o[i].z = bf1(*(const LAS bf16r*)(L + QS + (16 * i + 4 * lq + 2) * RS + cc * 2)); o[i].w = bf1(*(const LAS bf16r*)(L + QS + (16 * i + 4 * lq + 3) * RS + cc * 2));
#elif DBG_HG_COPY == 2
            o[i].x = bf1(*(const LAS bf16r*)(L + VT + cc * TS + (16 * i + 4 * lq + 0) * 2)); o[i].y = bf1(*(const LAS bf16r*)(L + VT + cc * TS + (16 * i + 4 * lq + 1) * 2));
            o[i].z = bf1(*(const LAS bf16r*)(L + VT + cc * TS + (16 * i + 4 * lq + 2) * 2)); o[i].w = bf1(*(const LAS bf16r*)(L + VT + cc * TS + (16 * i + 4 * lq + 3) * 2));
#else
            o[i].x = bf1(*(const LAS bf16r*)(L + PS + (16 * i + 4 * lq + 0) * TS + (cc & 63) * 2)); o[i].y = bf1(*(const LAS bf16r*)(L + PS + (16 * i + 4 * lq + 1) * TS + (cc & 63) * 2));
            o[i].z = bf1(*(const LAS bf16r*)(L + PS + (16 * i + 4 * lq + 2) * TS + (cc & 63) * 2)); o[i].w = bf1(*(const LAS bf16r*)(L + PS + (16 * i + 4 * lq + 3) * TS + (cc & 63) * 2));
#endif
        }
#endif
        HG_BARL();
#pragma unroll
        for (int i = 0; i < 4; ++i) {
            *(LAS float*)(L + (16 * i + 4 * lq + 0) * 528 + (16 * wave + lr) * 4) = o[i].x; *(LAS float*)(L + (16 * i + 4 * lq + 1) * 528 + (16 * wave + lr) * 4) = o[i].y;
            *(LAS float*)(L + (16 * i + 4 * lq + 2) * 528 + (16 * wave + lr) * 4) = o[i].z; *(LAS float*)(L + (16 * i + 4 * lq + 3) * 528 + (16 * wave + lr) * 4) = o[i].w;
        }
        HG_BARL();
        {
#pragma unroll
            for (int k = 0; k < 4; ++k) { const int pc = tid + 512 * k, row = pc >> 5, col = (pc & 31) * 4;
                *(f32x4*)(OBPRE + (tok0 + (size_t)c * 64 + row) * HG_W + h * 128 + col) = *(const LAS f32x4*)(L + row * 528 + col * 4); }
        }
    }
#undef HG_ISSUE
}

__device__ __forceinline__ ab::BlockRef<__hip_bfloat16, __hip_bfloat16> attn_ref(const __hip_bfloat16* Qp, const __hip_bfloat16* Kp, const __hip_bfloat16* Vp, __hip_bfloat16* Op, int L, int pass) {
    const int bh = L >> 3, x = L & 7, qb = pass ? 15 - x : x;
    const int b = bh >> 5, hq = bh & 31, h = hq >> 2, c = (hq >> 1) & 1, vh = hq & 1;
    ab::BlockRef<__hip_bfloat16, __hip_bfloat16> r;
    r.Q = Qp + ((size_t)(b * 16 + h * 2 + c) * SEQ + (size_t)qb * 256) * 128;
    r.K = Kp + (size_t)(b * 16 + h * 2 + c) * SEQ * 128;
    r.V = Vp + (size_t)(b * 16 + h * 2 + vh) * SEQ * 128;
    r.O = Op + ((size_t)(b * 32 + hq) * SEQ + (size_t)qb * 256) * 128;
    r.P0 = qb * 256;
    return r;
}

__device__ __forceinline__ ab::BlockRef<__hip_bfloat16, __hip_bfloat16> attn_ref_q(const __hip_bfloat16* Qp, const __hip_bfloat16* Kp, const __hip_bfloat16* Vp, __hip_bfloat16* Op, int J) {
    const int qb = 15 - (J >> 7), bh = J & 127;
    const int b = bh >> 5, hq = bh & 31, h = hq >> 2, c = (hq >> 1) & 1, vh = hq & 1;
    ab::BlockRef<__hip_bfloat16, __hip_bfloat16> r;
    r.Q = Qp + ((size_t)(b * 16 + h * 2 + c) * SEQ + (size_t)qb * 256) * 128;
    r.K = Kp + (size_t)(b * 16 + h * 2 + c) * SEQ * 128;
    r.V = Vp + (size_t)(b * 16 + h * 2 + vh) * SEQ * 128;
    r.O = Op + ((size_t)(b * 32 + hq) * SEQ + (size_t)qb * 256) * 128;
    r.P0 = qb * 256;
    return r;
}

__global__ void __launch_bounds__(NTHREADS, 2) hymba_fwd(Args args) {
    extern __shared__ __attribute__((aligned(16))) unsigned char lds[];
    LAS unsigned char* ldsl = (LAS unsigned char*)lds;
    const int G = gridDim.x;
    const int bx = blockIdx.x;
    const int vcu = (G % 8 == 0) ? (bx % 8) * (G / 8) + bx / 8 : bx;
    const int ngw = G * NWAVES;
    volatile LAS unsigned* MISC = (volatile LAS unsigned*)(ldsl + MISC_OFF);
    for (int u = threadIdx.x; u < (LDS_BYTES - RING_BYTES) / 4; u += NTHREADS) ((LAS unsigned*)(ldsl + RING_BYTES))[u] = 0u;
    __syncthreads();
    const int lo = karg_int(0), hi = karg_int(1);
    const bool multi = (hi - lo) > 1;
    XcdBarrier bar; bar.bar = WSP(unsigned, WS_CTL) + CW_BAR; bar.x = 0; bar.st = nullptr;
    if (multi) bar = xcd_barrier_post(WSP(unsigned, WS_CTL) + CW_BAR, MISC + 8);
#ifndef EN_MASK
#define EN_MASK 0xFFFF
#endif
#define ENK(j) (((EN_MASK) >> (j)) & 1)
#ifndef DBG_TWICE_MASK
#define DBG_TWICE_MASK 0
#endif
#define REPS(j) ((((DBG_TWICE_MASK) >> (j)) & 1) ? 2 : 1)
#define IN(k) (lo <= (k) && (k) < hi)
#define SEAM(k) do { if (IN((k) + 1)) xcd_barrier(bar); } while (0)

    if (ENK(15) && IN(0)) {
        PHASE_IDS;
        for (int rep_ = 0; rep_ < REPS(15); ++rep_) {
        bf16r* const W_IN = WSP(bf16r, WS_WIN);
        bf16r* const W_OUT = WSP(bf16r, WS_WOUT);
        bf16r* const W_FF1 = WSP(bf16r, WS_WFF1);
        bf16r* const W_FF2 = WSP(bf16r, WS_WFF2);
        bf16r* const W_GATE = WSP(bf16r, WS_WGATE);
        float* const LB = WSP(float, WS_LB);
        float* const ROPE_COS = WSP(float, WS_ROPE); float* const ROPE_SIN = ROPE_COS + SEQ * 64;
        LAS float* scr = (LAS float*)(ldsl + wave * 16384);
        constexpr int I_IN = (D_MODEL / 64) * (IN_WIDTH / 32), I_OUT = (D_MODEL / 64) * (D_MODEL / 32), I_F1 = (D_MODEL / 64) * (D_FF / 32), I_F2 = (D_FF / 64) * (D_MODEL / 32);
        constexpr int I_LAYER = I_IN + I_OUT + I_F1 + I_F2;
        for (int it = gw; it < DEPTH * I_LAYER; it += ngw) {
            const int l = it / I_LAYER; int r = it - l * I_LAYER;
            if (r < I_IN) { p0_transpose_item(karg_in(I_WIN) + (size_t)l * D_MODEL * IN_WIDTH, D_MODEL, IN_WIDTH, W_IN + (size_t)l * IN_WIDTH * D_MODEL, scr, r, lane); continue; } r -= I_IN;
            if (r < I_OUT) { p0_transpose_item(karg_in(I_WOUT) + (size_t)l * D_MODEL * D_MODEL, D_MODEL, D_MODEL, W_OUT + (size_t)l * D_MODEL * D_MODEL, scr, r, lane); continue; } r -= I_OUT;
            if (r < I_F1) { p0_transpose_item(karg_in(I_WFF1) + (size_t)l * D_MODEL * D_FF, D_MODEL, D_FF, W_FF1 + (size_t)l * D_FF * D_MODEL, scr, r, lane); continue; } r -= I_F1;
            p0_transpose_item(karg_in(I_WFF2) + (size_t)l * D_FF * D_MODEL, D_FF, D_MODEL, W_FF2 + (size_t)l * D_MODEL * D_FF, scr, r, lane);
        }
        for (int idx = gw * 64 + lane; idx < DEPTH * 2048 * 128; idx += ngw * 64) {
            const int l = idx / (2048 * 128), n = (idx / 128) % 2048, k0 = (idx % 128) * 8;
            const int g = n >> 10, nn = n & 1023, h = nn >> 7, j = nn & 127;
            v4u o = {0u, 0u, 0u, 0u};
            if ((k0 >> 7) == h) { const float* w = karg_in(g ? I_WI : I_WR) + (((size_t)l * 8 + h) * 128 + (k0 & 127)) * 128 + j;
                o.x = pk2(w[0 * 128], w[1 * 128]); o.y = pk2(w[2 * 128], w[3 * 128]); o.z = pk2(w[4 * 128], w[5 * 128]); o.w = pk2(w[6 * 128], w[7 * 128]); }
            *(v4u*)(W_GATE + ((size_t)l * 2048 + n) * 1024 + k0) = o;
        }
        for (int c = gw * 64 + lane; c < HG_W; c += ngw * 64) {
            const float b0 = karg_in(I_HLB)[c], b1 = karg_in(I_HLB)[HG_W + c]; const float mx = fmaxf(b0, b1);
            const float e0 = __expf(b0 - mx), e1 = __expf(b1 - mx);
            LB[c] = 0.f; LB[HG_W + c] = e1 / (e0 + e1);
        }
        for (int idx = gw * 64 + lane; idx < SEQ * 64; idx += ngw * 64) {
            const int t = idx >> 6, j = idx & 63;
            const float inv = exp2f(-(float)(2 * j) * (1.0f / 128.0f) * 13.287712379549449f);
            const float angf = (float)t * inv;
            double rev = (double)angf * 0.15915494309189535; rev -= floor(rev);
            const float rf = (float)rev;
            ROPE_COS[idx] = __builtin_amdgcn_cosf(rf); ROPE_SIN[idx] = __builtin_amdgcn_sinf(rf);
        }
        }
        SEAM(0);
    }

#pragma unroll 1
    for (int l = 0; l < DEPTH; ++l) {
        const int pb = 1 + l * PH_PER_LAYER;

        if (ENK(0) && IN(pb + 0)) {
            PHASE_IDS;
            for (int rep_ = 0; rep_ < REPS(0); ++rep_) {
            const float* const xin = (l == 0) ? karg_in(I_X) : (const float*)karg_out();
            bf16r* const HB = WSP(bf16r, WS_H);
            const float* gain = karg_in(I_LN1) + l * D_MODEL;
            for (int m = gw; m < M_TOK; m += ngw) {
                const f32x4* xr = (const f32x4*)(xin + (size_t)m * D_MODEL) + lane;
                f32x4 v[16]; float ss = 0.f;
#pragma unroll
                for (int j = 0; j < 16; ++j) { v[j] = xr[64 * j]; ss += (v[j].x * v[j].x + v[j].y * v[j].y) + (v[j].z * v[j].z + v[j].w * v[j].w); }
                ss = wave_sum(ss);
                const float rs = 1.0f / sqrtf(ss * (1.0f / D_MODEL) + NORM_EPS);
                const f32x4* gr = (const f32x4*)gain + lane; v2u* o = (v2u*)(HB + (size_t)m * D_MODEL) + lane;
#pragma unroll
                for (int j = 0; j < 16; ++j) { const f32x4 g = gr[64 * j]; v2u w; w.x = pk2(v[j].x * rs * g.x, v[j].y * rs * g.y); w.y = pk2(v[j].z * rs * g.z, v[j].w * rs * g.w); o[64 * j] = w; }
            }
            }
            SEAM(pb + 0);
        }

        if (ENK(1) && IN(pb + 1)) {
            PHASE_IDS;
            for (int rep_ = 0; rep_ < REPS(1); ++rep_) {
            bf16r* const HB = WSP(bf16r, WS_H);
            bf16r* const W_IN = WSP(bf16r, WS_WIN);
            bf16r* const Z = WSP(bf16r, WS_Z);
            pg8::Gemm g{HB, W_IN + (size_t)l * IN_WIDTH * D_MODEL, M_TOK, IN_WIDTH, D_MODEL}; pg8::StaticOrder S; S.init(M_TOK, IN_WIDTH, G, bx);
            pg8::EpiBf16X<0> E{Z, IN_WIDTH, nullptr, nullptr, 0};
            pg8::gemm_phase<pg8::EpiBf16X<0>, pg8::StaticOrder, true, true>(ldsl, g, S, E);
            }
            SEAM(pb + 1);
        }

        if (ENK(2) && IN(pb + 2)) {
            PHASE_IDS;
            for (int rep_ = 0; rep_ < REPS(2); ++rep_) {
            bf16r* const Z = WSP(bf16r, WS_Z);
            bf16r* const XA = WSP(bf16r, WS_XA);
            bf16r* const QT = WSP(bf16r, WS_QT);
            bf16r* const KK = WSP(bf16r, WS_KK);
            bf16r* const QH = WSP(bf16r, WS_QH);
            bf16r* const KH = WSP(bf16r, WS_KH);
            bf16r* const VH = WSP(bf16r, WS_VH);
            float* const LB = WSP(float, WS_LB);
            float* const ROPE_COS = WSP(float, WS_ROPE); float* const ROPE_SIN = ROPE_COS + SEQ * 64;
            const float* convw = karg_in(I_CONVW) + l * 4 * LRU_W; const float* convb = karg_in(I_CONVB) + l * LRU_W;
            const float* lbl = LB + l * HG_W;
            const float* qg = karg_in(I_QNG) + l * 128; const float* kg = karg_in(I_KNG) + l * 128;
            for (int m = gw; m < M_TOK; m += ngw) {
                const int t = m & (SEQ - 1), b = m >> 12;
                const bf16r* zr = Z + (size_t)m * IN_WIDTH;
#pragma unroll
                for (int it = 0; it < 2; ++it) {
                    const int c0 = it * 512 + lane * 8;
                    const f32x4 b0 = *(const f32x4*)(convb + c0), b1 = *(const f32x4*)(convb + c0 + 4);
                    float a0 = b0.x, a1 = b0.y, a2 = b0.z, a3 = b0.w, a4 = b1.x, a5 = b1.y, a6 = b1.z, a7 = b1.w;
#pragma unroll
                    for (int j = 0; j < 4; ++j) {
                        if (t - 3 + j >= 0) {
                            const v4u xv = *(const v4u*)(zr - (ptrdiff_t)(3 - j) * IN_WIDTH + OFF_A_X + c0);
                            const f32x4 w0 = *(const f32x4*)(convw + j * LRU_W + c0), w1 = *(const f32x4*)(convw + j * LRU_W + c0 + 4);
                            a0 += bflo(xv.x) * w0.x; a1 += bfhi(xv.x) * w0.y; a2 += bflo(xv.y) * w0.z; a3 += bfhi(xv.y) * w0.w;
                            a4 += bflo(xv.z) * w1.x; a5 += bfhi(xv.z) * w1.y; a6 += bflo(xv.w) * w1.z; a7 += bfhi(xv.w) * w1.w;
                        }
                    }
                    v4u o; o.x = pk2(a0, a1); o.y = pk2(a2, a3); o.z = pk2(a4, a5); o.w = pk2(a6, a7);
                    *(v4u*)(XA + (size_t)m * LRU_W + c0) = o;
                }
#pragma unroll
                for (int it = 0; it < 2; ++it) {
                    const int c0 = it * 512 + lane * 8;
                    const v4u qv = *(const v4u*)(zr + OFF_B_Q + c0), fv = *(const v4u*)(zr + OFF_B_F + c0);
                    const f32x4 l0 = *(const f32x4*)(lbl + c0), l1 = *(const f32x4*)(lbl + c0 + 4);
                    const float qs = 0.08838834764831845f;
#define SILU(x) ((x) * sigmoidf_(x) * qs)
#define KF(x, lbv) ((1.0f - (lbv)) * __builtin_amdgcn_rcpf(1.0f + fast_exp(x)))
                    v4u oq, ok;
                    oq.x = pk2(SILU(bflo(qv.x)), SILU(bfhi(qv.x))); oq.y = pk2(SILU(bflo(qv.y)), SILU(bfhi(qv.y))); oq.z = pk2(SILU(bflo(qv.z)), SILU(bfhi(qv.z))); oq.w = pk2(SILU(bflo(qv.w)), SILU(bfhi(qv.w)));
                    ok.x = pk2(KF(bflo(fv.x), l0.x), KF(bfhi(fv.x), l0.y)); ok.y = pk2(KF(bflo(fv.y), l0.z), KF(bfhi(fv.y), l0.w)); ok.z = pk2(KF(bflo(fv.z), l1.x), KF(bfhi(fv.z), l1.y)); ok.w = pk2(KF(bflo(fv.w), l1.z), KF(bfhi(fv.w), l1.w));
#undef SILU
#undef KF
                    *(v4u*)(QT + (size_t)m * HG_W + c0) = oq; *(v4u*)(KK + (size_t)m * HG_W + c0) = ok;
                }
#pragma unroll
                for (int it = 0; it < 4; ++it) {
                    const int isk = it >> 1, vi = (it & 1) * 8 + (lane >> 3), sub = lane & 7;
                    const bf16r* src = zr + (isk ? OFF_C_K : OFF_C_Q) + vi * 128 + sub * 8;
                    const v4u av = *(const v4u*)src, cv = *(const v4u*)(src + 64);
                    float x1[8] = {bflo(av.x), bfhi(av.x), bflo(av.y), bfhi(av.y), bflo(av.z), bfhi(av.z), bflo(av.w), bfhi(av.w)};
                    float x2[8] = {bflo(cv.x), bfhi(cv.x), bflo(cv.y), bfhi(cv.y), bflo(cv.z), bfhi(cv.z), bflo(cv.w), bfhi(cv.w)};
                    float ss = 0.f;
#pragma unroll
                    for (int e = 0; e < 8; ++e) ss += x1[e] * x1[e] + x2[e] * x2[e];
                    ss += __shfl_xor(ss, 1); ss += __shfl_xor(ss, 2); ss += __shfl_xor(ss, 4);
                    const float rs = 1.0f / sqrtf(ss * (1.0f / 128.0f) + NORM_EPS);
                    const float* gp = (isk ? kg : qg) + sub * 8;
                    const f32x4 g1a = *(const f32x4*)gp, g1b = *(const f32x4*)(gp + 4), g2a = *(const f32x4*)(gp + 64), g2b = *(const f32x4*)(gp + 68);
                    const f32x4 ca = *(const f32x4*)(ROPE_COS + t * 64 + sub * 8), cb = *(const f32x4*)(ROPE_COS + t * 64 + sub * 8 + 4);
                    const f32x4 sa = *(const f32x4*)(ROPE_SIN + t * 64 + sub * 8), sb = *(const f32x4*)(ROPE_SIN + t * 64 + sub * 8 + 4);
                    const float g1[8] = {g1a.x, g1a.y, g1a.z, g1a.w, g1b.x, g1b.y, g1b.z, g1b.w}, g2[8] = {g2a.x, g2a.y, g2a.z, g2a.w, g2b.x, g2b.y, g2b.z, g2b.w};
                    const float cc[8] = {ca.x, ca.y, ca.z, ca.w, cb.x, cb.y, cb.z, cb.w}, sn[8] = {sa.x, sa.y, sa.z, sa.w, sb.x, sb.y, sb.z, sb.w};
                    float o1[8], o2[8];
#pragma unroll
                    for (int e = 0; e < 8; ++e) { const float y1 = x1[e] * rs * g1[e], y2 = x2[e] * rs * g2[e]; o1[e] = y1 * cc[e] - y2 * sn[e]; o2[e] = y2 * cc[e] + y1 * sn[e]; }
                    bf16r* dst = (isk ? KH : QH) + ((size_t)(b * 16 + vi) * SEQ + t) * 128 + sub * 8;
                    v4u w1, w2; w1.x = pk2(o1[0], o1[1]); w1.y = pk2(o1[2], o1[3]); w1.z = pk2(o1[4], o1[5]); w1.w = pk2(o1[6], o1[7]);
                    w2.x = pk2(o2[0], o2[1]); w2.y = pk2(o2[2], o2[3]); w2.z = pk2(o2[4], o2[5]); w2.w = pk2(o2[6], o2[7]);
                    *(v4u*)dst = w1; *(v4u*)(dst + 64) = w2;
                }
#pragma unroll
                for (int it = 0; it < 4; ++it) {
                    const int e = it * 512 + lane * 8, vi = e >> 7, d = e & 127;
                    *(v4u*)(VH + ((size_t)(b * 16 + vi) * SEQ + t) * 128 + d) = *(const v4u*)(zr + OFF_C_V + e);
                }
            }
            }
            SEAM(pb + 2);
        }

        if (ENK(3) && IN(pb + 3)) {
            PHASE_IDS;
            for (int rep_ = 0; rep_ < REPS(3); ++rep_) {
            bf16r* const XA = WSP(bf16r, WS_XA);
            bf16r* const W_GATE = WSP(bf16r, WS_WGATE);
            bf16r* const RI = WSP(bf16r, WS_RI);
            pg8::Gemm g{XA, W_GATE + (size_t)l * 2048 * 1024, M_TOK, 2048, 1024}; pg8::StaticOrder S; S.init(M_TOK, 2048, G, bx);
            pg8::EpiBf16X<1> E{RI, 2048, karg_in(I_BR) + l * LRU_W, karg_in(I_BI) + l * LRU_W, 1024};
            pg8::gemm_phase<pg8::EpiBf16X<1>, pg8::StaticOrder, true, true>(ldsl, g, S, E);
            }
            SEAM(pb + 3);
        }

        if ((ENK(4) || ENK(5)) && (IN(pb + 4) || IN(pb + 5))) {
            PHASE_IDS;
            bf16r* const XA = WSP(bf16r, WS_XA);
            bf16r* const RI = WSP(bf16r, WS_RI);
            float* const LSUM = WSP(float, WS_LSUM);
            bf16r* const Z = WSP(bf16r, WS_Z);
            float* const YAPRE = WSP(float, WS_YAPRE);
            const float* lam = karg_in(I_LAM) + l * LRU_W;
            const int c = tid * 2;
            const float sp0 = 8.0f * log1pf(__expf(-lam[c])), sp1 = 8.0f * log1pf(__expf(-lam[c + 1]));
            if (ENK(4) && IN(pb + 4)) {
                for (int u = bx; u < BATCH * 64; u += G) {
                    const int b = u >> 6, s = u & 63;
                    float h0 = 0.f, h1 = 0.f, A0 = 0.f, A1 = 0.f;
#pragma unroll 4
                    for (int t = 0; t < 64; ++t) {
                        const size_t m = (size_t)b * SEQ + s * 64 + t;
                        const unsigned rr = *(const unsigned*)(RI + m * 2048 + c), ii = *(const unsigned*)(RI + m * 2048 + 1024 + c), xx = *(const unsigned*)(XA + m * LRU_W + c);
                        const bool first = (s == 0 && t == 0);
                        lru_step(bflo(rr), bflo(ii), bflo(xx), sp0, first, h0, A0);
                        lru_step(bfhi(rr), bfhi(ii), bfhi(xx), sp1, first, h1, A1);
                    }
                    *(f32x4*)(LSUM + ((size_t)u * LRU_W + c) * 2) = (f32x4){A0, h0, A1, h1};
                }
                SEAM(pb + 4);
            }
            if (ENK(5) && IN(pb + 5)) {
                constexpr int NHU = BATCH * 8;
                const bool split = G >= 2 * NHU;
                if (!split || vcu >= NHU) {
                    for (int u = split ? vcu - NHU : vcu; u < BATCH * 64; u += split ? G - NHU : G) {
                        const int b = u >> 6, s = u & 63;
                        float h0 = 0.f, h1 = 0.f, A0 = 0.f, A1 = 0.f;
                        for (int sp = 0; sp < s; ++sp) {
                            const f32x4 v = *(const f32x4*)(LSUM + ((size_t)(b * 64 + sp) * LRU_W + c) * 2);
                            h0 = fast_exp(v.x) * h0 + v.y; h1 = fast_exp(v.z) * h1 + v.w;
                        }
#pragma unroll 4
                        for (int t = 0; t < 64; ++t) {
                            const size_t m = (size_t)b * SEQ + s * 64 + t;
                            const unsigned rr = *(const unsigned*)(RI + m * 2048 + c), ii = *(const unsigned*)(RI + m * 2048 + 1024 + c), xx = *(const unsigned*)(XA + m * LRU_W + c);
                            const unsigned gg = *(const unsigned*)(Z + m * IN_WIDTH + OFF_A_GATE + c);
                            const bool first = (s == 0 && t == 0);
                            lru_step(bflo(rr), bflo(ii), bflo(xx), sp0, first, h0, A0);
                            lru_step(bfhi(rr), bfhi(ii), bfhi(xx), sp1, first, h1, A1);
                            *(f32x2*)(YAPRE + m * LRU_W + c) = (f32x2){h0 * gelu_tanh(bflo(gg)), h1 * gelu_tanh(bfhi(gg))};
                        }
                    }
                }
                for (int ubh = vcu; ubh < NHU; ubh += G) hgrn_chunked(ldsl, WSP(bf16r, WS_QT), WSP(bf16r, WS_KK), Z, WSP(float, WS_OBPRE), ubh >> 3, ubh & 7, tid);
                __syncthreads();
                {
                    typedef __hip_bfloat16 abf;
                    const abf* Qp = (const abf*)WSP(bf16r, WS_QH); const abf* Kp = (const abf*)WSP(bf16r, WS_KH); const abf* Vp = (const abf*)WSP(bf16r, WS_VH); abf* Op = (abf*)WSP(bf16r, WS_OATT);
                    unsigned* qctr = WSP(unsigned, WS_CTL) + 2048 + 64 * l;
                    constexpr int NQ = BATCH * 32 * 16;
#define AQ_FETCH(dst) do { if (tid == 0) MISC[16] = __hip_atomic_fetch_add(qctr, 1u, __ATOMIC_RELAXED, __HIP_MEMORY_SCOPE_AGENT); __syncthreads(); dst = (int)MISC[16]; __syncthreads(); } while (0)
                    int cur, nxt;
                    AQ_FETCH(cur);
                    if (cur < NQ) {
                        AQ_FETCH(nxt);
                        ab::BlockRef<abf, abf> cref = attn_ref_q(Qp, Kp, Vp, Op, cur);
                        ab::Seam<abf> Sm;
                        ab::causal_swa_prime<abf, abf>(cref, SEQ, (char*)lds, Sm);
                        for (;;) {
                            const bool more = nxt < NQ;
                            unsigned pend = 0u;
                            if (more && tid == 0) pend = __hip_atomic_fetch_add(qctr, 1u, __ATOMIC_RELAXED, __HIP_MEMORY_SCOPE_AGENT);
                            const ab::BlockRef<abf, abf> nref = more ? attn_ref_q(Qp, Kp, Vp, Op, nxt) : cref;
                            ab::causal_swa_block<abf, abf>(cref, nref, SEQ, SEQ, (char*)lds, Sm);
                            if (!more) break;
                            if (tid == 0) MISC[16] = pend;
                            __syncthreads();
                            cref = nref; nxt = (int)MISC[16];
                            __syncthreads();
                        }
                    }
#undef AQ_FETCH
                }
                SEAM(pb + 7);
            }
        }

        if (ENK(8) && IN(pb + 8)) {
            PHASE_IDS;
            for (int rep_ = 0; rep_ < REPS(8); ++rep_) {
            float* const YAPRE = WSP(float, WS_YAPRE);
            float* const OBPRE = WSP(float, WS_OBPRE);
            bf16r* const OATT = WSP(bf16r, WS_OATT);
            bf16r* const Z = WSP(bf16r, WS_Z);
            bf16r* const YCAT = WSP(bf16r, WS_YCAT);
            const float lam_init = 0.8f - 0.6f * __expf(-0.3f * (float)l);
            const float* dl = karg_in(I_DLAM) + l * 4 * 128;
            float d1 = dl[lane] * dl[128 + lane] + dl[64 + lane] * dl[128 + 64 + lane];
            float d2 = dl[256 + lane] * dl[384 + lane] + dl[256 + 64 + lane] * dl[384 + 64 + lane];
            d1 = wave_sum(d1); d2 = wave_sum(d2);
            const float lamv = __expf(d1) - __expf(d2) + lam_init;
            const float* lg = karg_in(I_LRUG) + l * LRU_W; const float* hg = karg_in(I_HNG) + l * 128; const float* sg = karg_in(I_SUBLN) + l * 256;
            const bool hg_bad = WSP(unsigned, WS_CTL)[2048] != 0u;
            for (int m = gw; m < M_TOK; m += ngw) {
                const int t = m & (SEQ - 1), b = m >> 12;
                bf16r* yrow = YCAT + (size_t)m * D_MODEL;
                {
                    const f32x4* pr = (const f32x4*)(YAPRE + (size_t)m * LRU_W) + lane;
                    f32x4 v[4]; float ss = 0.f;
#pragma unroll
                    for (int j = 0; j < 4; ++j) { v[j] = pr[64 * j]; ss += (v[j].x * v[j].x + v[j].y * v[j].y) + (v[j].z * v[j].z + v[j].w * v[j].w); }
                    ss = wave_sum(ss);
                    const float rs = 1.0f / sqrtf(ss * (1.0f / LRU_W) + NORM_EPS);
#pragma unroll
                    for (int j = 0; j < 4; ++j) { const f32x4 g = *((const f32x4*)lg + lane + 64 * j); v2u w; w.x = pk2(v[j].x * rs * g.x, v[j].y * rs * g.y); w.y = pk2(v[j].z * rs * g.z, v[j].w * rs * g.w);
#if defined(DBG_ZERO) && (DBG_ZERO & 1)
                        w = (v2u){0u, 0u};
#endif
                        *((v2u*)yrow + lane + 64 * j) = w; }
                }
                {
                    const int e0 = lane * 16;
                    f32x4 v[4]; float ss = 0.f;
#pragma unroll
                    for (int j = 0; j < 4; ++j) { v[j] = *(const f32x4*)(OBPRE + (size_t)m * HG_W + e0 + 4 * j); ss += (v[j].x * v[j].x + v[j].y * v[j].y) + (v[j].z * v[j].z + v[j].w * v[j].w); }
                    ss += __shfl_xor(ss, 1); ss += __shfl_xor(ss, 2); ss += __shfl_xor(ss, 4);
                    const float rs = 1.0f / sqrtf(ss * (1.0f / 128.0f) + NORM_EPS);
                    const bf16r* gz = Z + (size_t)m * IN_WIDTH + OFF_B_G + e0;
                    const v4u ga = *(const v4u*)gz, gb = *(const v4u*)(gz + 8);
                    const float gv[16] = {bflo(ga.x), bfhi(ga.x), bflo(ga.y), bfhi(ga.y), bflo(ga.z), bfhi(ga.z), bflo(ga.w), bfhi(ga.w), bflo(gb.x), bfhi(gb.x), bflo(gb.y), bfhi(gb.y), bflo(gb.z), bfhi(gb.z), bflo(gb.w), bfhi(gb.w)};
                    const float* hgp = hg + (e0 & 127);
                    float o[16];
#pragma unroll
                    for (int j = 0; j < 4; ++j) { const f32x4 g = *(const f32x4*)(hgp + 4 * j);
                        o[4 * j + 0] = v[j].x * rs * g.x * (gv[4 * j + 0] * sigmoidf_(gv[4 * j + 0])); o[4 * j + 1] = v[j].y * rs * g.y * (gv[4 * j + 1] * sigmoidf_(gv[4 * j + 1]));
                        o[4 * j + 2] = v[j].z * rs * g.z * (gv[4 * j + 2] * sigmoidf_(gv[4 * j + 2])); o[4 * j + 3] = v[j].w * rs * g.w * (gv[4 * j + 3] * sigmoidf_(gv[4 * j + 3])); }
                    v4u w0, w1; w0.x = pk2(o[0], o[1]); w0.y = pk2(o[2], o[3]); w0.z = pk2(o[4], o[5]); w0.w = pk2(o[6], o[7]); w1.x = pk2(o[8], o[9]); w1.y = pk2(o[10], o[11]); w1.z = pk2(o[12], o[13]); w1.w = pk2(o[14], o[15]);
#if defined(DBG_ZERO) && (DBG_ZERO & 2)
                    w0 = (v4u){0u,0u,0u,0u}; w1 = w0;
#endif
                    *(v4u*)(yrow + 1024 + e0) = w0; *(v4u*)(yrow + 1024 + e0 + 8) = w1;
                }
#pragma unroll
                for (int it = 0; it < 4; ++it) {
                    const int e = it * 512 + lane * 8, h = e >> 8, vh = (e >> 7) & 1, d = e & 127;
                    const bf16r* o1p = OATT + ((size_t)(b * 32 + h * 4 + 0 + vh) * SEQ + t) * 128 + d;
                    const bf16r* o2p = OATT + ((size_t)(b * 32 + h * 4 + 2 + vh) * SEQ + t) * 128 + d;
                    const v4u a = *(const v4u*)o1p, c2 = *(const v4u*)o2p;
                    float oc[8] = {bflo(a.x) - lamv * bflo(c2.x), bfhi(a.x) - lamv * bfhi(c2.x), bflo(a.y) - lamv * bflo(c2.y), bfhi(a.y) - lamv * bfhi(c2.y),
                                   bflo(a.z) - lamv * bflo(c2.z), bfhi(a.z) - lamv * bfhi(c2.z), bflo(a.w) - lamv * bflo(c2.w), bfhi(a.w) - lamv * bfhi(c2.w)};
                    float ss = 0.f;
#pragma unroll
                    for (int j = 0; j < 8; ++j) ss += oc[j] * oc[j];
                    ss += __shfl_xor(ss, 1); ss += __shfl_xor(ss, 2); ss += __shfl_xor(ss, 4); ss += __shfl_xor(ss, 8); ss += __shfl_xor(ss, 16);
                    const float rs = (1.0f - lam_init) / sqrtf(ss * (1.0f / 256.0f) + NORM_EPS);
                    const f32x4 g0 = *(const f32x4*)(sg + (e & 255)), g1 = *(const f32x4*)(sg + (e & 255) + 4);
                    v4u w; w.x = pk2(oc[0] * rs * g0.x, oc[1] * rs * g0.y); w.y = pk2(oc[2] * rs * g0.z, oc[3] * rs * g0.w); w.z = pk2(oc[4] * rs * g1.x, oc[5] * rs * g1.y); w.w = pk2(oc[6] * rs * g1.z, oc[7] * rs * g1.w);
#if defined(DBG_ZERO) && (DBG_ZERO & 4)
                    w = (v4u){0u,0u,0u,0u};
#endif
                    *(v4u*)(yrow + 2048 + e) = w;
                }
            }
            }
            SEAM(pb + 8);
        }

        if (ENK(9) && IN(pb + 9)) {
            PHASE_IDS;
            for (int rep_ = 0; rep_ < REPS(9); ++rep_) {
            bf16r* const YCAT = WSP(bf16r, WS_YCAT);
            bf16r* const W_OUT = WSP(bf16r, WS_WOUT);
            float* const OUT = karg_out();
            const float* const xin = (l == 0) ? karg_in(I_X) : (const float*)karg_out();
            pg8::Gemm g{YCAT, W_OUT + (size_t)l * D_MODEL * D_MODEL, M_TOK, D_MODEL, D_MODEL}; pg8::StaticOrder S; S.init(M_TOK, D_MODEL, G, bx);
            pg8::EpiResF32 E{xin, OUT, D_MODEL};
            pg8::gemm_phase<pg8::EpiResF32, pg8::StaticOrder, true, true>(ldsl, g, S, E);
            }
            SEAM(pb + 9);
        }

        if (ENK(10) && IN(pb + 10)) {
            PHASE_IDS;
            for (int rep_ = 0; rep_ < REPS(10); ++rep_) {
            float* const OUT = karg_out();
            bf16r* const HB = WSP(bf16r, WS_H);
            const float* gain = karg_in(I_LN2) + l * D_MODEL;
            for (int m = gw; m < M_TOK; m += ngw) {
                const f32x4* xr = (const f32x4*)(OUT + (size_t)m * D_MODEL) + lane;
                f32x4 v[16]; float ss = 0.f;
#pragma unroll
                for (int j = 0; j < 16; ++j) { v[j] = xr[64 * j]; ss += (v[j].x * v[j].x + v[j].y * v[j].y) + (v[j].z * v[j].z + v[j].w * v[j].w); }
                ss = wave_sum(ss);
                const float rs = 1.0f / sqrtf(ss * (1.0f / D_MODEL) + NORM_EPS);
                const f32x4* gr = (const f32x4*)gain + lane; v2u* o = (v2u*)(HB + (size_t)m * D_MODEL) + lane;
#pragma unroll
                for (int j = 0; j < 16; ++j) { const f32x4 g = gr[64 * j]; v2u w; w.x = pk2(v[j].x * rs * g.x, v[j].y * rs * g.y); w.y = pk2(v[j].z * rs * g.z, v[j].w * rs * g.w); o[64 * j] = w; }
            }
            }
            SEAM(pb + 10);
        }

        if (ENK(11) && IN(pb + 11)) {
            PHASE_IDS;
            for (int rep_ = 0; rep_ < REPS(11); ++rep_) {
            bf16r* const HB = WSP(bf16r, WS_H);
            bf16r* const W_FF1 = WSP(bf16r, WS_WFF1);
            bf16r* const HID = WSP(bf16r, WS_HID);
            pg8::Gemm g{HB, W_FF1 + (size_t)l * D_FF * D_MODEL, M_TOK, D_FF, D_MODEL}; pg8::StaticOrder S; S.init(M_TOK, D_FF, G, bx);
            pg8::EpiBf16X<2> E{HID, D_FF, nullptr, nullptr, 0};
            pg8::gemm_phase<pg8::EpiBf16X<2>, pg8::StaticOrder, true, true>(ldsl, g, S, E);
            }
            SEAM(pb + 11);
        }

        if (ENK(12) && IN(pb + 12)) {
            PHASE_IDS;
            for (int rep_ = 0; rep_ < REPS(12); ++rep_) {
            bf16r* const HID = WSP(bf16r, WS_HID);
            bf16r* const W_FF2 = WSP(bf16r, WS_WFF2);
            float* const OUT = karg_out();
            pg8::Gemm g{HID, W_FF2 + (size_t)l * D_MODEL * D_FF, M_TOK, D_MODEL, D_FF}; pg8::StaticOrder S; S.init(M_TOK, D_MODEL, G, bx);
            pg8::EpiResF32 E{OUT, OUT, D_MODEL};
            pg8::gemm_phase<pg8::EpiResF32, pg8::StaticOrder, true, true>(ldsl, g, S, E);
            }
            SEAM(pb + 12);
        }
    }
#undef IN
#undef SEAM
}


#if defined(DBG_CKPT_PROBE)
__global__ void k_checksum(const unsigned* p, size_t nwords, unsigned long long* slot) {
    unsigned long long s = 0;
    for (size_t i = (size_t)blockIdx.x * blockDim.x + threadIdx.x; i < nwords; i += (size_t)gridDim.x * blockDim.x) s += (unsigned long long)p[i] * (unsigned long long)(1u + (unsigned)(i & 1023u));
    for (int o = 32; o >= 1; o >>= 1) s += __shfl_xor(s, o);
    if ((threadIdx.x & 63) == 0) atomicAdd(slot, s);
}
__global__ void k_emit(const unsigned long long* slots, int n, float* out) {
    const int j = threadIdx.x; if (blockIdx.x == 0 && j < n) { const float frac = (float)(slots[j] % 1000003ull) * (1.0f / 1000003.0f); out[j] = __powf(10.0f, 14.5f - 1.5f * (float)j) * (1.0f + frac); }
}
#endif

#if defined(DBG_DUMP)
__global__ void k_dump(const unsigned char* ws, float* out, int mode) {
    for (size_t i = (size_t)blockIdx.x * blockDim.x + threadIdx.x; i < (size_t)M_TOK * D_MODEL; i += (size_t)gridDim.x * blockDim.x) {
        const size_t m = i >> 12, c = i & 4095; float v = 0.f;
        if (mode == 1) { const bf16r* z = (const bf16r*)(ws + WS_Z) + m * IN_WIDTH; v = bf1(z[c]) + bf1(z[4096 + c]) + bf1(z[8192 + c]); }
        if (mode == 2) { v = bf1(((const bf16r*)(ws + WS_OATT))[i]); }
        if (mode == 3) { v = c < 1024 ? ((const float*)(ws + WS_YAPRE))[m * 1024 + c] : c < 2048 ? ((const float*)(ws + WS_OBPRE))[m * 1024 + (c - 1024)] : c < 3072 ? bf1(((const bf16r*)(ws + WS_RI))[m * 2048 + (c - 2048)]) : bf1(((const bf16r*)(ws + WS_RI))[m * 2048 + (c - 2048)]); }
        if (mode == 7) { v = ((const float*)(ws + WS_YAPRE))[m * 1024 + (c & 1023)]; }
        if (mode == 8) { v = ((const float*)(ws + WS_OBPRE))[i & ((size_t)M_TOK * 1024 - 1)]; }
        if (mode == 9) { v = bf1(((const bf16r*)(ws + WS_RI))[m * 2048 + (c & 2047)]); }
        if (mode == 10) { v = c < 1024 ? bf1(((const bf16r*)(ws + WS_XA))[m * 1024 + c]) : c < 2048 ? bf1(((const bf16r*)(ws + WS_QT))[m * 1024 + (c - 1024)]) : c < 3072 ? bf1(((const bf16r*)(ws + WS_KK))[m * 1024 + (c - 2048)]) : bf1(((const bf16r*)(ws + WS_RI))[m * 2048 + (c - 3072)]); }
        if (mode == 4) { v = bf1(((const bf16r*)(ws + WS_YCAT))[i]); }
        out[i] = v;
    }
}
#endif
#if defined(DBG_MAXP)
__global__ void k_absmax(const void* p, size_t n, int is_f32, unsigned* slot) {
    float mx = 0.f;
    for (size_t i = (size_t)blockIdx.x * blockDim.x + threadIdx.x; i < n; i += (size_t)gridDim.x * blockDim.x) { const float v = is_f32 ? ((const float*)p)[i] : bf1(((const bf16r*)p)[i]); mx = fmaxf(mx, fabsf(v)); }
    for (int o = 32; o >= 1; o >>= 1) mx = fmaxf(mx, __shfl_xor(mx, o));
    if ((threadIdx.x & 63) == 0) atomicMax(slot, __float_as_uint(mx));
}
__global__ void k_emit2(const unsigned* slots, float* out) { if (blockIdx.x == 0 && threadIdx.x < 2) out[threadIdx.x] = 1.0e6f * __uint_as_float(slots[threadIdx.x]); }
#endif
#if defined(DBG_HG_LDSCMP)
__global__ void k_emit_flag(const unsigned* flag, float* out) { if (blockIdx.x == 0 && threadIdx.x == 0) { const unsigned m = *flag; out[0] = 1.0e6f * (float)(1u + (m & 15u)); out[1] = 1.0e6f * (float)(1u + ((m >> 4) & 31u)); } }
#endif
#ifndef MK_PER_PHASE
#define MK_PER_PHASE 0
#endif
extern "C" void kernel_launch(void* const* d_in, const int* in_sizes, int n_in, void* d_out, int out_size, void* d_ws, size_t ws_size, hipStream_t stream) {
    static int grid = 0;
    if (grid == 0) {
        if (n_in != N_INPUTS || out_size != M_TOK * D_MODEL || ws_size < WS_END) { fprintf(stderr, "kernel_launch: unexpected shapes (n_in %d, out %d, ws %zu < %zu); nothing launched\n", n_in, out_size, ws_size, (size_t)WS_END); grid = -1; return; }
        int dev = 0, cus = 0;
        if (hipGetDevice(&dev) != hipSuccess || hipDeviceGetAttribute(&cus, hipDeviceAttributeMultiprocessorCount, dev) != hipSuccess || cus <= 0) { fprintf(stderr, "kernel_launch: device query failed\n"); grid = -1; return; }
        if (hipFuncSetAttribute((const void*)hymba_fwd, hipFuncAttributeMaxDynamicSharedMemorySize, LDS_BYTES) != hipSuccess) { fprintf(stderr, "kernel_launch: hipFuncSetAttribute failed\n"); grid = -1; return; }
        int per_cu = 0;
        if (hipOccupancyMaxActiveBlocksPerMultiprocessor(&per_cu, (const void*)hymba_fwd, NTHREADS, LDS_BYTES) != hipSuccess || per_cu < 1) fprintf(stderr, "kernel_launch: occupancy query reports %d blocks per CU\n", per_cu);
        (void)hipGetLastError();
        grid = cus;
    }
    if (grid < 0) return;
    (void)in_sizes;
    if (hipMemsetAsync((char*)d_ws + WS_CTL, 0, CTL_ZERO_BYTES, stream) != hipSuccess) { fprintf(stderr, "kernel_launch: memset failed\n"); return; }
#if defined(DBG_NAN_POISON)
    (void)hipMemsetAsync((char*)d_ws + WS_LB, 0xFF, WS_END - WS_LB, stream);
    (void)hipMemsetAsync(d_out, 0xFF, (size_t)out_size * 4, stream);
#endif
    Args a{};
    for (int i = 0; i < N_INPUTS; ++i) a.in[i] = (const float*)d_in[i];
    a.out = (float*)d_out; a.ws = (unsigned char*)d_ws;
#if defined(DBG_HG_LDSCMP)
    {
        for (int p = 0; p <= 7; ++p) { a.ph_lo = p; a.ph_hi = p + 1; hipLaunchKernelGGL(hymba_fwd, dim3(grid), dim3(NTHREADS), LDS_BYTES, stream, a); }
        (void)hipMemsetAsync(d_out, 0, (size_t)out_size * 4, stream);
        hipLaunchKernelGGL(k_emit_flag, dim3(1), dim3(64), 0, stream, (const unsigned*)((unsigned char*)d_ws + 8192), (float*)d_out);
    }
#elif defined(DBG_MAXP)
        unsigned char* w = (unsigned char*)d_ws; unsigned* slots = (unsigned*)(w + 512 * 1024);
        for (int p = 0; p <= DBG_LAST; ++p) { a.ph_lo = p; a.ph_hi = p + 1; hipLaunchKernelGGL(hymba_fwd, dim3(grid), dim3(NTHREADS), LDS_BYTES, stream, a); }
#if defined(DBG_MAXP_IN_A)
        hipLaunchKernelGGL(k_absmax, dim3(64), dim3(256), 0, stream, (const void*)d_in[DBG_MAXP_IN_A], (size_t)in_sizes[DBG_MAXP_IN_A], 1, slots + 0);
        hipLaunchKernelGGL(k_absmax, dim3(64), dim3(256), 0, stream, (const void*)d_in[DBG_MAXP_IN_B], (size_t)in_sizes[DBG_MAXP_IN_B], 1, slots + 1);
#else
        hipLaunchKernelGGL(k_absmax, dim3(2048), dim3(256), 0, stream, (const void*)(w + DBG_MAXP_A_OFF), (size_t)DBG_MAXP_A_N, DBG_MAXP_A_F32, slots + 0);
        hipLaunchKernelGGL(k_absmax, dim3(2048), dim3(256), 0, stream, (const void*)(w + DBG_MAXP_B_OFF), (size_t)DBG_MAXP_B_N, DBG_MAXP_B_F32, slots + 1);
#endif
        hipMemsetAsync(d_out, 0, (size_t)out_size * 4, stream);
        hipLaunchKernelGGL(k_emit2, dim3(1), dim3(64), 0, stream, (const unsigned*)slots, (float*)d_out);
    }
#elif defined(DBG_DUMP)
        const int last = DBG_LAST;
        for (int p = 0; p <= last; ++p) {
            if (DBG_DUMP == 2 && p >= DBG_LAST - 4 && p <= DBG_LAST - 1) continue;
            a.ph_lo = p; a.ph_hi = p + 1; hipLaunchKernelGGL(hymba_fwd, dim3(grid), dim3(NTHREADS), LDS_BYTES, stream, a);
        }
        if (DBG_DUMP >= 1 && DBG_DUMP != 5 && DBG_DUMP != 6) hipLaunchKernelGGL(k_dump, dim3(4096), dim3(256), 0, stream, (const unsigned char*)d_ws, (float*)d_out, (int)DBG_DUMP);
    }
#elif defined(DBG_CKPT_PROBE)
    {
        unsigned char* w = (unsigned char*)d_ws; unsigned long long* slots = (unsigned long long*)(w + 512 * 1024);
        auto cks = [&](size_t off, size_t bytes, int j) { hipLaunchKernelGGL(k_checksum, dim3(2048), dim3(256), 0, stream, (const unsigned*)(w + off), bytes / 4, slots + j); };
        for (int p = 0; p < N_PHASES; ++p) {
            a.ph_lo = p; a.ph_hi = p + 1; hipLaunchKernelGGL(hymba_fwd, dim3(grid), dim3(NTHREADS), LDS_BYTES, stream, a);
            if (p == 0) cks(1 * MiB, 11 * MiB, 0), cks(16 * MiB, 768 * MiB, 0);
            if (p == 2) cks(WS_Z, 384 * MiB, 1);
            if (p == 4) cks(WS_XA, 32 * MiB, 2), cks(WS_RI, 64 * MiB, 2), cks(WS_QT, 256 * MiB, 2);
            if (p == 6) cks(WS_YAPRE, 64 * MiB, 3);
            if (p == 7) cks(WS_OBPRE, 64 * MiB, 4);
            if (p == 8) cks(WS_OATT, 128 * MiB, 5);
            if (p == 10) hipLaunchKernelGGL(k_checksum, dim3(2048), dim3(256), 0, stream, (const unsigned*)d_out, (size_t)M_TOK * D_MODEL, slots + 6);
            if (p == 13) hipLaunchKernelGGL(k_checksum, dim3(2048), dim3(256), 0, stream, (const unsigned*)d_out, (size_t)M_TOK * D_MODEL, slots + 7);
        }
        hipLaunchKernelGGL(k_emit, dim3(1), dim3(64), 0, stream, (const unsigned long long*)slots, 8, (float*)d_out);
    }
#elif MK_PER_PHASE
    for (int p = 0; p < N_PHASES; ++p) { a.ph_lo = p; a.ph_hi = p + 1; hipLaunchKernelGGL(hymba_fwd, dim3(grid), dim3(NTHREADS), LDS_BYTES, stream, a); }
#else
    a.ph_lo = 0; a.ph_hi = N_PHASES;
    hipLaunchKernelGGL(hymba_fwd, dim3(grid), dim3(NTHREADS), LDS_BYTES, stream, a);
#endif
    const hipError_t le = hipPeekAtLastError();
    if (le != hipSuccess) fprintf(stderr, "kernel_launch: launch failed: %s\n", hipGetErrorName(le));
}
```

```cpp
#include <hip/hip_runtime.h>
#include <hip/hip_bf16.h>
#include <cstdio>
#include <cstdint>
__device__ __forceinline__ int tid_opaque() { int t = threadIdx.x; asm volatile("" : "+v"(t)); return t; }
typedef __bf16 hw_bf16x2 __attribute__((ext_vector_type(2)));
typedef float hw_f32x2 __attribute__((ext_vector_type(2)));
__device__ __forceinline__ unsigned pk_bf16_builtin(float lo, float hi) { hw_f32x2 f = {lo, hi}; hw_bf16x2 r = __builtin_convertvector(f, hw_bf16x2); return __builtin_bit_cast(unsigned, r); }
namespace pg8 {
#define PG8_LAS __attribute__((address_space(3)))
typedef unsigned short bf16_t;
typedef short bf16x8 __attribute__((ext_vector_type(8)));
typedef float f32x4 __attribute__((ext_vector_type(4)));
typedef unsigned u32x4 __attribute__((ext_vector_type(4)));
constexpr int BM = 256, BK = 64, HALF = 128, HTB = HALF * BK * 2  , STAGE_BYTES = 8 * HTB, NXCD = 8, WGM = 8;

__host__ __device__ __forceinline__ int lds_byte(int r, int c) { const int st = (r >> 4) * 2 + (c >> 5), rr = r & 15, cc = c & 31, ob = rr * 64 + cc * 2; return st * 1024 + (ob ^ (((ob >> 9) & 1) << 5)); }
__host__ __device__ __forceinline__ void stage_rc(int b, int& R, int& C) { const int st = b / 1024, sb = b % 1024, swz = sb ^ (((sb >> 9) & 1) << 5); R = (st >> 1) * 16 + swz / 64; C = (st & 1) * 32 + (swz % 64) / 2; }
__host__ __device__ __forceinline__ int perm32(int rho) { const int n = rho >> 4, i = rho & 15; return 8 * (i >> 2) + 4 * n + (i & 3); }

struct Unit { int pm, pn; };
struct Gemm { const bf16_t* A; const bf16_t* Bt; int M, N, K; size_t a_pn_stride = 0; int a_pn_shift = 0; int ld = 0;
    __device__ __forceinline__ size_t aoff(int pn) const { return (size_t)(pn >> a_pn_shift) * a_pn_stride; } };

struct StaticOrder {
    int nM, nN, nwg, G, c;
    __host__ __device__ void init(int M, int N, int G_, int c_) { nM = M / BM; nN = N / BM; nwg = nM * nN; G = G_; c = c_; }
    __host__ __device__ bool next(int i, Unit& u) const {
        const long L = (long)i * G + c; if (L >= nwg) return false;
        int wgid = (int)L; { const int q = nwg / NXCD, r = nwg % NXCD, xcd = wgid % NXCD, off = wgid / NXCD; wgid = (xcd < r ? xcd * (q + 1) : r * (q + 1) + (xcd - r) * q) + off; }
        const int nig = WGM * nN, gid = wgid / nig, fm = gid * WGM, gsz = (nM - fm) < WGM ? (nM - fm) : WGM;
        u.pm = fm + ((wgid % nig) % gsz); u.pn = (wgid % nig) / gsz; return true;
    }
    __device__ __forceinline__ void a_ready(const Unit&) const {}
    __device__ __forceinline__ void done(const Unit&) const {}
};

__device__ __forceinline__ unsigned cvt_pk_bf16(float lo, float hi) { return pk_bf16_builtin(lo, hi); }
typedef float f32x2 __attribute__((ext_vector_type(2)));
__device__ __forceinline__ f32x2 gelu_pk(f32x2 v) {
    const f32x2 av = __builtin_elementwise_abs(v), d = av * 0.2316418882f + 1.0f;
    f32x2 t; t.x = __builtin_amdgcn_rcpf(d.x); t.y = __builtin_amdgcn_rcpf(d.y);
    f32x2 q = t * 0.5307027145f + (-0.7265760135f); q = q * t + 0.7107068705f; q = q * t + (-0.142248368f); q = q * t + 0.127414796f; q = q * t;
    const f32x2 s = (v * v) * (-0.72134752044f);
    f32x2 e; e.x = __builtin_amdgcn_exp2f(s.x); e.y = __builtin_amdgcn_exp2f(s.y);
    const f32x2 m = v * (q * e), r = v - m;
    f32x2 o; o.x = v.x < 0.f ? m.x : r.x; o.y = v.y < 0.f ? m.y : r.y; return o;
}

template <int ACT> struct EpiBf16X {
    static constexpr bool PERM = true, AFTER_DRAIN = false;
    bf16_t* O; int ldc; const float* bias0; const float* bias1; int bias_split;
    const PG8_LAS float* rs_lds;
    __device__ __forceinline__ void operator()(const f32x4 (&acc)[2][2][4][2], const Unit& u, int wr, int wc, int fr, int fq) const {
        const int row0 = u.pm * BM + wr * 64 + fr; const int colt = u.pn * BM;
        const int col0 = colt + wc * 32 + 8 * fq;
        f32x4 bv[2][2];
#pragma unroll
        for (int bj = 0; bj < 2; ++bj)
#pragma unroll
            for (int n = 0; n < 2; ++n) {
                if (ACT == 1) { const float* bp = ((u.pn & 1) ? bias1 : bias0) + (u.pn >> 1) * BM + (col0 - colt); bv[bj][n] = *(const f32x4*)(bp + bj * HALF + 4 * n); }
                else bv[bj][n] = (f32x4){0.f, 0.f, 0.f, 0.f};
            }
#pragma unroll
        for (int ai = 0; ai < 2; ++ai)
#pragma unroll
            for (int m = 0; m < 4; ++m) { bf16_t* rowp = O + (size_t)(row0 + ai * HALF + m * 16) * ldc + col0;
                float rsc = 1.0f;
                if (rs_lds) rsc = rs_lds[wr * 64 + fr + ai * HALF + m * 16];
#pragma unroll
                for (int bj = 0; bj < 2; ++bj) { f32x4 v0 = (acc[ai][bj][m][0] + bv[bj][0]) * rsc, v1 = (acc[ai][bj][m][1] + bv[bj][1]) * rsc;
                    if (ACT == 1) {
#pragma unroll
                        for (int j = 0; j < 4; ++j) { v0[j] = __builtin_amdgcn_rcpf(1.0f + __builtin_amdgcn_exp2f(-1.4426950408889634f * v0[j])); v1[j] = __builtin_amdgcn_rcpf(1.0f + __builtin_amdgcn_exp2f(-1.4426950408889634f * v1[j])); } }
                    if (ACT == 2) {
#pragma unroll
                        for (int j = 0; j < 4; ++j) { const float a = fmaxf(v0[j], 0.f), b = fmaxf(v1[j], 0.f); v0[j] = a * a; v1[j] = b * b; } }
                    u32x4 w; w.x = cvt_pk_bf16(v0[0], v0[1]); w.y = cvt_pk_bf16(v0[2], v0[3]); w.z = cvt_pk_bf16(v1[0], v1[1]); w.w = cvt_pk_bf16(v1[2], v1[3]);
                    *(u32x4*)(rowp + bj * HALF) = w; } }
    }
};
struct EpiResX {
    static constexpr bool PERM = true, AFTER_DRAIN = false;
    const float* basef; const bf16_t* baseh; float* outf; bf16_t* outh; float* pss; int ldc, nrows;
    __device__ __forceinline__ void operator()(const f32x4 (&acc)[2][2][4][2], const Unit& u, int wr, int wc, int fr, int fq) const {
        const int row0 = u.pm * BM + wr * 64 + fr, col0 = u.pn * BM + wc * 32 + 8 * fq;
        float ssq[2][4];
#pragma unroll
        for (int ai = 0; ai < 2; ++ai)
#pragma unroll
            for (int m = 0; m < 4; ++m) { const size_t off = (size_t)(row0 + ai * HALF + m * 16) * ldc + col0;
                float sq = 0.f;
#pragma unroll
                for (int bj = 0; bj < 2; ++bj) {
                    f32x4 b0, b1;
                    if (basef) { b0 = *(const f32x4*)(basef + off + bj * HALF); b1 = *(const f32x4*)(basef + off + bj * HALF + 4); }
                    else { const u32x4 w = *(const u32x4*)(baseh + off + bj * HALF);
                        b0 = (f32x4){__uint_as_float(w.x << 16), __uint_as_float(w.x & 0xffff0000u), __uint_as_float(w.y << 16), __uint_as_float(w.y & 0xffff0000u)};
                        b1 = (f32x4){__uint_as_float(w.z << 16), __uint_as_float(w.z & 0xffff0000u), __uint_as_float(w.w << 16), __uint_as_float(w.w & 0xffff0000u)}; }
                    const f32x4 v0 = acc[ai][bj][m][0] + b0, v1 = acc[ai][bj][m][1] + b1;
                    if (outf) { *(f32x4*)(outf + off + bj * HALF) = v0; *(f32x4*)(outf + off + bj * HALF + 4) = v1; }
                    else { u32x4 w; w.x = cvt_pk_bf16(v0[0], v0[1]); w.y = cvt_pk_bf16(v0[2], v0[3]); w.z = cvt_pk_bf16(v1[0], v1[1]); w.w = cvt_pk_bf16(v1[2], v1[3]);
                        *(u32x4*)(outh + off + bj * HALF) = w;
                        sq += ((v0[0] * v0[0] + v0[1] * v0[1]) + (v0[2] * v0[2] + v0[3] * v0[3])) + ((v1[0] * v1[0] + v1[1] * v1[1]) + (v1[2] * v1[2] + v1[3] * v1[3])); } }
                ssq[ai][m] = sq;
                asm volatile("" ::: "memory"); }
        if (!outf) {
#pragma unroll
            for (int ai = 0; ai < 2; ++ai)
#pragma unroll
                for (int m = 0; m < 4; ++m) ssq[ai][m] += __shfl_xor(ssq[ai][m], 16);
#pragma unroll
            for (int ai = 0; ai < 2; ++ai)
#pragma unroll
                for (int m = 0; m < 4; ++m) ssq[ai][m] += __shfl_xor(ssq[ai][m], 32);
            if (fq == 0) {
#pragma unroll
                for (int ai = 0; ai < 2; ++ai)
#pragma unroll
                    for (int m = 0; m < 4; ++m) pss[(size_t)(u.pn * 4 + wc) * nrows + (row0 + ai * HALF + m * 16)] = ssq[ai][m];
            }
        }
    }
};
template <class Epi, class Sched, bool ALIGN_EPI = false, bool SP2 = false>
__device__ __forceinline__ void gemm_phase(PG8_LAS unsigned char* lds, const Gemm g, const Sched& S, const Epi& E) {
    const int tid = tid_opaque(), wid = __builtin_amdgcn_readfirstlane(tid >> 6), lane = tid & 63, wr = wid >> 2, wc = wid & 3, fr = lane & 15, fq = lane >> 4;
    const int K = g.K, nt = K / BK, LD = g.ld ? g.ld : K;
    unsigned voffA[2], voffB[2];
#pragma unroll
    for (int i = 0; i < 2; ++i) { int R, C; stage_rc(tid * 16 + i * 8192, R, C); const int Rb = Epi::PERM ? ((R & ~31) + perm32(R & 31)) : R;
        voffA[i] = (unsigned)(R * LD + C) * 2u; voffB[i] = (unsigned)(Rb * LD + C) * 2u; }
    const size_t kstep = (size_t)(BK * 2);
    const size_t hstep = (size_t)HALF * LD * 2;
    const size_t tstep = 2 * hstep;
    const unsigned ldsw = (unsigned)wid * 1024u;
    const int aoff = lds_byte(wr * 64 + fr, fq * 8), boff = lds_byte(wc * 32 + fr, fq * 8);
#define PG8_SA(b, h) (((b) * 2 + (h)) * HTB)
#define PG8_SB(b, h) ((4 + (b) * 2 + (h)) * HTB)
#define PG8_STAGE(bufoff, gbase, voff) do { _Pragma("unroll") for (int _i = 0; _i < 2; ++_i) \
        __builtin_amdgcn_global_load_lds((const unsigned*)((const char*)(gbase) + (voff)[_i]), (PG8_LAS unsigned*)(lds + (bufoff) + ldsw + _i * 8192), 16, 0, 0); } while (0)
#define PG8_LDA(dst, b, h) do { _Pragma("unroll") for (int m = 0; m < 4; ++m) _Pragma("unroll") for (int k = 0; k < 2; ++k) dst[m][k] = *(const PG8_LAS bf16x8*)(lds + PG8_SA(b, h) + aoff + m * 2048 + k * 1024); } while (0)
#define PG8_LDB(dst, b, h) do { _Pragma("unroll") for (int n = 0; n < 2; ++n) _Pragma("unroll") for (int k = 0; k < 2; ++k) dst[n][k] = *(const PG8_LAS bf16x8*)(lds + PG8_SB(b, h) + boff + n * 2048 + k * 1024); } while (0)
#define PG8_MMA(ai, bj, At, Bt) do { __builtin_amdgcn_s_setprio(1); _Pragma("unroll") for (int m = 0; m < 4; ++m) _Pragma("unroll") for (int n = 0; n < 2; ++n) _Pragma("unroll") for (int k = 0; k < 2; ++k) \
        acc[ai][bj][m][n] = __builtin_amdgcn_mfma_f32_16x16x32_bf16(Bt[n][k], At[m][k], acc[ai][bj][m][n], 0, 0, 0); __builtin_amdgcn_s_setprio(0); } while (0)
#define PG8_WAIT_V(n) asm volatile("s_waitcnt vmcnt(" #n ")" ::: "memory")
#define PG8_WAIT_L(n) asm volatile("s_waitcnt lgkmcnt(" #n ")" ::: "memory")
#define PG8_BAR __builtin_amdgcn_s_barrier()
#define PG8_SCHED __builtin_amdgcn_sched_barrier(0)
    Unit cur, nxt; int ui = 0;
    if (!S.next(0, cur)) return;
    f32x4 acc[2][2][4][2];
#pragma unroll
    for (int a = 0; a < 2; ++a)
#pragma unroll
        for (int b = 0; b < 2; ++b)
#pragma unroll
            for (int m = 0; m < 4; ++m)
#pragma unroll
                for (int n = 0; n < 2; ++n) acc[a][b][m][n] = (f32x4){0.f, 0.f, 0.f, 0.f};
    bf16x8 At[4][2], B0[2][2], B1[2][2];
    const char* cA = (const char*)g.A + (size_t)cur.pm * tstep + g.aoff(cur.pn); const char* cB = (const char*)g.Bt + (size_t)cur.pn * tstep;
    S.a_ready(cur);
    if constexpr (SP2) {
        PG8_STAGE(PG8_SB(0, 0), cB, voffB); PG8_STAGE(PG8_SB(0, 1), cB + hstep, voffB); PG8_STAGE(PG8_SA(0, 0), cA, voffA); PG8_STAGE(PG8_SA(0, 1), cA + hstep, voffA);
        if (wr == 1) PG8_BAR;
        PG8_WAIT_V(2); PG8_BAR;
        PG8_STAGE(PG8_SB(1, 0), cB + kstep, voffB); PG8_STAGE(PG8_SA(1, 0), cA + kstep, voffA); PG8_STAGE(PG8_SB(1, 1), cB + hstep + kstep, voffB);
        PG8_WAIT_V(6); PG8_BAR;
    } else {
        PG8_STAGE(PG8_SB(0, 0), cB, voffB); PG8_STAGE(PG8_SA(0, 0), cA, voffA); PG8_STAGE(PG8_SB(0, 1), cB + hstep, voffB); PG8_STAGE(PG8_SA(0, 1), cA + hstep, voffA);
        if (wr == 1) PG8_BAR;
        PG8_WAIT_V(4); PG8_BAR;
        PG8_STAGE(PG8_SB(1, 0), cB + kstep, voffB); PG8_STAGE(PG8_SA(1, 0), cA + kstep, voffA); PG8_STAGE(PG8_SB(1, 1), cB + hstep + kstep, voffB);
        PG8_WAIT_V(6); PG8_BAR;
    }
    for (;;) {
        const bool has_next = S.next(ui + 1, nxt);
        const char* nA = has_next ? (const char*)g.A + (size_t)nxt.pm * tstep + g.aoff(nxt.pn) : cA; const char* nB = has_next ? (const char*)g.Bt + (size_t)nxt.pn * tstep : cB;
        _Pragma("unroll 1")
        for (int t = 0; t < nt; t += 2) {
            const bool last = (t == nt - 2);
            const char* a1 = cA + (size_t)(t + 1) * kstep;
            const char* a2 = last ? nA : cA + (size_t)(t + 2) * kstep; const char* b2 = last ? nB : cB + (size_t)(t + 2) * kstep;
            const char* a3 = a2 + kstep; const char* b3 = b2 + kstep;
            if (last && has_next) S.a_ready(nxt);
            if constexpr (SP2) {
            PG8_LDB(B0, 0, 0); PG8_LDB(B1, 0, 1); PG8_SCHED; PG8_LDA(At, 0, 0); PG8_STAGE(PG8_SA(1, 1), a1 + hstep, voffA);
            PG8_WAIT_V(8); PG8_WAIT_L(0); PG8_BAR; PG8_MMA(0, 0, At, B0); PG8_MMA(0, 1, At, B1); PG8_BAR; PG8_SCHED;
            PG8_LDA(At, 0, 1); PG8_STAGE(PG8_SB(0, 0), b2, voffB); PG8_STAGE(PG8_SB(0, 1), b2 + hstep, voffB); PG8_STAGE(PG8_SA(0, 0), a2, voffA);
            PG8_WAIT_V(8); PG8_WAIT_L(0); PG8_BAR; PG8_MMA(1, 0, At, B0); PG8_MMA(1, 1, At, B1); PG8_BAR; PG8_SCHED;
            PG8_LDB(B0, 1, 0); PG8_LDB(B1, 1, 1); PG8_SCHED; PG8_LDA(At, 1, 0); PG8_STAGE(PG8_SA(0, 1), a2 + hstep, voffA);
            PG8_WAIT_V(8); PG8_WAIT_L(0); PG8_BAR; PG8_MMA(0, 0, At, B0); PG8_MMA(0, 1, At, B1); PG8_BAR; PG8_SCHED;
            PG8_LDA(At, 1, 1); PG8_STAGE(PG8_SB(1, 0), b3, voffB); PG8_STAGE(PG8_SB(1, 1), b3 + hstep, voffB); PG8_STAGE(PG8_SA(1, 0), a3, voffA);
            PG8_WAIT_V(8); PG8_WAIT_L(0); PG8_BAR; PG8_MMA(1, 0, At, B0); PG8_MMA(1, 1, At, B1); PG8_BAR; PG8_SCHED;
            } else {
            PG8_LDB(B0, 0, 0); PG8_SCHED; PG8_LDA(At, 0, 0); PG8_STAGE(PG8_SA(1, 1), a1 + hstep, voffA);
            PG8_WAIT_L(8); PG8_BAR; PG8_WAIT_L(0); PG8_MMA(0, 0, At, B0); PG8_BAR; PG8_SCHED;
            PG8_LDB(B1, 0, 1); PG8_STAGE(PG8_SB(0, 0), b2, voffB);
            PG8_BAR; PG8_WAIT_L(0); PG8_MMA(0, 1, At, B1); PG8_BAR;
            PG8_LDA(At, 0, 1); PG8_STAGE(PG8_SA(0, 0), a2, voffA);
            PG8_BAR; PG8_WAIT_L(0); PG8_MMA(1, 0, At, B0); PG8_BAR; PG8_SCHED;
            PG8_STAGE(PG8_SB(0, 1), b2 + hstep, voffB);
            PG8_WAIT_V(6); PG8_BAR; PG8_MMA(1, 1, At, B1); PG8_BAR;
            PG8_LDB(B0, 1, 0); PG8_SCHED; PG8_LDA(At, 1, 0); PG8_STAGE(PG8_SA(0, 1), a2 + hstep, voffA);
            PG8_WAIT_L(8); PG8_BAR; PG8_WAIT_L(0); PG8_MMA(0, 0, At, B0); PG8_BAR; PG8_SCHED;
            PG8_LDB(B1, 1, 1); PG8_STAGE(PG8_SB(1, 0), b3, voffB);
            PG8_BAR; PG8_WAIT_L(0); PG8_MMA(0, 1, At, B1); PG8_BAR;
            PG8_LDA(At, 1, 1); PG8_STAGE(PG8_SA(1, 0), a3, voffA);
            PG8_BAR; PG8_WAIT_L(0); PG8_MMA(1, 0, At, B0); PG8_BAR; PG8_SCHED;
            PG8_STAGE(PG8_SB(1, 1), b3 + hstep, voffB);
            PG8_WAIT_V(6); PG8_BAR; PG8_MMA(1, 1, At, B1); PG8_BAR;
            }
        }
        if constexpr (ALIGN_EPI) { if (wr == 0) PG8_BAR; }
        if constexpr (!Epi::AFTER_DRAIN) { E(acc, cur, wr, wc, fr, fq); S.done(cur); }
        if (!has_next) break;
#pragma unroll
        for (int a = 0; a < 2; ++a)
#pragma unroll
            for (int b = 0; b < 2; ++b)
#pragma unroll
                for (int m = 0; m < 4; ++m)
#pragma unroll
                    for (int n = 0; n < 2; ++n) acc[a][b][m][n] = (f32x4){0.f, 0.f, 0.f, 0.f};
        cur = nxt; cA = nA; cB = nB; ++ui;
        if constexpr (ALIGN_EPI) { if (wr == 1) PG8_BAR; }
    }
    PG8_WAIT_V(0);
    if constexpr (!ALIGN_EPI) { if (wr == 0) PG8_BAR; }
    PG8_BAR;
    if constexpr (Epi::AFTER_DRAIN) { E.fused(acc, cur, wr, wc, fr, fq, lds, wid, lane); S.done(cur); }
#undef PG8_SA
#undef PG8_SB
#undef PG8_STAGE
#undef PG8_LDA
#undef PG8_LDB
#undef PG8_MMA
#undef PG8_WAIT_V
#undef PG8_WAIT_L
#undef PG8_BAR
#undef PG8_SCHED
}
}

namespace ab {
enum { ORDER_NATURAL = 0, ORDER_REVERSED = 1, ORDER_PAIRED = 2, ORDER_XCD = 4 };
using TIN = __hip_bfloat16; using TOUT = __hip_bfloat16;
constexpr int B = 4, H = 32, HKV = 32, SQ = 4096, SKV = 4096, D = 128;
constexpr int QOFF = 0; constexpr int WINDOW = SKV; constexpr float THR = 8.f; constexpr int ORDER = ORDER_PAIRED; constexpr int GRID_WGS = 0; constexpr bool WSKIP = false;
constexpr float SCALE = 0.08838834764831845f;
constexpr int NW = 8, QBLK = 32, KVBLK = 64, QB = NW * QBLK;
constexpr int SHM_V = KVBLK * D * 2, SHM_K = KVBLK * D * 2;
constexpr int LDS_BYTES = 2 * SHM_V + 2 * SHM_K + NW * 64 * 4;
constexpr int V_ROW = 12288;
constexpr int O_STAGE = LDS_BYTES, O_STAGE_ROW = 272, O_STAGE_WAVE = 32 * O_STAGE_ROW;
using bf16 = __hip_bfloat16;
typedef short bf16x8 __attribute__((ext_vector_type(8)));
typedef short s16x4 __attribute__((ext_vector_type(4)));
typedef float f32x16 __attribute__((ext_vector_type(16)));
typedef float f32x4 __attribute__((ext_vector_type(4)));
typedef unsigned u32x4 __attribute__((ext_vector_type(4)));
template <class A, class Bt> struct same_t { static constexpr bool v = false; };
template <class A> struct same_t<A, A> { static constexpr bool v = true; };

#define KSWZ(row, colB) ((row) * 256 + ((colB) ^ (((row) & 7) << 4)))
#define SBAR() __builtin_amdgcn_sched_barrier(0)
__device__ __forceinline__ int v_st(int k, int c) { const int kk = (k & ~0xC) | ((k & 4) << 1) | ((k & 8) >> 1); return ((kk >> 3) * 4 + (c >> 5)) * 512 + ((kk & 7) * 32 + (c & 31)) * 2; }
__device__ __forceinline__ int v_rd_base(int lane) { return ((lane & 3) << 3) | (((lane >> 2) & 3) << 6) | (((lane >> 4) & 1) << 5) | (((lane >> 5) & 1) << 8); }
constexpr int v_rd_off(int d0, int ks, int half) { return d0 * 512 + ks * 4096 + half * 2048; }
__device__ __forceinline__ int crow(int r, int hi) { return (r & 3) + 8 * (r >> 2) + 4 * hi; }
__device__ __forceinline__ unsigned cvtpk(float lo, float hi) {
    return pk_bf16_builtin(lo, hi);
}
__device__ __forceinline__ bf16x8 pack8(f32x4 a, f32x4 b) {
    u32x4 w = {cvtpk(a[0], a[1]), cvtpk(a[2], a[3]), cvtpk(b[0], b[1]), cvtpk(b[2], b[3])};
    return *reinterpret_cast<bf16x8*>(&w);
}
template <class T> __device__ __forceinline__ bf16x8 load8(const T* p) {
    if constexpr (same_t<T, float>::v) { return pack8(*(const f32x4*)p, *(const f32x4*)(p + 4)); }
    else { return *reinterpret_cast<const bf16x8*>(p); }
}
__device__ __forceinline__ void mask_tile(f32x16& p0, f32x16& p1, int dq, unsigned W) {
    const float NEG = -__builtin_inff();
#pragma unroll
    for (int r = 0; r < 16; ++r) {
        const int c = (r & 3) + 8 * (r >> 2);
        if ((unsigned)(dq - c) >= W) p0[r] = NEG;
        if ((unsigned)(dq - c - 32) >= W) p1[r] = NEG;
    }
}
__device__ __forceinline__ void partialSM(f32x16& p0, f32x16& p1, float& m_reg, float& mn, float& alpha) {
    float pmax = p0[0]; for (int r = 1; r < 16; ++r) pmax = fmaxf(pmax, p0[r]); for (int r = 0; r < 16; ++r) pmax = fmaxf(pmax, p1[r]);
    { auto rr = __builtin_amdgcn_permlane32_swap(__float_as_uint(pmax), __float_as_uint(pmax), false, false);
      pmax = fmaxf(__uint_as_float(rr[0]), __uint_as_float(rr[1])); }
    constexpr float C2 = 1.4426950408889634f * SCALE;
    if (__builtin_expect(__all((pmax - m_reg) * SCALE <= THR), 1)) { mn = m_reg; alpha = 1.f; }
    else { mn = fmaxf(m_reg, pmax); alpha = __builtin_amdgcn_exp2f((m_reg - mn) * C2); m_reg = mn; }
    const float mnL = -mn * C2;
    for (int r = 0; r < 16; ++r) p0[r] = fmaf(p0[r], C2, mnL); for (int r = 0; r < 16; ++r) p1[r] = fmaf(p1[r], C2, mnL);
    for (int r = 0; r < 16; ++r) p0[r] = __builtin_amdgcn_exp2f(p0[r]);
}
__device__ __forceinline__ void finishSM(f32x16& p0, f32x16& p1, float alpha, float& l_reg, bf16x8& pa0, bf16x8& pa1, bf16x8& pa2, bf16x8& pa3) {
    for (int r = 0; r < 16; ++r) p1[r] = __builtin_amdgcn_exp2f(p1[r]);
    float ps = 0; for (int r = 0; r < 16; ++r) ps += p0[r]; for (int r = 0; r < 16; ++r) ps += p1[r];
    { auto rr = __builtin_amdgcn_permlane32_swap(__float_as_uint(ps), __float_as_uint(ps), false, false);
      ps = __uint_as_float(rr[0]) + __uint_as_float(rr[1]); }
    l_reg = l_reg * alpha + ps;
#define PK4(P, B_, OUT) do { unsigned a0 = cvtpk(P[B_+0], P[B_+1]), a1 = cvtpk(P[B_+2], P[B_+3]);                          \
        unsigned b0 = cvtpk(P[B_+4], P[B_+5]), b1 = cvtpk(P[B_+6], P[B_+7]);                                             \
        auto r0 = __builtin_amdgcn_permlane32_swap(a0, b0, false, false); auto r1 = __builtin_amdgcn_permlane32_swap(a1, b1, false, false); \
        u32x4 w = {r0[0], r1[0], r0[1], r1[1]}; OUT = *reinterpret_cast<bf16x8*>(&w); } while (0)
    PK4(p0, 0, pa0); PK4(p0, 8, pa1); PK4(p1, 0, pa2); PK4(p1, 8, pa3);
#undef PK4
}
template <int KB, bool SK>
__device__ __forceinline__ void qkt(f32x16& p0, f32x16& p1, const char* K_lds, int r32, int hi, const bf16x8* qr, bool act) {
    if (SK && !act) { const float NEG = -__builtin_inff();
#pragma unroll
        for (int r = 0; r < 16; ++r) { p0[r] = NEG; p1[r] = NEG; } return; }
    p0 = f32x16{}; p1 = f32x16{};
    const char* kb[4];
#pragma unroll
    for (int dd = 0; dd < 4; ++dd) kb[dd] = K_lds + KB * SHM_K + KSWZ(r32, (dd * 16 + hi * 8) * 2);
#pragma unroll
    for (int d0 = 0; d0 < 8; ++d0) { const char* a = kb[d0 & 3] + (d0 >> 2) * 128;
        bf16x8 b0 = *reinterpret_cast<const bf16x8*>(a);
        bf16x8 b1 = *reinterpret_cast<const bf16x8*>(a + 32 * 256);
        p0 = __builtin_amdgcn_mfma_f32_32x32x16_bf16(b0, qr[d0], p0, 0, 0, 0);
        p1 = __builtin_amdgcn_mfma_f32_32x32x16_bf16(b1, qr[d0], p1, 0, 0, 0); }
}
template <int VB, bool SK>
__device__ __forceinline__ void pv_tile(f32x16* o, int vb0, bf16x8 pa0, bf16x8 pa1, bf16x8 pa2, bf16x8 pa3, bool act) {
    if (SK && !act) return;
#define TRRD(dst, off) asm volatile("ds_read_b64_tr_b16 %0, %1 offset:%2" : "=&v"(dst) : "v"(vb0), "i"(off) : "memory")
#define PV_D0(d0) do { s16x4 l0, l1, l2, l3, h0, h1, h2, h3; constexpr int b_ = VB * SHM_V + v_rd_off(d0, 0, 0);     \
        TRRD(l0, b_); TRRD(h0, b_ + 2048); TRRD(l1, b_ + 4096); TRRD(h1, b_ + 6144); TRRD(l2, b_ + 8192); TRRD(h2, b_ + 10240); TRRD(l3, b_ + 12288); TRRD(h3, b_ + 14336); \
        asm volatile("s_waitcnt lgkmcnt(0)" ::: "memory"); SBAR();                 \
        o[d0] = __builtin_amdgcn_mfma_f32_32x32x16_bf16(pa0, (bf16x8){l0[0], l0[1], l0[2], l0[3], h0[0], h0[1], h0[2], h0[3]}, o[d0], 0, 0, 0);   \
        o[d0] = __builtin_amdgcn_mfma_f32_32x32x16_bf16(pa1, (bf16x8){l1[0], l1[1], l1[2], l1[3], h1[0], h1[1], h1[2], h1[3]}, o[d0], 0, 0, 0);   \
        o[d0] = __builtin_amdgcn_mfma_f32_32x32x16_bf16(pa2, (bf16x8){l2[0], l2[1], l2[2], l2[3], h2[0], h2[1], h2[2], h2[3]}, o[d0], 0, 0, 0);   \
        o[d0] = __builtin_amdgcn_mfma_f32_32x32x16_bf16(pa3, (bf16x8){l3[0], l3[1], l3[2], l3[3], h3[0], h3[1], h3[2], h3[3]}, o[d0], 0, 0, 0); } while (0)
    PV_D0(0); PV_D0(1); PV_D0(2); PV_D0(3);
#undef PV_D0
#undef TRRD
}

template <class TIn, class TOut> struct BlockRef { const TIn* Q; const TIn* K; const TIn* V; TOut* O; int P0; };
template <class TIn> struct Seam {
    bf16x8 qr[8];
    bf16x8 st_v0, st_v1, st_k0, st_k1; f32x4 sf0, sf1, sf2, sf3;
    f32x4 tq[16];
};
__device__ __forceinline__ int swa_jlo(int P0, int W) { const int lowk = P0 - W + 1; return lowk > 0 ? lowk / KVBLK : 0; }
#define ROW(p, k0, rr) ((p) + (size_t)((k0) + (rr)) * D + sc)
#define ROWV(p, k0, rr) ((p) + (size_t)((k0) + (rr)) * V_ROW + sc)
#define VMW() asm volatile("s_waitcnt vmcnt(0)" ::: "memory")
#define VMWN(n) asm volatile("s_waitcnt vmcnt(%0)" :: "i"(n) : "memory")
#define SLOAD_H(Kp, Vp, k0) do { S.st_v0 = load8<TIn>(ROWV(Vp, k0, sr)); S.st_v1 = load8<TIn>(ROWV(Vp, k0, 32 + sr));              \
                         S.st_k0 = load8<TIn>(ROW(Kp, k0, sr)); S.st_k1 = load8<TIn>(ROW(Kp, k0, 32 + sr)); } while (0)
#define SWRITE_HK(bf) do { *(bf16x8*)(K_lds + (bf) * SHM_K + kws) = S.st_k0; *(bf16x8*)(K_lds + (bf) * SHM_K + kws + 32 * 256) = S.st_k1; } while (0)
#define SWRITE_HV(bf) do { *(bf16x8*)(V_lds + (bf) * SHM_V + vst0) = S.st_v0; *(bf16x8*)(V_lds + (bf) * SHM_V + vst1) = S.st_v1; } while (0)
#define SWRITE_H(bf) do { SWRITE_HV(bf); SWRITE_HK(bf); } while (0)
#define SLOAD_F(p, k0) do { S.sf0 = *(const f32x4*)ROW(p, k0, sr); S.sf1 = *(const f32x4*)(ROW(p, k0, sr) + 4);                \
                            S.sf2 = *(const f32x4*)ROW(p, k0, 32 + sr); S.sf3 = *(const f32x4*)(ROW(p, k0, 32 + sr) + 4); } while (0)
#define SWRITE_KF(bf) do { *(bf16x8*)(K_lds + (bf) * SHM_K + kws) = pack8(S.sf0, S.sf1); *(bf16x8*)(K_lds + (bf) * SHM_K + kws + 32 * 256) = pack8(S.sf2, S.sf3); } while (0)
#define SWRITE_VF(bf) do { *(bf16x8*)(V_lds + (bf) * SHM_V + vst0) = pack8(S.sf0, S.sf1); *(bf16x8*)(V_lds + (bf) * SHM_V + vst1) = pack8(S.sf2, S.sf3); } while (0)
template <class TIn, class TOut>
__device__ __forceinline__ void causal_swa_prime(const BlockRef<TIn, TOut>& cur, int W, char* lds, Seam<TIn>& S) {
    constexpr bool F32 = same_t<TIn, float>::v;
    const int tid = tid_opaque(), wid = __builtin_amdgcn_readfirstlane(tid >> 6), lane = tid & 63, r32 = lane & 31, hi = lane >> 5;
    const int sr = tid >> 4, sc = (tid & 15) * 8, kws = KSWZ(sr, sc * 2); char* K_lds = lds + 2 * SHM_V;
    const int kb0 = swa_jlo(cur.P0, W) * KVBLK;
    for (int d0 = 0; d0 < 8; ++d0) S.qr[d0] = load8<TIn>(cur.Q + (size_t)(wid * QBLK + r32) * D + d0 * 16 + hi * 8);
    if constexpr (F32) { SLOAD_F((const float*)cur.K, kb0); VMW(); SWRITE_KF(0); SBAR(); SLOAD_F((const float*)cur.V, kb0); }
    else { SLOAD_H(cur.K, cur.V, kb0); VMW(); SWRITE_HK(0); }
    __syncthreads();
}
template <class TIn, class TOut>
__device__ __forceinline__ void causal_swa_block(const BlockRef<TIn, TOut>& cur, const BlockRef<TIn, TOut>& nxt, int skv, int W, char* lds, Seam<TIn>& S) {
    constexpr bool F32 = same_t<TIn, float>::v;
    const int tid = tid_opaque(), wid = __builtin_amdgcn_readfirstlane(tid >> 6), lane = tid & 63, r32 = lane & 31, hi = lane >> 5;
    const int j_lo = swa_jlo(cur.P0, W);
    int j_hi = (cur.P0 + QB - 1) / KVBLK + 1; if (j_hi > skv / KVBLK) j_hi = skv / KVBLK;
    const int NT = j_hi - j_lo;
    const int kbn = swa_jlo(nxt.P0, W) * KVBLK;
    const int qlo = cur.P0 + wid * QBLK, qm = qlo + r32 - 4 * hi;
    char* V_lds = lds; char* K_lds = lds + 2 * SHM_V;
    float* ws = (float*)(lds + 2 * SHM_V + 2 * SHM_K) + wid * 64; float* li_l = ws, * al_l = ws + 32;
    float m_reg = -1e30f, l_reg = 0; f32x16 o[4] = {};
    const int sr = tid >> 4, sc = (tid & 15) * 8, vst0 = v_st(sr, sc), vst1 = v_st(32 + sr, sc), kws = KSWZ(sr, sc * 2);
    const int vb0 = (int)(uintptr_t)V_lds + v_rd_base(lane);
    const TIn* Kh = cur.K; const TIn* Vh = cur.V;
#define RESC(a) do { if (__any((a) < 1.f)) { if (hi == 0) al_l[r32] = (a); asm volatile("s_waitcnt lgkmcnt(0)" ::: "memory");              \
                     for (int d_ = 0; d_ < 4; ++d_) for (int r = 0; r < 16; ++r) o[d_][r] *= al_l[crow(r, hi)]; } } while (0)
#define KBASE(t) ((j_lo + (t)) * KVBLK)
#define ACT(t) (KBASE(t) <= qlo + QBLK - 1 && KBASE(t) + KVBLK - 1 >= qlo - W + 1)
#define MASKT(P0_, P1_, t) do { const int kb_ = KBASE(t); if ((!SK || ACT(t)) && (kb_ + KVBLK - 1 > qlo || kb_ <= qlo + QBLK - 1 - W)) mask_tile(P0_, P1_, qm - kb_, (unsigned)W); } while (0)
    constexpr int NQL = F32 ? 16 : 8;
    constexpr bool SK = WSKIP && !F32;
#define SEAM_K0() do { VMWN(NQL); if constexpr (F32) { SWRITE_KF(0); SBAR(); SLOAD_F((const float*)nxt.V, kbn); } else { SWRITE_HK(0); } SBAR(); } while (0)
    f32x16 pA0, pA1, pB0, pB1; float mnA, mnB, alA, alB; bf16x8 pa0, pa1, pa2, pa3;
    if constexpr (F32) { VMW(); SWRITE_VF(0); SBAR(); } else { SWRITE_HV(0); SBAR(); }
    if (NT > 1) { if constexpr (F32) SLOAD_F((const float*)Kh, KBASE(1)); else SLOAD_H(Kh, Vh, KBASE(1)); }
    SBAR(); qkt<0, SK>(pA0, pA1, K_lds, r32, hi, S.qr, ACT(0));
    if constexpr (F32) { if (NT > 1) { VMW(); SWRITE_KF(1); SBAR(); SLOAD_F((const float*)Vh, KBASE(1)); } }
    MASKT(pA0, pA1, 0); partialSM(pA0, pA1, m_reg, mnA, alA);
    if (NT > 1) { VMW(); if constexpr (F32) { SWRITE_VF(1); SBAR(); if (NT > 2) SLOAD_F((const float*)Kh, KBASE(2)); } else SWRITE_H(1); }
    __syncthreads();
#define HALF_STEP(PX0, PX1, mnX, alX, PY0, PY1, alY, t, KB, VB, SB) do {                                                      \
        SBAR(); qkt<KB, SK>(PX0, PX1, K_lds, r32, hi, S.qr, ACT(t));                                             \
        finishSM(PY0, PY1, alY, l_reg, pa0, pa1, pa2, pa3); SBAR();                                                           \
        if ((t) + 1 < NT) { if constexpr (F32) { VMW(); SWRITE_KF(SB); SBAR(); SLOAD_F((const float*)Vh, KBASE((t) + 1)); }  \
                            else { SLOAD_H(Kh, Vh, KBASE((t) + 1)); } SBAR(); }                                               \
        pv_tile<VB, SK>(o, vb0, pa0, pa1, pa2, pa3, ACT((t) - 1)); MASKT(PX0, PX1, (t)); partialSM(PX0, PX1, m_reg, mnX, alX);                                        \
        __syncthreads();                                                                                                      \
        if ((t) + 1 < NT) { VMW(); if constexpr (F32) { SWRITE_VF(SB); SBAR(); if ((t) + 2 < NT) SLOAD_F((const float*)Kh, KBASE((t) + 2)); } \
                            else { SWRITE_H(SB); } }                                                                          \
        RESC(alX); __syncthreads(); } while (0)
    for (int t = 1; t + 1 < NT; t += 2) {
        HALF_STEP(pB0, pB1, mnB, alB, pA0, pA1, alA, t, 1, 0, 0);
        HALF_STEP(pA0, pA1, mnA, alA, pB0, pB1, alB, t + 1, 0, 1, 1);
    }
    const bool even = (NT & 1) == 0;
    if (even) { SBAR(); qkt<1, SK>(pB0, pB1, K_lds, r32, hi, S.qr, ACT(NT - 1)); SBAR(); }
#define QROW(e) (nxt.Q + (size_t)(wid * QBLK + r32) * D + ((e) >> 1) * 16 + hi * 8 + ((e) & 1) * 4)
    if constexpr (F32) { SLOAD_F((const float*)nxt.K, kbn); SBAR();
#pragma unroll
        for (int e = 0; e < 8; ++e) S.tq[e] = *(const f32x4*)QROW(e); }
    else { SLOAD_H(nxt.K, nxt.V, kbn); SBAR();
#pragma unroll
        for (int d0 = 0; d0 < 8; ++d0) S.qr[d0] = load8<TIn>(nxt.Q + (size_t)(wid * QBLK + r32) * D + d0 * 16 + hi * 8); }
    SBAR();
    finishSM(pA0, pA1, alA, l_reg, pa0, pa1, pa2, pa3); SBAR();
    if constexpr (F32) {
#pragma unroll
        for (int e = 8; e < 16; ++e) S.tq[e] = *(const f32x4*)QROW(e); SBAR(); }
#undef QROW
    pv_tile<0, SK>(o, vb0, pa0, pa1, pa2, pa3, ACT(even ? NT - 2 : NT - 1));
    if (even) { MASKT(pB0, pB1, NT - 1); partialSM(pB0, pB1, m_reg, mnB, alB); __syncthreads(); RESC(alB);
        finishSM(pB0, pB1, alB, l_reg, pa0, pa1, pa2, pa3); SBAR(); pv_tile<1, SK>(o, vb0, pa0, pa1, pa2, pa3, ACT(NT - 1)); }
    SBAR(); SEAM_K0();
    if (hi == 0) li_l[r32] = l_reg; asm volatile("s_waitcnt lgkmcnt(0)" ::: "memory");
    float rli[16];
#pragma unroll
    for (int r = 0; r < 16; ++r) rli[r] = __builtin_amdgcn_rcpf(li_l[crow(r, hi)]);
    TOut* Ow = cur.O + (size_t)(wid * QBLK) * D;
#pragma unroll
    for (int r = 0; r < 16; ++r) { const int orow = crow(r, hi);
#pragma unroll
        for (int d0 = 0; d0 < 4; ++d0) { const float v = o[d0][r] * rli[r];
            if constexpr (same_t<TOut, float>::v) { Ow[(size_t)orow * D + d0 * 32 + r32] = v; }
            else { *(unsigned short*)(lds + O_STAGE + wid * O_STAGE_WAVE + orow * O_STAGE_ROW + (d0 * 32 + r32) * 2) = (unsigned short)cvtpk(v, 0.f); } } }
    if constexpr (!same_t<TOut, float>::v) {
#pragma unroll
        for (int j = 0; j < 8; ++j) { const int ch = j * 64 + lane, orow = ch >> 4, c16 = ch & 15;
            *(u32x4*)((char*)(Ow + (size_t)orow * D) + c16 * 16) = *(const u32x4*)(lds + O_STAGE + wid * O_STAGE_WAVE + orow * O_STAGE_ROW + c16 * 16); } }
    if constexpr (F32) {
#pragma unroll
        for (int d0 = 0; d0 < 8; ++d0) S.qr[d0] = pack8(S.tq[2 * d0], S.tq[2 * d0 + 1]); }
    __syncthreads();
#undef RESC
#undef KBASE
#undef ACT
#undef MASKT
#undef SEAM_K0
#undef HALF_STEP
}
#undef ROW
#undef VMW
#undef VMWN
#undef SLOAD_H
#undef SWRITE_HK
#undef SWRITE_HV
#undef SWRITE_H
#undef SLOAD_F
#undef SWRITE_KF
#undef SWRITE_VF

}

#define XB_TMO      128
#define XB_XCNT(j)  (256  + 64 * (j))
#define XB_XSUB(j)  (1280 + 64 * (j))
#define XB_XGEN(j)  (2304 + 64 * (j))
#define XB_TOP      3328
#define XB_TOPGEN   3392
#define XCD_BAR_WORDS 3456
#define XB_SPIN_CAP (1u << 18)
#define LAS __attribute__((address_space(3)))

__device__ __forceinline__ unsigned xb_ld(unsigned* p)              { return __hip_atomic_load(p, __ATOMIC_RELAXED, __HIP_MEMORY_SCOPE_AGENT); }
__device__ __forceinline__ unsigned xb_add(unsigned* p, unsigned v) { return __hip_atomic_fetch_add(p, v, __ATOMIC_RELAXED, __HIP_MEMORY_SCOPE_AGENT); }
__device__ __forceinline__ unsigned xb_xcc_id() { return (unsigned)__builtin_amdgcn_s_getreg((3 << 11) | 20) & 0xFu; }
#define XB_SPIN(cond, bar) do { unsigned _sp = 0; while (cond) { __builtin_amdgcn_s_sleep(1); \
    if ((++_sp & 255u) == 0u) { if (xb_ld(&(bar)[XB_TMO])) break; if (_sp > XB_SPIN_CAP) { atomicAdd(&(bar)[XB_TMO], 1u); break; } } } } while (0)

struct XcdBarrier {
    unsigned* bar; unsigned x;
    volatile LAS unsigned* st;
};

__device__ __forceinline__ XcdBarrier xcd_barrier_post(unsigned* bar, volatile LAS unsigned* st) {
    XcdBarrier b; b.bar = bar; b.x = xb_xcc_id(); b.st = st;
    if (threadIdx.x == 0) (void)xb_add(&bar[XB_XCNT(b.x)], 1u);
    return b;
}
__device__ __forceinline__ void xcd_barrier_complete(unsigned* bar, unsigned x, unsigned& nloc, unsigned& nx) {
    const unsigned G = gridDim.x * gridDim.y * gridDim.z;
    unsigned sum, cnt, mine, sp = 0u;
    for (;;) {
        sum = 0u; cnt = 0u; mine = 0u;
#pragma unroll
        for (unsigned j = 0; j < 16; ++j) { const unsigned c = xb_ld(&bar[XB_XCNT(j)]); sum += c; cnt += (c > 0u) ? 1u : 0u; mine = (j == x) ? c : mine; }
        if (sum == G) break;
        __builtin_amdgcn_s_sleep(1);
        if ((++sp & 255u) == 0u) { if (xb_ld(&bar[XB_TMO])) break; if (sp > XB_SPIN_CAP) { atomicAdd(&bar[XB_TMO], 1u); break; } }
    }
    nloc = mine > 0u ? mine : 1u; nx = cnt > 0u ? cnt : 1u;
}

__device__ __forceinline__ void xcd_barrier(const XcdBarrier& b) {
    asm volatile("s_waitcnt vmcnt(0)" ::: "memory");
    __syncthreads();
    if (threadIdx.x == 0) {
        unsigned* bar = b.bar;
        __builtin_amdgcn_s_waitcnt(0);
        unsigned nloc = b.st[0], nx = b.st[1];
        if (nloc == 0u) { xcd_barrier_complete(bar, b.x, nloc, nx); b.st[0] = nloc; b.st[1] = nx; }
        const unsigned old = xb_add(&bar[XB_XSUB(b.x)], 1u);
        const unsigned gen = old / nloc;
        if (old + 1u == (gen + 1u) * nloc) {
            __builtin_amdgcn_fence(__ATOMIC_RELEASE, "agent");
            asm volatile("s_waitcnt vmcnt(0)" ::: "memory");
            const unsigned og = xb_add(&bar[XB_TOP], 1u);
            const unsigned tg = og / nx;
            if (og + 1u == (tg + 1u) * nx) xb_add(&bar[XB_TOPGEN], 1u);
            else XB_SPIN(xb_ld(&bar[XB_TOPGEN]) == tg, bar);
            __builtin_amdgcn_fence(__ATOMIC_ACQUIRE, "agent");
            xb_add(&bar[XB_XGEN(b.x)], 1u);
            asm volatile("s_waitcnt vmcnt(0)" ::: "memory");
        } else {
            XB_SPIN(xb_ld(&bar[XB_XGEN(b.x)]) == gen, bar);
            __builtin_amdgcn_fence(__ATOMIC_ACQUIRE, "agent");
            asm volatile("s_waitcnt vmcnt(0)" ::: "memory");
        }
    }
    __syncthreads();
}

constexpr int D_MODEL = 4096, BATCH = 4, SEQ = 4096, DEPTH = 2, M_TOK = BATCH * SEQ;
constexpr int D_FF_LD = 16384 + 128;
constexpr int IN_WIDTH = 12288, D_FF = 16384, LRU_W = 1024, HG_W = 1024, DIFF_W = 2048;
constexpr int OFF_A_GATE = 0, OFF_A_X = 1024, OFF_B_Q = 2048, OFF_B_F = 3072, OFF_B_I = 4096, OFF_B_G = 5120, OFF_C_Q = 6144, OFF_C_K = 8192, OFF_C_V = 10240;
constexpr float NORM_EPS = 1e-6f;
constexpr int NWAVES = 8, NTHREADS = NWAVES * 64;
constexpr int N_INPUTS = 21;
enum { I_X = 0, I_LN1, I_WIN, I_CONVW, I_CONVB, I_WR, I_BR, I_WI, I_BI, I_LAM, I_LRUG, I_HLB, I_HNG, I_QNG, I_KNG, I_DLAM, I_SUBLN, I_WOUT, I_LN2, I_WFF1, I_WFF2 };

constexpr size_t MiB = (size_t)1 << 20;
constexpr size_t WS_CTL = 0, CTL_ZERO_BYTES = 1 * MiB;
constexpr size_t WS_LB = 1 * MiB;
constexpr size_t WS_ROPE = 2 * MiB;
constexpr size_t WS_WGATE = 4 * MiB;
constexpr size_t WS_WIN = 16 * MiB;
constexpr size_t WS_WOUT = 208 * MiB;
constexpr size_t WS_WFF1 = 272 * MiB;
constexpr size_t WS_WFF2 = 528 * MiB;
constexpr size_t WS_H = 1904 * MiB;
constexpr size_t WS_YCAT = 912 * MiB;
constexpr size_t WS_Z = 1040 * MiB;
constexpr size_t WS_XA = 1424 * MiB;
constexpr size_t WS_RI = 1456 * MiB;
constexpr size_t WS_PSS = 1712 * MiB;
constexpr size_t WS_RS0 = 1724 * MiB;
constexpr size_t WS_QH = 1584 * MiB, WS_KH = 1648 * MiB;
constexpr size_t WS_OATT = 1776 * MiB;
constexpr size_t WS_LSUM = 2032 * MiB;
constexpr size_t WS_HID = 1040 * MiB;
constexpr size_t WS_END = 2034 * MiB;
constexpr int CW_BAR = 4096;

constexpr int RING_BYTES = 131072, LDS_BYTES = 147456, MISC_OFF = LDS_BYTES - 512;
static_assert(ab::O_STAGE + 8 * ab::O_STAGE_WAVE <= MISC_OFF, "attention LDS (tiles + output stage) must stay below the control words");

#define GAS __attribute__((address_space(1)))
typedef unsigned short bf16r;
typedef unsigned v4u __attribute__((ext_vector_type(4)));
typedef unsigned v2u __attribute__((ext_vector_type(2)));
typedef float f32x4 __attribute__((ext_vector_type(4)));
typedef float f32x2 __attribute__((ext_vector_type(2)));
#define LDS_WAIT() asm volatile("s_waitcnt lgkmcnt(0)" ::: "memory")
__device__ __forceinline__ float bflo(unsigned w) { return __uint_as_float(w << 16); }
__device__ __forceinline__ float bfhi(unsigned w) { return __uint_as_float(w & 0xffff0000u); }
__device__ __forceinline__ float bf1(bf16r b) { return __uint_as_float((unsigned)b << 16); }
__device__ __forceinline__ unsigned pk2(float lo, float hi) { return pk_bf16_builtin(lo, hi); }
__device__ __forceinline__ float wave_sum(float v) {
#pragma unroll
    for (int o = 1; o < 64; o <<= 1) v += __shfl_xor(v, o);
    return v;
}
__device__ __forceinline__ float fast_exp(float x) { return __builtin_amdgcn_exp2f(x * 1.4426950408889634f); }
__device__ __forceinline__ float sigmoidf_(float x) { return __builtin_amdgcn_rcpf(1.0f + fast_exp(-x)); }

__device__ __forceinline__ void p0_transpose_item(const float* W, int K, int N, bf16r* WT, LAS float* scr, int item, int lane, const float* kgain, int ldw) {
    const int nblk = N / 32, kb = item / nblk, nb = item % nblk, k0 = 64 * kb, n0 = 32 * nb;
    {
        const int l8 = lane & 7, lr = lane >> 3; f32x4 v[8];
#pragma unroll
        for (int i = 0; i < 8; ++i) v[i] = __builtin_nontemporal_load((const f32x4*)(W + (size_t)(k0 + 8 * i + lr) * N + n0 + 4 * l8));
#pragma unroll
        for (int i = 0; i < 8; ++i) { LAS float* d = scr + (8 * i + lr) * 33 + 4 * l8; d[0] = v[i].x; d[1] = v[i].y; d[2] = v[i].z; d[3] = v[i].w; }
    }
    LDS_WAIT(); asm volatile("" ::: "memory");
    const int c = lane & 7;
    f32x4 g0 = (f32x4){1.f, 1.f, 1.f, 1.f}, g1 = g0;
    if (kgain) { g0 = *(const f32x4*)(kgain + k0 + 8 * c); g1 = *(const f32x4*)(kgain + k0 + 8 * c + 4); }
#pragma unroll
    for (int j = 0; j < 4; ++j) { const int n = (lane >> 3) + 8 * j; const LAS float* s = scr + (8 * c) * 33 + n;
        v4u o; o.x = pk2(s[0 * 33] * g0.x, s[1 * 33] * g0.y); o.y = pk2(s[2 * 33] * g0.z, s[3 * 33] * g0.w); o.z = pk2(s[4 * 33] * g1.x, s[5 * 33] * g1.y); o.w = pk2(s[6 * 33] * g1.z, s[7 * 33] * g1.w);
        *(v4u*)(WT + (size_t)(n0 + n) * ldw + k0 + 8 * c) = o; }
    LDS_WAIT(); asm volatile("" ::: "memory");
}

struct Args { const float* in[N_INPUTS]; float* out; unsigned char* ws; int ph_lo, ph_hi; };

#ifndef GEMM_ALIGN
#define GEMM_ALIGN true
#endif
#ifndef GEMM_SP2
#define GEMM_SP2 true
#endif
constexpr int PH_PER_LAYER = 13, N_PHASES = 1 + DEPTH * PH_PER_LAYER;

__device__ __forceinline__ float neg_expm1(float x) {
    if (x > -0.3f) { float p = 1.0f + x * (1.0f / 7.0f); p = 1.0f + x * (1.0f / 6.0f) * p; p = 1.0f + x * 0.2f * p; p = 1.0f + x * 0.25f * p; p = 1.0f + x * (1.0f / 3.0f) * p; p = 1.0f + x * 0.5f * p; return -x * p; }
    return 1.0f - fast_exp(x);
}
__device__ __forceinline__ void lru_step(float r, float ig, float x, float sp8, bool first, float& h, float& A) {
    const float la = -r * sp8; const float a = fast_exp(la);
    const float mult = first ? 1.0f : sqrtf(neg_expm1(2.0f * la));
    h = a * h + mult * (ig * x); A += la;
}
__device__ __forceinline__ float gelu_tanh(float x) { const float y = 1.5957691216057308f * (x + 0.044715f * x * x * x); return x * __builtin_amdgcn_rcpf(1.0f + fast_exp(-y)); }

typedef const __attribute__((address_space(4))) unsigned char* kargp_t;
__device__ __forceinline__ kargp_t karg_base() { kargp_t kp = (kargp_t)__builtin_amdgcn_kernarg_segment_ptr(); asm volatile("" : "+s"(kp)); return kp; }
__device__ __forceinline__ const float* karg_in(int i) { return *(const float* const __attribute__((address_space(4)))*)(karg_base() + 8 * i); }
__device__ __forceinline__ float* karg_out() { return *(float* const __attribute__((address_space(4)))*)(karg_base() + 8 * N_INPUTS); }
__device__ __forceinline__ unsigned char* karg_ws() { return *(unsigned char* const __attribute__((address_space(4)))*)(karg_base() + 8 * N_INPUTS + 8); }
__device__ __forceinline__ int karg_int(int i) { return *(const int __attribute__((address_space(4)))*)(karg_base() + 8 * N_INPUTS + 16 + 4 * i); }
#define WSP(T, off) ((T*)(karg_ws() + (off)))
#define PHASE_IDS const int tid = tid_opaque(), lane = tid & 63, wave = __builtin_amdgcn_readfirstlane(tid >> 6), gw = vcu * NWAVES + wave; (void)tid; (void)lane; (void)wave; (void)gw

typedef short hg_bf16x8 __attribute__((ext_vector_type(8)));
#define HG_MFMA(a, b, c) __builtin_amdgcn_mfma_f32_16x16x32_bf16((a), (b), (c), 0, 0, 0)
#define HG_BAR() do { asm volatile("s_waitcnt vmcnt(0) lgkmcnt(0)" ::: "memory"); __builtin_amdgcn_s_barrier(); asm volatile("" ::: "memory"); } while (0)
#define HG_BARL() do { asm volatile("s_waitcnt lgkmcnt(0)" ::: "memory"); __builtin_amdgcn_s_barrier(); asm volatile("" ::: "memory"); } while (0)
__device__ __forceinline__ void hgrn_chunked(LAS unsigned char* L, const bf16r* Z, const float* lbp, const float* hgain, bf16r* YCAT, int b, int h, int tid) {
    constexpr int QS = 0, KS = 17408, KT = 34816, VT = 53248, STO = 71680, PS = 106496, SP = 115712, DM = 123904, DH = 124416;
    constexpr int RS = 272, TS = 144;
    const int lane = tid & 63, wave = __builtin_amdgcn_readfirstlane(tid >> 6), lr = lane & 15, lq = lane >> 4;
    const int u = tid & 255, j8 = (u & 15) * 8, seg = u >> 4;
    const bool scaler = wave < 4;
    const bool backward = wave < 2;
    const size_t tok0 = (size_t)b * SEQ;
    f32x4 stm[8];
#pragma unroll
    for (int n = 0; n < 8; ++n) stm[n] = (f32x4){0.f, 0.f, 0.f, 0.f};
    constexpr int LBS = 124928;
    if (tid < 128) *(LAS float*)(L + LBS + tid * 4) = 1.0f - lbp[h * 128 + tid];
    HG_BARL();
    v4u ldA[4], ldB[4];
#define HG_ISSUE(c) do { const size_t m_ = tok0 + (size_t)(c) * 64 + 4 * seg; \
        if (scaler) { _Pragma("unroll") for (int r = 0; r < 4; ++r) { ldA[r] = __builtin_nontemporal_load((const v4u*)(Z + (m_ + r) * IN_WIDTH + OFF_B_F + h * 128 + j8)); ldB[r] = __builtin_nontemporal_load((const v4u*)(Z + (m_ + r) * IN_WIDTH + OFF_B_Q + h * 128 + j8)); } } \
        else { _Pragma("unroll") for (int r = 0; r < 4; ++r) ldA[r] = *(const v4u*)(Z + (m_ + r) * IN_WIDTH + OFF_B_I + h * 128 + j8); } } while (0)
    HG_ISSUE(0);
#pragma unroll 1
    for (int c = 0; c < SEQ / 64; ++c) {
        float loc[4][8], Lp[8];
        if (scaler) {
            asm volatile("s_waitcnt vmcnt(0)" ::: "memory");
#pragma unroll
            for (int r = 0; r < 4; ++r) {
                const unsigned zw[4] = {ldA[r].x, ldA[r].y, ldA[r].z, ldA[r].w}; unsigned kwp[4];
                const f32x4 om0 = *(const LAS f32x4*)(L + LBS + j8 * 4), om1 = *(const LAS f32x4*)(L + LBS + j8 * 4 + 16);
                const float oml[8] = {om0.x, om0.y, om0.z, om0.w, om1.x, om1.y, om1.z, om1.w};
#pragma unroll
                for (int e2 = 0; e2 < 4; ++e2) { const float k0_ = oml[2 * e2] * __builtin_amdgcn_rcpf(1.0f + fast_exp(bflo(zw[e2]))), k1_ = oml[2 * e2 + 1] * __builtin_amdgcn_rcpf(1.0f + fast_exp(bfhi(zw[e2]))); kwp[e2] = pk2(k0_, k1_); }
                ldA[r] = (v4u){kwp[0], kwp[1], kwp[2], kwp[3]};
            }
            const unsigned kw0[4] = {ldA[0].x, ldA[0].y, ldA[0].z, ldA[0].w}, kw1[4] = {ldA[1].x, ldA[1].y, ldA[1].z, ldA[1].w}, kw2[4] = {ldA[2].x, ldA[2].y, ldA[2].z, ldA[2].w}, kw3[4] = {ldA[3].x, ldA[3].y, ldA[3].z, ldA[3].w};
#pragma unroll
            for (int e = 0; e < 8; ++e) {
                const float f0 = 1.0f - ((e & 1) ? bfhi(kw0[e >> 1]) : bflo(kw0[e >> 1])), f1 = 1.0f - ((e & 1) ? bfhi(kw1[e >> 1]) : bflo(kw1[e >> 1]));
                const float f2 = 1.0f - ((e & 1) ? bfhi(kw2[e >> 1]) : bflo(kw2[e >> 1])), f3 = 1.0f - ((e & 1) ? bfhi(kw3[e >> 1]) : bflo(kw3[e >> 1]));
                if (backward) { loc[3][e] = 1.0f; loc[2][e] = f3; loc[1][e] = f3 * f2; loc[0][e] = f3 * f2 * f1; Lp[e] = loc[0][e] * f0; }
                else { loc[0][e] = f0; loc[1][e] = f0 * f1; loc[2][e] = loc[1][e] * f2; loc[3][e] = loc[2][e] * f3; Lp[e] = loc[3][e]; }
            }
            *(LAS f32x4*)(L + SP + (seg * 128 + j8) * 4) = (f32x4){Lp[0], Lp[1], Lp[2], Lp[3]};
            *(LAS f32x4*)(L + SP + (seg * 128 + j8) * 4 + 16) = (f32x4){Lp[4], Lp[5], Lp[6], Lp[7]};
        }
        HG_BAR();
        if (scaler) {
            float X[8];
#pragma unroll
            for (int e = 0; e < 8; ++e) X[e] = 1.0f;
#pragma unroll
            for (int k = 0; k < 7; ++k) {
                const int sp = backward ? (1 + k) : (8 + k);
                const bool use = backward ? (sp > seg) : (sp < seg);
                const f32x4 a = *(const LAS f32x4*)(L + SP + (sp * 128 + j8) * 4), b4 = *(const LAS f32x4*)(L + SP + (sp * 128 + j8) * 4 + 16);
                X[0] *= use ? a.x : 1.0f; X[1] *= use ? a.y : 1.0f; X[2] *= use ? a.z : 1.0f; X[3] *= use ? a.w : 1.0f;
                X[4] *= use ? b4.x : 1.0f; X[5] *= use ? b4.y : 1.0f; X[6] *= use ? b4.z : 1.0f; X[7] *= use ? b4.w : 1.0f;
            }
            if (seg == 0) { *(LAS f32x4*)(L + DM + j8 * 4) = (f32x4){Lp[0] * X[0], Lp[1] * X[1], Lp[2] * X[2], Lp[3] * X[3]}; *(LAS f32x4*)(L + DM + j8 * 4 + 16) = (f32x4){Lp[4] * X[4], Lp[5] * X[5], Lp[6] * X[6], Lp[7] * X[7]}; }
            if (seg == 15) { *(LAS f32x4*)(L + DH + j8 * 4) = (f32x4){Lp[0] * X[0], Lp[1] * X[1], Lp[2] * X[2], Lp[3] * X[3]}; *(LAS f32x4*)(L + DH + j8 * 4 + 16) = (f32x4){Lp[4] * X[4], Lp[5] * X[5], Lp[6] * X[6], Lp[7] * X[7]}; }
            unsigned kt[8][2];
#pragma unroll
            for (int r = 0; r < 4; ++r) {
                float qs[8], ks[8];
                const unsigned kwr[4] = {ldA[r].x, ldA[r].y, ldA[r].z, ldA[r].w}, qwr[4] = {ldB[r].x, ldB[r].y, ldB[r].z, ldB[r].w};
#pragma unroll
                for (int e = 0; e < 8; ++e) {
                    float E, IE;
                    if (backward) { IE = fmaxf(loc[r][e] * X[e], 1.0e-30f); E = __builtin_amdgcn_rcpf(IE); }
                    else { E = fmaxf(loc[r][e] * X[e], 1.0e-30f); IE = __builtin_amdgcn_rcpf(E); }
                    { const float zq_ = (e & 1) ? bfhi(qwr[e >> 1]) : bflo(qwr[e >> 1]); qs[e] = zq_ * sigmoidf_(zq_) * 0.08838834764831845f * E; } ks[e] = ((e & 1) ? bfhi(kwr[e >> 1]) : bflo(kwr[e >> 1])) * IE;
                }
                v4u wq, wk; wq.x = pk2(qs[0], qs[1]); wq.y = pk2(qs[2], qs[3]); wq.z = pk2(qs[4], qs[5]); wq.w = pk2(qs[6], qs[7]);
                wk.x = pk2(ks[0], ks[1]); wk.y = pk2(ks[2], ks[3]); wk.z = pk2(ks[4], ks[5]); wk.w = pk2(ks[6], ks[7]);
                *(LAS v4u*)(L + QS + (4 * seg + r) * RS + j8 * 2) = wq; *(LAS v4u*)(L + KS + (4 * seg + r) * RS + j8 * 2) = wk;
                const unsigned kw[4] = {wk.x, wk.y, wk.z, wk.w};
#pragma unroll
                for (int e = 0; e < 8; ++e) { const unsigned hv = (e & 1) ? (kw[e >> 1] >> 16) : (kw[e >> 1] & 0xffffu);
                    if (r == 0) kt[e][0] = hv; else if (r == 1) kt[e][0] |= hv << 16; else if (r == 2) kt[e][1] = hv; else kt[e][1] |= hv << 16; }
            }
#pragma unroll
            for (int e = 0; e < 8; ++e) *(LAS v2u*)(L + KT + (j8 + e) * TS + (4 * seg) * 2) = (v2u){kt[e][0], kt[e][1]};
        } else {
            asm volatile("s_waitcnt vmcnt(0)" ::: "memory");
            const unsigned vw[4][4] = {{ldA[0].x, ldA[0].y, ldA[0].z, ldA[0].w}, {ldA[1].x, ldA[1].y, ldA[1].z, ldA[1].w}, {ldA[2].x, ldA[2].y, ldA[2].z, ldA[2].w}, {ldA[3].x, ldA[3].y, ldA[3].z, ldA[3].w}};
#pragma unroll
            for (int e = 0; e < 8; ++e) {
                unsigned h0, h1, h2, h3;
                if (e & 1) { h0 = vw[0][e >> 1] >> 16; h1 = vw[1][e >> 1] >> 16; h2 = vw[2][e >> 1] >> 16; h3 = vw[3][e >> 1] >> 16; }
                else { h0 = vw[0][e >> 1] & 0xffffu; h1 = vw[1][e >> 1] & 0xffffu; h2 = vw[2][e >> 1] & 0xffffu; h3 = vw[3][e >> 1] & 0xffffu; }
                *(LAS v2u*)(L + VT + (j8 + e) * TS + (4 * seg) * 2) = (v2u){h0 | (h1 << 16), h2 | (h3 << 16)};
            }
        }
        HG_BARL();
#pragma unroll
        for (int n = 0; n < 8; ++n) {
            const f32x4 dm = *(const LAS f32x4*)(L + DM + (16 * n + 4 * lq) * 4); const f32x4 sv = stm[n] * dm;
            *(LAS v2u*)(L + STO + (16 * wave + lr) * RS + (16 * n + 4 * lq) * 2) = (v2u){pk2(sv.x, sv.y), pk2(sv.z, sv.w)};
        }
        {
            const int ti = wave >> 1;
#pragma unroll
            for (int jj = 0; jj < 2; ++jj) {
                const int sj = 2 * (wave & 1) + jj;
                f32x4 acc = (f32x4){0.f, 0.f, 0.f, 0.f};
#pragma unroll
                for (int ks = 0; ks < 4; ++ks) {
                    const hg_bf16x8 a = *(const LAS hg_bf16x8*)(L + KS + (16 * sj + lr) * RS + (ks * 32 + 8 * lq) * 2);
                    const hg_bf16x8 bq = *(const LAS hg_bf16x8*)(L + QS + (16 * ti + lr) * RS + (ks * 32 + 8 * lq) * 2);
                    acc = HG_MFMA(a, bq, acc);
                }
                {
                    const int s0 = 16 * sj + 4 * lq, tt = 16 * ti + lr;
                    acc.x = (s0 + 0 <= tt) ? acc.x : 0.f; acc.y = (s0 + 1 <= tt) ? acc.y : 0.f; acc.z = (s0 + 2 <= tt) ? acc.z : 0.f; acc.w = (s0 + 3 <= tt) ? acc.w : 0.f;
                }
                *(LAS v2u*)(L + PS + (16 * ti + lr) * TS + (16 * sj + 4 * lq) * 2) = (v2u){pk2(acc.x, acc.y), pk2(acc.z, acc.w)};
            }
        }
        if (c + 1 < SEQ / 64) HG_ISSUE(c + 1);
        v2u gld[4];
        int tG = tid; asm volatile("" : "+v"(tG));
#pragma unroll
        for (int k = 0; k < 4; ++k) { const int pc = tG + 512 * k; gld[k] = __builtin_nontemporal_load((const v2u*)(Z + (tok0 + (size_t)c * 64 + (pc >> 5)) * IN_WIDTH + OFF_B_G + h * 128 + (pc & 31) * 4)); }
        HG_BARL();
        f32x4 o[4];
        {
#pragma unroll
            for (int i = 0; i < 4; ++i) o[i] = (f32x4){0.f, 0.f, 0.f, 0.f};
            hg_bf16x8 bs[4];
#pragma unroll
            for (int ks = 0; ks < 4; ++ks) bs[ks] = *(const LAS hg_bf16x8*)(L + STO + (16 * wave + lr) * RS + (ks * 32 + 8 * lq) * 2);
#pragma unroll
            for (int i = 0; i < 4; ++i)
#pragma unroll
                for (int ks = 0; ks < 4; ++ks) { const hg_bf16x8 a = *(const LAS hg_bf16x8*)(L + QS + (16 * i + lr) * RS + (ks * 32 + 8 * lq) * 2); o[i] = HG_MFMA(a, bs[ks], o[i]); }
            hg_bf16x8 bv[2];
#pragma unroll
            for (int ks = 0; ks < 2; ++ks) bv[ks] = *(const LAS hg_bf16x8*)(L + VT + (16 * wave + lr) * TS + (ks * 32 + 8 * lq) * 2);
#pragma unroll
            for (int i = 0; i < 4; ++i)
#pragma unroll
                for (int ks = 0; ks < 2; ++ks) { if (ks == 1 && i < 2) continue; const hg_bf16x8 a = *(const LAS hg_bf16x8*)(L + PS + (16 * i + lr) * TS + (ks * 32 + 8 * lq) * 2); o[i] = HG_MFMA(a, bv[ks], o[i]); }
#pragma unroll
            for (int n = 0; n < 8; ++n) {
                f32x4 U = (f32x4){0.f, 0.f, 0.f, 0.f};
#pragma unroll
                for (int ks = 0; ks < 2; ++ks) { const hg_bf16x8 a = *(const LAS hg_bf16x8*)(L + KT + (16 * n + lr) * TS + (ks * 32 + 8 * lq) * 2); U = HG_MFMA(a, bv[ks], U); }
                const f32x4 dm = *(const LAS f32x4*)(L + DM + (16 * n + 4 * lq) * 4), dh = *(const LAS f32x4*)(L + DH + (16 * n + 4 * lq) * 4);
                stm[n] = stm[n] * (dm * dh) + dh * U;
            }
        }
        HG_BARL();
#pragma unroll
        for (int i = 0; i < 4; ++i) {
            *(LAS float*)(L + (16 * i + 4 * lq + 0) * 528 + (16 * wave + lr) * 4) = o[i].x; *(LAS float*)(L + (16 * i + 4 * lq + 1) * 528 + (16 * wave + lr) * 4) = o[i].y;
            *(LAS float*)(L + (16 * i + 4 * lq + 2) * 528 + (16 * wave + lr) * 4) = o[i].z; *(LAS float*)(L + (16 * i + 4 * lq + 3) * 528 + (16 * wave + lr) * 4) = o[i].w;
        }
        HG_BARL();
        {
            int tE = tid; asm volatile("" : "+v"(tE));
#pragma unroll
            for (int k = 0; k < 4; ++k) { const int pc = tE + 512 * k, row = pc >> 5, col = (pc & 31) * 4;
                const f32x4 ov = *(const LAS f32x4*)(L + row * 528 + col * 4);
                float ss = (ov.x * ov.x + ov.y * ov.y) + (ov.z * ov.z + ov.w * ov.w);
                ss += __shfl_xor(ss, 1); ss += __shfl_xor(ss, 2); ss += __shfl_xor(ss, 4); ss += __shfl_xor(ss, 8); ss += __shfl_xor(ss, 16);
                const float rs = 1.0f / sqrtf(ss * (1.0f / 128.0f) + NORM_EPS);
                const size_t m = tok0 + (size_t)c * 64 + row;
                const v2u gw2 = gld[k];
                const f32x4 hgv = *(const f32x4*)(hgain + col);
                const float g0 = bflo(gw2.x), g1 = bfhi(gw2.x), g2 = bflo(gw2.y), g3 = bfhi(gw2.y);
                v2u w; w.x = pk2(ov.x * rs * hgv.x * (g0 * sigmoidf_(g0)), ov.y * rs * hgv.y * (g1 * sigmoidf_(g1))); w.y = pk2(ov.z * rs * hgv.z * (g2 * sigmoidf_(g2)), ov.w * rs * hgv.w * (g3 * sigmoidf_(g3)));
                *(v2u*)(YCAT + m * D_MODEL + 1024 + h * 128 + col) = w; }
        }
    }
#undef HG_ISSUE
}

__device__ __forceinline__ void xcopy_rows(const float* xin, bf16r* HB, float* RS0, int gw, int ngw, int lane) {
    for (int m = gw; m < M_TOK; m += ngw) {
        const f32x4* xr = (const f32x4*)(xin + (size_t)m * D_MODEL) + lane;
        f32x4 v[16]; float ss = 0.f;
#pragma unroll
        for (int j = 0; j < 16; ++j) { v[j] = xr[64 * j]; ss += (v[j].x * v[j].x + v[j].y * v[j].y) + (v[j].z * v[j].z + v[j].w * v[j].w); }
        ss = wave_sum(ss);
        v2u* o = (v2u*)(HB + (size_t)m * D_MODEL) + lane;
#pragma unroll
        for (int j = 0; j < 16; ++j) { v2u w; w.x = pk2(v[j].x, v[j].y); w.y = pk2(v[j].z, v[j].w); o[64 * j] = w; }
        if (lane == 0) RS0[m] = ss;
    }
}
#define RS_TABLE_OFF (RING_BYTES + 1024)
#define RS_TABLE_FILL(pssp, nparts, pm_) do { { const int r_ = tid & 255, hf_ = tid >> 8; float ss_ = 0.f;                                                                         \
        if ((nparts) == 1) { if (!hf_) ss_ = (pssp)[(pm_) * 256 + r_]; }                                                                                                           \
        else { _Pragma("unroll 16") for (int j_ = 0; j_ < 32; ++j_) ss_ += (pssp)[(size_t)(hf_ * 32 + j_) * M_TOK + (pm_) * 256 + r_]; }                                           \
        if (hf_) ((LAS float*)(ldsl + RS_TABLE_OFF))[256 + r_] = ss_;                                                                                                              \
        __syncthreads();                                                                                                                                                           \
        if (!hf_) ((LAS float*)(ldsl + RS_TABLE_OFF))[r_] = 1.0f / sqrtf((ss_ + ((LAS float*)(ldsl + RS_TABLE_OFF))[256 + r_]) * (1.0f / D_MODEL) + NORM_EPS); } __syncthreads(); } while (0)

constexpr int WC_IN = (D_MODEL / 64) * (IN_WIDTH / 32), WC_OUT = (D_MODEL / 64) * (D_MODEL / 32), WC_F1 = (D_MODEL / 64) * (D_FF / 32), WC_F2 = (D_FF / 64) * (D_MODEL / 32);
constexpr int WC_LAYER = WC_IN + WC_OUT + WC_F1 + WC_F2;
__device__ __forceinline__ void convert_weights(int it0, int it1, int w, int nw, LAS float* scr, int lane) {
    bf16r* const W_IN = WSP(bf16r, WS_WIN); bf16r* const W_OUT = WSP(bf16r, WS_WOUT); bf16r* const W_FF1 = WSP(bf16r, WS_WFF1); bf16r* const W_FF2 = WSP(bf16r, WS_WFF2);
    for (int it = it0 + w; it < it1; it += nw) {
        const int l = it / WC_LAYER; int r = it - l * WC_LAYER;
        if (r < WC_IN) { p0_transpose_item(karg_in(I_WIN) + (size_t)l * D_MODEL * IN_WIDTH, D_MODEL, IN_WIDTH, W_IN + (size_t)l * IN_WIDTH * D_MODEL, scr, r, lane, karg_in(I_LN1) + l * D_MODEL, D_MODEL); continue; } r -= WC_IN;
        if (r < WC_OUT) { p0_transpose_item(karg_in(I_WOUT) + (size_t)l * D_MODEL * D_MODEL, D_MODEL, D_MODEL, W_OUT + (size_t)l * D_MODEL * D_MODEL, scr, r, lane, nullptr, D_MODEL); continue; } r -= WC_OUT;
        if (r < WC_F1) { p0_transpose_item(karg_in(I_WFF1) + (size_t)l * D_MODEL * D_FF, D_MODEL, D_FF, W_FF1 + (size_t)l * D_FF * D_MODEL, scr, r, lane, karg_in(I_LN2) + l * D_MODEL, D_MODEL); continue; } r -= WC_F1;
        p0_transpose_item(karg_in(I_WFF2) + (size_t)l * D_FF * D_MODEL, D_FF, D_MODEL, W_FF2 + (size_t)l * D_MODEL * D_FF_LD, scr, r, lane, nullptr, D_FF_LD);
    }
}

__device__ __forceinline__ ab::BlockRef<__hip_bfloat16, __hip_bfloat16> attn_ref(const __hip_bfloat16* Qp, const __hip_bfloat16* Kp, const __hip_bfloat16* Vp, __hip_bfloat16* Op, int L, int pass) {
    const int bh = L >> 3, x = L & 7, qb = pass ? 15 - x : x;
    const int b = bh >> 5, hq = bh & 31, h = hq >> 2, c = (hq >> 1) & 1, vh = hq & 1;
    ab::BlockRef<__hip_bfloat16, __hip_bfloat16> r;
    r.Q = Qp + ((size_t)(b * 16 + h * 2 + c) * SEQ + (size_t)qb * 256) * 128;
    r.K = Kp + (size_t)(b * 16 + h * 2 + c) * SEQ * 128;
    r.V = Vp + (size_t)b * SEQ * IN_WIDTH + OFF_C_V + (h * 2 + vh) * 128;
    r.O = Op + ((size_t)(b * 32 + hq) * SEQ + (size_t)qb * 256) * 128;
    r.P0 = qb * 256;
    return r;
}

__device__ __forceinline__ ab::BlockRef<__hip_bfloat16, __hip_bfloat16> attn_ref_q(const __hip_bfloat16* Qp, const __hip_bfloat16* Kp, const __hip_bfloat16* Vp, __hip_bfloat16* Op, int J) {
    const int pr = (J >> 8) * 4 + (J & 3), i = (J & 255) >> 2;
    const int qb = 15 - (i >> 2), b = pr >> 3, h = pr & 7, c = (i >> 1) & 1, vh = i & 1, hq = h * 4 + c * 2 + vh;
    ab::BlockRef<__hip_bfloat16, __hip_bfloat16> r;
    r.Q = Qp + ((size_t)(b * 16 + h * 2 + c) * SEQ + (size_t)qb * 256) * 128;
    r.K = Kp + (size_t)(b * 16 + h * 2 + c) * SEQ * 128;
    r.V = Vp + (size_t)b * SEQ * IN_WIDTH + OFF_C_V + (h * 2 + vh) * 128;
    r.O = Op + ((size_t)(b * 32 + hq) * SEQ + (size_t)qb * 256) * 128;
    r.P0 = qb * 256;
    return r;
}

__device__ __forceinline__ void group4_barrier(unsigned* ctr, unsigned* ctr2, unsigned* bar) {
    asm volatile("s_waitcnt vmcnt(0)" ::: "memory");
    __syncthreads();
    if (threadIdx.x == 0) {
        __builtin_amdgcn_s_waitcnt(0);
        __builtin_amdgcn_fence(__ATOMIC_RELEASE, "agent");
        asm volatile("s_waitcnt vmcnt(0)" ::: "memory");
        (void)xb_add(ctr, 1u);
        XB_SPIN(xb_ld(ctr) < 4u, bar);
        if (ctr2) XB_SPIN(xb_ld(ctr2) < 4u, bar);
        __builtin_amdgcn_fence(__ATOMIC_ACQUIRE, "agent");
        asm volatile("s_waitcnt vmcnt(0)" ::: "memory");
    }
    __syncthreads();
}

constexpr int NQ_ALL = BATCH * 32 * 16, NQ_XCD = NQ_ALL / 8;
__device__ __forceinline__ int aq_take(unsigned* qbase, int x0, volatile LAS unsigned* st) {
    unsigned dx = *st;
    while (dx < 8u) {
        const unsigned q = ((unsigned)x0 + dx) & 7u;
        const unsigned v = __hip_atomic_fetch_add(qbase + 64 * q, 1u, __ATOMIC_RELAXED, __HIP_MEMORY_SCOPE_AGENT);
        if (v < (unsigned)NQ_XCD) { *st = dx; return (int)(q * NQ_XCD + v); }
        ++dx;
    }
    *st = 8u; return NQ_ALL;
}

__global__ void __launch_bounds__(NTHREADS, 2) hymba_fwd(Args args) {
    extern __shared__ __attribute__((aligned(16))) unsigned char lds[];
    LAS unsigned char* ldsl = (LAS unsigned char*)lds;
    const int G = gridDim.x;
    int bx = blockIdx.x;
    int vcu = (G % 8 == 0) ? (bx % 8) * (G / 8) + bx / 8 : bx;
    const int ngw = G * NWAVES;
    volatile LAS unsigned* MISC = (volatile LAS unsigned*)(ldsl + MISC_OFF);
    for (int u = threadIdx.x; u < (LDS_BYTES - RING_BYTES) / 4; u += NTHREADS) ((LAS unsigned*)(ldsl + RING_BYTES))[u] = 0u;
    __syncthreads();
#if MK_PER_PHASE
    const int lo = karg_int(0), hi = karg_int(1);
#else
    constexpr int lo = 0, hi = N_PHASES;
#endif
    const bool multi = (hi - lo) > 1;
    XcdBarrier bar; bar.bar = WSP(unsigned, WS_CTL) + CW_BAR; bar.x = 0; bar.st = nullptr;
    if (multi) bar = xcd_barrier_post(WSP(unsigned, WS_CTL) + CW_BAR, MISC + 8);
    if (multi && threadIdx.x == 0) MISC[18] = __hip_atomic_fetch_add(WSP(unsigned, WS_CTL) + 3072 + 64 * (xb_xcc_id() & 7u), 1u, __ATOMIC_RELAXED, __HIP_MEMORY_SCOPE_AGENT);
#ifndef EN_MASK
#define EN_MASK 0xFFFF
#endif
#define ENK(j) (((EN_MASK) >> (j)) & 1)
#ifndef DBG_TWICE_MASK
#define DBG_TWICE_MASK 0
#endif
#define REPS(j) ((((DBG_TWICE_MASK) >> (j)) & 1) ? 2 : 1)
#define IN(k) (lo <= (k) && (k) < hi)
#if defined(DBG_STAMP_MASK)
#define SEAM(k) do { if (IN((k) + 1)) { if (threadIdx.x == 0) WSP(unsigned long long, 12 * MiB)[((k) * 2 + 0) * 256 + blockIdx.x] = __builtin_amdgcn_s_memrealtime(); xcd_barrier(bar); \
    if (threadIdx.x == 0) WSP(unsigned long long, 12 * MiB)[((k) * 2 + 1) * 256 + blockIdx.x] = __builtin_amdgcn_s_memrealtime(); } } while (0)
#else
#define SEAM(k) do { if (IN((k) + 1)) xcd_barrier(bar); } while (0)
#endif
#define PANEL_PM ((bx & 7) * 8 + ((bx >> 3) & 7))
#define PANEL_R4 ((bx >> 6) & 3)
#define SEAM4(k, slot) do { if (IN((k) + 1)) group4_barrier(WSP(unsigned, WS_CTL) + 16384 + ((slot) * 64 + PANEL_PM) * 64, nullptr, bar.bar); } while (0)
#define SEAM4H(k, slot) do { if (IN((k) + 1)) group4_barrier(WSP(unsigned, WS_CTL) + 16384 + ((slot) * 64 + PANEL_PM) * 64, \
        (PANEL_R4 == 0 && (PANEL_PM & 15) != 0) ? WSP(unsigned, WS_CTL) + 16384 + ((slot) * 64 + PANEL_PM - 1) * 64 : (unsigned*)nullptr, bar.bar); } while (0)

    if (ENK(15) && IN(0)) {
        PHASE_IDS;
#pragma unroll 1
        for (int rep_ = 0; rep_ < REPS(15); ++rep_) {
        bf16r* const W_IN = WSP(bf16r, WS_WIN);
        bf16r* const W_OUT = WSP(bf16r, WS_WOUT);
        bf16r* const W_FF1 = WSP(bf16r, WS_WFF1);
        bf16r* const W_FF2 = WSP(bf16r, WS_WFF2);
        bf16r* const W_GATE = WSP(bf16r, WS_WGATE);
        float* const LB = WSP(float, WS_LB);
        float* const ROPE_COS = WSP(float, WS_ROPE); float* const ROPE_SIN = ROPE_COS + SEQ * 64;
        LAS float* scr = (LAS float*)(ldsl + wave * 16384);
        convert_weights(0, WC_IN, gw, ngw, scr, lane);
        for (int idx = gw * 64 + lane; idx < DEPTH * 2048 * 32; idx += ngw * 64) {
            const int l = idx / (2048 * 32), n = (idx / 32) % 2048, k0 = (idx % 32) * 8;
            const int pn = n >> 8, p = pn >> 1, g = pn & 1, hh = (n >> 7) & 1, j = n & 127;
            v4u o = {0u, 0u, 0u, 0u};
            if ((k0 >> 7) == hh) { const float* w = karg_in(g ? I_WI : I_WR) + (((size_t)l * 8 + 2 * p + hh) * 128 + (k0 & 127)) * 128 + j;
                o.x = pk2(w[0 * 128], w[1 * 128]); o.y = pk2(w[2 * 128], w[3 * 128]); o.z = pk2(w[4 * 128], w[5 * 128]); o.w = pk2(w[6 * 128], w[7 * 128]); }
            *(v4u*)(W_GATE + ((size_t)l * 2048 + n) * 256 + k0) = o;
        }
        for (int c = gw * 64 + lane; c < HG_W; c += ngw * 64) {
            const float b0 = karg_in(I_HLB)[c], b1 = karg_in(I_HLB)[HG_W + c]; const float mx = fmaxf(b0, b1);
            const float e0 = __expf(b0 - mx), e1 = __expf(b1 - mx);
            LB[c] = 0.f; LB[HG_W + c] = e1 / (e0 + e1);
        }
        for (int idx = gw * 64 + lane; idx < SEQ * 64; idx += ngw * 64) {
            const int t = idx >> 6, j = idx & 63;
            const float inv = exp2f(-(float)(2 * j) * (1.0f / 128.0f) * 13.287712379549449f);
            const float angf = (float)t * inv;
            double rev = (double)angf * 0.15915494309189535; rev -= floor(rev);
            const float rf = (float)rev;
            ROPE_COS[idx] = __builtin_amdgcn_cosf(rf); ROPE_SIN[idx] = __builtin_amdgcn_sinf(rf);
        }
        }
        xcopy_rows(karg_in(I_X), WSP(bf16r, WS_H), WSP(float, WS_RS0), gw, ngw, lane);
        SEAM(0);
    }
    if (multi && IN(0) && IN(1) && G % 8 == 0) {
        if (threadIdx.x == 0) {
            const unsigned x = xb_xcc_id() & 7u; unsigned before = 0u;
            for (unsigned j = 0; j < 8u; ++j) { const unsigned cj = __hip_atomic_load(WSP(unsigned, WS_CTL) + 3072 + 64 * j, __ATOMIC_RELAXED, __HIP_MEMORY_SCOPE_AGENT); before += (j < x) ? cj : 0u; }
            MISC[17] = before + MISC[18];
        }
        __syncthreads();
        const int lb = (int)MISC[17];
        if (lb >= 0 && lb < G) { vcu = lb; bx = (lb % (G / 8)) * 8 + lb / (G / 8); }
    }

#pragma unroll 1
    for (int l = 0; l < DEPTH; ++l) {
        const int pb = 1 + l * PH_PER_LAYER;

        if (ENK(1) && IN(pb + 1)) {
            PHASE_IDS;
#pragma unroll 1
            for (int rep_ = 0; rep_ < REPS(1); ++rep_) {
            bf16r* const HB = WSP(bf16r, WS_H);
            bf16r* const W_IN = WSP(bf16r, WS_WIN);
            bf16r* const Z = WSP(bf16r, WS_Z);
            pg8::Gemm g{HB, W_IN + (size_t)l * IN_WIDTH * D_MODEL, M_TOK, IN_WIDTH, D_MODEL}; pg8::StaticOrder S; S.init(M_TOK, IN_WIDTH, G, bx);
            { const float* pssp = (l == 0) ? WSP(float, WS_RS0) : WSP(float, WS_PSS) + (size_t)1 * 64 * M_TOK; const int nparts = (l == 0) ? 1 : 64;
              pg8::Unit u0; if (S.next(0, u0)) RS_TABLE_FILL(pssp, nparts, u0.pm); }
            pg8::EpiBf16X<0> E{Z, IN_WIDTH, nullptr, nullptr, 0, (const LAS float*)(ldsl + RS_TABLE_OFF)};
            pg8::gemm_phase<pg8::EpiBf16X<0>, pg8::StaticOrder, GEMM_ALIGN, GEMM_SP2>(ldsl, g, S, E);
            }
            SEAM4H(pb + 1, 8 * l + 2);
        }

        if (ENK(2) && IN(pb + 2)) {
            PHASE_IDS;
#pragma unroll 1
            for (int rep_ = 0; rep_ < REPS(2); ++rep_) {
            bf16r* const Z = WSP(bf16r, WS_Z);
            bf16r* const XA = WSP(bf16r, WS_XA);
            bf16r* const QH = WSP(bf16r, WS_QH);
            bf16r* const KH = WSP(bf16r, WS_KH);
            float* const LB = WSP(float, WS_LB);
            float* const ROPE_COS = WSP(float, WS_ROPE); float* const ROPE_SIN = ROPE_COS + SEQ * 64;
            const float* convw = karg_in(I_CONVW) + l * 4 * LRU_W; const float* convb = karg_in(I_CONVB) + l * LRU_W;
            const float* qg = karg_in(I_QNG) + l * 128; const float* kg = karg_in(I_KNG) + l * 128;
            for (int m = PANEL_PM * 256 + PANEL_R4 * 64 + wave; m < PANEL_PM * 256 + PANEL_R4 * 64 + 64; m += NWAVES) {
                const int t = m & (SEQ - 1), b = m >> 12;
                const bf16r* zr = Z + (size_t)m * IN_WIDTH;
#pragma unroll
                for (int it = 0; it < 2; ++it) {
                    const int c0 = it * 512 + lane * 8;
                    const f32x4 b0 = *(const f32x4*)(convb + c0), b1 = *(const f32x4*)(convb + c0 + 4);
                    float a0 = b0.x, a1 = b0.y, a2 = b0.z, a3 = b0.w, a4 = b1.x, a5 = b1.y, a6 = b1.z, a7 = b1.w;
#pragma unroll
                    for (int j = 0; j < 4; ++j) {
                        if (t - 3 + j >= 0) {
                            const v4u xv = *(const v4u*)(zr - (ptrdiff_t)(3 - j) * IN_WIDTH + OFF_A_X + c0);
                            const f32x4 w0 = *(const f32x4*)(convw + j * LRU_W + c0), w1 = *(const f32x4*)(convw + j * LRU_W + c0 + 4);
                            a0 += bflo(xv.x) * w0.x; a1 += bfhi(xv.x) * w0.y; a2 += bflo(xv.y) * w0.z; a3 += bfhi(xv.y) * w0.w;
                            a4 += bflo(xv.z) * w1.x; a5 += bfhi(xv.z) * w1.y; a6 += bflo(xv.w) * w1.z; a7 += bfhi(xv.w) * w1.w;
                        }
                    }
                    v4u o; o.x = pk2(a0, a1); o.y = pk2(a2, a3); o.z = pk2(a4, a5); o.w = pk2(a6, a7);
                    *(v4u*)(XA + ((size_t)(c0 >> 8) * M_TOK + m) * 256 + (c0 & 255)) = o;
                }
#pragma unroll
                for (int it = 0; it < 4; ++it) {
                    const int isk = it >> 1, vi = (it & 1) * 8 + (lane >> 3), sub = lane & 7;
                    const bf16r* src = zr + (isk ? OFF_C_K : OFF_C_Q) + vi * 128 + sub * 8;
                    const v4u av = __builtin_nontemporal_load((const v4u*)src), cv = __builtin_nontemporal_load((const v4u*)(src + 64));
                    float x1[8] = {bflo(av.x), bfhi(av.x), bflo(av.y), bfhi(av.y), bflo(av.z), bfhi(av.z), bflo(av.w), bfhi(av.w)};
                    float x2[8] = {bflo(cv.x), bfhi(cv.x), bflo(cv.y), bfhi(cv.y), bflo(cv.z), bfhi(cv.z), bflo(cv.w), bfhi(cv.w)};
                    float ss = 0.f;
#pragma unroll
                    for (int e = 0; e < 8; ++e) ss += x1[e] * x1[e] + x2[e] * x2[e];
                    ss += __shfl_xor(ss, 1); ss += __shfl_xor(ss, 2); ss += __shfl_xor(ss, 4);
                    const float rs = 1.0f / sqrtf(ss * (1.0f / 128.0f) + NORM_EPS);
                    const float* gp = (isk ? kg : qg) + sub * 8;
                    const f32x4 g1a = *(const f32x4*)gp, g1b = *(const f32x4*)(gp + 4), g2a = *(const f32x4*)(gp + 64), g2b = *(const f32x4*)(gp + 68);
                    const f32x4 ca = *(const f32x4*)(ROPE_COS + t * 64 + sub * 8), cb = *(const f32x4*)(ROPE_COS + t * 64 + sub * 8 + 4);
                    const f32x4 sa = *(const f32x4*)(ROPE_SIN + t * 64 + sub * 8), sb = *(const f32x4*)(ROPE_SIN + t * 64 + sub * 8 + 4);
                    const float g1[8] = {g1a.x, g1a.y, g1a.z, g1a.w, g1b.x, g1b.y, g1b.z, g1b.w}, g2[8] = {g2a.x, g2a.y, g2a.z, g2a.w, g2b.x, g2b.y, g2b.z, g2b.w};
                    const float cc[8] = {ca.x, ca.y, ca.z, ca.w, cb.x, cb.y, cb.z, cb.w}, sn[8] = {sa.x, sa.y, sa.z, sa.w, sb.x, sb.y, sb.z, sb.w};
                    float o1[8], o2[8];
#pragma unroll
                    for (int e = 0; e < 8; ++e) { const float y1 = x1[e] * rs * g1[e], y2 = x2[e] * rs * g2[e]; o1[e] = y1 * cc[e] - y2 * sn[e]; o2[e] = y2 * cc[e] + y1 * sn[e]; }
                    bf16r* dst = (isk ? KH : QH) + ((size_t)(b * 16 + vi) * SEQ + t) * 128 + sub * 8;
                    v4u w1, w2; w1.x = pk2(o1[0], o1[1]); w1.y = pk2(o1[2], o1[3]); w1.z = pk2(o1[4], o1[5]); w1.w = pk2(o1[6], o1[7]);
                    w2.x = pk2(o2[0], o2[1]); w2.y = pk2(o2[2], o2[3]); w2.z = pk2(o2[4], o2[5]); w2.w = pk2(o2[6], o2[7]);
                    *(v4u*)dst = w1; *(v4u*)(dst + 64) = w2;
                }
            }
            }
            SEAM4(pb + 2, 8 * l + 3);
        }

        if (ENK(3) && IN(pb + 3)) {
            PHASE_IDS;
#pragma unroll 1
            for (int rep_ = 0; rep_ < REPS(3); ++rep_) {
            bf16r* const XA = WSP(bf16r, WS_XA);
            bf16r* const W_GATE = WSP(bf16r, WS_WGATE);
            bf16r* const RI = WSP(bf16r, WS_RI);
            pg8::Gemm g{XA, W_GATE + (size_t)l * 2048 * 256, M_TOK, 2048, 256, (size_t)M_TOK * 256 * 2, 1}; pg8::StaticOrder S; S.init(M_TOK, 2048, G, bx);
            pg8::EpiBf16X<1> E{RI, 2048, karg_in(I_BR) + l * LRU_W, karg_in(I_BI) + l * LRU_W, 1024, nullptr};
            pg8::gemm_phase<pg8::EpiBf16X<1>, pg8::StaticOrder, GEMM_ALIGN, GEMM_SP2>(ldsl, g, S, E);
            }
            SEAM4(pb + 3, 8 * l + 4);
        }

        if ((ENK(4) || ENK(5)) && (IN(pb + 4) || IN(pb + 5))) {
            PHASE_IDS;
            bf16r* const XA = WSP(bf16r, WS_XA);
            bf16r* const RI = WSP(bf16r, WS_RI);
            float* const LSUM = WSP(float, WS_LSUM);
            bf16r* const Z = WSP(bf16r, WS_Z);
            const float* lam = karg_in(I_LAM) + l * LRU_W;
            const int c = tid * 2;
            const float sp0 = 8.0f * log1pf(__expf(-lam[c])), sp1 = 8.0f * log1pf(__expf(-lam[c + 1]));
            if (ENK(4) && IN(pb + 4)) {
#pragma unroll 1
                for (int rep_ = 0; rep_ < REPS(4); ++rep_)
                for (int u = PANEL_PM * 4 + PANEL_R4; u < BATCH * 64; u += BATCH * 64) {
                    const int b = u >> 6, s = u & 63;
                    float h0 = 0.f, h1 = 0.f, A0 = 0.f, A1 = 0.f;
#pragma unroll 4
                    for (int t = 0; t < 64; ++t) {
                        const size_t m = (size_t)b * SEQ + s * 64 + t;
                        const unsigned rr = *(const unsigned*)(RI + m * 2048 + (c >> 8) * 512 + (c & 255)), ii = *(const unsigned*)(RI + m * 2048 + (c >> 8) * 512 + 256 + (c & 255)), xx = *(const unsigned*)(XA + ((size_t)(c >> 8) * M_TOK + m) * 256 + (c & 255));
                        const bool first = (s == 0 && t == 0);
                        lru_step(bflo(rr), bflo(ii), bflo(xx), sp0, first, h0, A0);
                        lru_step(bfhi(rr), bfhi(ii), bfhi(xx), sp1, first, h1, A1);
                    }
                    *(f32x4*)(LSUM + ((size_t)u * LRU_W + c) * 2) = (f32x4){A0, h0, A1, h1};
                }
                SEAM(pb + 4);
            }
            if (ENK(5) && IN(pb + 5)) {
                constexpr int NHU = BATCH * 8, NCV = 48;
                const bool split = G >= 2 * (NHU + NCV);
                const int rid = bx;
                {
                    const int it0 = l * WC_LAYER + WC_IN, it1 = (l + 1 < DEPTH) ? (l + 1) * WC_LAYER + WC_IN : DEPTH * WC_LAYER;
                    LAS float* scr = (LAS float*)(ldsl + wave * 16384);
                    if (!split) convert_weights(it0, it1, gw, ngw, scr, lane);
                    else if (rid >= NHU && rid < NHU + NCV) convert_weights(it0, it1, (rid - NHU) * NWAVES + wave, NCV * NWAVES, scr, lane);
                }
                if (!split) __syncthreads();
                if (!split || rid >= NHU + NCV) {
                    const float* lg = karg_in(I_LRUG) + l * LRU_W; bf16r* const YCAT = WSP(bf16r, WS_YCAT);
                    for (int u = split ? rid - (NHU + NCV) : rid; u < BATCH * 64; u += split ? G - (NHU + NCV) : G) {
                        const int b = u >> 6, s = u & 63;
                        float h0 = 0.f, h1 = 0.f, A0 = 0.f, A1 = 0.f;
                        for (int sp = 0; sp < s; ++sp) {
                            const f32x4 v = *(const f32x4*)(LSUM + ((size_t)(b * 64 + sp) * LRU_W + c) * 2);
                            h0 = fast_exp(v.x) * h0 + v.y; h1 = fast_exp(v.z) * h1 + v.w;
                        }
#pragma unroll 1
                        for (int hb = 0; hb < 2; ++hb) {
#pragma unroll 4
                            for (int tt = 0; tt < 32; ++tt) {
                                const size_t m = (size_t)b * SEQ + s * 64 + hb * 32 + tt;
                                const unsigned rr = *(const unsigned*)(RI + m * 2048 + (c >> 8) * 512 + (c & 255)), ii = *(const unsigned*)(RI + m * 2048 + (c >> 8) * 512 + 256 + (c & 255)), xx = *(const unsigned*)(XA + ((size_t)(c >> 8) * M_TOK + m) * 256 + (c & 255));
                                const unsigned gg = *(const unsigned*)(Z + m * IN_WIDTH + OFF_A_GATE + c);
                                const bool first = (s == 0 && hb == 0 && tt == 0);
                                lru_step(bflo(rr), bflo(ii), bflo(xx), sp0, first, h0, A0);
                                lru_step(bfhi(rr), bfhi(ii), bfhi(xx), sp1, first, h1, A1);
                                *(LAS f32x2*)(ldsl + ((size_t)tt * LRU_W + c) * 4) = (f32x2){h0 * gelu_tanh(bflo(gg)), h1 * gelu_tanh(bfhi(gg))};
                            }
                            __syncthreads();
#pragma unroll
                            for (int q = 0; q < 4; ++q) {
                                const int tt = wave * 4 + q; const size_t m = (size_t)b * SEQ + s * 64 + hb * 32 + tt;
                                f32x4 v[4]; float ss = 0.f;
#pragma unroll
                                for (int j = 0; j < 4; ++j) { v[j] = *(const LAS f32x4*)(ldsl + ((size_t)tt * LRU_W + 256 * j + 4 * lane) * 4); ss += (v[j].x * v[j].x + v[j].y * v[j].y) + (v[j].z * v[j].z + v[j].w * v[j].w); }
                                ss = wave_sum(ss);
                                const float rs = 1.0f / sqrtf(ss * (1.0f / LRU_W) + NORM_EPS);
#pragma unroll
                                for (int j = 0; j < 4; ++j) { const f32x4 g = *((const f32x4*)lg + lane + 64 * j); v2u w; w.x = pk2(v[j].x * rs * g.x, v[j].y * rs * g.y); w.y = pk2(v[j].z * rs * g.z, v[j].w * rs * g.w);
                                    *((v2u*)(YCAT + m * D_MODEL) + lane + 64 * j) = w; }
                            }
                            __syncthreads();
                        }
                    }
                }
                for (int ubh = rid; ubh < NHU; ubh += G) hgrn_chunked(ldsl, Z, WSP(float, WS_LB) + l * HG_W, karg_in(I_HNG) + l * 128, WSP(bf16r, WS_YCAT), ubh >> 3, ubh & 7, tid);
                __syncthreads();
                {
                    typedef __hip_bfloat16 abf;
                    const abf* Qp = (const abf*)WSP(bf16r, WS_QH); const abf* Kp = (const abf*)WSP(bf16r, WS_KH); const abf* Vp = (const abf*)WSP(bf16r, WS_Z); abf* Op = (abf*)WSP(bf16r, WS_OATT);
                    unsigned* qctr = WSP(unsigned, WS_CTL) + 2048 + 512 * l;
                    constexpr int NQ = NQ_ALL;
                    const int x0 = bx & 7;
                    if (tid == 0) MISC[20] = 0u;
#define AQ_FETCH(dst) do { if (tid == 0) MISC[16] = (unsigned)aq_take(qctr, x0, MISC + 20); __syncthreads(); dst = (int)MISC[16]; __syncthreads(); } while (0)
                    int cur, nxt;
                    if (wave >= 4) __builtin_amdgcn_s_setprio(1);
                    AQ_FETCH(cur);
                    if (cur < NQ) {
                        AQ_FETCH(nxt);
                        ab::BlockRef<abf, abf> cref = attn_ref_q(Qp, Kp, Vp, Op, cur);
                        ab::Seam<abf> Sm;
                        ab::causal_swa_prime<abf, abf>(cref, SEQ, (char*)lds, Sm);
                        for (;;) {
                            const bool more = nxt < NQ;
                            unsigned pend = 0u;
                            if (more && wave == 0) { unsigned p_ = 0u; if (lane == 0) p_ = (unsigned)aq_take(qctr, x0, MISC + 20); pend = (unsigned)__builtin_amdgcn_readfirstlane((int)p_); }
                            const ab::BlockRef<abf, abf> nref = more ? attn_ref_q(Qp, Kp, Vp, Op, nxt) : cref;
                            ab::causal_swa_block<abf, abf>(cref, nref, SEQ, SEQ, (char*)lds, Sm);
                            if (!more) break;
                            if (tid == 0) MISC[16] = pend;
                            __syncthreads();
                            cref = nref; nxt = (int)MISC[16];
                            __syncthreads();
                        }
                    }
                    __builtin_amdgcn_s_setprio(0);
#undef AQ_FETCH
                }
                SEAM(pb + 7);
            }
        }

        if (ENK(8) && IN(pb + 8)) {
            PHASE_IDS;
#pragma unroll 1
            for (int rep_ = 0; rep_ < REPS(8); ++rep_) {
            bf16r* const OATT = WSP(bf16r, WS_OATT);
            bf16r* const Z = WSP(bf16r, WS_Z);
            bf16r* const YCAT = WSP(bf16r, WS_YCAT);
            const float lam_init = 0.8f - 0.6f * __expf(-0.3f * (float)l);
            const float* dl = karg_in(I_DLAM) + l * 4 * 128;
            float d1 = dl[lane] * dl[128 + lane] + dl[64 + lane] * dl[128 + 64 + lane];
            float d2 = dl[256 + lane] * dl[384 + lane] + dl[256 + 64 + lane] * dl[384 + 64 + lane];
            d1 = wave_sum(d1); d2 = wave_sum(d2);
            const float lamv = __expf(d1) - __expf(d2) + lam_init;
            const float* sg = karg_in(I_SUBLN) + l * 256;
            for (int m = PANEL_PM * 256 + PANEL_R4 * 64 + wave; m < PANEL_PM * 256 + PANEL_R4 * 64 + 64; m += NWAVES) {
                const int t = m & (SEQ - 1), b = m >> 12;
                bf16r* yrow = YCAT + (size_t)m * D_MODEL;
#pragma unroll
                for (int it = 0; it < 4; ++it) {
                    const int e = it * 512 + lane * 8, h = e >> 8, vh = (e >> 7) & 1, d = e & 127;
                    const bf16r* o1p = OATT + ((size_t)(b * 32 + h * 4 + 0 + vh) * SEQ + t) * 128 + d;
                    const bf16r* o2p = OATT + ((size_t)(b * 32 + h * 4 + 2 + vh) * SEQ + t) * 128 + d;
                    const v4u a = __builtin_nontemporal_load((const v4u*)o1p), c2 = __builtin_nontemporal_load((const v4u*)o2p);
                    float oc[8] = {bflo(a.x) - lamv * bflo(c2.x), bfhi(a.x) - lamv * bfhi(c2.x), bflo(a.y) - lamv * bflo(c2.y), bfhi(a.y) - lamv * bfhi(c2.y),
                                   bflo(a.z) - lamv * bflo(c2.z), bfhi(a.z) - lamv * bfhi(c2.z), bflo(a.w) - lamv * bflo(c2.w), bfhi(a.w) - lamv * bfhi(c2.w)};
                    float ss = 0.f;
#pragma unroll
                    for (int j = 0; j < 8; ++j) ss += oc[j] * oc[j];
                    ss += __shfl_xor(ss, 1); ss += __shfl_xor(ss, 2); ss += __shfl_xor(ss, 4); ss += __shfl_xor(ss, 8); ss += __shfl_xor(ss, 16);
                    const float rs = (1.0f - lam_init) / sqrtf(ss * (1.0f / 256.0f) + NORM_EPS);
                    const f32x4 g0 = *(const f32x4*)(sg + (e & 255)), g1 = *(const f32x4*)(sg + (e & 255) + 4);
                    v4u w; w.x = pk2(oc[0] * rs * g0.x, oc[1] * rs * g0.y); w.y = pk2(oc[2] * rs * g0.z, oc[3] * rs * g0.w); w.z = pk2(oc[4] * rs * g1.x, oc[5] * rs * g1.y); w.w = pk2(oc[6] * rs * g1.z, oc[7] * rs * g1.w);
                    *(v4u*)(yrow + 2048 + e) = w;
                }
            }
            }
            SEAM4(pb + 8, 8 * l + 5);
        }

        if (ENK(9) && IN(pb + 9)) {
            PHASE_IDS;
#pragma unroll 1
            for (int rep_ = 0; rep_ < REPS(9); ++rep_) {
            bf16r* const YCAT = WSP(bf16r, WS_YCAT);
            bf16r* const W_OUT = WSP(bf16r, WS_WOUT);
            bf16r* const XB = WSP(bf16r, WS_H);
            pg8::Gemm g{YCAT, W_OUT + (size_t)l * D_MODEL * D_MODEL, M_TOK, D_MODEL, D_MODEL}; pg8::StaticOrder S; S.init(M_TOK, D_MODEL, G, bx);
            pg8::EpiResX E{(l == 0) ? karg_in(I_X) : (const float*)nullptr, XB, nullptr, XB, WSP(float, WS_PSS) + (size_t)(2 * l) * 64 * M_TOK, D_MODEL, M_TOK};
            pg8::gemm_phase<pg8::EpiResX, pg8::StaticOrder, GEMM_ALIGN, GEMM_SP2>(ldsl, g, S, E);
            }
            SEAM4(pb + 9, 8 * l + 0);
        }

        if (ENK(11) && IN(pb + 11)) {
            PHASE_IDS;
#pragma unroll 1
            for (int rep_ = 0; rep_ < REPS(11); ++rep_) {
            bf16r* const HB = WSP(bf16r, WS_H);
            bf16r* const W_FF1 = WSP(bf16r, WS_WFF1);
            bf16r* const HID = WSP(bf16r, WS_HID);
            pg8::Gemm g{HB, W_FF1 + (size_t)l * D_FF * D_MODEL, M_TOK, D_FF, D_MODEL}; pg8::StaticOrder S; S.init(M_TOK, D_FF, G, bx);
            { const float* pssp = WSP(float, WS_PSS) + (size_t)(2 * l) * 64 * M_TOK;
              pg8::Unit u0; if (S.next(0, u0)) RS_TABLE_FILL(pssp, 64, u0.pm); }
            pg8::EpiBf16X<2> E{HID, D_FF_LD, nullptr, nullptr, 0, (const LAS float*)(ldsl + RS_TABLE_OFF)};
            pg8::gemm_phase<pg8::EpiBf16X<2>, pg8::StaticOrder, GEMM_ALIGN, GEMM_SP2>(ldsl, g, S, E);
            }
            SEAM4(pb + 11, 8 * l + 1);
        }

        if (ENK(12) && IN(pb + 12)) {
            PHASE_IDS;
#pragma unroll 1
            for (int rep_ = 0; rep_ < REPS(12); ++rep_) {
            bf16r* const HID = WSP(bf16r, WS_HID);
            bf16r* const W_FF2 = WSP(bf16r, WS_WFF2);
            float* const OUT = karg_out();
            pg8::Gemm g{HID, W_FF2 + (size_t)l * D_MODEL * D_FF_LD, M_TOK, D_MODEL, D_FF, 0, 0, D_FF_LD}; pg8::StaticOrder S; S.init(M_TOK, D_MODEL, G, bx);
            bf16r* const XB = WSP(bf16r, WS_H);
            pg8::EpiResX E{nullptr, XB, (l + 1 == DEPTH) ? OUT : (float*)nullptr, XB, WSP(float, WS_PSS) + (size_t)1 * 64 * M_TOK, D_MODEL, M_TOK};
            pg8::gemm_phase<pg8::EpiResX, pg8::StaticOrder, GEMM_ALIGN, GEMM_SP2>(ldsl, g, S, E);
            }
            SEAM(pb + 12);
        }
    }
#if defined(DBG_STAMP_MASK)
    if (multi) {
        xcd_barrier(bar);
        if (blockIdx.x == 0 && threadIdx.x == 0) {
            const unsigned long long* st = WSP(unsigned long long, 12 * MiB);
            double idle = 0.0, lat = 0.0;
            for (int k = 0; k < N_PHASES - 1; ++k) {
                if (!((DBG_STAMP_MASK >> k) & 1)) continue;
                unsigned long long amax = 0, emax = 0; double asum = 0.0; bool any = false;
                for (int b2 = 0; b2 < G; ++b2) { const unsigned long long a = st[(k * 2 + 0) * 256 + b2], e = st[(k * 2 + 1) * 256 + b2]; if (a == 0xAAAAAAAAAAAAAAAAull) continue; any = true; amax = a > amax ? a : amax; emax = e > emax ? e : emax; asum += (double)a; }
                if (!any) continue;
                idle += (double)amax - asum / (double)G; lat += (double)emax - (double)amax;
            }
            karg_out()[0] = (float)(floor(idle * 0.01 / 200.0 + 0.5) * 200.0 * 1.0e4);
            karg_out()[1] = (float)(floor(lat * 0.01 / 100.0 + 0.5) * 100.0 * 1.0e4);
        }
    }
#endif
#undef IN
#undef SEAM
#undef SEAM4
#undef SEAM4H
}


#ifndef MK_PER_PHASE
#define MK_PER_PHASE 0
#endif
extern "C" void kernel_launch(void* const* d_in, const int* in_sizes, int n_in, void* d_out, int out_size, void* d_ws, size_t ws_size, hipStream_t stream) {
    static int grid = 0;
    if (grid == 0) {
        if (n_in != N_INPUTS || out_size != M_TOK * D_MODEL || ws_size < WS_END) { fprintf(stderr, "kernel_launch: unexpected shapes (n_in %d, out %d, ws %zu < %zu); nothing launched\n", n_in, out_size, ws_size, (size_t)WS_END); grid = -1; return; }
        int dev = 0, cus = 0;
        if (hipGetDevice(&dev) != hipSuccess || hipDeviceGetAttribute(&cus, hipDeviceAttributeMultiprocessorCount, dev) != hipSuccess || cus <= 0) { fprintf(stderr, "kernel_launch: device query failed\n"); grid = -1; return; }
        if (hipFuncSetAttribute((const void*)hymba_fwd, hipFuncAttributeMaxDynamicSharedMemorySize, LDS_BYTES) != hipSuccess) { fprintf(stderr, "kernel_launch: hipFuncSetAttribute failed\n"); grid = -1; return; }
        int per_cu = 0;
        if (hipOccupancyMaxActiveBlocksPerMultiprocessor(&per_cu, (const void*)hymba_fwd, NTHREADS, LDS_BYTES) != hipSuccess || per_cu < 1) fprintf(stderr, "kernel_launch: occupancy query reports %d blocks per CU\n", per_cu);
        (void)hipGetLastError();
        grid = cus;
        if (grid != 256) { fprintf(stderr, "kernel_launch: built for a 256-CU device (one row panel per workgroup in the z and ff1 GEMM phases); this device reports %d CUs; nothing launched\n", cus); grid = -1; return; }
    }
    if (grid < 0) return;
    (void)in_sizes;
    if (hipMemsetAsync((char*)d_ws + WS_CTL, 0, CTL_ZERO_BYTES, stream) != hipSuccess) { fprintf(stderr, "kernel_launch: memset failed\n"); return; }
    Args a{};
    for (int i = 0; i < N_INPUTS; ++i) a.in[i] = (const float*)d_in[i];
    a.out = (float*)d_out; a.ws = (unsigned char*)d_ws;
#if MK_PER_PHASE
    for (int p = 0; p < N_PHASES; ++p) { a.ph_lo = p; a.ph_hi = p + 1; hipLaunchKernelGGL(hymba_fwd, dim3(grid), dim3(NTHREADS), LDS_BYTES, stream, a); }
#else
    a.ph_lo = 0; a.ph_hi = N_PHASES;
    hipLaunchKernelGGL(hymba_fwd, dim3(grid), dim3(NTHREADS), LDS_BYTES, stream, a);
#endif
    const hipError_t le = hipPeekAtLastError();
    if (le != hipSuccess) fprintf(stderr, "kernel_launch: launch failed: %s\n", hipGetErrorName(le));
}
```

```cpp
#include <hip/hip_runtime.h>
#include <hip/hip_bf16.h>
#include <cstdio>
#include <cstdint>
__device__ __forceinline__ int tid_opaque() { int t = threadIdx.x; asm volatile("" : "+v"(t)); return t; }
typedef __bf16 hw_bf16x2 __attribute__((ext_vector_type(2)));
typedef float hw_f32x2 __attribute__((ext_vector_type(2)));
__device__ __forceinline__ unsigned pk_bf16_builtin(float lo, float hi) { hw_f32x2 f = {lo, hi}; hw_bf16x2 r = __builtin_convertvector(f, hw_bf16x2); return __builtin_bit_cast(unsigned, r); }
namespace pg8 {
#define PG8_LAS __attribute__((address_space(3)))
typedef unsigned short bf16_t;
typedef short bf16x8 __attribute__((ext_vector_type(8)));
typedef float f32x4 __attribute__((ext_vector_type(4)));
typedef unsigned u32x4 __attribute__((ext_vector_type(4)));
constexpr int BM = 256, BK = 64, HALF = 128, HTB = HALF * BK * 2  , STAGE_BYTES = 8 * HTB, NXCD = 8, WGM = 8;

__host__ __device__ __forceinline__ int lds_byte(int r, int c) { const int st = (r >> 4) * 2 + (c >> 5), rr = r & 15, cc = c & 31, ob = rr * 64 + cc * 2; return st * 1024 + (ob ^ (((ob >> 9) & 1) << 5)); }
__host__ __device__ __forceinline__ void stage_rc(int b, int& R, int& C) { const int st = b / 1024, sb = b % 1024, swz = sb ^ (((sb >> 9) & 1) << 5); R = (st >> 1) * 16 + swz / 64; C = (st & 1) * 32 + (swz % 64) / 2; }
__host__ __device__ __forceinline__ int perm32(int rho) { const int n = rho >> 4, i = rho & 15; return 8 * (i >> 2) + 4 * n + (i & 3); }

struct Unit { int pm, pn; };
struct Gemm { const bf16_t* A; const bf16_t* Bt; int M, N, K; size_t a_pn_stride = 0; int a_pn_shift = 0; int ld = 0;
    __device__ __forceinline__ size_t aoff(int pn) const { return (size_t)(pn >> a_pn_shift) * a_pn_stride; } };

struct StaticOrder {
    int nM, nN, nwg, G, c;
    __host__ __device__ void init(int M, int N, int G_, int c_) { nM = M / BM; nN = N / BM; nwg = nM * nN; G = G_; c = c_; }
    __host__ __device__ bool next(int i, Unit& u) const {
        const long L = (long)i * G + c; if (L >= nwg) return false;
        int wgid = (int)L; { const int q = nwg / NXCD, r = nwg % NXCD, xcd = wgid % NXCD, off = wgid / NXCD; wgid = (xcd < r ? xcd * (q + 1) : r * (q + 1) + (xcd - r) * q) + off; }
        const int nig = WGM * nN, gid = wgid / nig, fm = gid * WGM, gsz = (nM - fm) < WGM ? (nM - fm) : WGM;
        u.pm = fm + ((wgid % nig) % gsz); u.pn = (wgid % nig) / gsz; return true;
    }
    __device__ __forceinline__ void a_ready(const Unit&) const {}
    __device__ __forceinline__ void done(const Unit&) const {}
};

__device__ __forceinline__ unsigned cvt_pk_bf16(float lo, float hi) { return pk_bf16_builtin(lo, hi); }
typedef float f32x2 __attribute__((ext_vector_type(2)));
__device__ __forceinline__ f32x2 gelu_pk(f32x2 v) {
    const f32x2 av = __builtin_elementwise_abs(v), d = av * 0.2316418882f + 1.0f;
    f32x2 t; t.x = __builtin_amdgcn_rcpf(d.x); t.y = __builtin_amdgcn_rcpf(d.y);
    f32x2 q = t * 0.5307027145f + (-0.7265760135f); q = q * t + 0.7107068705f; q = q * t + (-0.142248368f); q = q * t + 0.127414796f; q = q * t;
    const f32x2 s = (v * v) * (-0.72134752044f);
    f32x2 e; e.x = __builtin_amdgcn_exp2f(s.x); e.y = __builtin_amdgcn_exp2f(s.y);
    const f32x2 m = v * (q * e), r = v - m;
    f32x2 o; o.x = v.x < 0.f ? m.x : r.x; o.y = v.y < 0.f ? m.y : r.y; return o;
}

template <int ACT> struct EpiBf16X {
    static constexpr bool PERM = true, AFTER_DRAIN = false;
    bf16_t* O; int ldc; const float* bias0; const float* bias1; int bias_split;
    const PG8_LAS float* rs_lds;
    __device__ __forceinline__ void operator()(const f32x4 (&acc)[2][2][4][2], const Unit& u, int wr, int wc, int fr, int fq) const {
        const int row0 = u.pm * BM + wr * 64 + fr; const int colt = u.pn * BM;
        const int col0 = colt + wc * 32 + 8 * fq;
        f32x4 bv[2][2];
#pragma unroll
        for (int bj = 0; bj < 2; ++bj)
#pragma unroll
            for (int n = 0; n < 2; ++n) {
                if (ACT == 1) { const float* bp = ((u.pn & 1) ? bias1 : bias0) + (u.pn >> 1) * BM + (col0 - colt); bv[bj][n] = *(const f32x4*)(bp + bj * HALF + 4 * n); }
                else bv[bj][n] = (f32x4){0.f, 0.f, 0.f, 0.f};
            }
#pragma unroll
        for (int ai = 0; ai < 2; ++ai)
#pragma unroll
            for (int m = 0; m < 4; ++m) { bf16_t* rowp = O + (size_t)(row0 + ai * HALF + m * 16) * ldc + col0;
                float rsc = 1.0f;
                if (rs_lds) rsc = rs_lds[wr * 64 + fr + ai * HALF + m * 16];
#pragma unroll
                for (int bj = 0; bj < 2; ++bj) { f32x4 v0 = (acc[ai][bj][m][0] + bv[bj][0]) * rsc, v1 = (acc[ai][bj][m][1] + bv[bj][1]) * rsc;
                    if (ACT == 1) {
#pragma unroll
                        for (int j = 0; j < 4; ++j) { v0[j] = __builtin_amdgcn_rcpf(1.0f + __builtin_amdgcn_exp2f(-1.4426950408889634f * v0[j])); v1[j] = __builtin_amdgcn_rcpf(1.0f + __builtin_amdgcn_exp2f(-1.4426950408889634f * v1[j])); } }
                    if (ACT == 2) {
#pragma unroll
                        for (int j = 0; j < 4; ++j) { const float a = fmaxf(v0[j], 0.f), b = fmaxf(v1[j], 0.f); v0[j] = a * a; v1[j] = b * b; } }
                    u32x4 w; w.x = cvt_pk_bf16(v0[0], v0[1]); w.y = cvt_pk_bf16(v0[2], v0[3]); w.z = cvt_pk_bf16(v1[0], v1[1]); w.w = cvt_pk_bf16(v1[2], v1[3]);
                    *(u32x4*)(rowp + bj * HALF) = w; } }
    }
};
struct EpiResX {
    static constexpr bool PERM = true, AFTER_DRAIN = false;
    const float* basef; const bf16_t* baseh; float* outf; bf16_t* outh; float* pss; int ldc, nrows;
    __device__ __forceinline__ void operator()(const f32x4 (&acc)[2][2][4][2], const Unit& u, int wr, int wc, int fr, int fq) const {
        const int row0 = u.pm * BM + wr * 64 + fr, col0 = u.pn * BM + wc * 32 + 8 * fq;
        float ssq[2][4];
#pragma unroll
        for (int ai = 0; ai < 2; ++ai)
#pragma unroll
            for (int m = 0; m < 4; ++m) { const size_t off = (size_t)(row0 + ai * HALF + m * 16) * ldc + col0;
                float sq = 0.f;
#pragma unroll
                for (int bj = 0; bj < 2; ++bj) {
                    f32x4 b0, b1;
                    if (basef) { b0 = *(const f32x4*)(basef + off + bj * HALF); b1 = *(const f32x4*)(basef + off + bj * HALF + 4); }
                    else { const u32x4 w = *(const u32x4*)(baseh + off + bj * HALF);
                        b0 = (f32x4){__uint_as_float(w.x << 16), __uint_as_float(w.x & 0xffff0000u), __uint_as_float(w.y << 16), __uint_as_float(w.y & 0xffff0000u)};
                        b1 = (f32x4){__uint_as_float(w.z << 16), __uint_as_float(w.z & 0xffff0000u), __uint_as_float(w.w << 16), __uint_as_float(w.w & 0xffff0000u)}; }
                    const f32x4 v0 = acc[ai][bj][m][0] + b0, v1 = acc[ai][bj][m][1] + b1;
                    if (outf) { *(f32x4*)(outf + off + bj * HALF) = v0; *(f32x4*)(outf + off + bj * HALF + 4) = v1; }
                    else { u32x4 w; w.x = cvt_pk_bf16(v0[0], v0[1]); w.y = cvt_pk_bf16(v0[2], v0[3]); w.z = cvt_pk_bf16(v1[0], v1[1]); w.w = cvt_pk_bf16(v1[2], v1[3]);
                        *(u32x4*)(outh + off + bj * HALF) = w;
                        sq += ((v0[0] * v0[0] + v0[1] * v0[1]) + (v0[2] * v0[2] + v0[3] * v0[3])) + ((v1[0] * v1[0] + v1[1] * v1[1]) + (v1[2] * v1[2] + v1[3] * v1[3])); } }
                ssq[ai][m] = sq;
                asm volatile("" ::: "memory"); }
        if (!outf) {
#pragma unroll
            for (int ai = 0; ai < 2; ++ai)
#pragma unroll
                for (int m = 0; m < 4; ++m) ssq[ai][m] += __shfl_xor(ssq[ai][m], 16);
#pragma unroll
            for (int ai = 0; ai < 2; ++ai)
#pragma unroll
                for (int m = 0; m < 4; ++m) ssq[ai][m] += __shfl_xor(ssq[ai][m], 32);
            if (fq == 0) {
#pragma unroll
                for (int ai = 0; ai < 2; ++ai)
#pragma unroll
                    for (int m = 0; m < 4; ++m) pss[(size_t)(u.pn * 4 + wc) * nrows + (row0 + ai * HALF + m * 16)] = ssq[ai][m];
            }
        }
    }
};
template <class Epi, class Sched, bool ALIGN_EPI = false, bool SP2 = false>
__device__ __forceinline__ void gemm_phase(PG8_LAS unsigned char* lds, const Gemm g, const Sched& S, const Epi& E) {
    const int tid = tid_opaque(), wid = __builtin_amdgcn_readfirstlane(tid >> 6), lane = tid & 63, wr = wid >> 2, wc = wid & 3, fr = lane & 15, fq = lane >> 4;
    const int K = g.K, nt = K / BK, LD = g.ld ? g.ld : K;
    unsigned voffA[2], voffB[2];
#pragma unroll
    for (int i = 0; i < 2; ++i) { int R, C; stage_rc(tid * 16 + i * 8192, R, C); const int Rb = Epi::PERM ? ((R & ~31) + perm32(R & 31)) : R;
        voffA[i] = (unsigned)(R * LD + C) * 2u; voffB[i] = (unsigned)(Rb * LD + C) * 2u; }
    const size_t kstep = (size_t)(BK * 2);
    const size_t hstep = (size_t)HALF * LD * 2;
    const size_t tstep = 2 * hstep;
    const unsigned ldsw = (unsigned)wid * 1024u;
    const int aoff = lds_byte(wr * 64 + fr, fq * 8), boff = lds_byte(wc * 32 + fr, fq * 8);
#define PG8_SA(b, h) (((b) * 2 + (h)) * HTB)
#define PG8_SB(b, h) ((4 + (b) * 2 + (h)) * HTB)
#define PG8_STAGE(bufoff, gbase, voff) do { _Pragma("unroll") for (int _i = 0; _i < 2; ++_i) \
        __builtin_amdgcn_global_load_lds((const unsigned*)((const char*)(gbase) + (voff)[_i]), (PG8_LAS unsigned*)(lds + (bufoff) + ldsw + _i * 8192), 16, 0, 0); } while (0)
#define PG8_LDA(dst, b, h) do { _Pragma("unroll") for (int m = 0; m < 4; ++m) _Pragma("unroll") for (int k = 0; k < 2; ++k) dst[m][k] = *(const PG8_LAS bf16x8*)(lds + PG8_SA(b, h) + aoff + m * 2048 + k * 1024); } while (0)
#define PG8_LDB(dst, b, h) do { _Pragma("unroll") for (int n = 0; n < 2; ++n) _Pragma("unroll") for (int k = 0; k < 2; ++k) dst[n][k] = *(const PG8_LAS bf16x8*)(lds + PG8_SB(b, h) + boff + n * 2048 + k * 1024); } while (0)
#define PG8_MMA(ai, bj, At, Bt) do { __builtin_amdgcn_s_setprio(1); _Pragma("unroll") for (int m = 0; m < 4; ++m) _Pragma("unroll") for (int n = 0; n < 2; ++n) _Pragma("unroll") for (int k = 0; k < 2; ++k) \
        acc[ai][bj][m][n] = __builtin_amdgcn_mfma_f32_16x16x32_bf16(Bt[n][k], At[m][k], acc[ai][bj][m][n], 0, 0, 0); __builtin_amdgcn_s_setprio(0); } while (0)
#define PG8_WAIT_V(n) asm volatile("s_waitcnt vmcnt(" #n ")" ::: "memory")
#define PG8_WAIT_L(n) asm volatile("s_waitcnt lgkmcnt(" #n ")" ::: "memory")
#define PG8_BAR __builtin_amdgcn_s_barrier()
#define PG8_SCHED __builtin_amdgcn_sched_barrier(0)
    Unit cur, nxt; int ui = 0;
    if (!S.next(0, cur)) return;
    f32x4 acc[2][2][4][2];
#pragma unroll
    for (int a = 0; a < 2; ++a)
#pragma unroll
        for (int b = 0; b < 2; ++b)
#pragma unroll
            for (int m = 0; m < 4; ++m)
#pragma unroll
                for (int n = 0; n < 2; ++n) acc[a][b][m][n] = (f32x4){0.f, 0.f, 0.f, 0.f};
    bf16x8 At[4][2], B0[2][2], B1[2][2];
    const char* cA = (const char*)g.A + (size_t)cur.pm * tstep + g.aoff(cur.pn); const char* cB = (const char*)g.Bt + (size_t)cur.pn * tstep;
    S.a_ready(cur);
    if constexpr (SP2) {
        PG8_STAGE(PG8_SB(0, 0), cB, voffB); PG8_STAGE(PG8_SB(0, 1), cB + hstep, voffB); PG8_STAGE(PG8_SA(0, 0), cA, voffA); PG8_STAGE(PG8_SA(0, 1), cA + hstep, voffA);
        if (wr == 1) PG8_BAR;
        PG8_WAIT_V(2); PG8_BAR;
        PG8_STAGE(PG8_SB(1, 0), cB + kstep, voffB); PG8_STAGE(PG8_SA(1, 0), cA + kstep, voffA); PG8_STAGE(PG8_SB(1, 1), cB + hstep + kstep, voffB);
        PG8_WAIT_V(6); PG8_BAR;
    } else {
        PG8_STAGE(PG8_SB(0, 0), cB, voffB); PG8_STAGE(PG8_SA(0, 0), cA, voffA); PG8_STAGE(PG8_SB(0, 1), cB + hstep, voffB); PG8_STAGE(PG8_SA(0, 1), cA + hstep, voffA);
        if (wr == 1) PG8_BAR;
        PG8_WAIT_V(4); PG8_BAR;
        PG8_STAGE(PG8_SB(1, 0), cB + kstep, voffB); PG8_STAGE(PG8_SA(1, 0), cA + kstep, voffA); PG8_STAGE(PG8_SB(1, 1), cB + hstep + kstep, voffB);
        PG8_WAIT_V(6); PG8_BAR;
    }
    for (;;) {
        const bool has_next = S.next(ui + 1, nxt);
        const char* nA = has_next ? (const char*)g.A + (size_t)nxt.pm * tstep + g.aoff(nxt.pn) : cA; const char* nB = has_next ? (const char*)g.Bt + (size_t)nxt.pn * tstep : cB;
        _Pragma("unroll 1")
        for (int t = 0; t < nt; t += 2) {
            const bool last = (t == nt - 2);
            const char* a1 = cA + (size_t)(t + 1) * kstep;
            const char* a2 = last ? nA : cA + (size_t)(t + 2) * kstep; const char* b2 = last ? nB : cB + (size_t)(t + 2) * kstep;
            const char* a3 = a2 + kstep; const char* b3 = b2 + kstep;
            if (last && has_next) S.a_ready(nxt);
            if constexpr (SP2) {
            PG8_LDB(B0, 0, 0); PG8_LDB(B1, 0, 1); PG8_SCHED; PG8_LDA(At, 0, 0); PG8_STAGE(PG8_SA(1, 1), a1 + hstep, voffA);
            PG8_WAIT_V(8); PG8_WAIT_L(0); PG8_BAR; PG8_MMA(0, 0, At, B0); PG8_MMA(0, 1, At, B1); PG8_BAR; PG8_SCHED;
            PG8_LDA(At, 0, 1); PG8_STAGE(PG8_SB(0, 0), b2, voffB); PG8_STAGE(PG8_SB(0, 1), b2 + hstep, voffB); PG8_STAGE(PG8_SA(0, 0), a2, voffA);
            PG8_WAIT_V(8); PG8_WAIT_L(0); PG8_BAR; PG8_MMA(1, 0, At, B0); PG8_MMA(1, 1, At, B1); PG8_BAR; PG8_SCHED;
            PG8_LDB(B0, 1, 0); PG8_LDB(B1, 1, 1); PG8_SCHED; PG8_LDA(At, 1, 0); PG8_STAGE(PG8_SA(0, 1), a2 + hstep, voffA);
            PG8_WAIT_V(8); PG8_WAIT_L(0); PG8_BAR; PG8_MMA(0, 0, At, B0); PG8_MMA(0, 1, At, B1); PG8_BAR; PG8_SCHED;
            PG8_LDA(At, 1, 1); PG8_STAGE(PG8_SB(1, 0), b3, voffB); PG8_STAGE(PG8_SB(1, 1), b3 + hstep, voffB); PG8_STAGE(PG8_SA(1, 0), a3, voffA);
            PG8_WAIT_V(8); PG8_WAIT_L(0); PG8_BAR; PG8_MMA(1, 0, At, B0); PG8_MMA(1, 1, At, B1); PG8_BAR; PG8_SCHED;
            } else {
            PG8_LDB(B0, 0, 0); PG8_SCHED; PG8_LDA(At, 0, 0); PG8_STAGE(PG8_SA(1, 1), a1 + hstep, voffA);
            PG8_WAIT_L(8); PG8_BAR; PG8_WAIT_L(0); PG8_MMA(0, 0, At, B0); PG8_BAR; PG8_SCHED;
            PG8_LDB(B1, 0, 1); PG8_STAGE(PG8_SB(0, 0), b2, voffB);
            PG8_BAR; PG8_WAIT_L(0); PG8_MMA(0, 1, At, B1); PG8_BAR;
            PG8_LDA(At, 0, 1); PG8_STAGE(PG8_SA(0, 0), a2, voffA);
            PG8_BAR; PG8_WAIT_L(0); PG8_MMA(1, 0, At, B0); PG8_BAR; PG8_SCHED;
            PG8_STAGE(PG8_SB(0, 1), b2 + hstep, voffB);
            PG8_WAIT_V(6); PG8_BAR; PG8_MMA(1, 1, At, B1); PG8_BAR;
            PG8_LDB(B0, 1, 0); PG8_SCHED; PG8_LDA(At, 1, 0); PG8_STAGE(PG8_SA(0, 1), a2 + hstep, voffA);
            PG8_WAIT_L(8); PG8_BAR; PG8_WAIT_L(0); PG8_MMA(0, 0, At, B0); PG8_BAR; PG8_SCHED;
            PG8_LDB(B1, 1, 1); PG8_STAGE(PG8_SB(1, 0), b3, voffB);
            PG8_BAR; PG8_WAIT_L(0); PG8_MMA(0, 1, At, B1); PG8_BAR;
            PG8_LDA(At, 1, 1); PG8_STAGE(PG8_SA(1, 0), a3, voffA);
            PG8_BAR; PG8_WAIT_L(0); PG8_MMA(1, 0, At, B0); PG8_BAR; PG8_SCHED;
            PG8_STAGE(PG8_SB(1, 1), b3 + hstep, voffB);
            PG8_WAIT_V(6); PG8_BAR; PG8_MMA(1, 1, At, B1); PG8_BAR;
            }
        }
        if constexpr (ALIGN_EPI) { if (wr == 0) PG8_BAR; }
        if constexpr (!Epi::AFTER_DRAIN) { E(acc, cur, wr, wc, fr, fq); S.done(cur); }
        if (!has_next) break;
#pragma unroll
        for (int a = 0; a < 2; ++a)
#pragma unroll
            for (int b = 0; b < 2; ++b)
#pragma unroll
                for (int m = 0; m < 4; ++m)
#pragma unroll
                    for (int n = 0; n < 2; ++n) acc[a][b][m][n] = (f32x4){0.f, 0.f, 0.f, 0.f};
        cur = nxt; cA = nA; cB = nB; ++ui;
        if constexpr (ALIGN_EPI) { if (wr == 1) PG8_BAR; }
    }
    PG8_WAIT_V(0);
    if constexpr (!ALIGN_EPI) { if (wr == 0) PG8_BAR; }
    PG8_BAR;
    if constexpr (Epi::AFTER_DRAIN) { E.fused(acc, cur, wr, wc, fr, fq, lds, wid, lane); S.done(cur); }
#undef PG8_SA
#undef PG8_SB
#undef PG8_STAGE
#undef PG8_LDA
#undef PG8_LDB
#undef PG8_MMA
#undef PG8_WAIT_V
#undef PG8_WAIT_L
#undef PG8_BAR
#undef PG8_SCHED
}
}

namespace ab {
enum { ORDER_NATURAL = 0, ORDER_REVERSED = 1, ORDER_PAIRED = 2, ORDER_XCD = 4 };
using TIN = __hip_bfloat16; using TOUT = __hip_bfloat16;
constexpr int B = 4, H = 32, HKV = 32, SQ = 4096, SKV = 4096, D = 128;
constexpr int QOFF = 0; constexpr int WINDOW = SKV; constexpr float THR = 8.f; constexpr int ORDER = ORDER_PAIRED; constexpr int GRID_WGS = 0; constexpr bool WSKIP = false;
constexpr float SCALE = 0.08838834764831845f;
constexpr int NW = 8, QBLK = 32, KVBLK = 64, QB = NW * QBLK;
constexpr int SHM_V = KVBLK * D * 2, SHM_K = KVBLK * D * 2;
constexpr int LDS_BYTES = 2 * SHM_V + 2 * SHM_K + NW * 64 * 4;
constexpr int V_ROW = 12288;
constexpr int O_STAGE = LDS_BYTES, O_STAGE_ROW = 272, O_STAGE_WAVE = 32 * O_STAGE_ROW;
using bf16 = __hip_bfloat16;
typedef short bf16x8 __attribute__((ext_vector_type(8)));
typedef short s16x4 __attribute__((ext_vector_type(4)));
typedef float f32x16 __attribute__((ext_vector_type(16)));
typedef float f32x4 __attribute__((ext_vector_type(4)));
typedef unsigned u32x4 __attribute__((ext_vector_type(4)));
template <class A, class Bt> struct same_t { static constexpr bool v = false; };
template <class A> struct same_t<A, A> { static constexpr bool v = true; };

#define KSWZ(row, colB) ((row) * 256 + ((colB) ^ (((row) & 7) << 4)))
#define SBAR() __builtin_amdgcn_sched_barrier(0)
__device__ __forceinline__ int v_st(int k, int c) { const int kk = (k & ~0xC) | ((k & 4) << 1) | ((k & 8) >> 1); return ((kk >> 3) * 4 + (c >> 5)) * 512 + ((kk & 7) * 32 + (c & 31)) * 2; }
__device__ __forceinline__ int v_rd_base(int lane) { return ((lane & 3) << 3) | (((lane >> 2) & 3) << 6) | (((lane >> 4) & 1) << 5) | (((lane >> 5) & 1) << 8); }
constexpr int v_rd_off(int d0, int ks, int half) { return d0 * 512 + ks * 4096 + half * 2048; }
__device__ __forceinline__ int crow(int r, int hi) { return (r & 3) + 8 * (r >> 2) + 4 * hi; }
__device__ __forceinline__ unsigned cvtpk(float lo, float hi) {
    return pk_bf16_builtin(lo, hi);
}
__device__ __forceinline__ bf16x8 pack8(f32x4 a, f32x4 b) {
    u32x4 w = {cvtpk(a[0], a[1]), cvtpk(a[2], a[3]), cvtpk(b[0], b[1]), cvtpk(b[2], b[3])};
    return *reinterpret_cast<bf16x8*>(&w);
}
template <class T> __device__ __forceinline__ bf16x8 load8(const T* p) {
    if constexpr (same_t<T, float>::v) { return pack8(*(const f32x4*)p, *(const f32x4*)(p + 4)); }
    else { return *reinterpret_cast<const bf16x8*>(p); }
}
__device__ __forceinline__ void mask_tile(f32x16& p0, f32x16& p1, int dq, unsigned W) {
    const float NEG = -__builtin_inff();
#pragma unroll
    for (int r = 0; r < 16; ++r) {
        const int c = (r & 3) + 8 * (r >> 2);
        if ((unsigned)(dq - c) >= W) p0[r] = NEG;
        if ((unsigned)(dq - c - 32) >= W) p1[r] = NEG;
    }
}
__device__ __forceinline__ void partialSM(f32x16& p0, f32x16& p1, float& m_reg, float& mn, float& alpha) {
    float pmax = p0[0]; for (int r = 1; r < 16; ++r) pmax = fmaxf(pmax, p0[r]); for (int r = 0; r < 16; ++r) pmax = fmaxf(pmax, p1[r]);
    { auto rr = __builtin_amdgcn_permlane32_swap(__float_as_uint(pmax), __float_as_uint(pmax), false, false);
      pmax = fmaxf(__uint_as_float(rr[0]), __uint_as_float(rr[1])); }
    constexpr float C2 = 1.4426950408889634f * SCALE;
    if (__builtin_expect(__all((pmax - m_reg) * SCALE <= THR), 1)) { mn = m_reg; alpha = 1.f; }
    else { mn = fmaxf(m_reg, pmax); alpha = __builtin_amdgcn_exp2f((m_reg - mn) * C2); m_reg = mn; }
    const float mnL = -mn * C2;
    for (int r = 0; r < 16; ++r) p0[r] = fmaf(p0[r], C2, mnL); for (int r = 0; r < 16; ++r) p1[r] = fmaf(p1[r], C2, mnL);
    for (int r = 0; r < 16; ++r) p0[r] = __builtin_amdgcn_exp2f(p0[r]);
}
__device__ __forceinline__ void finishSM(f32x16& p0, f32x16& p1, float alpha, float& l_reg, bf16x8& pa0, bf16x8& pa1, bf16x8& pa2, bf16x8& pa3) {
    for (int r = 0; r < 16; ++r) p1[r] = __builtin_amdgcn_exp2f(p1[r]);
    float ps = 0; for (int r = 0; r < 16; ++r) ps += p0[r]; for (int r = 0; r < 16; ++r) ps += p1[r];
    { auto rr = __builtin_amdgcn_permlane32_swap(__float_as_uint(ps), __float_as_uint(ps), false, false);
      ps = __uint_as_float(rr[0]) + __uint_as_float(rr[1]); }
    l_reg = l_reg * alpha + ps;
#define PK4(P, B_, OUT) do { unsigned a0 = cvtpk(P[B_+0], P[B_+1]), a1 = cvtpk(P[B_+2], P[B_+3]);                          \
        unsigned b0 = cvtpk(P[B_+4], P[B_+5]), b1 = cvtpk(P[B_+6], P[B_+7]);                                             \
        auto r0 = __builtin_amdgcn_permlane32_swap(a0, b0, false, false); auto r1 = __builtin_amdgcn_permlane32_swap(a1, b1, false, false); \
        u32x4 w = {r0[0], r1[0], r0[1], r1[1]}; OUT = *reinterpret_cast<bf16x8*>(&w); } while (0)
    PK4(p0, 0, pa0); PK4(p0, 8, pa1); PK4(p1, 0, pa2); PK4(p1, 8, pa3);
#undef PK4
}
template <int KB, bool SK>
__device__ __forceinline__ void qkt(f32x16& p0, f32x16& p1, const char* K_lds, int r32, int hi, const bf16x8* qr, bool act) {
    if (SK && !act) { const float NEG = -__builtin_inff();
#pragma unroll
        for (int r = 0; r < 16; ++r) { p0[r] = NEG; p1[r] = NEG; } return; }
    p0 = f32x16{}; p1 = f32x16{};
    const char* kb[4];
#pragma unroll
    for (int dd = 0; dd < 4; ++dd) kb[dd] = K_lds + KB * SHM_K + KSWZ(r32, (dd * 16 + hi * 8) * 2);
#pragma unroll
    for (int d0 = 0; d0 < 8; ++d0) { const char* a = kb[d0 & 3] + (d0 >> 2) * 128;
        bf16x8 b0 = *reinterpret_cast<const bf16x8*>(a);
        bf16x8 b1 = *reinterpret_cast<const bf16x8*>(a + 32 * 256);
        p0 = __builtin_amdgcn_mfma_f32_32x32x16_bf16(b0, qr[d0], p0, 0, 0, 0);
        p1 = __builtin_amdgcn_mfma_f32_32x32x16_bf16(b1, qr[d0], p1, 0, 0, 0); }
}
template <int VB, bool SK>
__device__ __forceinline__ void pv_tile(f32x16* o, int vb0, bf16x8 pa0, bf16x8 pa1, bf16x8 pa2, bf16x8 pa3, bool act) {
    if (SK && !act) return;
#define TRRD(dst, off) asm volatile("ds_read_b64_tr_b16 %0, %1 offset:%2" : "=&v"(dst) : "v"(vb0), "i"(off) : "memory")
#define PV_D0(d0) do { s16x4 l0, l1, l2, l3, h0, h1, h2, h3; constexpr int b_ = VB * SHM_V + v_rd_off(d0, 0, 0);     \
        TRRD(l0, b_); TRRD(h0, b_ + 2048); TRRD(l1, b_ + 4096); TRRD(h1, b_ + 6144); TRRD(l2, b_ + 8192); TRRD(h2, b_ + 10240); TRRD(l3, b_ + 12288); TRRD(h3, b_ + 14336); \
        asm volatile("s_waitcnt lgkmcnt(0)" ::: "memory"); SBAR();                 \
        o[d0] = __builtin_amdgcn_mfma_f32_32x32x16_bf16(pa0, (bf16x8){l0[0], l0[1], l0[2], l0[3], h0[0], h0[1], h0[2], h0[3]}, o[d0], 0, 0, 0);   \
        o[d0] = __builtin_amdgcn_mfma_f32_32x32x16_bf16(pa1, (bf16x8){l1[0], l1[1], l1[2], l1[3], h1[0], h1[1], h1[2], h1[3]}, o[d0], 0, 0, 0);   \
        o[d0] = __builtin_amdgcn_mfma_f32_32x32x16_bf16(pa2, (bf16x8){l2[0], l2[1], l2[2], l2[3], h2[0], h2[1], h2[2], h2[3]}, o[d0], 0, 0, 0);   \
        o[d0] = __builtin_amdgcn_mfma_f32_32x32x16_bf16(pa3, (bf16x8){l3[0], l3[1], l3[2], l3[3], h3[0], h3[1], h3[2], h3[3]}, o[d0], 0, 0, 0); } while (0)
    PV_D0(0); PV_D0(1); PV_D0(2); PV_D0(3);
#undef PV_D0
#undef TRRD
}

template <class TIn, class TOut> struct BlockRef { const TIn* Q; const TIn* K; const TIn* V; TOut* O; int P0; };
template <class TIn> struct Seam {
    bf16x8 qr[8];
    bf16x8 st_v0, st_v1, st_k0, st_k1; f32x4 sf0, sf1, sf2, sf3;
    f32x4 tq[16];
};
__device__ __forceinline__ int swa_jlo(int P0, int W) { const int lowk = P0 - W + 1; return lowk > 0 ? lowk / KVBLK : 0; }
#define ROW(p, k0, rr) ((p) + (size_t)((k0) + (rr)) * D + sc)
#define ROWV(p, k0, rr) ((p) + (size_t)((k0) + (rr)) * V_ROW + sc)
#define VMW() asm volatile("s_waitcnt vmcnt(0)" ::: "memory")
#define VMWN(n) asm volatile("s_waitcnt vmcnt(%0)" :: "i"(n) : "memory")
#define SLOAD_H(Kp, Vp, k0) do { S.st_v0 = load8<TIn>(ROWV(Vp, k0, sr)); S.st_v1 = load8<TIn>(ROWV(Vp, k0, 32 + sr));              \
                         S.st_k0 = load8<TIn>(ROW(Kp, k0, sr)); S.st_k1 = load8<TIn>(ROW(Kp, k0, 32 + sr)); } while (0)
#define SWRITE_HK(bf) do { *(bf16x8*)(K_lds + (bf) * SHM_K + kws) = S.st_k0; *(bf16x8*)(K_lds + (bf) * SHM_K + kws + 32 * 256) = S.st_k1; } while (0)
#define SWRITE_HV(bf) do { *(bf16x8*)(V_lds + (bf) * SHM_V + vst0) = S.st_v0; *(bf16x8*)(V_lds + (bf) * SHM_V + vst1) = S.st_v1; } while (0)
#define SWRITE_H(bf) do { SWRITE_HV(bf); SWRITE_HK(bf); } while (0)
#define SLOAD_F(p, k0) do { S.sf0 = *(const f32x4*)ROW(p, k0, sr); S.sf1 = *(const f32x4*)(ROW(p, k0, sr) + 4);                \
                            S.sf2 = *(const f32x4*)ROW(p, k0, 32 + sr); S.sf3 = *(const f32x4*)(ROW(p, k0, 32 + sr) + 4); } while (0)
#define SWRITE_KF(bf) do { *(bf16x8*)(K_lds + (bf) * SHM_K + kws) = pack8(S.sf0, S.sf1); *(bf16x8*)(K_lds + (bf) * SHM_K + kws + 32 * 256) = pack8(S.sf2, S.sf3); } while (0)
#define SWRITE_VF(bf) do { *(bf16x8*)(V_lds + (bf) * SHM_V + vst0) = pack8(S.sf0, S.sf1); *(bf16x8*)(V_lds + (bf) * SHM_V + vst1) = pack8(S.sf2, S.sf3); } while (0)
template <class TIn, class TOut>
__device__ __forceinline__ void causal_swa_prime(const BlockRef<TIn, TOut>& cur, int W, char* lds, Seam<TIn>& S) {
    constexpr bool F32 = same_t<TIn, float>::v;
    const int tid = tid_opaque(), wid = __builtin_amdgcn_readfirstlane(tid >> 6), lane = tid & 63, r32 = lane & 31, hi = lane >> 5;
    const int sr = tid >> 4, sc = (tid & 15) * 8, kws = KSWZ(sr, sc * 2); char* K_lds = lds + 2 * SHM_V;
    const int kb0 = swa_jlo(cur.P0, W) * KVBLK;
    for (int d0 = 0; d0 < 8; ++d0) S.qr[d0] = load8<TIn>(cur.Q + (size_t)(wid * QBLK + r32) * D + d0 * 16 + hi * 8);
    if constexpr (F32) { SLOAD_F((const float*)cur.K, kb0); VMW(); SWRITE_KF(0); SBAR(); SLOAD_F((const float*)cur.V, kb0); }
    else { SLOAD_H(cur.K, cur.V, kb0); VMW(); SWRITE_HK(0); }
    __syncthreads();
}
template <class TIn, class TOut>
__device__ __forceinline__ void causal_swa_block(const BlockRef<TIn, TOut>& cur, const BlockRef<TIn, TOut>& nxt, int skv, int W, char* lds, Seam<TIn>& S) {
    constexpr bool F32 = same_t<TIn, float>::v;
    const int tid = tid_opaque(), wid = __builtin_amdgcn_readfirstlane(tid >> 6), lane = tid & 63, r32 = lane & 31, hi = lane >> 5;
    const int j_lo = swa_jlo(cur.P0, W);
    int j_hi = (cur.P0 + QB - 1) / KVBLK + 1; if (j_hi > skv / KVBLK) j_hi = skv / KVBLK;
    const int NT = j_hi - j_lo;
    const int kbn = swa_jlo(nxt.P0, W) * KVBLK;
    const int qlo = cur.P0 + wid * QBLK, qm = qlo + r32 - 4 * hi;
    char* V_lds = lds; char* K_lds = lds + 2 * SHM_V;
    float* ws = (float*)(lds + 2 * SHM_V + 2 * SHM_K) + wid * 64; float* li_l = ws, * al_l = ws + 32;
    float m_reg = -1e30f, l_reg = 0; f32x16 o[4] = {};
    const int sr = tid >> 4, sc = (tid & 15) * 8, vst0 = v_st(sr, sc), vst1 = v_st(32 + sr, sc), kws = KSWZ(sr, sc * 2);
    const int vb0 = (int)(uintptr_t)V_lds + v_rd_base(lane);
    const TIn* Kh = cur.K; const TIn* Vh = cur.V;
#define RESC(a) do { if (__any((a) < 1.f)) { if (hi == 0) al_l[r32] = (a); asm volatile("s_waitcnt lgkmcnt(0)" ::: "memory");              \
                     for (int d_ = 0; d_ < 4; ++d_) for (int r = 0; r < 16; ++r) o[d_][r] *= al_l[crow(r, hi)]; } } while (0)
#define KBASE(t) ((j_lo + (t)) * KVBLK)
#define ACT(t) (KBASE(t) <= qlo + QBLK - 1 && KBASE(t) + KVBLK - 1 >= qlo - W + 1)
#define MASKT(P0_, P1_, t) do { const int kb_ = KBASE(t); if ((!SK || ACT(t)) && (kb_ + KVBLK - 1 > qlo || kb_ <= qlo + QBLK - 1 - W)) mask_tile(P0_, P1_, qm - kb_, (unsigned)W); } while (0)
    constexpr int NQL = F32 ? 16 : 8;
    constexpr bool SK = WSKIP && !F32;
#define SEAM_K0() do { VMWN(NQL); if constexpr (F32) { SWRITE_KF(0); SBAR(); SLOAD_F((const float*)nxt.V, kbn); } else { SWRITE_HK(0); } SBAR(); } while (0)
    f32x16 pA0, pA1, pB0, pB1; float mnA, mnB, alA, alB; bf16x8 pa0, pa1, pa2, pa3;
    if constexpr (F32) { VMW(); SWRITE_VF(0); SBAR(); } else { SWRITE_HV(0); SBAR(); }
    if (NT > 1) { if constexpr (F32) SLOAD_F((const float*)Kh, KBASE(1)); else SLOAD_H(Kh, Vh, KBASE(1)); }
    SBAR(); qkt<0, SK>(pA0, pA1, K_lds, r32, hi, S.qr, ACT(0));
    if constexpr (F32) { if (NT > 1) { VMW(); SWRITE_KF(1); SBAR(); SLOAD_F((const float*)Vh, KBASE(1)); } }
    MASKT(pA0, pA1, 0); partialSM(pA0, pA1, m_reg, mnA, alA);
    if (NT > 1) { VMW(); if constexpr (F32) { SWRITE_VF(1); SBAR(); if (NT > 2) SLOAD_F((const float*)Kh, KBASE(2)); } else SWRITE_H(1); }
    __syncthreads();
#define HALF_STEP(PX0, PX1, mnX, alX, PY0, PY1, alY, t, KB, VB, SB) do {                                                      \
        SBAR(); qkt<KB, SK>(PX0, PX1, K_lds, r32, hi, S.qr, ACT(t));                                             \
        finishSM(PY0, PY1, alY, l_reg, pa0, pa1, pa2, pa3); SBAR();                                                           \
        if ((t) + 1 < NT) { if constexpr (F32) { VMW(); SWRITE_KF(SB); SBAR(); SLOAD_F((const float*)Vh, KBASE((t) + 1)); }  \
                            else { SLOAD_H(Kh, Vh, KBASE((t) + 1)); } SBAR(); }                                               \
        pv_tile<VB, SK>(o, vb0, pa0, pa1, pa2, pa3, ACT((t) - 1)); MASKT(PX0, PX1, (t)); partialSM(PX0, PX1, m_reg, mnX, alX);                                        \
        __syncthreads();                                                                                                      \
        if ((t) + 1 < NT) { VMW(); if constexpr (F32) { SWRITE_VF(SB); SBAR(); if ((t) + 2 < NT) SLOAD_F((const float*)Kh, KBASE((t) + 2)); } \
                            else { SWRITE_H(SB); } }                                                                          \
        RESC(alX); __syncthreads(); } while (0)
    for (int t = 1; t + 1 < NT; t += 2) {
        HALF_STEP(pB0, pB1, mnB, alB, pA0, pA1, alA, t, 1, 0, 0);
        HALF_STEP(pA0, pA1, mnA, alA, pB0, pB1, alB, t + 1, 0, 1, 1);
    }
    const bool even = (NT & 1) == 0;
    if (even) { SBAR(); qkt<1, SK>(pB0, pB1, K_lds, r32, hi, S.qr, ACT(NT - 1)); SBAR(); }
#define QROW(e) (nxt.Q + (size_t)(wid * QBLK + r32) * D + ((e) >> 1) * 16 + hi * 8 + ((e) & 1) * 4)
    if constexpr (F32) { SLOAD_F((const float*)nxt.K, kbn); SBAR();
#pragma unroll
        for (int e = 0; e < 8; ++e) S.tq[e] = *(const f32x4*)QROW(e); }
    else { SLOAD_H(nxt.K, nxt.V, kbn); SBAR();
#pragma unroll
        for (int d0 = 0; d0 < 8; ++d0) S.qr[d0] = load8<TIn>(nxt.Q + (size_t)(wid * QBLK + r32) * D + d0 * 16 + hi * 8); }
    SBAR();
    finishSM(pA0, pA1, alA, l_reg, pa0, pa1, pa2, pa3); SBAR();
    if constexpr (F32) {
#pragma unroll
        for (int e = 8; e < 16; ++e) S.tq[e] = *(const f32x4*)QROW(e); SBAR(); }
#undef QROW
    pv_tile<0, SK>(o, vb0, pa0, pa1, pa2, pa3, ACT(even ? NT - 2 : NT - 1));
    if (even) { MASKT(pB0, pB1, NT - 1); partialSM(pB0, pB1, m_reg, mnB, alB); __syncthreads(); RESC(alB);
        finishSM(pB0, pB1, alB, l_reg, pa0, pa1, pa2, pa3); SBAR(); pv_tile<1, SK>(o, vb0, pa0, pa1, pa2, pa3, ACT(NT - 1)); }
    SBAR(); SEAM_K0();
    if (hi == 0) li_l[r32] = l_reg; asm volatile("s_waitcnt lgkmcnt(0)" ::: "memory");
    float rli[16];
#pragma unroll
    for (int r = 0; r < 16; ++r) rli[r] = __builtin_amdgcn_rcpf(li_l[crow(r, hi)]);
    TOut* Ow = cur.O + (size_t)(wid * QBLK) * D;
#pragma unroll
    for (int r = 0; r < 16; ++r) { const int orow = crow(r, hi);
#pragma unroll
        for (int d0 = 0; d0 < 4; ++d0) { const float v = o[d0][r] * rli[r];
            if constexpr (same_t<TOut, float>::v) { Ow[(size_t)orow * D + d0 * 32 + r32] = v; }
            else { *(unsigned short*)(lds + O_STAGE + wid * O_STAGE_WAVE + orow * O_STAGE_ROW + (d0 * 32 + r32) * 2) = (unsigned short)cvtpk(v, 0.f); } } }
    if constexpr (!same_t<TOut, float>::v) {
#pragma unroll
        for (int j = 0; j < 8; ++j) { const int ch = j * 64 + lane, orow = ch >> 4, c16 = ch & 15;
            *(u32x4*)((char*)(Ow + (size_t)orow * D) + c16 * 16) = *(const u32x4*)(lds + O_STAGE + wid * O_STAGE_WAVE + orow * O_STAGE_ROW + c16 * 16); } }
    if constexpr (F32) {
#pragma unroll
        for (int d0 = 0; d0 < 8; ++d0) S.qr[d0] = pack8(S.tq[2 * d0], S.tq[2 * d0 + 1]); }
    __syncthreads();
#undef RESC
#undef KBASE
#undef ACT
#undef MASKT
#undef SEAM_K0
#undef HALF_STEP
}
#undef ROW
#undef VMW
#undef VMWN
#undef SLOAD_H
#undef SWRITE_HK
#undef SWRITE_HV
#undef SWRITE_H
#undef SLOAD_F
#undef SWRITE_KF
#undef SWRITE_VF

}

#define XB_TMO      128
#define XB_XCNT(j)  (256  + 64 * (j))
#define XB_XSUB(j)  (1280 + 64 * (j))
#define XB_XGEN(j)  (2304 + 64 * (j))
#define XB_TOP      3328
#define XB_TOPGEN   3392
#define XCD_BAR_WORDS 3456
#define XB_SPIN_CAP (1u << 18)
#define LAS __attribute__((address_space(3)))

__device__ __forceinline__ unsigned xb_ld(unsigned* p)              { return __hip_atomic_load(p, __ATOMIC_RELAXED, __HIP_MEMORY_SCOPE_AGENT); }
__device__ __forceinline__ unsigned xb_add(unsigned* p, unsigned v) { return __hip_atomic_fetch_add(p, v, __ATOMIC_RELAXED, __HIP_MEMORY_SCOPE_AGENT); }
__device__ __forceinline__ unsigned xb_xcc_id() { return (unsigned)__builtin_amdgcn_s_getreg((3 << 11) | 20) & 0xFu; }
#define XB_SPIN(cond, bar) do { unsigned _sp = 0; while (cond) { __builtin_amdgcn_s_sleep(1); \
    if ((++_sp & 255u) == 0u) { if (xb_ld(&(bar)[XB_TMO])) break; if (_sp > XB_SPIN_CAP) { atomicAdd(&(bar)[XB_TMO], 1u); break; } } } } while (0)

struct XcdBarrier {
    unsigned* bar; unsigned x;
    volatile LAS unsigned* st;
};

__device__ __forceinline__ XcdBarrier xcd_barrier_post(unsigned* bar, volatile LAS unsigned* st) {
    XcdBarrier b; b.bar = bar; b.x = xb_xcc_id(); b.st = st;
    if (threadIdx.x == 0) (void)xb_add(&bar[XB_XCNT(b.x)], 1u);
    return b;
}
__device__ __forceinline__ void xcd_barrier_complete(unsigned* bar, unsigned x, unsigned& nloc, unsigned& nx) {
    const unsigned G = gridDim.x * gridDim.y * gridDim.z;
    unsigned sum, cnt, mine, sp = 0u;
    for (;;) {
        sum = 0u; cnt = 0u; mine = 0u;
#pragma unroll
        for (unsigned j = 0; j < 16; ++j) { const unsigned c = xb_ld(&bar[XB_XCNT(j)]); sum += c; cnt += (c > 0u) ? 1u : 0u; mine = (j == x) ? c : mine; }
        if (sum == G) break;
        __builtin_amdgcn_s_sleep(1);
        if ((++sp & 255u) == 0u) { if (xb_ld(&bar[XB_TMO])) break; if (sp > XB_SPIN_CAP) { atomicAdd(&bar[XB_TMO], 1u); break; } }
    }
    nloc = mine > 0u ? mine : 1u; nx = cnt > 0u ? cnt : 1u;
}

__device__ __forceinline__ void xcd_barrier(const XcdBarrier& b) {
    asm volatile("s_waitcnt vmcnt(0)" ::: "memory");
    __syncthreads();
    if (threadIdx.x == 0) {
        unsigned* bar = b.bar;
        __builtin_amdgcn_s_waitcnt(0);
        unsigned nloc = b.st[0], nx = b.st[1];
        if (nloc == 0u) { xcd_barrier_complete(bar, b.x, nloc, nx); b.st[0] = nloc; b.st[1] = nx; }
        const unsigned old = xb_add(&bar[XB_XSUB(b.x)], 1u);
        const unsigned gen = old / nloc;
        if (old + 1u == (gen + 1u) * nloc) {
            __builtin_amdgcn_fence(__ATOMIC_RELEASE, "agent");
            asm volatile("s_waitcnt vmcnt(0)" ::: "memory");
            const unsigned og = xb_add(&bar[XB_TOP], 1u);
            const unsigned tg = og / nx;
            if (og + 1u == (tg + 1u) * nx) xb_add(&bar[XB_TOPGEN], 1u);
            else XB_SPIN(xb_ld(&bar[XB_TOPGEN]) == tg, bar);
            __builtin_amdgcn_fence(__ATOMIC_ACQUIRE, "agent");
            xb_add(&bar[XB_XGEN(b.x)], 1u);
            asm volatile("s_waitcnt vmcnt(0)" ::: "memory");
        } else {
            XB_SPIN(xb_ld(&bar[XB_XGEN(b.x)]) == gen, bar);
            __builtin_amdgcn_fence(__ATOMIC_ACQUIRE, "agent");
            asm volatile("s_waitcnt vmcnt(0)" ::: "memory");
        }
    }
    __syncthreads();
}

constexpr int D_MODEL = 4096, BATCH = 4, SEQ = 4096, DEPTH = 2, M_TOK = BATCH * SEQ;
constexpr int D_FF_LD = 16384 + 128;
constexpr int IN_WIDTH = 12288, D_FF = 16384, LRU_W = 1024, HG_W = 1024, DIFF_W = 2048;
constexpr int OFF_A_GATE = 0, OFF_A_X = 1024, OFF_B_Q = 2048, OFF_B_F = 3072, OFF_B_I = 4096, OFF_B_G = 5120, OFF_C_Q = 6144, OFF_C_K = 8192, OFF_C_V = 10240;
constexpr float NORM_EPS = 1e-6f;
constexpr int NWAVES = 8, NTHREADS = NWAVES * 64;
constexpr int N_INPUTS = 21;
enum { I_X = 0, I_LN1, I_WIN, I_CONVW, I_CONVB, I_WR, I_BR, I_WI, I_BI, I_LAM, I_LRUG, I_HLB, I_HNG, I_QNG, I_KNG, I_DLAM, I_SUBLN, I_WOUT, I_LN2, I_WFF1, I_WFF2 };

constexpr size_t MiB = (size_t)1 << 20;
constexpr size_t WS_CTL = 0, CTL_ZERO_BYTES = 1 * MiB;
constexpr size_t WS_LB = 1 * MiB;
constexpr size_t WS_ROPE = 2 * MiB;
constexpr size_t WS_WGATE = 4 * MiB;
constexpr size_t WS_WIN = 16 * MiB;
constexpr size_t WS_WOUT = 208 * MiB;
constexpr size_t WS_WFF1 = 272 * MiB;
constexpr size_t WS_WFF2 = 528 * MiB;
constexpr size_t WS_H = 1904 * MiB;
constexpr size_t WS_YCAT = 912 * MiB;
constexpr size_t WS_Z = 1040 * MiB;
constexpr size_t WS_XA = 1424 * MiB;
constexpr size_t WS_RI = 1456 * MiB;
constexpr size_t WS_PSS = 1712 * MiB;
constexpr size_t WS_RS0 = 1724 * MiB;
constexpr size_t WS_QH = 1584 * MiB, WS_KH = 1648 * MiB;
constexpr size_t WS_OATT = 1776 * MiB;
constexpr size_t WS_LSUM = 2032 * MiB;
constexpr size_t WS_HID = 1040 * MiB;
constexpr size_t WS_END = 2034 * MiB;
constexpr int CW_BAR = 4096;

constexpr int RING_BYTES = 131072, LDS_BYTES = 147456, MISC_OFF = LDS_BYTES - 512;
static_assert(ab::O_STAGE + 8 * ab::O_STAGE_WAVE <= MISC_OFF, "attention LDS (tiles + output stage) must stay below the control words");

#define GAS __attribute__((address_space(1)))
typedef unsigned short bf16r;
typedef unsigned v4u __attribute__((ext_vector_type(4)));
typedef unsigned v2u __attribute__((ext_vector_type(2)));
typedef float f32x4 __attribute__((ext_vector_type(4)));
typedef float f32x2 __attribute__((ext_vector_type(2)));
#define LDS_WAIT() asm volatile("s_waitcnt lgkmcnt(0)" ::: "memory")
__device__ __forceinline__ float bflo(unsigned w) { return __uint_as_float(w << 16); }
__device__ __forceinline__ float bfhi(unsigned w) { return __uint_as_float(w & 0xffff0000u); }
__device__ __forceinline__ float bf1(bf16r b) { return __uint_as_float((unsigned)b << 16); }
__device__ __forceinline__ unsigned pk2(float lo, float hi) { return pk_bf16_builtin(lo, hi); }
__device__ __forceinline__ float wave_sum(float v) {
#pragma unroll
    for (int o = 1; o < 64; o <<= 1) v += __shfl_xor(v, o);
    return v;
}
__device__ __forceinline__ float fast_exp(float x) { return __builtin_amdgcn_exp2f(x * 1.4426950408889634f); }
__device__ __forceinline__ float sigmoidf_(float x) { return __builtin_amdgcn_rcpf(1.0f + fast_exp(-x)); }

__device__ __forceinline__ void p0_transpose_item(const float* W, int K, int N, bf16r* WT, LAS float* scr, int item, int lane, const float* kgain, int ldw) {
    const int nblk = N / 32, kb = item / nblk, nb = item % nblk, k0 = 64 * kb, n0 = 32 * nb;
    {
        const int l8 = lane & 7, lr = lane >> 3; f32x4 v[8];
#pragma unroll
        for (int i = 0; i < 8; ++i) v[i] = __builtin_nontemporal_load((const f32x4*)(W + (size_t)(k0 + 8 * i + lr) * N + n0 + 4 * l8));
#pragma unroll
        for (int i = 0; i < 8; ++i) { LAS float* d = scr + (8 * i + lr) * 33 + 4 * l8; d[0] = v[i].x; d[1] = v[i].y; d[2] = v[i].z; d[3] = v[i].w; }
    }
    LDS_WAIT(); asm volatile("" ::: "memory");
    const int c = lane & 7;
    f32x4 g0 = (f32x4){1.f, 1.f, 1.f, 1.f}, g1 = g0;
    if (kgain) { g0 = *(const f32x4*)(kgain + k0 + 8 * c); g1 = *(const f32x4*)(kgain + k0 + 8 * c + 4); }
#pragma unroll
    for (int j = 0; j < 4; ++j) { const int n = (lane >> 3) + 8 * j; const LAS float* s = scr + (8 * c) * 33 + n;
        v4u o; o.x = pk2(s[0 * 33] * g0.x, s[1 * 33] * g0.y); o.y = pk2(s[2 * 33] * g0.z, s[3 * 33] * g0.w); o.z = pk2(s[4 * 33] * g1.x, s[5 * 33] * g1.y); o.w = pk2(s[6 * 33] * g1.z, s[7 * 33] * g1.w);
        *(v4u*)(WT + (size_t)(n0 + n) * ldw + k0 + 8 * c) = o; }
    LDS_WAIT(); asm volatile("" ::: "memory");
}

struct Args { const float* in[N_INPUTS]; float* out; unsigned char* ws; int ph_lo, ph_hi; };

#ifndef GEMM_ALIGN
#define GEMM_ALIGN true
#endif
#ifndef GEMM_SP2
#define GEMM_SP2 true
#endif
constexpr int PH_PER_LAYER = 13, N_PHASES = 1 + DEPTH * PH_PER_LAYER;

__device__ __forceinline__ float neg_expm1(float x) {
    if (x > -0.3f) { float p = 1.0f + x * (1.0f / 7.0f); p = 1.0f + x * (1.0f / 6.0f) * p; p = 1.0f + x * 0.2f * p; p = 1.0f + x * 0.25f * p; p = 1.0f + x * (1.0f / 3.0f) * p; p = 1.0f + x * 0.5f * p; return -x * p; }
    return 1.0f - fast_exp(x);
}
__device__ __forceinline__ void lru_step(float r, float ig, float x, float sp8, bool first, float& h, float& A) {
    const float la = -r * sp8; const float a = fast_exp(la);
    const float mult = first ? 1.0f : sqrtf(neg_expm1(2.0f * la));
    h = a * h + mult * (ig * x); A += la;
}
__device__ __forceinline__ float gelu_tanh(float x) { const float y = 1.5957691216057308f * (x + 0.044715f * x * x * x); return x * __builtin_amdgcn_rcpf(1.0f + fast_exp(-y)); }

typedef const __attribute__((address_space(4))) unsigned char* kargp_t;
__device__ __forceinline__ kargp_t karg_base() { kargp_t kp = (kargp_t)__builtin_amdgcn_kernarg_segment_ptr(); asm volatile("" : "+s"(kp)); return kp; }
__device__ __forceinline__ const float* karg_in(int i) { return *(const float* const __attribute__((address_space(4)))*)(karg_base() + 8 * i); }
__device__ __forceinline__ float* karg_out() { return *(float* const __attribute__((address_space(4)))*)(karg_base() + 8 * N_INPUTS); }
__device__ __forceinline__ unsigned char* karg_ws() { return *(unsigned char* const __attribute__((address_space(4)))*)(karg_base() + 8 * N_INPUTS + 8); }
__device__ __forceinline__ int karg_int(int i) { return *(const int __attribute__((address_space(4)))*)(karg_base() + 8 * N_INPUTS + 16 + 4 * i); }
#define WSP(T, off) ((T*)(karg_ws() + (off)))
#define PHASE_IDS const int tid = tid_opaque(), lane = tid & 63, wave = __builtin_amdgcn_readfirstlane(tid >> 6), gw = vcu * NWAVES + wave; (void)tid; (void)lane; (void)wave; (void)gw

typedef short hg_bf16x8 __attribute__((ext_vector_type(8)));
#define HG_MFMA(a, b, c) __builtin_amdgcn_mfma_f32_16x16x32_bf16((a), (b), (c), 0, 0, 0)
#define HG_BAR() do { asm volatile("s_waitcnt vmcnt(0) lgkmcnt(0)" ::: "memory"); __builtin_amdgcn_s_barrier(); asm volatile("" ::: "memory"); } while (0)
#define HG_BARL() do { asm volatile("s_waitcnt lgkmcnt(0)" ::: "memory"); __builtin_amdgcn_s_barrier(); asm volatile("" ::: "memory"); } while (0)
__device__ __forceinline__ void hgrn_chunked(LAS unsigned char* L, const bf16r* Z, const float* lbp, const float* hgain, bf16r* YCAT, int b, int h, int tid) {
    constexpr int QS = 0, KS = 17408, KT = 34816, VT = 53248, STO = 71680, PS = 106496, SP = 115712, DM = 123904, DH = 124416;
    constexpr int RS = 272, TS = 144;
    const int lane = tid & 63, wave = __builtin_amdgcn_readfirstlane(tid >> 6), lr = lane & 15, lq = lane >> 4;
    const int u = tid & 255, j8 = (u & 15) * 8, seg = u >> 4;
    const bool scaler = wave < 4;
    const bool backward = wave < 2;
    const size_t tok0 = (size_t)b * SEQ;
    f32x4 stm[8];
#pragma unroll
    for (int n = 0; n < 8; ++n) stm[n] = (f32x4){0.f, 0.f, 0.f, 0.f};
    constexpr int LBS = 124928;
    if (tid < 128) *(LAS float*)(L + LBS + tid * 4) = 1.0f - lbp[h * 128 + tid];
    HG_BARL();
    v4u ldA[4], ldB[4];
#define HG_ISSUE(c) do { const size_t m_ = tok0 + (size_t)(c) * 64 + 4 * seg; \
        if (scaler) { _Pragma("unroll") for (int r = 0; r < 4; ++r) { ldA[r] = __builtin_nontemporal_load((const v4u*)(Z + (m_ + r) * IN_WIDTH + OFF_B_F + h * 128 + j8)); ldB[r] = __builtin_nontemporal_load((const v4u*)(Z + (m_ + r) * IN_WIDTH + OFF_B_Q + h * 128 + j8)); } } \
        else { _Pragma("unroll") for (int r = 0; r < 4; ++r) ldA[r] = *(const v4u*)(Z + (m_ + r) * IN_WIDTH + OFF_B_I + h * 128 + j8); } } while (0)
    HG_ISSUE(0);
#pragma unroll 1
    for (int c = 0; c < SEQ / 64; ++c) {
        float loc[4][8], Lp[8];
        if (scaler) {
            asm volatile("s_waitcnt vmcnt(0)" ::: "memory");
#pragma unroll
            for (int r = 0; r < 4; ++r) {
                const unsigned zw[4] = {ldA[r].x, ldA[r].y, ldA[r].z, ldA[r].w}; unsigned kwp[4];
                const f32x4 om0 = *(const LAS f32x4*)(L + LBS + j8 * 4), om1 = *(const LAS f32x4*)(L + LBS + j8 * 4 + 16);
                const float oml[8] = {om0.x, om0.y, om0.z, om0.w, om1.x, om1.y, om1.z, om1.w};
#pragma unroll
                for (int e2 = 0; e2 < 4; ++e2) { const float k0_ = oml[2 * e2] * __builtin_amdgcn_rcpf(1.0f + fast_exp(bflo(zw[e2]))), k1_ = oml[2 * e2 + 1] * __builtin_amdgcn_rcpf(1.0f + fast_exp(bfhi(zw[e2]))); kwp[e2] = pk2(k0_, k1_); }
                ldA[r] = (v4u){kwp[0], kwp[1], kwp[2], kwp[3]};
            }
            const unsigned kw0[4] = {ldA[0].x, ldA[0].y, ldA[0].z, ldA[0].w}, kw1[4] = {ldA[1].x, ldA[1].y, ldA[1].z, ldA[1].w}, kw2[4] = {ldA[2].x, ldA[2].y, ldA[2].z, ldA[2].w}, kw3[4] = {ldA[3].x, ldA[3].y, ldA[3].z, ldA[3].w};
#pragma unroll
            for (int e = 0; e < 8; ++e) {
                const float f0 = 1.0f - ((e & 1) ? bfhi(kw0[e >> 1]) : bflo(kw0[e >> 1])), f1 = 1.0f - ((e & 1) ? bfhi(kw1[e >> 1]) : bflo(kw1[e >> 1]));
                const float f2 = 1.0f - ((e & 1) ? bfhi(kw2[e >> 1]) : bflo(kw2[e >> 1])), f3 = 1.0f - ((e & 1) ? bfhi(kw3[e >> 1]) : bflo(kw3[e >> 1]));
                if (backward) { loc[3][e] = 1.0f; loc[2][e] = f3; loc[1][e] = f3 * f2; loc[0][e] = f3 * f2 * f1; Lp[e] = loc[0][e] * f0; }
                else { loc[0][e] = f0; loc[1][e] = f0 * f1; loc[2][e] = loc[1][e] * f2; loc[3][e] = loc[2][e] * f3; Lp[e] = loc[3][e]; }
            }
            *(LAS f32x4*)(L + SP + (seg * 128 + j8) * 4) = (f32x4){Lp[0], Lp[1], Lp[2], Lp[3]};
            *(LAS f32x4*)(L + SP + (seg * 128 + j8) * 4 + 16) = (f32x4){Lp[4], Lp[5], Lp[6], Lp[7]};
        }
        HG_BAR();
        if (scaler) {
            float X[8];
#pragma unroll
            for (int e = 0; e < 8; ++e) X[e] = 1.0f;
#pragma unroll
            for (int k = 0; k < 7; ++k) {
                const int sp = backward ? (1 + k) : (8 + k);
                const bool use = backward ? (sp > seg) : (sp < seg);
                const f32x4 a = *(const LAS f32x4*)(L + SP + (sp * 128 + j8) * 4), b4 = *(const LAS f32x4*)(L + SP + (sp * 128 + j8) * 4 + 16);
                X[0] *= use ? a.x : 1.0f; X[1] *= use ? a.y : 1.0f; X[2] *= use ? a.z : 1.0f; X[3] *= use ? a.w : 1.0f;
                X[4] *= use ? b4.x : 1.0f; X[5] *= use ? b4.y : 1.0f; X[6] *= use ? b4.z : 1.0f; X[7] *= use ? b4.w : 1.0f;
            }
            if (seg == 0) { *(LAS f32x4*)(L + DM + j8 * 4) = (f32x4){Lp[0] * X[0], Lp[1] * X[1], Lp[2] * X[2], Lp[3] * X[3]}; *(LAS f32x4*)(L + DM + j8 * 4 + 16) = (f32x4){Lp[4] * X[4], Lp[5] * X[5], Lp[6] * X[6], Lp[7] * X[7]}; }
            if (seg == 15) { *(LAS f32x4*)(L + DH + j8 * 4) = (f32x4){Lp[0] * X[0], Lp[1] * X[1], Lp[2] * X[2], Lp[3] * X[3]}; *(LAS f32x4*)(L + DH + j8 * 4 + 16) = (f32x4){Lp[4] * X[4], Lp[5] * X[5], Lp[6] * X[6], Lp[7] * X[7]}; }
            unsigned kt[8][2];
#pragma unroll
            for (int r = 0; r < 4; ++r) {
                float qs[8], ks[8];
                const unsigned kwr[4] = {ldA[r].x, ldA[r].y, ldA[r].z, ldA[r].w}, qwr[4] = {ldB[r].x, ldB[r].y, ldB[r].z, ldB[r].w};
#pragma unroll
                for (int e = 0; e < 8; ++e) {
                    float E, IE;
                    if (backward) { IE = fmaxf(loc[r][e] * X[e], 1.0e-30f); E = __builtin_amdgcn_rcpf(IE); }
                    else { E = fmaxf(loc[r][e] * X[e], 1.0e-30f); IE = __builtin_amdgcn_rcpf(E); }
                    { const float zq_ = (e & 1) ? bfhi(qwr[e >> 1]) : bflo(qwr[e >> 1]); qs[e] = zq_ * sigmoidf_(zq_) * 0.08838834764831845f * E; } ks[e] = ((e & 1) ? bfhi(kwr[e >> 1]) : bflo(kwr[e >> 1])) * IE;
                }
                v4u wq, wk; wq.x = pk2(qs[0], qs[1]); wq.y = pk2(qs[2], qs[3]); wq.z = pk2(qs[4], qs[5]); wq.w = pk2(qs[6], qs[7]);
                wk.x = pk2(ks[0], ks[1]); wk.y = pk2(ks[2], ks[3]); wk.z = pk2(ks[4], ks[5]); wk.w = pk2(ks[6], ks[7]);
                *(LAS v4u*)(L + QS + (4 * seg + r) * RS + j8 * 2) = wq; *(LAS v4u*)(L + KS + (4 * seg + r) * RS + j8 * 2) = wk;
                const unsigned kw[4] = {wk.x, wk.y, wk.z, wk.w};
#pragma unroll
                for (int e = 0; e < 8; ++e) { const unsigned hv = (e & 1) ? (kw[e >> 1] >> 16) : (kw[e >> 1] & 0xffffu);
                    if (r == 0) kt[e][0] = hv; else if (r == 1) kt[e][0] |= hv << 16; else if (r == 2) kt[e][1] = hv; else kt[e][1] |= hv << 16; }
            }
#pragma unroll
            for (int e = 0; e < 8; ++e) *(LAS v2u*)(L + KT + (j8 + e) * TS + (4 * seg) * 2) = (v2u){kt[e][0], kt[e][1]};
        } else {
            asm volatile("s_waitcnt vmcnt(0)" ::: "memory");
            const unsigned vw[4][4] = {{ldA[0].x, ldA[0].y, ldA[0].z, ldA[0].w}, {ldA[1].x, ldA[1].y, ldA[1].z, ldA[1].w}, {ldA[2].x, ldA[2].y, ldA[2].z, ldA[2].w}, {ldA[3].x, ldA[3].y, ldA[3].z, ldA[3].w}};
#pragma unroll
            for (int e = 0; e < 8; ++e) {
                unsigned h0, h1, h2, h3;
                if (e & 1) { h0 = vw[0][e >> 1] >> 16; h1 = vw[1][e >> 1] >> 16; h2 = vw[2][e >> 1] >> 16; h3 = vw[3][e >> 1] >> 16; }
                else { h0 = vw[0][e >> 1] & 0xffffu; h1 = vw[1][e >> 1] & 0xffffu; h2 = vw[2][e >> 1] & 0xffffu; h3 = vw[3][e >> 1] & 0xffffu; }
                *(LAS v2u*)(L + VT + (j8 + e) * TS + (4 * seg) * 2) = (v2u){h0 | (h1 << 16), h2 | (h3 << 16)};
            }
        }
        HG_BARL();
#pragma unroll
        for (int n = 0; n < 8; ++n) {
            const f32x4 dm = *(const LAS f32x4*)(L + DM + (16 * n + 4 * lq) * 4); const f32x4 sv = stm[n] * dm;
            *(LAS v2u*)(L + STO + (16 * wave + lr) * RS + (16 * n + 4 * lq) * 2) = (v2u){pk2(sv.x, sv.y), pk2(sv.z, sv.w)};
        }
        {
            const int ti = wave >> 1;
#pragma unroll
            for (int jj = 0; jj < 2; ++jj) {
                const int sj = 2 * (wave & 1) + jj;
                f32x4 acc = (f32x4){0.f, 0.f, 0.f, 0.f};
#pragma unroll
                for (int ks = 0; ks < 4; ++ks) {
                    const hg_bf16x8 a = *(const LAS hg_bf16x8*)(L + KS + (16 * sj + lr) * RS + (ks * 32 + 8 * lq) * 2);
                    const hg_bf16x8 bq = *(const LAS hg_bf16x8*)(L + QS + (16 * ti + lr) * RS + (ks * 32 + 8 * lq) * 2);
                    acc = HG_MFMA(a, bq, acc);
                }
                {
                    const int s0 = 16 * sj + 4 * lq, tt = 16 * ti + lr;
                    acc.x = (s0 + 0 <= tt) ? acc.x : 0.f; acc.y = (s0 + 1 <= tt) ? acc.y : 0.f; acc.z = (s0 + 2 <= tt) ? acc.z : 0.f; acc.w = (s0 + 3 <= tt) ? acc.w : 0.f;
                }
                *(LAS v2u*)(L + PS + (16 * ti + lr) * TS + (16 * sj + 4 * lq) * 2) = (v2u){pk2(acc.x, acc.y), pk2(acc.z, acc.w)};
            }
        }
        if (c + 1 < SEQ / 64) HG_ISSUE(c + 1);
        v2u gld[4];
        int tG = tid; asm volatile("" : "+v"(tG));
#pragma unroll
        for (int k = 0; k < 4; ++k) { const int pc = tG + 512 * k; gld[k] = __builtin_nontemporal_load((const v2u*)(Z + (tok0 + (size_t)c * 64 + (pc >> 5)) * IN_WIDTH + OFF_B_G + h * 128 + (pc & 31) * 4)); }
        HG_BARL();
        f32x4 o[4];
        {
#pragma unroll
            for (int i = 0; i < 4; ++i) o[i] = (f32x4){0.f, 0.f, 0.f, 0.f};
            hg_bf16x8 bs[4];
#pragma unroll
            for (int ks = 0; ks < 4; ++ks) bs[ks] = *(const LAS hg_bf16x8*)(L + STO + (16 * wave + lr) * RS + (ks * 32 + 8 * lq) * 2);
#pragma unroll
            for (int i = 0; i < 4; ++i)
#pragma unroll
                for (int ks = 0; ks < 4; ++ks) { const hg_bf16x8 a = *(const LAS hg_bf16x8*)(L + QS + (16 * i + lr) * RS + (ks * 32 + 8 * lq) * 2); o[i] = HG_MFMA(a, bs[ks], o[i]); }
            hg_bf16x8 bv[2];
#pragma unroll
            for (int ks = 0; ks < 2; ++ks) bv[ks] = *(const LAS hg_bf16x8*)(L + VT + (16 * wave + lr) * TS + (ks * 32 + 8 * lq) * 2);
#pragma unroll
            for (int i = 0; i < 4; ++i)
#pragma unroll
                for (int ks = 0; ks < 2; ++ks) { if (ks == 1 && i < 2) continue; const hg_bf16x8 a = *(const LAS hg_bf16x8*)(L + PS + (16 * i + lr) * TS + (ks * 32 + 8 * lq) * 2); o[i] = HG_MFMA(a, bv[ks], o[i]); }
#pragma unroll
            for (int n = 0; n < 8; ++n) {
                f32x4 U = (f32x4){0.f, 0.f, 0.f, 0.f};
#pragma unroll
                for (int ks = 0; ks < 2; ++ks) { const hg_bf16x8 a = *(const LAS hg_bf16x8*)(L + KT + (16 * n + lr) * TS + (ks * 32 + 8 * lq) * 2); U = HG_MFMA(a, bv[ks], U); }
                const f32x4 dm = *(const LAS f32x4*)(L + DM + (16 * n + 4 * lq) * 4), dh = *(const LAS f32x4*)(L + DH + (16 * n + 4 * lq) * 4);
                stm[n] = stm[n] * (dm * dh) + dh * U;
            }
        }
        HG_BARL();
#pragma unroll
        for (int i = 0; i < 4; ++i) {
            *(LAS float*)(L + (16 * i + 4 * lq + 0) * 528 + (16 * wave + lr) * 4) = o[i].x; *(LAS float*)(L + (16 * i + 4 * lq + 1) * 528 + (16 * wave + lr) * 4) = o[i].y;
            *(LAS float*)(L + (16 * i + 4 * lq + 2) * 528 + (16 * wave + lr) * 4) = o[i].z; *(LAS float*)(L + (16 * i + 4 * lq + 3) * 528 + (16 * wave + lr) * 4) = o[i].w;
        }
        HG_BARL();
        {
            int tE = tid; asm volatile("" : "+v"(tE));
#pragma unroll
            for (int k = 0; k < 4; ++k) { const int pc = tE + 512 * k, row = pc >> 5, col = (pc & 31) * 4;
                const f32x4 ov = *(const LAS f32x4*)(L + row * 528 + col * 4);
                float ss = (ov.x * ov.x + ov.y * ov.y) + (ov.z * ov.z + ov.w * ov.w);
                ss += __shfl_xor(ss, 1); ss += __shfl_xor(ss, 2); ss += __shfl_xor(ss, 4); ss += __shfl_xor(ss, 8); ss += __shfl_xor(ss, 16);
                const float rs = 1.0f / sqrtf(ss * (1.0f / 128.0f) + NORM_EPS);
                const size_t m = tok0 + (size_t)c * 64 + row;
                const v2u gw2 = gld[k];
                const f32x4 hgv = *(const f32x4*)(hgain + col);
                const float g0 = bflo(gw2.x), g1 = bfhi(gw2.x), g2 = bflo(gw2.y), g3 = bfhi(gw2.y);
                v2u w; w.x = pk2(ov.x * rs * hgv.x * (g0 * sigmoidf_(g0)), ov.y * rs * hgv.y * (g1 * sigmoidf_(g1))); w.y = pk2(ov.z * rs * hgv.z * (g2 * sigmoidf_(g2)), ov.w * rs * hgv.w * (g3 * sigmoidf_(g3)));
                *(v2u*)(YCAT + m * D_MODEL + 1024 + h * 128 + col) = w; }
        }
    }
#undef HG_ISSUE
}

__device__ __forceinline__ void xcopy_rows(const float* xin, bf16r* HB, float* RS0, int gw, int ngw, int lane) {
    for (int m = gw; m < M_TOK; m += ngw) {
        const f32x4* xr = (const f32x4*)(xin + (size_t)m * D_MODEL) + lane;
        f32x4 v[16]; float ss = 0.f;
#pragma unroll
        for (int j = 0; j < 16; ++j) { v[j] = __builtin_nontemporal_load(xr + 64 * j); ss += (v[j].x * v[j].x + v[j].y * v[j].y) + (v[j].z * v[j].z + v[j].w * v[j].w); }
        ss = wave_sum(ss);
        v2u* o = (v2u*)(HB + (size_t)m * D_MODEL) + lane;
#pragma unroll
        for (int j = 0; j < 16; ++j) { v2u w; w.x = pk2(v[j].x, v[j].y); w.y = pk2(v[j].z, v[j].w); o[64 * j] = w; }
        if (lane == 0) RS0[m] = ss;
    }
}
#define RS_TABLE_OFF (RING_BYTES + 1024)
#define RS_TABLE_FILL(pssp, nparts, pm_) do { { const int r_ = tid & 255, hf_ = tid >> 8; float ss_ = 0.f;                                                                         \
        if ((nparts) == 1) { if (!hf_) ss_ = (pssp)[(pm_) * 256 + r_]; }                                                                                                           \
        else { _Pragma("unroll 16") for (int j_ = 0; j_ < 32; ++j_) ss_ += (pssp)[(size_t)(hf_ * 32 + j_) * M_TOK + (pm_) * 256 + r_]; }                                           \
        if (hf_) ((LAS float*)(ldsl + RS_TABLE_OFF))[256 + r_] = ss_;                                                                                                              \
        __syncthreads();                                                                                                                                                           \
        if (!hf_) ((LAS float*)(ldsl + RS_TABLE_OFF))[r_] = 1.0f / sqrtf((ss_ + ((LAS float*)(ldsl + RS_TABLE_OFF))[256 + r_]) * (1.0f / D_MODEL) + NORM_EPS); } __syncthreads(); } while (0)

constexpr int WC_IN = (D_MODEL / 64) * (IN_WIDTH / 32), WC_OUT = (D_MODEL / 64) * (D_MODEL / 32), WC_F1 = (D_MODEL / 64) * (D_FF / 32), WC_F2 = (D_FF / 64) * (D_MODEL / 32);
constexpr int WC_LAYER = WC_IN + WC_OUT + WC_F1 + WC_F2;
__device__ __forceinline__ void convert_weights(int it0, int it1, int w, int nw, LAS float* scr, int lane) {
    bf16r* const W_IN = WSP(bf16r, WS_WIN); bf16r* const W_OUT = WSP(bf16r, WS_WOUT); bf16r* const W_FF1 = WSP(bf16r, WS_WFF1); bf16r* const W_FF2 = WSP(bf16r, WS_WFF2);
    for (int it = it0 + w; it < it1; it += nw) {
        const int l = it / WC_LAYER; int r = it - l * WC_LAYER;
        if (r < WC_IN) { p0_transpose_item(karg_in(I_WIN) + (size_t)l * D_MODEL * IN_WIDTH, D_MODEL, IN_WIDTH, W_IN + (size_t)l * IN_WIDTH * D_MODEL, scr, r, lane, karg_in(I_LN1) + l * D_MODEL, D_MODEL); continue; } r -= WC_IN;
        if (r < WC_OUT) { p0_transpose_item(karg_in(I_WOUT) + (size_t)l * D_MODEL * D_MODEL, D_MODEL, D_MODEL, W_OUT + (size_t)l * D_MODEL * D_MODEL, scr, r, lane, nullptr, D_MODEL); continue; } r -= WC_OUT;
        if (r < WC_F1) { p0_transpose_item(karg_in(I_WFF1) + (size_t)l * D_MODEL * D_FF, D_MODEL, D_FF, W_FF1 + (size_t)l * D_FF * D_MODEL, scr, r, lane, karg_in(I_LN2) + l * D_MODEL, D_MODEL); continue; } r -= WC_F1;
        p0_transpose_item(karg_in(I_WFF2) + (size_t)l * D_FF * D_MODEL, D_FF, D_MODEL, W_FF2 + (size_t)l * D_MODEL * D_FF_LD, scr, r, lane, nullptr, D_FF_LD);
    }
}

__device__ __forceinline__ ab::BlockRef<__hip_bfloat16, __hip_bfloat16> attn_ref(const __hip_bfloat16* Qp, const __hip_bfloat16* Kp, const __hip_bfloat16* Vp, __hip_bfloat16* Op, int L, int pass) {
    const int bh = L >> 3, x = L & 7, qb = pass ? 15 - x : x;
    const int b = bh >> 5, hq = bh & 31, h = hq >> 2, c = (hq >> 1) & 1, vh = hq & 1;
    ab::BlockRef<__hip_bfloat16, __hip_bfloat16> r;
    r.Q = Qp + ((size_t)(b * 16 + h * 2 + c) * SEQ + (size_t)qb * 256) * 128;
    r.K = Kp + (size_t)(b * 16 + h * 2 + c) * SEQ * 128;
    r.V = Vp + (size_t)b * SEQ * IN_WIDTH + OFF_C_V + (h * 2 + vh) * 128;
    r.O = Op + ((size_t)(b * 32 + hq) * SEQ + (size_t)qb * 256) * 128;
    r.P0 = qb * 256;
    return r;
}

__device__ __forceinline__ ab::BlockRef<__hip_bfloat16, __hip_bfloat16> attn_ref_q(const __hip_bfloat16* Qp, const __hip_bfloat16* Kp, const __hip_bfloat16* Vp, __hip_bfloat16* Op, int J) {
    const int pr = (J >> 8) * 4 + (J & 3), i = (J & 255) >> 2;
    const int qb = 15 - (i >> 2), b = pr >> 3, h = pr & 7, c = (i >> 1) & 1, vh = i & 1, hq = h * 4 + c * 2 + vh;
    ab::BlockRef<__hip_bfloat16, __hip_bfloat16> r;
    r.Q = Qp + ((size_t)(b * 16 + h * 2 + c) * SEQ + (size_t)qb * 256) * 128;
    r.K = Kp + (size_t)(b * 16 + h * 2 + c) * SEQ * 128;
    r.V = Vp + (size_t)b * SEQ * IN_WIDTH + OFF_C_V + (h * 2 + vh) * 128;
    r.O = Op + ((size_t)(b * 32 + hq) * SEQ + (size_t)qb * 256) * 128;
    r.P0 = qb * 256;
    return r;
}

__device__ __forceinline__ void group4_barrier(unsigned* ctr, unsigned* ctr2, unsigned* bar) {
    asm volatile("s_waitcnt vmcnt(0)" ::: "memory");
    __syncthreads();
    if (threadIdx.x == 0) {
        __builtin_amdgcn_s_waitcnt(0);
        __builtin_amdgcn_fence(__ATOMIC_RELEASE, "agent");
        asm volatile("s_waitcnt vmcnt(0)" ::: "memory");
        (void)xb_add(ctr, 1u);
        XB_SPIN(xb_ld(ctr) < 4u, bar);
        if (ctr2) XB_SPIN(xb_ld(ctr2) < 4u, bar);
        __builtin_amdgcn_fence(__ATOMIC_ACQUIRE, "agent");
        asm volatile("s_waitcnt vmcnt(0)" ::: "memory");
    }
    __syncthreads();
}

constexpr int NQ_ALL = BATCH * 32 * 16, NQ_XCD = NQ_ALL / 8;
__device__ __forceinline__ int aq_take(unsigned* qbase, int x0, volatile LAS unsigned* st) {
    unsigned dx = *st;
    while (dx < 8u) {
        const unsigned q = ((unsigned)x0 + dx) & 7u;
        const unsigned v = __hip_atomic_fetch_add(qbase + 64 * q, 1u, __ATOMIC_RELAXED, __HIP_MEMORY_SCOPE_AGENT);
        if (v < (unsigned)NQ_XCD) { *st = dx; return (int)(q * NQ_XCD + v); }
        ++dx;
    }
    *st = 8u; return NQ_ALL;
}

__global__ void __launch_bounds__(NTHREADS, 2) hymba_fwd(Args args) {
    extern __shared__ __attribute__((aligned(16))) unsigned char lds[];
    LAS unsigned char* ldsl = (LAS unsigned char*)lds;
    const int G = gridDim.x;
    int bx = blockIdx.x;
    int vcu = (G % 8 == 0) ? (bx % 8) * (G / 8) + bx / 8 : bx;
    const int ngw = G * NWAVES;
    volatile LAS unsigned* MISC = (volatile LAS unsigned*)(ldsl + MISC_OFF);
    for (int u = threadIdx.x; u < (LDS_BYTES - RING_BYTES) / 4; u += NTHREADS) ((LAS unsigned*)(ldsl + RING_BYTES))[u] = 0u;
    __syncthreads();
#if MK_PER_PHASE
    const int lo = karg_int(0), hi = karg_int(1);
#else
    constexpr int lo = 0, hi = N_PHASES;
#endif
    const bool multi = (hi - lo) > 1;
    XcdBarrier bar; bar.bar = WSP(unsigned, WS_CTL) + CW_BAR; bar.x = 0; bar.st = nullptr;
    if (multi) bar = xcd_barrier_post(WSP(unsigned, WS_CTL) + CW_BAR, MISC + 8);
    if (multi && threadIdx.x == 0) MISC[18] = __hip_atomic_fetch_add(WSP(unsigned, WS_CTL) + 3072 + 64 * (xb_xcc_id() & 7u), 1u, __ATOMIC_RELAXED, __HIP_MEMORY_SCOPE_AGENT);
#ifndef EN_MASK
#define EN_MASK 0xFFFF
#endif
#define ENK(j) (((EN_MASK) >> (j)) & 1)
#ifndef DBG_TWICE_MASK
#define DBG_TWICE_MASK 0
#endif
#define REPS(j) ((((DBG_TWICE_MASK) >> (j)) & 1) ? 2 : 1)
#define IN(k) (lo <= (k) && (k) < hi)
#if defined(DBG_STAMP_MASK)
#define SEAM(k) do { if (IN((k) + 1)) { if (threadIdx.x == 0) WSP(unsigned long long, 12 * MiB)[((k) * 2 + 0) * 256 + blockIdx.x] = __builtin_amdgcn_s_memrealtime(); xcd_barrier(bar); \
    if (threadIdx.x == 0) WSP(unsigned long long, 12 * MiB)[((k) * 2 + 1) * 256 + blockIdx.x] = __builtin_amdgcn_s_memrealtime(); } } while (0)
#else
#define SEAM(k) do { if (IN((k) + 1)) xcd_barrier(bar); } while (0)
#endif
#define PANEL_PM ((bx & 7) * 8 + ((bx >> 3) & 7))
#define PANEL_R4 ((bx >> 6) & 3)
#define SEAM4(k, slot) do { if (IN((k) + 1)) group4_barrier(WSP(unsigned, WS_CTL) + 16384 + ((slot) * 64 + PANEL_PM) * 64, nullptr, bar.bar); } while (0)
#define SEAM4H(k, slot) do { if (IN((k) + 1)) group4_barrier(WSP(unsigned, WS_CTL) + 16384 + ((slot) * 64 + PANEL_PM) * 64, \
        (PANEL_R4 == 0 && (PANEL_PM & 15) != 0) ? WSP(unsigned, WS_CTL) + 16384 + ((slot) * 64 + PANEL_PM - 1) * 64 : (unsigned*)nullptr, bar.bar); } while (0)

    if (ENK(15) && IN(0)) {
        PHASE_IDS;
#pragma unroll 1
        for (int rep_ = 0; rep_ < REPS(15); ++rep_) {
        bf16r* const W_IN = WSP(bf16r, WS_WIN);
        bf16r* const W_OUT = WSP(bf16r, WS_WOUT);
        bf16r* const W_FF1 = WSP(bf16r, WS_WFF1);
        bf16r* const W_FF2 = WSP(bf16r, WS_WFF2);
        bf16r* const W_GATE = WSP(bf16r, WS_WGATE);
        float* const LB = WSP(float, WS_LB);
        float* const ROPE_COS = WSP(float, WS_ROPE); float* const ROPE_SIN = ROPE_COS + SEQ * 64;
        LAS float* scr = (LAS float*)(ldsl + wave * 16384);
        convert_weights(0, WC_IN, gw, ngw, scr, lane);
        for (int idx = gw * 64 + lane; idx < DEPTH * 2048 * 32; idx += ngw * 64) {
            const int l = idx / (2048 * 32), n = (idx / 32) % 2048, k0 = (idx % 32) * 8;
            const int pn = n >> 8, p = pn >> 1, g = pn & 1, hh = (n >> 7) & 1, j = n & 127;
            v4u o = {0u, 0u, 0u, 0u};
            if ((k0 >> 7) == hh) { const float* w = karg_in(g ? I_WI : I_WR) + (((size_t)l * 8 + 2 * p + hh) * 128 + (k0 & 127)) * 128 + j;
                o.x = pk2(w[0 * 128], w[1 * 128]); o.y = pk2(w[2 * 128], w[3 * 128]); o.z = pk2(w[4 * 128], w[5 * 128]); o.w = pk2(w[6 * 128], w[7 * 128]); }
            *(v4u*)(W_GATE + ((size_t)l * 2048 + n) * 256 + k0) = o;
        }
        for (int c = gw * 64 + lane; c < HG_W; c += ngw * 64) {
            const float b0 = karg_in(I_HLB)[c], b1 = karg_in(I_HLB)[HG_W + c]; const float mx = fmaxf(b0, b1);
            const float e0 = __expf(b0 - mx), e1 = __expf(b1 - mx);
            LB[c] = 0.f; LB[HG_W + c] = e1 / (e0 + e1);
        }
        for (int idx = gw * 64 + lane; idx < SEQ * 64; idx += ngw * 64) {
            const int t = idx >> 6, j = idx & 63;
            const float inv = exp2f(-(float)(2 * j) * (1.0f / 128.0f) * 13.287712379549449f);
            const float angf = (float)t * inv;
            double rev = (double)angf * 0.15915494309189535; rev -= floor(rev);
            const float rf = (float)rev;
            ROPE_COS[idx] = __builtin_amdgcn_cosf(rf); ROPE_SIN[idx] = __builtin_amdgcn_sinf(rf);
        }
        }
        xcopy_rows(karg_in(I_X), WSP(bf16r, WS_H), WSP(float, WS_RS0), gw, ngw, lane);
        SEAM(0);
    }
    if (multi && IN(0) && IN(1) && G % 8 == 0) {
        if (threadIdx.x == 0) {
            const unsigned x = xb_xcc_id() & 7u; unsigned before = 0u;
            for (unsigned j = 0; j < 8u; ++j) { const unsigned cj = __hip_atomic_load(WSP(unsigned, WS_CTL) + 3072 + 64 * j, __ATOMIC_RELAXED, __HIP_MEMORY_SCOPE_AGENT); before += (j < x) ? cj : 0u; }
            MISC[17] = before + MISC[18];
        }
        __syncthreads();
        const int lb = (int)MISC[17];
        if (lb >= 0 && lb < G) { vcu = lb; bx = (lb % (G / 8)) * 8 + lb / (G / 8); }
    }

#pragma unroll 1
    for (int l = 0; l < DEPTH; ++l) {
        const int pb = 1 + l * PH_PER_LAYER;

        if (ENK(1) && IN(pb + 1)) {
            PHASE_IDS;
#pragma unroll 1
            for (int rep_ = 0; rep_ < REPS(1); ++rep_) {
            bf16r* const HB = WSP(bf16r, WS_H);
            bf16r* const W_IN = WSP(bf16r, WS_WIN);
            bf16r* const Z = WSP(bf16r, WS_Z);
            pg8::Gemm g{HB, W_IN + (size_t)l * IN_WIDTH * D_MODEL, M_TOK, IN_WIDTH, D_MODEL}; pg8::StaticOrder S; S.init(M_TOK, IN_WIDTH, G, bx);
            { const float* pssp = (l == 0) ? WSP(float, WS_RS0) : WSP(float, WS_PSS) + (size_t)1 * 64 * M_TOK; const int nparts = (l == 0) ? 1 : 64;
              pg8::Unit u0; if (S.next(0, u0)) RS_TABLE_FILL(pssp, nparts, u0.pm); }
            pg8::EpiBf16X<0> E{Z, IN_WIDTH, nullptr, nullptr, 0, (const LAS float*)(ldsl + RS_TABLE_OFF)};
            pg8::gemm_phase<pg8::EpiBf16X<0>, pg8::StaticOrder, GEMM_ALIGN, GEMM_SP2>(ldsl, g, S, E);
            }
            SEAM4H(pb + 1, 8 * l + 2);
        }

        if (ENK(2) && IN(pb + 2)) {
            PHASE_IDS;
#pragma unroll 1
            for (int rep_ = 0; rep_ < REPS(2); ++rep_) {
            bf16r* const Z = WSP(bf16r, WS_Z);
            bf16r* const XA = WSP(bf16r, WS_XA);
            bf16r* const QH = WSP(bf16r, WS_QH);
            bf16r* const KH = WSP(bf16r, WS_KH);
            float* const LB = WSP(float, WS_LB);
            float* const ROPE_COS = WSP(float, WS_ROPE); float* const ROPE_SIN = ROPE_COS + SEQ * 64;
            const float* convw = karg_in(I_CONVW) + l * 4 * LRU_W; const float* convb = karg_in(I_CONVB) + l * LRU_W;
            const float* qg = karg_in(I_QNG) + l * 128; const float* kg = karg_in(I_KNG) + l * 128;
            for (int m = PANEL_PM * 256 + PANEL_R4 * 64 + wave; m < PANEL_PM * 256 + PANEL_R4 * 64 + 64; m += NWAVES) {
                const int t = m & (SEQ - 1), b = m >> 12;
                const bf16r* zr = Z + (size_t)m * IN_WIDTH;
#pragma unroll
                for (int it = 0; it < 2; ++it) {
                    const int c0 = it * 512 + lane * 8;
                    const f32x4 b0 = *(const f32x4*)(convb + c0), b1 = *(const f32x4*)(convb + c0 + 4);
                    float a0 = b0.x, a1 = b0.y, a2 = b0.z, a3 = b0.w, a4 = b1.x, a5 = b1.y, a6 = b1.z, a7 = b1.w;
#pragma unroll
                    for (int j = 0; j < 4; ++j) {
                        if (t - 3 + j >= 0) {
                            const v4u xv = *(const v4u*)(zr - (ptrdiff_t)(3 - j) * IN_WIDTH + OFF_A_X + c0);
                            const f32x4 w0 = *(const f32x4*)(convw + j * LRU_W + c0), w1 = *(const f32x4*)(convw + j * LRU_W + c0 + 4);
                            a0 += bflo(xv.x) * w0.x; a1 += bfhi(xv.x) * w0.y; a2 += bflo(xv.y) * w0.z; a3 += bfhi(xv.y) * w0.w;
                            a4 += bflo(xv.z) * w1.x; a5 += bfhi(xv.z) * w1.y; a6 += bflo(xv.w) * w1.z; a7 += bfhi(xv.w) * w1.w;
                        }
                    }
                    v4u o; o.x = pk2(a0, a1); o.y = pk2(a2, a3); o.z = pk2(a4, a5); o.w = pk2(a6, a7);
                    *(v4u*)(XA + ((size_t)(c0 >> 8) * M_TOK + m) * 256 + (c0 & 255)) = o;
                }
#pragma unroll
                for (int it = 0; it < 4; ++it) {
                    const int isk = it >> 1, vi = (it & 1) * 8 + (lane >> 3), sub = lane & 7;
                    const bf16r* src = zr + (isk ? OFF_C_K : OFF_C_Q) + vi * 128 + sub * 8;
                    const v4u av = __builtin_nontemporal_load((const v4u*)src), cv = __builtin_nontemporal_load((const v4u*)(src + 64));
                    float x1[8] = {bflo(av.x), bfhi(av.x), bflo(av.y), bfhi(av.y), bflo(av.z), bfhi(av.z), bflo(av.w), bfhi(av.w)};
                    float x2[8] = {bflo(cv.x), bfhi(cv.x), bflo(cv.y), bfhi(cv.y), bflo(cv.z), bfhi(cv.z), bflo(cv.w), bfhi(cv.w)};
                    float ss = 0.f;
#pragma unroll
                    for (int e = 0; e < 8; ++e) ss += x1[e] * x1[e] + x2[e] * x2[e];
                    ss += __shfl_xor(ss, 1); ss += __shfl_xor(ss, 2); ss += __shfl_xor(ss, 4);
                    const float rs = 1.0f / sqrtf(ss * (1.0f / 128.0f) + NORM_EPS);
                    const float* gp = (isk ? kg : qg) + sub * 8;
                    const f32x4 g1a = *(const f32x4*)gp, g1b = *(const f32x4*)(gp + 4), g2a = *(const f32x4*)(gp + 64), g2b = *(const f32x4*)(gp + 68);
                    const f32x4 ca = *(const f32x4*)(ROPE_COS + t * 64 + sub * 8), cb = *(const f32x4*)(ROPE_COS + t * 64 + sub * 8 + 4);
                    const f32x4 sa = *(const f32x4*)(ROPE_SIN + t * 64 + sub * 8), sb = *(const f32x4*)(ROPE_SIN + t * 64 + sub * 8 + 4);
                    const float g1[8] = {g1a.x, g1a.y, g1a.z, g1a.w, g1b.x, g1b.y, g1b.z, g1b.w}, g2[8] = {g2a.x, g2a.y, g2a.z, g2a.w, g2b.x, g2b.y, g2b.z, g2b.w};
                    const float cc[8] = {ca.x, ca.y, ca.z, ca.w, cb.x, cb.y, cb.z, cb.w}, sn[8] = {sa.x, sa.y, sa.z, sa.w, sb.x, sb.y, sb.z, sb.w};
                    float o1[8], o2[8];
#pragma unroll
                    for (int e = 0; e < 8; ++e) { const float y1 = x1[e] * rs * g1[e], y2 = x2[e] * rs * g2[e]; o1[e] = y1 * cc[e] - y2 * sn[e]; o2[e] = y2 * cc[e] + y1 * sn[e]; }
                    bf16r* dst = (isk ? KH : QH) + ((size_t)(b * 16 + vi) * SEQ + t) * 128 + sub * 8;
                    v4u w1, w2; w1.x = pk2(o1[0], o1[1]); w1.y = pk2(o1[2], o1[3]); w1.z = pk2(o1[4], o1[5]); w1.w = pk2(o1[6], o1[7]);
                    w2.x = pk2(o2[0], o2[1]); w2.y = pk2(o2[2], o2[3]); w2.z = pk2(o2[4], o2[5]); w2.w = pk2(o2[6], o2[7]);
                    *(v4u*)dst = w1; *(v4u*)(dst + 64) = w2;
                }
            }
            }
            SEAM4(pb + 2, 8 * l + 3);
        }

        if (ENK(3) && IN(pb + 3)) {
            PHASE_IDS;
#pragma unroll 1
            for (int rep_ = 0; rep_ < REPS(3); ++rep_) {
            bf16r* const XA = WSP(bf16r, WS_XA);
            bf16r* const W_GATE = WSP(bf16r, WS_WGATE);
            bf16r* const RI = WSP(bf16r, WS_RI);
            pg8::Gemm g{XA, W_GATE + (size_t)l * 2048 * 256, M_TOK, 2048, 256, (size_t)M_TOK * 256 * 2, 1}; pg8::StaticOrder S; S.init(M_TOK, 2048, G, bx);
            pg8::EpiBf16X<1> E{RI, 2048, karg_in(I_BR) + l * LRU_W, karg_in(I_BI) + l * LRU_W, 1024, nullptr};
            pg8::gemm_phase<pg8::EpiBf16X<1>, pg8::StaticOrder, GEMM_ALIGN, GEMM_SP2>(ldsl, g, S, E);
            }
            SEAM4(pb + 3, 8 * l + 4);
        }

        if ((ENK(4) || ENK(5)) && (IN(pb + 4) || IN(pb + 5))) {
            PHASE_IDS;
            bf16r* const XA = WSP(bf16r, WS_XA);
            bf16r* const RI = WSP(bf16r, WS_RI);
            float* const LSUM = WSP(float, WS_LSUM);
            bf16r* const Z = WSP(bf16r, WS_Z);
            const float* lam = karg_in(I_LAM) + l * LRU_W;
            const int c = tid * 2;
            const float sp0 = 8.0f * log1pf(__expf(-lam[c])), sp1 = 8.0f * log1pf(__expf(-lam[c + 1]));
            if (ENK(4) && IN(pb + 4)) {
#pragma unroll 1
                for (int rep_ = 0; rep_ < REPS(4); ++rep_)
                for (int u = PANEL_PM * 4 + PANEL_R4; u < BATCH * 64; u += BATCH * 64) {
                    const int b = u >> 6, s = u & 63;
                    float h0 = 0.f, h1 = 0.f, A0 = 0.f, A1 = 0.f;
#pragma unroll 4
                    for (int t = 0; t < 64; ++t) {
                        const size_t m = (size_t)b * SEQ + s * 64 + t;
                        const unsigned rr = *(const unsigned*)(RI + m * 2048 + (c >> 8) * 512 + (c & 255)), ii = *(const unsigned*)(RI + m * 2048 + (c >> 8) * 512 + 256 + (c & 255)), xx = *(const unsigned*)(XA + ((size_t)(c >> 8) * M_TOK + m) * 256 + (c & 255));
                        const bool first = (s == 0 && t == 0);
                        lru_step(bflo(rr), bflo(ii), bflo(xx), sp0, first, h0, A0);
                        lru_step(bfhi(rr), bfhi(ii), bfhi(xx), sp1, first, h1, A1);
                    }
                    *(f32x4*)(LSUM + ((size_t)u * LRU_W + c) * 2) = (f32x4){A0, h0, A1, h1};
                }
                SEAM(pb + 4);
            }
            if (ENK(5) && IN(pb + 5)) {
                constexpr int NHU = BATCH * 8, NCV = 64;
                const bool split = G >= 2 * (NHU + NCV);
                const int rid = bx;
                {
                    const int it0 = l * WC_LAYER + WC_IN, it1 = (l + 1 < DEPTH) ? (l + 1) * WC_LAYER + WC_IN : DEPTH * WC_LAYER;
                    LAS float* scr = (LAS float*)(ldsl + wave * 16384);
                    if (!split) convert_weights(it0, it1, gw, ngw, scr, lane);
                    else if (rid >= NHU && rid < NHU + NCV) convert_weights(it0, it1, (rid - NHU) * NWAVES + wave, NCV * NWAVES, scr, lane);
                }
                if (!split) __syncthreads();
                if (!split || rid >= NHU + NCV) {
                    const float* lg = karg_in(I_LRUG) + l * LRU_W; bf16r* const YCAT = WSP(bf16r, WS_YCAT);
                    for (int u = split ? rid - (NHU + NCV) : rid; u < BATCH * 64; u += split ? G - (NHU + NCV) : G) {
                        const int b = u >> 6, s = u & 63;
                        float h0 = 0.f, h1 = 0.f, A0 = 0.f, A1 = 0.f;
                        for (int sp = 0; sp < s; ++sp) {
                            const f32x4 v = *(const f32x4*)(LSUM + ((size_t)(b * 64 + sp) * LRU_W + c) * 2);
                            h0 = fast_exp(v.x) * h0 + v.y; h1 = fast_exp(v.z) * h1 + v.w;
                        }
#pragma unroll 1
                        for (int hb = 0; hb < 2; ++hb) {
#pragma unroll 4
                            for (int tt = 0; tt < 32; ++tt) {
                                const size_t m = (size_t)b * SEQ + s * 64 + hb * 32 + tt;
                                const unsigned rr = *(const unsigned*)(RI + m * 2048 + (c >> 8) * 512 + (c & 255)), ii = *(const unsigned*)(RI + m * 2048 + (c >> 8) * 512 + 256 + (c & 255)), xx = *(const unsigned*)(XA + ((size_t)(c >> 8) * M_TOK + m) * 256 + (c & 255));
                                const unsigned gg = *(const unsigned*)(Z + m * IN_WIDTH + OFF_A_GATE + c);
                                const bool first = (s == 0 && hb == 0 && tt == 0);
                                lru_step(bflo(rr), bflo(ii), bflo(xx), sp0, first, h0, A0);
                                lru_step(bfhi(rr), bfhi(ii), bfhi(xx), sp1, first, h1, A1);
                                *(LAS f32x2*)(ldsl + ((size_t)tt * LRU_W + c) * 4) = (f32x2){h0 * gelu_tanh(bflo(gg)), h1 * gelu_tanh(bfhi(gg))};
                            }
                            __syncthreads();
#pragma unroll
                            for (int q = 0; q < 4; ++q) {
                                const int tt = wave * 4 + q; const size_t m = (size_t)b * SEQ + s * 64 + hb * 32 + tt;
                                f32x4 v[4]; float ss = 0.f;
#pragma unroll
                                for (int j = 0; j < 4; ++j) { v[j] = *(const LAS f32x4*)(ldsl + ((size_t)tt * LRU_W + 256 * j + 4 * lane) * 4); ss += (v[j].x * v[j].x + v[j].y * v[j].y) + (v[j].z * v[j].z + v[j].w * v[j].w); }
                                ss = wave_sum(ss);
                                const float rs = 1.0f / sqrtf(ss * (1.0f / LRU_W) + NORM_EPS);
#pragma unroll
                                for (int j = 0; j < 4; ++j) { const f32x4 g = *((const f32x4*)lg + lane + 64 * j); v2u w; w.x = pk2(v[j].x * rs * g.x, v[j].y * rs * g.y); w.y = pk2(v[j].z * rs * g.z, v[j].w * rs * g.w);
                                    *((v2u*)(YCAT + m * D_MODEL) + lane + 64 * j) = w; }
                            }
                            __syncthreads();
                        }
                    }
                }
                for (int ubh = rid; ubh < NHU; ubh += G) hgrn_chunked(ldsl, Z, WSP(float, WS_LB) + l * HG_W, karg_in(I_HNG) + l * 128, WSP(bf16r, WS_YCAT), ubh >> 3, ubh & 7, tid);
                __syncthreads();
                {
                    typedef __hip_bfloat16 abf;
                    const abf* Qp = (const abf*)WSP(bf16r, WS_QH); const abf* Kp = (const abf*)WSP(bf16r, WS_KH); const abf* Vp = (const abf*)WSP(bf16r, WS_Z); abf* Op = (abf*)WSP(bf16r, WS_OATT);
                    unsigned* qctr = WSP(unsigned, WS_CTL) + 2048 + 512 * l;
                    constexpr int NQ = NQ_ALL;
                    const int x0 = bx & 7;
                    if (tid == 0) MISC[20] = 0u;
#define AQ_FETCH(dst) do { if (tid == 0) MISC[16] = (unsigned)aq_take(qctr, x0, MISC + 20); __syncthreads(); dst = (int)MISC[16]; __syncthreads(); } while (0)
                    int cur, nxt;
                    if (wave >= 4) __builtin_amdgcn_s_setprio(1);
                    AQ_FETCH(cur);
                    if (cur < NQ) {
                        AQ_FETCH(nxt);
                        ab::BlockRef<abf, abf> cref = attn_ref_q(Qp, Kp, Vp, Op, cur);
                        ab::Seam<abf> Sm;
                        ab::causal_swa_prime<abf, abf>(cref, SEQ, (char*)lds, Sm);
                        for (;;) {
                            const bool more = nxt < NQ;
                            unsigned pend = 0u;
                            if (more && wave == 0) { unsigned p_ = 0u; if (lane == 0) p_ = (unsigned)aq_take(qctr, x0, MISC + 20); pend = (unsigned)__builtin_amdgcn_readfirstlane((int)p_); }
                            const ab::BlockRef<abf, abf> nref = more ? attn_ref_q(Qp, Kp, Vp, Op, nxt) : cref;
                            ab::causal_swa_block<abf, abf>(cref, nref, SEQ, SEQ, (char*)lds, Sm);
                            if (!more) break;
                            if (tid == 0) MISC[16] = pend;
                            __syncthreads();
                            cref = nref; nxt = (int)MISC[16];
                            __syncthreads();
                        }
                    }
                    __builtin_amdgcn_s_setprio(0);
#undef AQ_FETCH
                }
                SEAM(pb + 7);
            }
        }

        if (ENK(8) && IN(pb + 8)) {
            PHASE_IDS;
#pragma unroll 1
            for (int rep_ = 0; rep_ < REPS(8); ++rep_) {
            bf16r* const OATT = WSP(bf16r, WS_OATT);
            bf16r* const Z = WSP(bf16r, WS_Z);
            bf16r* const YCAT = WSP(bf16r, WS_YCAT);
            const float lam_init = 0.8f - 0.6f * __expf(-0.3f * (float)l);
            const float* dl = karg_in(I_DLAM) + l * 4 * 128;
            float d1 = dl[lane] * dl[128 + lane] + dl[64 + lane] * dl[128 + 64 + lane];
            float d2 = dl[256 + lane] * dl[384 + lane] + dl[256 + 64 + lane] * dl[384 + 64 + lane];
            d1 = wave_sum(d1); d2 = wave_sum(d2);
            const float lamv = __expf(d1) - __expf(d2) + lam_init;
            const float* sg = karg_in(I_SUBLN) + l * 256;
            for (int m = PANEL_PM * 256 + PANEL_R4 * 64 + wave; m < PANEL_PM * 256 + PANEL_R4 * 64 + 64; m += NWAVES) {
                const int t = m & (SEQ - 1), b = m >> 12;
                bf16r* yrow = YCAT + (size_t)m * D_MODEL;
#pragma unroll
                for (int it = 0; it < 4; ++it) {
                    const int e = it * 512 + lane * 8, h = e >> 8, vh = (e >> 7) & 1, d = e & 127;
                    const bf16r* o1p = OATT + ((size_t)(b * 32 + h * 4 + 0 + vh) * SEQ + t) * 128 + d;
                    const bf16r* o2p = OATT + ((size_t)(b * 32 + h * 4 + 2 + vh) * SEQ + t) * 128 + d;
                    const v4u a = __builtin_nontemporal_load((const v4u*)o1p), c2 = __builtin_nontemporal_load((const v4u*)o2p);
                    float oc[8] = {bflo(a.x) - lamv * bflo(c2.x), bfhi(a.x) - lamv * bfhi(c2.x), bflo(a.y) - lamv * bflo(c2.y), bfhi(a.y) - lamv * bfhi(c2.y),
                                   bflo(a.z) - lamv * bflo(c2.z), bfhi(a.z) - lamv * bfhi(c2.z), bflo(a.w) - lamv * bflo(c2.w), bfhi(a.w) - lamv * bfhi(c2.w)};
                    float ss = 0.f;
#pragma unroll
                    for (int j = 0; j < 8; ++j) ss += oc[j] * oc[j];
                    ss += __shfl_xor(ss, 1); ss += __shfl_xor(ss, 2); ss += __shfl_xor(ss, 4); ss += __shfl_xor(ss, 8); ss += __shfl_xor(ss, 16);
                    const float rs = (1.0f - lam_init) / sqrtf(ss * (1.0f / 256.0f) + NORM_EPS);
                    const f32x4 g0 = *(const f32x4*)(sg + (e & 255)), g1 = *(const f32x4*)(sg + (e & 255) + 4);
                    v4u w; w.x = pk2(oc[0] * rs * g0.x, oc[1] * rs * g0.y); w.y = pk2(oc[2] * rs * g0.z, oc[3] * rs * g0.w); w.z = pk2(oc[4] * rs * g1.x, oc[5] * rs * g1.y); w.w = pk2(oc[6] * rs * g1.z, oc[7] * rs * g1.w);
                    *(v4u*)(yrow + 2048 + e) = w;
                }
            }
            }
            SEAM4(pb + 8, 8 * l + 5);
        }

        if (ENK(9) && IN(pb + 9)) {
            PHASE_IDS;
#pragma unroll 1
            for (int rep_ = 0; rep_ < REPS(9); ++rep_) {
            bf16r* const YCAT = WSP(bf16r, WS_YCAT);
            bf16r* const W_OUT = WSP(bf16r, WS_WOUT);
            bf16r* const XB = WSP(bf16r, WS_H);
            pg8::Gemm g{YCAT, W_OUT + (size_t)l * D_MODEL * D_MODEL, M_TOK, D_MODEL, D_MODEL}; pg8::StaticOrder S; S.init(M_TOK, D_MODEL, G, bx);
            pg8::EpiResX E{(l == 0) ? karg_in(I_X) : (const float*)nullptr, XB, nullptr, XB, WSP(float, WS_PSS) + (size_t)(2 * l) * 64 * M_TOK, D_MODEL, M_TOK};
            pg8::gemm_phase<pg8::EpiResX, pg8::StaticOrder, GEMM_ALIGN, GEMM_SP2>(ldsl, g, S, E);
            }
            SEAM4(pb + 9, 8 * l + 0);
        }

        if (ENK(11) && IN(pb + 11)) {
            PHASE_IDS;
#pragma unroll 1
            for (int rep_ = 0; rep_ < REPS(11); ++rep_) {
            bf16r* const HB = WSP(bf16r, WS_H);
            bf16r* const W_FF1 = WSP(bf16r, WS_WFF1);
            bf16r* const HID = WSP(bf16r, WS_HID);
            pg8::Gemm g{HB, W_FF1 + (size_t)l * D_FF * D_MODEL, M_TOK, D_FF, D_MODEL}; pg8::StaticOrder S; S.init(M_TOK, D_FF, G, bx);
            { const float* pssp = WSP(float, WS_PSS) + (size_t)(2 * l) * 64 * M_TOK;
              pg8::Unit u0; if (S.next(0, u0)) RS_TABLE_FILL(pssp, 64, u0.pm); }
            pg8::EpiBf16X<2> E{HID, D_FF_LD, nullptr, nullptr, 0, (const LAS float*)(ldsl + RS_TABLE_OFF)};
            pg8::gemm_phase<pg8::EpiBf16X<2>, pg8::StaticOrder, GEMM_ALIGN, GEMM_SP2>(ldsl, g, S, E);
            }
            SEAM4(pb + 11, 8 * l + 1);
        }

        if (ENK(12) && IN(pb + 12)) {
            PHASE_IDS;
#pragma unroll 1
            for (int rep_ = 0; rep_ < REPS(12); ++rep_) {
            bf16r* const HID = WSP(bf16r, WS_HID);
            bf16r* const W_FF2 = WSP(bf16r, WS_WFF2);
            float* const OUT = karg_out();
            pg8::Gemm g{HID, W_FF2 + (size_t)l * D_MODEL * D_FF_LD, M_TOK, D_MODEL, D_FF, 0, 0, D_FF_LD}; pg8::StaticOrder S; S.init(M_TOK, D_MODEL, G, bx);
            bf16r* const XB = WSP(bf16r, WS_H);
            pg8::EpiResX E{nullptr, XB, (l + 1 == DEPTH) ? OUT : (float*)nullptr, XB, WSP(float, WS_PSS) + (size_t)1 * 64 * M_TOK, D_MODEL, M_TOK};
            pg8::gemm_phase<pg8::EpiResX, pg8::StaticOrder, GEMM_ALIGN, GEMM_SP2>(ldsl, g, S, E);
            }
            SEAM(pb + 12);
        }
    }
#if defined(DBG_STAMP_MASK)
    if (multi) {
        xcd_barrier(bar);
        if (blockIdx.x == 0 && threadIdx.x == 0) {
            const unsigned long long* st = WSP(unsigned long long, 12 * MiB);
            double idle = 0.0, lat = 0.0;
            for (int k = 0; k < N_PHASES - 1; ++k) {
                if (!((DBG_STAMP_MASK >> k) & 1)) continue;
                unsigned long long amax = 0, emax = 0; double asum = 0.0; bool any = false;
                for (int b2 = 0; b2 < G; ++b2) { const unsigned long long a = st[(k * 2 + 0) * 256 + b2], e = st[(k * 2 + 1) * 256 + b2]; if (a == 0xAAAAAAAAAAAAAAAAull) continue; any = true; amax = a > amax ? a : amax; emax = e > emax ? e : emax; asum += (double)a; }
                if (!any) continue;
                idle += (double)amax - asum / (double)G; lat += (double)emax - (double)amax;
            }
            karg_out()[0] = (float)(floor(idle * 0.01 / 200.0 + 0.5) * 200.0 * 1.0e4);
            karg_out()[1] = (float)(floor(lat * 0.01 / 100.0 + 0.5) * 100.0 * 1.0e4);
        }
    }
#endif
#undef IN
#undef SEAM
#undef SEAM4
#undef SEAM4H
}


#ifndef MK_PER_PHASE
#define MK_PER_PHASE 0
#endif
extern "C" void kernel_launch(void* const* d_in, const int* in_sizes, int n_in, void* d_out, int out_size, void* d_ws, size_t ws_size, hipStream_t stream) {
    static int grid = 0;
    if (grid == 0) {
        if (n_in != N_INPUTS || out_size != M_TOK * D_MODEL || ws_size < WS_END) { fprintf(stderr, "kernel_launch: unexpected shapes (n_in %d, out %d, ws %zu < %zu); nothing launched\n", n_in, out_size, ws_size, (size_t)WS_END); grid = -1; return; }
        int dev = 0, cus = 0;
        if (hipGetDevice(&dev) != hipSuccess || hipDeviceGetAttribute(&cus, hipDeviceAttributeMultiprocessorCount, dev) != hipSuccess || cus <= 0) { fprintf(stderr, "kernel_launch: device query failed\n"); grid = -1; return; }
        if (hipFuncSetAttribute((const void*)hymba_fwd, hipFuncAttributeMaxDynamicSharedMemorySize, LDS_BYTES) != hipSuccess) { fprintf(stderr, "kernel_launch: hipFuncSetAttribute failed\n"); grid = -1; return; }
        int per_cu = 0;
        if (hipOccupancyMaxActiveBlocksPerMultiprocessor(&per_cu, (const void*)hymba_fwd, NTHREADS, LDS_BYTES) != hipSuccess || per_cu < 1) fprintf(stderr, "kernel_launch: occupancy query reports %d blocks per CU\n", per_cu);
        (void)hipGetLastError();
        grid = cus;
        if (grid != 256) { fprintf(stderr, "kernel_launch: built for a 256-CU device (one row panel per workgroup in the z and ff1 GEMM phases); this device reports %d CUs; nothing launched\n", cus); grid = -1; return; }
    }
    if (grid < 0) return;
    (void)in_sizes;
    if (hipMemsetAsync((char*)d_ws + WS_CTL, 0, CTL_ZERO_BYTES, stream) != hipSuccess) { fprintf(stderr, "kernel_launch: memset failed\n"); return; }
    Args a{};
    for (int i = 0; i < N_INPUTS; ++i) a.in[i] = (const float*)d_in[i];
    a.out = (float*)d_out; a.ws = (unsigned char*)d_ws;
#if MK_PER_PHASE
    for (int p = 0; p < N_PHASES; ++p) { a.ph_lo = p; a.ph_hi = p + 1; hipLaunchKernelGGL(hymba_fwd, dim3(grid), dim3(NTHREADS), LDS_BYTES, stream, a); }
#else
    a.ph_lo = 0; a.ph_hi = N_PHASES;
    hipLaunchKernelGGL(hymba_fwd, dim3(grid), dim3(NTHREADS), LDS_BYTES, stream, a);
#endif
    const hipError_t le = hipPeekAtLastError();
    if (le != hipSuccess) fprintf(stderr, "kernel_launch: launch failed: %s\n", hipGetErrorName(le));
}
```

```cpp
#include <hip/hip_runtime.h>
#include <hip/hip_bf16.h>
#include <cstdio>
#include <cstdint>
__device__ __forceinline__ int tid_opaque() { int t = threadIdx.x; asm volatile("" : "+v"(t)); return t; }
typedef __bf16 hw_bf16x2 __attribute__((ext_vector_type(2)));
typedef float hw_f32x2 __attribute__((ext_vector_type(2)));
__device__ __forceinline__ unsigned pk_bf16_builtin(float lo, float hi) { hw_f32x2 f = {lo, hi}; hw_bf16x2 r = __builtin_convertvector(f, hw_bf16x2); return __builtin_bit_cast(unsigned, r); }
namespace pg8 {
#define PG8_LAS __attribute__((address_space(3)))
typedef unsigned short bf16_t;
typedef short bf16x8 __attribute__((ext_vector_type(8)));
typedef float f32x4 __attribute__((ext_vector_type(4)));
typedef unsigned u32x4 __attribute__((ext_vector_type(4)));
constexpr int BM = 256, BK = 64, HALF = 128, HTB = HALF * BK * 2  , STAGE_BYTES = 8 * HTB, NXCD = 8, WGM = 8;

__host__ __device__ __forceinline__ int lds_byte(int r, int c) { const int st = (r >> 4) * 2 + (c >> 5), rr = r & 15, cc = c & 31, ob = rr * 64 + cc * 2; return st * 1024 + (ob ^ (((ob >> 9) & 1) << 5)); }
__host__ __device__ __forceinline__ void stage_rc(int b, int& R, int& C) { const int st = b / 1024, sb = b % 1024, swz = sb ^ (((sb >> 9) & 1) << 5); R = (st >> 1) * 16 + swz / 64; C = (st & 1) * 32 + (swz % 64) / 2; }
__host__ __device__ __forceinline__ int perm32(int rho) { const int n = rho >> 4, i = rho & 15; return 8 * (i >> 2) + 4 * n + (i & 3); }

struct Unit { int pm, pn; };
struct Gemm { const bf16_t* A; const bf16_t* Bt; int M, N, K; size_t a_pn_stride = 0; int a_pn_shift = 0; int ld = 0;
    __device__ __forceinline__ size_t aoff(int pn) const { return (size_t)(pn >> a_pn_shift) * a_pn_stride; } };

struct StaticOrder {
    int nM, nN, nwg, G, c;
    __host__ __device__ void init(int M, int N, int G_, int c_) { nM = M / BM; nN = N / BM; nwg = nM * nN; G = G_; c = c_; }
    __host__ __device__ bool next(int i, Unit& u) const {
        const long L = (long)i * G + c; if (L >= nwg) return false;
        int wgid = (int)L; { const int q = nwg / NXCD, r = nwg % NXCD, xcd = wgid % NXCD, off = wgid / NXCD; wgid = (xcd < r ? xcd * (q + 1) : r * (q + 1) + (xcd - r) * q) + off; }
        const int nig = WGM * nN, gid = wgid / nig, fm = gid * WGM, gsz = (nM - fm) < WGM ? (nM - fm) : WGM;
        u.pm = fm + ((wgid % nig) % gsz); u.pn = (wgid % nig) / gsz; return true;
    }
    __device__ __forceinline__ void a_ready(const Unit&) const {}
    __device__ __forceinline__ void done(const Unit&) const {}
};

__device__ __forceinline__ unsigned cvt_pk_bf16(float lo, float hi) { return pk_bf16_builtin(lo, hi); }
typedef float f32x2 __attribute__((ext_vector_type(2)));
__device__ __forceinline__ f32x2 gelu_pk(f32x2 v) {
    const f32x2 av = __builtin_elementwise_abs(v), d = av * 0.2316418882f + 1.0f;
    f32x2 t; t.x = __builtin_amdgcn_rcpf(d.x); t.y = __builtin_amdgcn_rcpf(d.y);
    f32x2 q = t * 0.5307027145f + (-0.7265760135f); q = q * t + 0.7107068705f; q = q * t + (-0.142248368f); q = q * t + 0.127414796f; q = q * t;
    const f32x2 s = (v * v) * (-0.72134752044f);
    f32x2 e; e.x = __builtin_amdgcn_exp2f(s.x); e.y = __builtin_amdgcn_exp2f(s.y);
    const f32x2 m = v * (q * e), r = v - m;
    f32x2 o; o.x = v.x < 0.f ? m.x : r.x; o.y = v.y < 0.f ? m.y : r.y; return o;
}

template <int ACT> struct EpiBf16X {
    static constexpr bool PERM = true, AFTER_DRAIN = false;
    bf16_t* O; int ldc; const float* bias0; const float* bias1; int bias_split;
    const PG8_LAS float* rs_lds;
    __device__ __forceinline__ void operator()(const f32x4 (&acc)[2][2][4][2], const Unit& u, int wr, int wc, int fr, int fq) const {
        const int row0 = u.pm * BM + wr * 64 + fr; const int colt = u.pn * BM;
        const int col0 = colt + wc * 32 + 8 * fq;
        f32x4 bv[2][2];
#pragma unroll
        for (int bj = 0; bj < 2; ++bj)
#pragma unroll
            for (int n = 0; n < 2; ++n) {
                if (ACT == 1) { const float* bp = ((u.pn & 1) ? bias1 : bias0) + (u.pn >> 1) * BM + (col0 - colt); bv[bj][n] = *(const f32x4*)(bp + bj * HALF + 4 * n); }
                else bv[bj][n] = (f32x4){0.f, 0.f, 0.f, 0.f};
            }
#pragma unroll
        for (int ai = 0; ai < 2; ++ai)
#pragma unroll
            for (int m = 0; m < 4; ++m) { bf16_t* rowp = O + (size_t)(row0 + ai * HALF + m * 16) * ldc + col0;
                float rsc = 1.0f;
                if (rs_lds) rsc = rs_lds[wr * 64 + fr + ai * HALF + m * 16];
#pragma unroll
                for (int bj = 0; bj < 2; ++bj) { f32x4 v0 = (acc[ai][bj][m][0] + bv[bj][0]) * rsc, v1 = (acc[ai][bj][m][1] + bv[bj][1]) * rsc;
                    if (ACT == 1) {
#pragma unroll
                        for (int j = 0; j < 4; ++j) { v0[j] = __builtin_amdgcn_rcpf(1.0f + __builtin_amdgcn_exp2f(-1.4426950408889634f * v0[j])); v1[j] = __builtin_amdgcn_rcpf(1.0f + __builtin_amdgcn_exp2f(-1.4426950408889634f * v1[j])); } }
                    if (ACT == 2) {
#pragma unroll
                        for (int j = 0; j < 4; ++j) { const float a = fmaxf(v0[j], 0.f), b = fmaxf(v1[j], 0.f); v0[j] = a * a; v1[j] = b * b; } }
                    u32x4 w; w.x = cvt_pk_bf16(v0[0], v0[1]); w.y = cvt_pk_bf16(v0[2], v0[3]); w.z = cvt_pk_bf16(v1[0], v1[1]); w.w = cvt_pk_bf16(v1[2], v1[3]);
                    *(u32x4*)(rowp + bj * HALF) = w; } }
    }
};
struct EpiResX {
    static constexpr bool PERM = true, AFTER_DRAIN = false;
    const float* basef; const bf16_t* baseh; float* outf; bf16_t* outh; float* pss; int ldc, nrows;
    __device__ __forceinline__ void operator()(const f32x4 (&acc)[2][2][4][2], const Unit& u, int wr, int wc, int fr, int fq) const {
        const int row0 = u.pm * BM + wr * 64 + fr, col0 = u.pn * BM + wc * 32 + 8 * fq;
        float ssq[2][4];
#pragma unroll
        for (int ai = 0; ai < 2; ++ai)
#pragma unroll
            for (int m = 0; m < 4; ++m) { const size_t off = (size_t)(row0 + ai * HALF + m * 16) * ldc + col0;
                float sq = 0.f;
#pragma unroll
                for (int bj = 0; bj < 2; ++bj) {
                    f32x4 b0, b1;
                    if (basef) { b0 = *(const f32x4*)(basef + off + bj * HALF); b1 = *(const f32x4*)(basef + off + bj * HALF + 4); }
                    else { const u32x4 w = *(const u32x4*)(baseh + off + bj * HALF);
                        b0 = (f32x4){__uint_as_float(w.x << 16), __uint_as_float(w.x & 0xffff0000u), __uint_as_float(w.y << 16), __uint_as_float(w.y & 0xffff0000u)};
                        b1 = (f32x4){__uint_as_float(w.z << 16), __uint_as_float(w.z & 0xffff0000u), __uint_as_float(w.w << 16), __uint_as_float(w.w & 0xffff0000u)}; }
                    const f32x4 v0 = acc[ai][bj][m][0] + b0, v1 = acc[ai][bj][m][1] + b1;
                    if (outf) { *(f32x4*)(outf + off + bj * HALF) = v0; *(f32x4*)(outf + off + bj * HALF + 4) = v1; }
                    else { u32x4 w; w.x = cvt_pk_bf16(v0[0], v0[1]); w.y = cvt_pk_bf16(v0[2], v0[3]); w.z = cvt_pk_bf16(v1[0], v1[1]); w.w = cvt_pk_bf16(v1[2], v1[3]);
                        *(u32x4*)(outh + off + bj * HALF) = w;
                        sq += ((v0[0] * v0[0] + v0[1] * v0[1]) + (v0[2] * v0[2] + v0[3] * v0[3])) + ((v1[0] * v1[0] + v1[1] * v1[1]) + (v1[2] * v1[2] + v1[3] * v1[3])); } }
                ssq[ai][m] = sq;
                asm volatile("" ::: "memory"); }
        if (!outf) {
#pragma unroll
            for (int ai = 0; ai < 2; ++ai)
#pragma unroll
                for (int m = 0; m < 4; ++m) ssq[ai][m] += __shfl_xor(ssq[ai][m], 16);
#pragma unroll
            for (int ai = 0; ai < 2; ++ai)
#pragma unroll
                for (int m = 0; m < 4; ++m) ssq[ai][m] += __shfl_xor(ssq[ai][m], 32);
            if (fq == 0) {
#pragma unroll
                for (int ai = 0; ai < 2; ++ai)
#pragma unroll
                    for (int m = 0; m < 4; ++m) pss[(size_t)(u.pn * 4 + wc) * nrows + (row0 + ai * HALF + m * 16)] = ssq[ai][m];
            }
        }
    }
};
template <class Epi, class Sched, bool ALIGN_EPI = false, bool SP2 = false>
__device__ __forceinline__ void gemm_phase(PG8_LAS unsigned char* lds, const Gemm g, const Sched& S, const Epi& E) {
    const int tid = tid_opaque(), wid = __builtin_amdgcn_readfirstlane(tid >> 6), lane = tid & 63, wr = wid >> 2, wc = wid & 3, fr = lane & 15, fq = lane >> 4;
    const int K = g.K, nt = K / BK, LD = g.ld ? g.ld : K;
    unsigned voffA[2], voffB[2];
#pragma unroll
    for (int i = 0; i < 2; ++i) { int R, C; stage_rc(tid * 16 + i * 8192, R, C); const int Rb = Epi::PERM ? ((R & ~31) + perm32(R & 31)) : R;
        voffA[i] = (unsigned)(R * LD + C) * 2u; voffB[i] = (unsigned)(Rb * LD + C) * 2u; }
    const size_t kstep = (size_t)(BK * 2);
    const size_t hstep = (size_t)HALF * LD * 2;
    const size_t tstep = 2 * hstep;
    const unsigned ldsw = (unsigned)wid * 1024u;
    const int aoff = lds_byte(wr * 64 + fr, fq * 8), boff = lds_byte(wc * 32 + fr, fq * 8);
#define PG8_SA(b, h) (((b) * 2 + (h)) * HTB)
#define PG8_SB(b, h) ((4 + (b) * 2 + (h)) * HTB)
#define PG8_STAGE(bufoff, gbase, voff) do { _Pragma("unroll") for (int _i = 0; _i < 2; ++_i) \
        __builtin_amdgcn_global_load_lds((const unsigned*)((const char*)(gbase) + (voff)[_i]), (PG8_LAS unsigned*)(lds + (bufoff) + ldsw + _i * 8192), 16, 0, 0); } while (0)
#define PG8_LDA(dst, b, h) do { _Pragma("unroll") for (int m = 0; m < 4; ++m) _Pragma("unroll") for (int k = 0; k < 2; ++k) dst[m][k] = *(const PG8_LAS bf16x8*)(lds + PG8_SA(b, h) + aoff + m * 2048 + k * 1024); } while (0)
#define PG8_LDB(dst, b, h) do { _Pragma("unroll") for (int n = 0; n < 2; ++n) _Pragma("unroll") for (int k = 0; k < 2; ++k) dst[n][k] = *(const PG8_LAS bf16x8*)(lds + PG8_SB(b, h) + boff + n * 2048 + k * 1024); } while (0)
#define PG8_MMA(ai, bj, At, Bt) do { __builtin_amdgcn_s_setprio(1); _Pragma("unroll") for (int m = 0; m < 4; ++m) _Pragma("unroll") for (int n = 0; n < 2; ++n) _Pragma("unroll") for (int k = 0; k < 2; ++k) \
        acc[ai][bj][m][n] = __builtin_amdgcn_mfma_f32_16x16x32_bf16(Bt[n][k], At[m][k], acc[ai][bj][m][n], 0, 0, 0); __builtin_amdgcn_s_setprio(0); } while (0)
#define PG8_WAIT_V(n) asm volatile("s_waitcnt vmcnt(" #n ")" ::: "memory")
#define PG8_WAIT_L(n) asm volatile("s_waitcnt lgkmcnt(" #n ")" ::: "memory")
#define PG8_BAR __builtin_amdgcn_s_barrier()
#define PG8_SCHED __builtin_amdgcn_sched_barrier(0)
    Unit cur, nxt; int ui = 0;
    if (!S.next(0, cur)) return;
    f32x4 acc[2][2][4][2];
#pragma unroll
    for (int a = 0; a < 2; ++a)
#pragma unroll
        for (int b = 0; b < 2; ++b)
#pragma unroll
            for (int m = 0; m < 4; ++m)
#pragma unroll
                for (int n = 0; n < 2; ++n) acc[a][b][m][n] = (f32x4){0.f, 0.f, 0.f, 0.f};
    bf16x8 At[4][2], B0[2][2], B1[2][2];
    const char* cA = (const char*)g.A + (size_t)cur.pm * tstep + g.aoff(cur.pn); const char* cB = (const char*)g.Bt + (size_t)cur.pn * tstep;
    S.a_ready(cur);
    if constexpr (SP2) {
        PG8_STAGE(PG8_SB(0, 0), cB, voffB); PG8_STAGE(PG8_SB(0, 1), cB + hstep, voffB); PG8_STAGE(PG8_SA(0, 0), cA, voffA); PG8_STAGE(PG8_SA(0, 1), cA + hstep, voffA);
        if (wr == 1) PG8_BAR;
        PG8_WAIT_V(2); PG8_BAR;
        PG8_STAGE(PG8_SB(1, 0), cB + kstep, voffB); PG8_STAGE(PG8_SA(1, 0), cA + kstep, voffA); PG8_STAGE(PG8_SB(1, 1), cB + hstep + kstep, voffB);
        PG8_WAIT_V(6); PG8_BAR;
    } else {
        PG8_STAGE(PG8_SB(0, 0), cB, voffB); PG8_STAGE(PG8_SA(0, 0), cA, voffA); PG8_STAGE(PG8_SB(0, 1), cB + hstep, voffB); PG8_STAGE(PG8_SA(0, 1), cA + hstep, voffA);
        if (wr == 1) PG8_BAR;
        PG8_WAIT_V(4); PG8_BAR;
        PG8_STAGE(PG8_SB(1, 0), cB + kstep, voffB); PG8_STAGE(PG8_SA(1, 0), cA + kstep, voffA); PG8_STAGE(PG8_SB(1, 1), cB + hstep + kstep, voffB);
        PG8_WAIT_V(6); PG8_BAR;
    }
    for (;;) {
        const bool has_next = S.next(ui + 1, nxt);
        const char* nA = has_next ? (const char*)g.A + (size_t)nxt.pm * tstep + g.aoff(nxt.pn) : cA; const char* nB = has_next ? (const char*)g.Bt + (size_t)nxt.pn * tstep : cB;
        _Pragma("unroll 1")
        for (int t = 0; t < nt; t += 2) {
            const bool last = (t == nt - 2);
            const char* a1 = cA + (size_t)(t + 1) * kstep;
            const char* a2 = last ? nA : cA + (size_t)(t + 2) * kstep; const char* b2 = last ? nB : cB + (size_t)(t + 2) * kstep;
            const char* a3 = a2 + kstep; const char* b3 = b2 + kstep;
            if (last && has_next) S.a_ready(nxt);
            if constexpr (SP2) {
            PG8_LDB(B0, 0, 0); PG8_LDB(B1, 0, 1); PG8_SCHED; PG8_LDA(At, 0, 0); PG8_STAGE(PG8_SA(1, 1), a1 + hstep, voffA);
            PG8_WAIT_V(8); PG8_WAIT_L(0); PG8_BAR; PG8_MMA(0, 0, At, B0); PG8_MMA(0, 1, At, B1); PG8_BAR; PG8_SCHED;
            PG8_LDA(At, 0, 1); PG8_STAGE(PG8_SB(0, 0), b2, voffB); PG8_STAGE(PG8_SB(0, 1), b2 + hstep, voffB); PG8_STAGE(PG8_SA(0, 0), a2, voffA);
            PG8_WAIT_V(8); PG8_WAIT_L(0); PG8_BAR; PG8_MMA(1, 0, At, B0); PG8_MMA(1, 1, At, B1); PG8_BAR; PG8_SCHED;
            PG8_LDB(B0, 1, 0); PG8_LDB(B1, 1, 1); PG8_SCHED; PG8_LDA(At, 1, 0); PG8_STAGE(PG8_SA(0, 1), a2 + hstep, voffA);
            PG8_WAIT_V(8); PG8_WAIT_L(0); PG8_BAR; PG8_MMA(0, 0, At, B0); PG8_MMA(0, 1, At, B1); PG8_BAR; PG8_SCHED;
            PG8_LDA(At, 1, 1); PG8_STAGE(PG8_SB(1, 0), b3, voffB); PG8_STAGE(PG8_SB(1, 1), b3 + hstep, voffB); PG8_STAGE(PG8_SA(1, 0), a3, voffA);
            PG8_WAIT_V(8); PG8_WAIT_L(0); PG8_BAR; PG8_MMA(1, 0, At, B0); PG8_MMA(1, 1, At, B1); PG8_BAR; PG8_SCHED;
            } else {
            PG8_LDB(B0, 0, 0); PG8_SCHED; PG8_LDA(At, 0, 0); PG8_STAGE(PG8_SA(1, 1), a1 + hstep, voffA);
            PG8_WAIT_L(8); PG8_BAR; PG8_WAIT_L(0); PG8_MMA(0, 0, At, B0); PG8_BAR; PG8_SCHED;
            PG8_LDB(B1, 0, 1); PG8_STAGE(PG8_SB(0, 0), b2, voffB);
            PG8_BAR; PG8_WAIT_L(0); PG8_MMA(0, 1, At, B1); PG8_BAR;
            PG8_LDA(At, 0, 1); PG8_STAGE(PG8_SA(0, 0), a2, voffA);
            PG8_BAR; PG8_WAIT_L(0); PG8_MMA(1, 0, At, B0); PG8_BAR; PG8_SCHED;
            PG8_STAGE(PG8_SB(0, 1), b2 + hstep, voffB);
            PG8_WAIT_V(6); PG8_BAR; PG8_MMA(1, 1, At, B1); PG8_BAR;
            PG8_LDB(B0, 1, 0); PG8_SCHED; PG8_LDA(At, 1, 0); PG8_STAGE(PG8_SA(0, 1), a2 + hstep, voffA);
            PG8_WAIT_L(8); PG8_BAR; PG8_WAIT_L(0); PG8_MMA(0, 0, At, B0); PG8_BAR; PG8_SCHED;
            PG8_LDB(B1, 1, 1); PG8_STAGE(PG8_SB(1, 0), b3, voffB);
            PG8_BAR; PG8_WAIT_L(0); PG8_MMA(0, 1, At, B1); PG8_BAR;
            PG8_LDA(At, 1, 1); PG8_STAGE(PG8_SA(1, 0), a3, voffA);
            PG8_BAR; PG8_WAIT_L(0); PG8_MMA(1, 0, At, B0); PG8_BAR; PG8_SCHED;
            PG8_STAGE(PG8_SB(1, 1), b3 + hstep, voffB);
            PG8_WAIT_V(6); PG8_BAR; PG8_MMA(1, 1, At, B1); PG8_BAR;
            }
        }
        if constexpr (ALIGN_EPI) { if (wr == 0) PG8_BAR; }
        if constexpr (!Epi::AFTER_DRAIN) { E(acc, cur, wr, wc, fr, fq); S.done(cur); }
        if (!has_next) break;
#pragma unroll
        for (int a = 0; a < 2; ++a)
#pragma unroll
            for (int b = 0; b < 2; ++b)
#pragma unroll
                for (int m = 0; m < 4; ++m)
#pragma unroll
                    for (int n = 0; n < 2; ++n) acc[a][b][m][n] = (f32x4){0.f, 0.f, 0.f, 0.f};
        cur = nxt; cA = nA; cB = nB; ++ui;
        if constexpr (ALIGN_EPI) { if (wr == 1) PG8_BAR; }
    }
    PG8_WAIT_V(0);
    if constexpr (!ALIGN_EPI) { if (wr == 0) PG8_BAR; }
    PG8_BAR;
    if constexpr (Epi::AFTER_DRAIN) { E.fused(acc, cur, wr, wc, fr, fq, lds, wid, lane); S.done(cur); }
#undef PG8_SA
#undef PG8_SB
#undef PG8_STAGE
#undef PG8_LDA
#undef PG8_LDB
#undef PG8_MMA
#undef PG8_WAIT_V
#undef PG8_WAIT_L
#undef PG8_BAR
#undef PG8_SCHED
}
}

namespace ab {
enum { ORDER_NATURAL = 0, ORDER_REVERSED = 1, ORDER_PAIRED = 2, ORDER_XCD = 4 };
using TIN = __hip_bfloat16; using TOUT = __hip_bfloat16;
constexpr int B = 4, H = 32, HKV = 32, SQ = 4096, SKV = 4096, D = 128;
constexpr int QOFF = 0; constexpr int WINDOW = SKV; constexpr float THR = 8.f; constexpr int ORDER = ORDER_PAIRED; constexpr int GRID_WGS = 0; constexpr bool WSKIP = false;
constexpr float SCALE = 0.08838834764831845f;
constexpr int NW = 8, QBLK = 32, KVBLK = 64, QB = NW * QBLK;
constexpr int SHM_V = KVBLK * D * 2, SHM_K = KVBLK * D * 2;
constexpr int LDS_BYTES = 2 * SHM_V + 2 * SHM_K + NW * 64 * 4;
constexpr int V_ROW = 12288;
constexpr int O_STAGE = LDS_BYTES, O_STAGE_ROW = 272, O_STAGE_WAVE = 32 * O_STAGE_ROW;
using bf16 = __hip_bfloat16;
typedef short bf16x8 __attribute__((ext_vector_type(8)));
typedef short s16x4 __attribute__((ext_vector_type(4)));
typedef float f32x16 __attribute__((ext_vector_type(16)));
typedef float f32x4 __attribute__((ext_vector_type(4)));
typedef unsigned u32x4 __attribute__((ext_vector_type(4)));
template <class A, class Bt> struct same_t { static constexpr bool v = false; };
template <class A> struct same_t<A, A> { static constexpr bool v = true; };

#define KSWZ(row, colB) ((row) * 256 + ((colB) ^ (((row) & 7) << 4)))
#define SBAR() __builtin_amdgcn_sched_barrier(0)
__device__ __forceinline__ int v_st(int k, int c) { const int kk = (k & ~0xC) | ((k & 4) << 1) | ((k & 8) >> 1); return ((kk >> 3) * 4 + (c >> 5)) * 512 + ((kk & 7) * 32 + (c & 31)) * 2; }
__device__ __forceinline__ int v_rd_base(int lane) { return ((lane & 3) << 3) | (((lane >> 2) & 3) << 6) | (((lane >> 4) & 1) << 5) | (((lane >> 5) & 1) << 8); }
constexpr int v_rd_off(int d0, int ks, int half) { return d0 * 512 + ks * 4096 + half * 2048; }
__device__ __forceinline__ int crow(int r, int hi) { return (r & 3) + 8 * (r >> 2) + 4 * hi; }
__device__ __forceinline__ unsigned cvtpk(float lo, float hi) {
    return pk_bf16_builtin(lo, hi);
}
__device__ __forceinline__ bf16x8 pack8(f32x4 a, f32x4 b) {
    u32x4 w = {cvtpk(a[0], a[1]), cvtpk(a[2], a[3]), cvtpk(b[0], b[1]), cvtpk(b[2], b[3])};
    return *reinterpret_cast<bf16x8*>(&w);
}
template <class T> __device__ __forceinline__ bf16x8 load8(const T* p) {
    if constexpr (same_t<T, float>::v) { return pack8(*(const f32x4*)p, *(const f32x4*)(p + 4)); }
    else { return *reinterpret_cast<const bf16x8*>(p); }
}
__device__ __forceinline__ void mask_tile(f32x16& p0, f32x16& p1, int dq, unsigned W) {
    const float NEG = -__builtin_inff();
#pragma unroll
    for (int r = 0; r < 16; ++r) {
        const int c = (r & 3) + 8 * (r >> 2);
        if ((unsigned)(dq - c) >= W) p0[r] = NEG;
        if ((unsigned)(dq - c - 32) >= W) p1[r] = NEG;
    }
}
__device__ __forceinline__ void partialSM(f32x16& p0, f32x16& p1, float& m_reg, float& mn, float& alpha) {
    float pmax = p0[0]; for (int r = 1; r < 16; ++r) pmax = fmaxf(pmax, p0[r]); for (int r = 0; r < 16; ++r) pmax = fmaxf(pmax, p1[r]);
    { auto rr = __builtin_amdgcn_permlane32_swap(__float_as_uint(pmax), __float_as_uint(pmax), false, false);
      pmax = fmaxf(__uint_as_float(rr[0]), __uint_as_float(rr[1])); }
    constexpr float C2 = 1.4426950408889634f * SCALE;
    if (__builtin_expect(__all((pmax - m_reg) * SCALE <= THR), 1)) { mn = m_reg; alpha = 1.f; }
    else { mn = fmaxf(m_reg, pmax); alpha = __builtin_amdgcn_exp2f((m_reg - mn) * C2); m_reg = mn; }
    const float mnL = -mn * C2;
    for (int r = 0; r < 16; ++r) p0[r] = fmaf(p0[r], C2, mnL); for (int r = 0; r < 16; ++r) p1[r] = fmaf(p1[r], C2, mnL);
    for (int r = 0; r < 16; ++r) p0[r] = __builtin_amdgcn_exp2f(p0[r]);
}
__device__ __forceinline__ void finishSM(f32x16& p0, f32x16& p1, float alpha, float& l_reg, bf16x8& pa0, bf16x8& pa1, bf16x8& pa2, bf16x8& pa3) {
    for (int r = 0; r < 16; ++r) p1[r] = __builtin_amdgcn_exp2f(p1[r]);
    float ps = 0; for (int r = 0; r < 16; ++r) ps += p0[r]; for (int r = 0; r < 16; ++r) ps += p1[r];
    { auto rr = __builtin_amdgcn_permlane32_swap(__float_as_uint(ps), __float_as_uint(ps), false, false);
      ps = __uint_as_float(rr[0]) + __uint_as_float(rr[1]); }
    l_reg = l_reg * alpha + ps;
#define PK4(P, B_, OUT) do { unsigned a0 = cvtpk(P[B_+0], P[B_+1]), a1 = cvtpk(P[B_+2], P[B_+3]);                          \
        unsigned b0 = cvtpk(P[B_+4], P[B_+5]), b1 = cvtpk(P[B_+6], P[B_+7]);                                             \
        auto r0 = __builtin_amdgcn_permlane32_swap(a0, b0, false, false); auto r1 = __builtin_amdgcn_permlane32_swap(a1, b1, false, false); \
        u32x4 w = {r0[0], r1[0], r0[1], r1[1]}; OUT = *reinterpret_cast<bf16x8*>(&w); } while (0)
    PK4(p0, 0, pa0); PK4(p0, 8, pa1); PK4(p1, 0, pa2); PK4(p1, 8, pa3);
#undef PK4
}
template <int KB, bool SK>
__device__ __forceinline__ void qkt(f32x16& p0, f32x16& p1, const char* K_lds, int r32, int hi, const bf16x8* qr, bool act) {
    if (SK && !act) { const float NEG = -__builtin_inff();
#pragma unroll
        for (int r = 0; r < 16; ++r) { p0[r] = NEG; p1[r] = NEG; } return; }
    p0 = f32x16{}; p1 = f32x16{};
    const char* kb[4];
#pragma unroll
    for (int dd = 0; dd < 4; ++dd) kb[dd] = K_lds + KB * SHM_K + KSWZ(r32, (dd * 16 + hi * 8) * 2);
#pragma unroll
    for (int d0 = 0; d0 < 8; ++d0) { const char* a = kb[d0 & 3] + (d0 >> 2) * 128;
        bf16x8 b0 = *reinterpret_cast<const bf16x8*>(a);
        bf16x8 b1 = *reinterpret_cast<const bf16x8*>(a + 32 * 256);
        p0 = __builtin_amdgcn_mfma_f32_32x32x16_bf16(b0, qr[d0], p0, 0, 0, 0);
        p1 = __builtin_amdgcn_mfma_f32_32x32x16_bf16(b1, qr[d0], p1, 0, 0, 0); }
}
template <int VB, bool SK>
__device__ __forceinline__ void pv_tile(f32x16* o, int vb0, bf16x8 pa0, bf16x8 pa1, bf16x8 pa2, bf16x8 pa3, bool act) {
    if (SK && !act) return;
#define TRRD(dst, off) asm volatile("ds_read_b64_tr_b16 %0, %1 offset:%2" : "=&v"(dst) : "v"(vb0), "i"(off) : "memory")
#define PV_D0(d0) do { s16x4 l0, l1, l2, l3, h0, h1, h2, h3; constexpr int b_ = VB * SHM_V + v_rd_off(d0, 0, 0);     \
        TRRD(l0, b_); TRRD(h0, b_ + 2048); TRRD(l1, b_ + 4096); TRRD(h1, b_ + 6144); TRRD(l2, b_ + 8192); TRRD(h2, b_ + 10240); TRRD(l3, b_ + 12288); TRRD(h3, b_ + 14336); \
        asm volatile("s_waitcnt lgkmcnt(0)" ::: "memory"); SBAR();                 \
        o[d0] = __builtin_amdgcn_mfma_f32_32x32x16_bf16(pa0, (bf16x8){l0[0], l0[1], l0[2], l0[3], h0[0], h0[1], h0[2], h0[3]}, o[d0], 0, 0, 0);   \
        o[d0] = __builtin_amdgcn_mfma_f32_32x32x16_bf16(pa1, (bf16x8){l1[0], l1[1], l1[2], l1[3], h1[0], h1[1], h1[2], h1[3]}, o[d0], 0, 0, 0);   \
        o[d0] = __builtin_amdgcn_mfma_f32_32x32x16_bf16(pa2, (bf16x8){l2[0], l2[1], l2[2], l2[3], h2[0], h2[1], h2[2], h2[3]}, o[d0], 0, 0, 0);   \
        o[d0] = __builtin_amdgcn_mfma_f32_32x32x16_bf16(pa3, (bf16x8){l3[0], l3[1], l3[2], l3[3], h3[0], h3[1], h3[2], h3[3]}, o[d0], 0, 0, 0); } while (0)
    PV_D0(0); PV_D0(1); PV_D0(2); PV_D0(3);
#undef PV_D0
#undef TRRD
}

template <class TIn, class TOut> struct BlockRef { const TIn* Q; const TIn* K; const TIn* V; TOut* O; int P0; };
template <class TIn> struct Seam {
    bf16x8 qr[8];
    bf16x8 st_v0, st_v1, st_k0, st_k1; f32x4 sf0, sf1, sf2, sf3;
    f32x4 tq[16];
};
__device__ __forceinline__ int swa_jlo(int P0, int W) { const int lowk = P0 - W + 1; return lowk > 0 ? lowk / KVBLK : 0; }
#define ROW(p, k0, rr) ((p) + (size_t)((k0) + (rr)) * D + sc)
#define ROWV(p, k0, rr) ((p) + (size_t)((k0) + (rr)) * V_ROW + sc)
#define VMW() asm volatile("s_waitcnt vmcnt(0)" ::: "memory")
#define VMWN(n) asm volatile("s_waitcnt vmcnt(%0)" :: "i"(n) : "memory")
#define SLOAD_H(Kp, Vp, k0) do { S.st_v0 = load8<TIn>(ROWV(Vp, k0, sr)); S.st_v1 = load8<TIn>(ROWV(Vp, k0, 32 + sr));              \
                         S.st_k0 = load8<TIn>(ROW(Kp, k0, sr)); S.st_k1 = load8<TIn>(ROW(Kp, k0, 32 + sr)); } while (0)
#define SWRITE_HK(bf) do { *(bf16x8*)(K_lds + (bf) * SHM_K + kws) = S.st_k0; *(bf16x8*)(K_lds + (bf) * SHM_K + kws + 32 * 256) = S.st_k1; } while (0)
#define SWRITE_HV(bf) do { *(bf16x8*)(V_lds + (bf) * SHM_V + vst0) = S.st_v0; *(bf16x8*)(V_lds + (bf) * SHM_V + vst1) = S.st_v1; } while (0)
#define SWRITE_H(bf) do { SWRITE_HV(bf); SWRITE_HK(bf); } while (0)
#define SLOAD_F(p, k0) do { S.sf0 = *(const f32x4*)ROW(p, k0, sr); S.sf1 = *(const f32x4*)(ROW(p, k0, sr) + 4);                \
                            S.sf2 = *(const f32x4*)ROW(p, k0, 32 + sr); S.sf3 = *(const f32x4*)(ROW(p, k0, 32 + sr) + 4); } while (0)
#define SWRITE_KF(bf) do { *(bf16x8*)(K_lds + (bf) * SHM_K + kws) = pack8(S.sf0, S.sf1); *(bf16x8*)(K_lds + (bf) * SHM_K + kws + 32 * 256) = pack8(S.sf2, S.sf3); } while (0)
#define SWRITE_VF(bf) do { *(bf16x8*)(V_lds + (bf) * SHM_V + vst0) = pack8(S.sf0, S.sf1); *(bf16x8*)(V_lds + (bf) * SHM_V + vst1) = pack8(S.sf2, S.sf3); } while (0)
template <class TIn, class TOut>
__device__ __forceinline__ void causal_swa_prime(const BlockRef<TIn, TOut>& cur, int W, char* lds, Seam<TIn>& S) {
    constexpr bool F32 = same_t<TIn, float>::v;
    const int tid = tid_opaque(), wid = __builtin_amdgcn_readfirstlane(tid >> 6), lane = tid & 63, r32 = lane & 31, hi = lane >> 5;
    const int sr = tid >> 4, sc = (tid & 15) * 8, kws = KSWZ(sr, sc * 2); char* K_lds = lds + 2 * SHM_V;
    const int kb0 = swa_jlo(cur.P0, W) * KVBLK;
    for (int d0 = 0; d0 < 8; ++d0) S.qr[d0] = load8<TIn>(cur.Q + (size_t)(wid * QBLK + r32) * D + d0 * 16 + hi * 8);
    if constexpr (F32) { SLOAD_F((const float*)cur.K, kb0); VMW(); SWRITE_KF(0); SBAR(); SLOAD_F((const float*)cur.V, kb0); }
    else { SLOAD_H(cur.K, cur.V, kb0); VMW(); SWRITE_HK(0); }
    __syncthreads();
}
template <class TIn, class TOut>
__device__ __forceinline__ void causal_swa_block(const BlockRef<TIn, TOut>& cur, const BlockRef<TIn, TOut>& nxt, int skv, int W, char* lds, Seam<TIn>& S) {
    constexpr bool F32 = same_t<TIn, float>::v;
    const int tid = tid_opaque(), wid = __builtin_amdgcn_readfirstlane(tid >> 6), lane = tid & 63, r32 = lane & 31, hi = lane >> 5;
    const int j_lo = swa_jlo(cur.P0, W);
    int j_hi = (cur.P0 + QB - 1) / KVBLK + 1; if (j_hi > skv / KVBLK) j_hi = skv / KVBLK;
    const int NT = j_hi - j_lo;
    const int kbn = swa_jlo(nxt.P0, W) * KVBLK;
    const int qlo = cur.P0 + wid * QBLK, qm = qlo + r32 - 4 * hi;
    char* V_lds = lds; char* K_lds = lds + 2 * SHM_V;
    float* ws = (float*)(lds + 2 * SHM_V + 2 * SHM_K) + wid * 64; float* li_l = ws, * al_l = ws + 32;
    float m_reg = -1e30f, l_reg = 0; f32x16 o[4] = {};
    const int sr = tid >> 4, sc = (tid & 15) * 8, vst0 = v_st(sr, sc), vst1 = v_st(32 + sr, sc), kws = KSWZ(sr, sc * 2);
    const int vb0 = (int)(uintptr_t)V_lds + v_rd_base(lane);
    const TIn* Kh = cur.K; const TIn* Vh = cur.V;
#define RESC(a) do { if (__any((a) < 1.f)) { if (hi == 0) al_l[r32] = (a); asm volatile("s_waitcnt lgkmcnt(0)" ::: "memory");              \
                     for (int d_ = 0; d_ < 4; ++d_) for (int r = 0; r < 16; ++r) o[d_][r] *= al_l[crow(r, hi)]; } } while (0)
#define KBASE(t) ((j_lo + (t)) * KVBLK)
#define ACT(t) (KBASE(t) <= qlo + QBLK - 1 && KBASE(t) + KVBLK - 1 >= qlo - W + 1)
#define MASKT(P0_, P1_, t) do { const int kb_ = KBASE(t); if ((!SK || ACT(t)) && (kb_ + KVBLK - 1 > qlo || kb_ <= qlo + QBLK - 1 - W)) mask_tile(P0_, P1_, qm - kb_, (unsigned)W); } while (0)
    constexpr int NQL = F32 ? 16 : 8;
    constexpr bool SK = WSKIP && !F32;
#define SEAM_K0() do { VMWN(NQL); if constexpr (F32) { SWRITE_KF(0); SBAR(); SLOAD_F((const float*)nxt.V, kbn); } else { SWRITE_HK(0); } SBAR(); } while (0)
    f32x16 pA0, pA1, pB0, pB1; float mnA, mnB, alA, alB; bf16x8 pa0, pa1, pa2, pa3;
    if constexpr (F32) { VMW(); SWRITE_VF(0); SBAR(); } else { SWRITE_HV(0); SBAR(); }
    if (NT > 1) { if constexpr (F32) SLOAD_F((const float*)Kh, KBASE(1)); else SLOAD_H(Kh, Vh, KBASE(1)); }
    SBAR(); qkt<0, SK>(pA0, pA1, K_lds, r32, hi, S.qr, ACT(0));
    if constexpr (F32) { if (NT > 1) { VMW(); SWRITE_KF(1); SBAR(); SLOAD_F((const float*)Vh, KBASE(1)); } }
    MASKT(pA0, pA1, 0); partialSM(pA0, pA1, m_reg, mnA, alA);
    if (NT > 1) { VMW(); if constexpr (F32) { SWRITE_VF(1); SBAR(); if (NT > 2) SLOAD_F((const float*)Kh, KBASE(2)); } else SWRITE_H(1); }
    __syncthreads();
#define HALF_STEP(PX0, PX1, mnX, alX, PY0, PY1, alY, t, KB, VB, SB) do {                                                      \
        SBAR(); qkt<KB, SK>(PX0, PX1, K_lds, r32, hi, S.qr, ACT(t));                                             \
        finishSM(PY0, PY1, alY, l_reg, pa0, pa1, pa2, pa3); SBAR();                                                           \
        if ((t) + 1 < NT) { if constexpr (F32) { VMW(); SWRITE_KF(SB); SBAR(); SLOAD_F((const float*)Vh, KBASE((t) + 1)); }  \
                            else { SLOAD_H(Kh, Vh, KBASE((t) + 1)); } SBAR(); }                                               \
        pv_tile<VB, SK>(o, vb0, pa0, pa1, pa2, pa3, ACT((t) - 1)); MASKT(PX0, PX1, (t)); partialSM(PX0, PX1, m_reg, mnX, alX);                                        \
        __syncthreads();                                                                                                      \
        if ((t) + 1 < NT) { VMW(); if constexpr (F32) { SWRITE_VF(SB); SBAR(); if ((t) + 2 < NT) SLOAD_F((const float*)Kh, KBASE((t) + 2)); } \
                            else { SWRITE_H(SB); } }                                                                          \
        RESC(alX); __syncthreads(); } while (0)
    for (int t = 1; t + 1 < NT; t += 2) {
        HALF_STEP(pB0, pB1, mnB, alB, pA0, pA1, alA, t, 1, 0, 0);
        HALF_STEP(pA0, pA1, mnA, alA, pB0, pB1, alB, t + 1, 0, 1, 1);
    }
    const bool even = (NT & 1) == 0;
    if (even) { SBAR(); qkt<1, SK>(pB0, pB1, K_lds, r32, hi, S.qr, ACT(NT - 1)); SBAR(); }
#define QROW(e) (nxt.Q + (size_t)(wid * QBLK + r32) * D + ((e) >> 1) * 16 + hi * 8 + ((e) & 1) * 4)
    if constexpr (F32) { SLOAD_F((const float*)nxt.K, kbn); SBAR();
#pragma unroll
        for (int e = 0; e < 8; ++e) S.tq[e] = *(const f32x4*)QROW(e); }
    else { SLOAD_H(nxt.K, nxt.V, kbn); SBAR();
#pragma unroll
        for (int d0 = 0; d0 < 8; ++d0) S.qr[d0] = load8<TIn>(nxt.Q + (size_t)(wid * QBLK + r32) * D + d0 * 16 + hi * 8); }
    SBAR();
    finishSM(pA0, pA1, alA, l_reg, pa0, pa1, pa2, pa3); SBAR();
    if constexpr (F32) {
#pragma unroll
        for (int e = 8; e < 16; ++e) S.tq[e] = *(const f32x4*)QROW(e); SBAR(); }
#undef QROW
    pv_tile<0, SK>(o, vb0, pa0, pa1, pa2, pa3, ACT(even ? NT - 2 : NT - 1));
    if (even) { MASKT(pB0, pB1, NT - 1); partialSM(pB0, pB1, m_reg, mnB, alB); __syncthreads(); RESC(alB);
        finishSM(pB0, pB1, alB, l_reg, pa0, pa1, pa2, pa3); SBAR(); pv_tile<1, SK>(o, vb0, pa0, pa1, pa2, pa3, ACT(NT - 1)); }
    SBAR(); SEAM_K0();
    if (hi == 0) li_l[r32] = l_reg; asm volatile("s_waitcnt lgkmcnt(0)" ::: "memory");
    float rli[16];
#pragma unroll
    for (int r = 0; r < 16; ++r) rli[r] = __builtin_amdgcn_rcpf(li_l[crow(r, hi)]);
    TOut* Ow = cur.O + (size_t)(wid * QBLK) * D;
#pragma unroll
    for (int r = 0; r < 16; ++r) { const int orow = crow(r, hi);
#pragma unroll
        for (int d0 = 0; d0 < 4; ++d0) { const float v = o[d0][r] * rli[r];
            if constexpr (same_t<TOut, float>::v) { Ow[(size_t)orow * D + d0 * 32 + r32] = v; }
            else { *(unsigned short*)(lds + O_STAGE + wid * O_STAGE_WAVE + orow * O_STAGE_ROW + (d0 * 32 + r32) * 2) = (unsigned short)cvtpk(v, 0.f); } } }
    if constexpr (!same_t<TOut, float>::v) {
#pragma unroll
        for (int j = 0; j < 8; ++j) { const int ch = j * 64 + lane, orow = ch >> 4, c16 = ch & 15;
            *(u32x4*)((char*)(Ow + (size_t)orow * D) + c16 * 16) = *(const u32x4*)(lds + O_STAGE + wid * O_STAGE_WAVE + orow * O_STAGE_ROW + c16 * 16); } }
    if constexpr (F32) {
#pragma unroll
        for (int d0 = 0; d0 < 8; ++d0) S.qr[d0] = pack8(S.tq[2 * d0], S.tq[2 * d0 + 1]); }
    __syncthreads();
#undef RESC
#undef KBASE
#undef ACT
#undef MASKT
#undef SEAM_K0
#undef HALF_STEP
}
#undef ROW
#undef VMW
#undef VMWN
#undef SLOAD_H
#undef SWRITE_HK
#undef SWRITE_HV
#undef SWRITE_H
#undef SLOAD_F
#undef SWRITE_KF
#undef SWRITE_VF

}

#define XB_TMO      128
#define XB_XCNT(j)  (256  + 64 * (j))
#define XB_XSUB(j)  (1280 + 64 * (j))
#define XB_XGEN(j)  (2304 + 64 * (j))
#define XB_TOP      3328
#define XB_TOPGEN   3392
#define XCD_BAR_WORDS 3456
#define XB_SPIN_CAP (1u << 18)
#define LAS __attribute__((address_space(3)))

__device__ __forceinline__ unsigned xb_ld(unsigned* p)              { return __hip_atomic_load(p, __ATOMIC_RELAXED, __HIP_MEMORY_SCOPE_AGENT); }
__device__ __forceinline__ unsigned xb_add(unsigned* p, unsigned v) { return __hip_atomic_fetch_add(p, v, __ATOMIC_RELAXED, __HIP_MEMORY_SCOPE_AGENT); }
__device__ __forceinline__ unsigned xb_xcc_id() { return (unsigned)__builtin_amdgcn_s_getreg((3 << 11) | 20) & 0xFu; }
#define XB_SPIN(cond, bar) do { unsigned _sp = 0; while (cond) { __builtin_amdgcn_s_sleep(1); \
    if ((++_sp & 255u) == 0u) { if (xb_ld(&(bar)[XB_TMO])) break; if (_sp > XB_SPIN_CAP) { atomicAdd(&(bar)[XB_TMO], 1u); break; } } } } while (0)

struct XcdBarrier {
    unsigned* bar; unsigned x;
    volatile LAS unsigned* st;
};

__device__ __forceinline__ XcdBarrier xcd_barrier_post(unsigned* bar, volatile LAS unsigned* st) {
    XcdBarrier b; b.bar = bar; b.x = xb_xcc_id(); b.st = st;
    if (threadIdx.x == 0) (void)xb_add(&bar[XB_XCNT(b.x)], 1u);
    return b;
}
__device__ __forceinline__ void xcd_barrier_complete(unsigned* bar, unsigned x, unsigned& nloc, unsigned& nx) {
    const unsigned G = gridDim.x * gridDim.y * gridDim.z;
    unsigned sum, cnt, mine, sp = 0u;
    for (;;) {
        sum = 0u; cnt = 0u; mine = 0u;
#pragma unroll
        for (unsigned j = 0; j < 16; ++j) { const unsigned c = xb_ld(&bar[XB_XCNT(j)]); sum += c; cnt += (c > 0u) ? 1u : 0u; mine = (j == x) ? c : mine; }
        if (sum == G) break;
        __builtin_amdgcn_s_sleep(1);
        if ((++sp & 255u) == 0u) { if (xb_ld(&bar[XB_TMO])) break; if (sp > XB_SPIN_CAP) { atomicAdd(&bar[XB_TMO], 1u); break; } }
    }
    nloc = mine > 0u ? mine : 1u; nx = cnt > 0u ? cnt : 1u;
}

__device__ __forceinline__ void xcd_barrier(const XcdBarrier& b) {
    asm volatile("s_waitcnt vmcnt(0)" ::: "memory");
    __syncthreads();
    if (threadIdx.x == 0) {
        unsigned* bar = b.bar;
        __builtin_amdgcn_s_waitcnt(0);
        unsigned nloc = b.st[0], nx = b.st[1];
        if (nloc == 0u) { xcd_barrier_complete(bar, b.x, nloc, nx); b.st[0] = nloc; b.st[1] = nx; }
        const unsigned old = xb_add(&bar[XB_XSUB(b.x)], 1u);
        const unsigned gen = old / nloc;
        if (old + 1u == (gen + 1u) * nloc) {
            __builtin_amdgcn_fence(__ATOMIC_RELEASE, "agent");
            asm volatile("s_waitcnt vmcnt(0)" ::: "memory");
            const unsigned og = xb_add(&bar[XB_TOP], 1u);
            const unsigned tg = og / nx;
            if (og + 1u == (tg + 1u) * nx) xb_add(&bar[XB_TOPGEN], 1u);
            else XB_SPIN(xb_ld(&bar[XB_TOPGEN]) == tg, bar);
            __builtin_amdgcn_fence(__ATOMIC_ACQUIRE, "agent");
            xb_add(&bar[XB_XGEN(b.x)], 1u);
            asm volatile("s_waitcnt vmcnt(0)" ::: "memory");
        } else {
            XB_SPIN(xb_ld(&bar[XB_XGEN(b.x)]) == gen, bar);
            __builtin_amdgcn_fence(__ATOMIC_ACQUIRE, "agent");
            asm volatile("s_waitcnt vmcnt(0)" ::: "memory");
        }
    }
    __syncthreads();
}

constexpr int D_MODEL = 4096, BATCH = 4, SEQ = 4096, DEPTH = 2, M_TOK = BATCH * SEQ;
constexpr int D_FF_LD = 16384 + 128;
constexpr int IN_WIDTH = 12288, D_FF = 16384, LRU_W = 1024, HG_W = 1024, DIFF_W = 2048;
constexpr int OFF_A_GATE = 0, OFF_A_X = 1024, OFF_B_Q = 2048, OFF_B_F = 3072, OFF_B_I = 4096, OFF_B_G = 5120, OFF_C_Q = 6144, OFF_C_K = 8192, OFF_C_V = 10240;
constexpr float NORM_EPS = 1e-6f;
constexpr int NWAVES = 8, NTHREADS = NWAVES * 64;
constexpr int N_INPUTS = 21;
enum { I_X = 0, I_LN1, I_WIN, I_CONVW, I_CONVB, I_WR, I_BR, I_WI, I_BI, I_LAM, I_LRUG, I_HLB, I_HNG, I_QNG, I_KNG, I_DLAM, I_SUBLN, I_WOUT, I_LN2, I_WFF1, I_WFF2 };

constexpr size_t MiB = (size_t)1 << 20;
constexpr size_t WS_CTL = 0, CTL_ZERO_BYTES = 1 * MiB;
constexpr size_t WS_LB = 1 * MiB;
constexpr size_t WS_ROPE = 2 * MiB;
constexpr size_t WS_WGATE = 4 * MiB;
constexpr size_t WS_WIN = 16 * MiB;
constexpr size_t WS_WOUT = 208 * MiB;
constexpr size_t WS_WFF1 = 272 * MiB;
constexpr size_t WS_WFF2 = 528 * MiB;
constexpr size_t WS_H = 1904 * MiB;
constexpr size_t WS_YCAT = 912 * MiB;
constexpr size_t WS_Z = 1040 * MiB;
constexpr size_t WS_XA = 1424 * MiB;
constexpr size_t WS_RI = 1456 * MiB;
constexpr size_t WS_PSS = 1712 * MiB;
constexpr size_t WS_RS0 = 1724 * MiB;
constexpr size_t WS_QH = 1584 * MiB, WS_KH = 1648 * MiB;
constexpr size_t WS_OATT = 1776 * MiB;
constexpr size_t WS_LSUM = 2032 * MiB;
constexpr size_t WS_HID = 1040 * MiB;
constexpr size_t WS_END = 2034 * MiB;
constexpr int CW_BAR = 4096;

constexpr int RING_BYTES = 131072, LDS_BYTES = 147456, MISC_OFF = LDS_BYTES - 512;
static_assert(ab::O_STAGE + 8 * ab::O_STAGE_WAVE <= MISC_OFF, "attention LDS (tiles + output stage) must stay below the control words");

#define GAS __attribute__((address_space(1)))
typedef unsigned short bf16r;
typedef unsigned v4u __attribute__((ext_vector_type(4)));
typedef unsigned v2u __attribute__((ext_vector_type(2)));
typedef float f32x4 __attribute__((ext_vector_type(4)));
typedef float f32x2 __attribute__((ext_vector_type(2)));
#define LDS_WAIT() asm volatile("s_waitcnt lgkmcnt(0)" ::: "memory")
__device__ __forceinline__ float bflo(unsigned w) { return __uint_as_float(w << 16); }
__device__ __forceinline__ float bfhi(unsigned w) { return __uint_as_float(w & 0xffff0000u); }
__device__ __forceinline__ float bf1(bf16r b) { return __uint_as_float((unsigned)b << 16); }
__device__ __forceinline__ unsigned pk2(float lo, float hi) { return pk_bf16_builtin(lo, hi); }
__device__ __forceinline__ float wave_sum(float v) {
#pragma unroll
    for (int o = 1; o < 64; o <<= 1) v += __shfl_xor(v, o);
    return v;
}
__device__ __forceinline__ float fast_exp(float x) { return __builtin_amdgcn_exp2f(x * 1.4426950408889634f); }
__device__ __forceinline__ float sigmoidf_(float x) { return __builtin_amdgcn_rcpf(1.0f + fast_exp(-x)); }

__device__ __forceinline__ void p0_transpose_item(const float* W, int K, int N, bf16r* WT, LAS float* scr, int item, int lane, const float* kgain, int ldw) {
    const int nblk = N / 32, kb = item / nblk, nb = item % nblk, k0 = 64 * kb, n0 = 32 * nb;
    {
        const int l8 = lane & 7, lr = lane >> 3; f32x4 v[8];
#pragma unroll
        for (int i = 0; i < 8; ++i) v[i] = __builtin_nontemporal_load((const f32x4*)(W + (size_t)(k0 + 8 * i + lr) * N + n0 + 4 * l8));
#pragma unroll
        for (int i = 0; i < 8; ++i) { LAS float* d = scr + (8 * i + lr) * 33 + 4 * l8; d[0] = v[i].x; d[1] = v[i].y; d[2] = v[i].z; d[3] = v[i].w; }
    }
    LDS_WAIT(); asm volatile("" ::: "memory");
    const int c = lane & 7;
    f32x4 g0 = (f32x4){1.f, 1.f, 1.f, 1.f}, g1 = g0;
    if (kgain) { g0 = *(const f32x4*)(kgain + k0 + 8 * c); g1 = *(const f32x4*)(kgain + k0 + 8 * c + 4); }
#pragma unroll
    for (int j = 0; j < 4; ++j) { const int n = (lane >> 3) + 8 * j; const LAS float* s = scr + (8 * c) * 33 + n;
        v4u o; o.x = pk2(s[0 * 33] * g0.x, s[1 * 33] * g0.y); o.y = pk2(s[2 * 33] * g0.z, s[3 * 33] * g0.w); o.z = pk2(s[4 * 33] * g1.x, s[5 * 33] * g1.y); o.w = pk2(s[6 * 33] * g1.z, s[7 * 33] * g1.w);
        *(v4u*)(WT + (size_t)(n0 + n) * ldw + k0 + 8 * c) = o; }
    LDS_WAIT(); asm volatile("" ::: "memory");
}

struct Args { const float* in[N_INPUTS]; float* out; unsigned char* ws; int ph_lo, ph_hi; };

#ifndef GEMM_ALIGN
#define GEMM_ALIGN true
#endif
#ifndef GEMM_SP2
#define GEMM_SP2 true
#endif
constexpr int PH_PER_LAYER = 13, N_PHASES = 1 + DEPTH * PH_PER_LAYER;

__device__ __forceinline__ float neg_expm1(float x) {
    if (x > -0.3f) { float p = 1.0f + x * (1.0f / 7.0f); p = 1.0f + x * (1.0f / 6.0f) * p; p = 1.0f + x * 0.2f * p; p = 1.0f + x * 0.25f * p; p = 1.0f + x * (1.0f / 3.0f) * p; p = 1.0f + x * 0.5f * p; return -x * p; }
    return 1.0f - fast_exp(x);
}
__device__ __forceinline__ void lru_step(float r, float ig, float x, float sp8, bool first, float& h, float& A) {
    const float la = -r * sp8; const float a = fast_exp(la);
    const float mult = first ? 1.0f : sqrtf(neg_expm1(2.0f * la));
    h = a * h + mult * (ig * x); A += la;
}
__device__ __forceinline__ float gelu_tanh(float x) { const float y = 1.5957691216057308f * (x + 0.044715f * x * x * x); return x * __builtin_amdgcn_rcpf(1.0f + fast_exp(-y)); }

typedef const __attribute__((address_space(4))) unsigned char* kargp_t;
__device__ __forceinline__ kargp_t karg_base() { kargp_t kp = (kargp_t)__builtin_amdgcn_kernarg_segment_ptr(); asm volatile("" : "+s"(kp)); return kp; }
__device__ __forceinline__ const float* karg_in(int i) { return *(const float* const __attribute__((address_space(4)))*)(karg_base() + 8 * i); }
__device__ __forceinline__ float* karg_out() { return *(float* const __attribute__((address_space(4)))*)(karg_base() + 8 * N_INPUTS); }
__device__ __forceinline__ unsigned char* karg_ws() { return *(unsigned char* const __attribute__((address_space(4)))*)(karg_base() + 8 * N_INPUTS + 8); }
__device__ __forceinline__ int karg_int(int i) { return *(const int __attribute__((address_space(4)))*)(karg_base() + 8 * N_INPUTS + 16 + 4 * i); }
#define WSP(T, off) ((T*)(karg_ws() + (off)))
#define PHASE_IDS const int tid = tid_opaque(), lane = tid & 63, wave = __builtin_amdgcn_readfirstlane(tid >> 6), gw = vcu * NWAVES + wave; (void)tid; (void)lane; (void)wave; (void)gw

typedef short hg_bf16x8 __attribute__((ext_vector_type(8)));
#define HG_MFMA(a, b, c) __builtin_amdgcn_mfma_f32_16x16x32_bf16((a), (b), (c), 0, 0, 0)
#define HG_BAR() do { asm volatile("s_waitcnt vmcnt(0) lgkmcnt(0)" ::: "memory"); __builtin_amdgcn_s_barrier(); asm volatile("" ::: "memory"); } while (0)
#define HG_BARL() do { asm volatile("s_waitcnt lgkmcnt(0)" ::: "memory"); __builtin_amdgcn_s_barrier(); asm volatile("" ::: "memory"); } while (0)
__device__ __forceinline__ void hgrn_chunked(LAS unsigned char* L, const bf16r* Z, const float* lbp, const float* hgain, bf16r* YCAT, int b, int h, int tid) {
    constexpr int QS = 0, KS = 17408, KT = 34816, VT = 53248, STO = 71680, PS = 106496, SP = 115712, DM = 123904, DH = 124416;
    constexpr int RS = 272, TS = 144;
    const int lane = tid & 63, wave = __builtin_amdgcn_readfirstlane(tid >> 6), lr = lane & 15, lq = lane >> 4;
    const int u = tid & 255, j8 = (u & 15) * 8, seg = u >> 4;
    const bool scaler = wave < 4;
    const bool backward = wave < 2;
    const size_t tok0 = (size_t)b * SEQ;
    f32x4 stm[8];
#pragma unroll
    for (int n = 0; n < 8; ++n) stm[n] = (f32x4){0.f, 0.f, 0.f, 0.f};
    constexpr int LBS = 124928;
    if (tid < 128) *(LAS float*)(L + LBS + tid * 4) = 1.0f - lbp[h * 128 + tid];
    HG_BARL();
    v4u ldA[4], ldB[4];
#define HG_ISSUE(c) do { const size_t m_ = tok0 + (size_t)(c) * 64 + 4 * seg; \
        if (scaler) { _Pragma("unroll") for (int r = 0; r < 4; ++r) { ldA[r] = __builtin_nontemporal_load((const v4u*)(Z + (m_ + r) * IN_WIDTH + OFF_B_F + h * 128 + j8)); ldB[r] = __builtin_nontemporal_load((const v4u*)(Z + (m_ + r) * IN_WIDTH + OFF_B_Q + h * 128 + j8)); } } \
        else { _Pragma("unroll") for (int r = 0; r < 4; ++r) ldA[r] = __builtin_nontemporal_load((const v4u*)(Z + (m_ + r) * IN_WIDTH + OFF_B_I + h * 128 + j8)); } } while (0)
    HG_ISSUE(0);
#pragma unroll 1
    for (int c = 0; c < SEQ / 64; ++c) {
        float loc[4][8], Lp[8];
        if (scaler) {
            asm volatile("s_waitcnt vmcnt(0)" ::: "memory");
#pragma unroll
            for (int r = 0; r < 4; ++r) {
                const unsigned zw[4] = {ldA[r].x, ldA[r].y, ldA[r].z, ldA[r].w}; unsigned kwp[4];
                const f32x4 om0 = *(const LAS f32x4*)(L + LBS + j8 * 4), om1 = *(const LAS f32x4*)(L + LBS + j8 * 4 + 16);
                const float oml[8] = {om0.x, om0.y, om0.z, om0.w, om1.x, om1.y, om1.z, om1.w};
#pragma unroll
                for (int e2 = 0; e2 < 4; ++e2) { const float k0_ = oml[2 * e2] * __builtin_amdgcn_rcpf(1.0f + fast_exp(bflo(zw[e2]))), k1_ = oml[2 * e2 + 1] * __builtin_amdgcn_rcpf(1.0f + fast_exp(bfhi(zw[e2]))); kwp[e2] = pk2(k0_, k1_); }
                ldA[r] = (v4u){kwp[0], kwp[1], kwp[2], kwp[3]};
            }
            const unsigned kw0[4] = {ldA[0].x, ldA[0].y, ldA[0].z, ldA[0].w}, kw1[4] = {ldA[1].x, ldA[1].y, ldA[1].z, ldA[1].w}, kw2[4] = {ldA[2].x, ldA[2].y, ldA[2].z, ldA[2].w}, kw3[4] = {ldA[3].x, ldA[3].y, ldA[3].z, ldA[3].w};
#pragma unroll
            for (int e = 0; e < 8; ++e) {
                const float f0 = 1.0f - ((e & 1) ? bfhi(kw0[e >> 1]) : bflo(kw0[e >> 1])), f1 = 1.0f - ((e & 1) ? bfhi(kw1[e >> 1]) : bflo(kw1[e >> 1]));
                const float f2 = 1.0f - ((e & 1) ? bfhi(kw2[e >> 1]) : bflo(kw2[e >> 1])), f3 = 1.0f - ((e & 1) ? bfhi(kw3[e >> 1]) : bflo(kw3[e >> 1]));
                if (backward) { loc[3][e] = 1.0f; loc[2][e] = f3; loc[1][e] = f3 * f2; loc[0][e] = f3 * f2 * f1; Lp[e] = loc[0][e] * f0; }
                else { loc[0][e] = f0; loc[1][e] = f0 * f1; loc[2][e] = loc[1][e] * f2; loc[3][e] = loc[2][e] * f3; Lp[e] = loc[3][e]; }
            }
            *(LAS f32x4*)(L + SP + (seg * 128 + j8) * 4) = (f32x4){Lp[0], Lp[1], Lp[2], Lp[3]};
            *(LAS f32x4*)(L + SP + (seg * 128 + j8) * 4 + 16) = (f32x4){Lp[4], Lp[5], Lp[6], Lp[7]};
        }
        HG_BAR();
        if (scaler) {
            float X[8];
#pragma unroll
            for (int e = 0; e < 8; ++e) X[e] = 1.0f;
#pragma unroll
            for (int k = 0; k < 7; ++k) {
                const int sp = backward ? (1 + k) : (8 + k);
                const bool use = backward ? (sp > seg) : (sp < seg);
                const f32x4 a = *(const LAS f32x4*)(L + SP + (sp * 128 + j8) * 4), b4 = *(const LAS f32x4*)(L + SP + (sp * 128 + j8) * 4 + 16);
                X[0] *= use ? a.x : 1.0f; X[1] *= use ? a.y : 1.0f; X[2] *= use ? a.z : 1.0f; X[3] *= use ? a.w : 1.0f;
                X[4] *= use ? b4.x : 1.0f; X[5] *= use ? b4.y : 1.0f; X[6] *= use ? b4.z : 1.0f; X[7] *= use ? b4.w : 1.0f;
            }
            if (seg == 0) { *(LAS f32x4*)(L + DM + j8 * 4) = (f32x4){Lp[0] * X[0], Lp[1] * X[1], Lp[2] * X[2], Lp[3] * X[3]}; *(LAS f32x4*)(L + DM + j8 * 4 + 16) = (f32x4){Lp[4] * X[4], Lp[5] * X[5], Lp[6] * X[6], Lp[7] * X[7]}; }
            if (seg == 15) { *(LAS f32x4*)(L + DH + j8 * 4) = (f32x4){Lp[0] * X[0], Lp[1] * X[1], Lp[2] * X[2], Lp[3] * X[3]}; *(LAS f32x4*)(L + DH + j8 * 4 + 16) = (f32x4){Lp[4] * X[4], Lp[5] * X[5], Lp[6] * X[6], Lp[7] * X[7]}; }
            unsigned kt[8][2];
#pragma unroll
            for (int r = 0; r < 4; ++r) {
                float qs[8], ks[8];
                const unsigned kwr[4] = {ldA[r].x, ldA[r].y, ldA[r].z, ldA[r].w}, qwr[4] = {ldB[r].x, ldB[r].y, ldB[r].z, ldB[r].w};
#pragma unroll
                for (int e = 0; e < 8; ++e) {
                    float E, IE;
                    if (backward) { IE = fmaxf(loc[r][e] * X[e], 1.0e-30f); E = __builtin_amdgcn_rcpf(IE); }
                    else { E = fmaxf(loc[r][e] * X[e], 1.0e-30f); IE = __builtin_amdgcn_rcpf(E); }
                    { const float zq_ = (e & 1) ? bfhi(qwr[e >> 1]) : bflo(qwr[e >> 1]); qs[e] = zq_ * sigmoidf_(zq_) * 0.08838834764831845f * E; } ks[e] = ((e & 1) ? bfhi(kwr[e >> 1]) : bflo(kwr[e >> 1])) * IE;
                }
                v4u wq, wk; wq.x = pk2(qs[0], qs[1]); wq.y = pk2(qs[2], qs[3]); wq.z = pk2(qs[4], qs[5]); wq.w = pk2(qs[6], qs[7]);
                wk.x = pk2(ks[0], ks[1]); wk.y = pk2(ks[2], ks[3]); wk.z = pk2(ks[4], ks[5]); wk.w = pk2(ks[6], ks[7]);
                *(LAS v4u*)(L + QS + (4 * seg + r) * RS + j8 * 2) = wq; *(LAS v4u*)(L + KS + (4 * seg + r) * RS + j8 * 2) = wk;
                const unsigned kw[4] = {wk.x, wk.y, wk.z, wk.w};
#pragma unroll
                for (int e = 0; e < 8; ++e) { const unsigned hv = (e & 1) ? (kw[e >> 1] >> 16) : (kw[e >> 1] & 0xffffu);
                    if (r == 0) kt[e][0] = hv; else if (r == 1) kt[e][0] |= hv << 16; else if (r == 2) kt[e][1] = hv; else kt[e][1] |= hv << 16; }
            }
#pragma unroll
            for (int e = 0; e < 8; ++e) *(LAS v2u*)(L + KT + (j8 + e) * TS + (4 * seg) * 2) = (v2u){kt[e][0], kt[e][1]};
        } else {
            asm volatile("s_waitcnt vmcnt(0)" ::: "memory");
            const unsigned vw[4][4] = {{ldA[0].x, ldA[0].y, ldA[0].z, ldA[0].w}, {ldA[1].x, ldA[1].y, ldA[1].z, ldA[1].w}, {ldA[2].x, ldA[2].y, ldA[2].z, ldA[2].w}, {ldA[3].x, ldA[3].y, ldA[3].z, ldA[3].w}};
#pragma unroll
            for (int e = 0; e < 8; ++e) {
                unsigned h0, h1, h2, h3;
                if (e & 1) { h0 = vw[0][e >> 1] >> 16; h1 = vw[1][e >> 1] >> 16; h2 = vw[2][e >> 1] >> 16; h3 = vw[3][e >> 1] >> 16; }
                else { h0 = vw[0][e >> 1] & 0xffffu; h1 = vw[1][e >> 1] & 0xffffu; h2 = vw[2][e >> 1] & 0xffffu; h3 = vw[3][e >> 1] & 0xffffu; }
                *(LAS v2u*)(L + VT + (j8 + e) * TS + (4 * seg) * 2) = (v2u){h0 | (h1 << 16), h2 | (h3 << 16)};
            }
        }
        HG_BARL();
#pragma unroll
        for (int n = 0; n < 8; ++n) {
            const f32x4 dm = *(const LAS f32x4*)(L + DM + (16 * n + 4 * lq) * 4); const f32x4 sv = stm[n] * dm;
            *(LAS v2u*)(L + STO + (16 * wave + lr) * RS + (16 * n + 4 * lq) * 2) = (v2u){pk2(sv.x, sv.y), pk2(sv.z, sv.w)};
        }
        {
            const int ti = wave >> 1;
#pragma unroll
            for (int jj = 0; jj < 2; ++jj) {
                const int sj = 2 * (wave & 1) + jj;
                f32x4 acc = (f32x4){0.f, 0.f, 0.f, 0.f};
#pragma unroll
                for (int ks = 0; ks < 4; ++ks) {
                    const hg_bf16x8 a = *(const LAS hg_bf16x8*)(L + KS + (16 * sj + lr) * RS + (ks * 32 + 8 * lq) * 2);
                    const hg_bf16x8 bq = *(const LAS hg_bf16x8*)(L + QS + (16 * ti + lr) * RS + (ks * 32 + 8 * lq) * 2);
                    acc = HG_MFMA(a, bq, acc);
                }
                {
                    const int s0 = 16 * sj + 4 * lq, tt = 16 * ti + lr;
                    acc.x = (s0 + 0 <= tt) ? acc.x : 0.f; acc.y = (s0 + 1 <= tt) ? acc.y : 0.f; acc.z = (s0 + 2 <= tt) ? acc.z : 0.f; acc.w = (s0 + 3 <= tt) ? acc.w : 0.f;
                }
                *(LAS v2u*)(L + PS + (16 * ti + lr) * TS + (16 * sj + 4 * lq) * 2) = (v2u){pk2(acc.x, acc.y), pk2(acc.z, acc.w)};
            }
        }
        if (c + 1 < SEQ / 64) HG_ISSUE(c + 1);
        v2u gld[4];
        int tG = tid; asm volatile("" : "+v"(tG));
#pragma unroll
        for (int k = 0; k < 4; ++k) { const int pc = tG + 512 * k; gld[k] = __builtin_nontemporal_load((const v2u*)(Z + (tok0 + (size_t)c * 64 + (pc >> 5)) * IN_WIDTH + OFF_B_G + h * 128 + (pc & 31) * 4)); }
        HG_BARL();
        f32x4 o[4];
        {
#pragma unroll
            for (int i = 0; i < 4; ++i) o[i] = (f32x4){0.f, 0.f, 0.f, 0.f};
            hg_bf16x8 bs[4];
#pragma unroll
            for (int ks = 0; ks < 4; ++ks) bs[ks] = *(const LAS hg_bf16x8*)(L + STO + (16 * wave + lr) * RS + (ks * 32 + 8 * lq) * 2);
#pragma unroll
            for (int i = 0; i < 4; ++i)
#pragma unroll
                for (int ks = 0; ks < 4; ++ks) { const hg_bf16x8 a = *(const LAS hg_bf16x8*)(L + QS + (16 * i + lr) * RS + (ks * 32 + 8 * lq) * 2); o[i] = HG_MFMA(a, bs[ks], o[i]); }
            hg_bf16x8 bv[2];
#pragma unroll
            for (int ks = 0; ks < 2; ++ks) bv[ks] = *(const LAS hg_bf16x8*)(L + VT + (16 * wave + lr) * TS + (ks * 32 + 8 * lq) * 2);
#pragma unroll
            for (int i = 0; i < 4; ++i)
#pragma unroll
                for (int ks = 0; ks < 2; ++ks) { if (ks == 1 && i < 2) continue; const hg_bf16x8 a = *(const LAS hg_bf16x8*)(L + PS + (16 * i + lr) * TS + (ks * 32 + 8 * lq) * 2); o[i] = HG_MFMA(a, bv[ks], o[i]); }
#pragma unroll
            for (int n = 0; n < 8; ++n) {
                f32x4 U = (f32x4){0.f, 0.f, 0.f, 0.f};
#pragma unroll
                for (int ks = 0; ks < 2; ++ks) { const hg_bf16x8 a = *(const LAS hg_bf16x8*)(L + KT + (16 * n + lr) * TS + (ks * 32 + 8 * lq) * 2); U = HG_MFMA(a, bv[ks], U); }
                const f32x4 dm = *(const LAS f32x4*)(L + DM + (16 * n + 4 * lq) * 4), dh = *(const LAS f32x4*)(L + DH + (16 * n + 4 * lq) * 4);
                stm[n] = stm[n] * (dm * dh) + dh * U;
            }
        }
        HG_BARL();
#pragma unroll
        for (int i = 0; i < 4; ++i) {
            *(LAS float*)(L + (16 * i + 4 * lq + 0) * 528 + (16 * wave + lr) * 4) = o[i].x; *(LAS float*)(L + (16 * i + 4 * lq + 1) * 528 + (16 * wave + lr) * 4) = o[i].y;
            *(LAS float*)(L + (16 * i + 4 * lq + 2) * 528 + (16 * wave + lr) * 4) = o[i].z; *(LAS float*)(L + (16 * i + 4 * lq + 3) * 528 + (16 * wave + lr) * 4) = o[i].w;
        }
        HG_BARL();
        {
            int tE = tid; asm volatile("" : "+v"(tE));
#pragma unroll
            for (int k = 0; k < 4; ++k) { const int pc = tE + 512 * k, row = pc >> 5, col = (pc & 31) * 4;
                const f32x4 ov = *(const LAS f32x4*)(L + row * 528 + col * 4);
                float ss = (ov.x * ov.x + ov.y * ov.y) + (ov.z * ov.z + ov.w * ov.w);
                ss += __shfl_xor(ss, 1); ss += __shfl_xor(ss, 2); ss += __shfl_xor(ss, 4); ss += __shfl_xor(ss, 8); ss += __shfl_xor(ss, 16);
                const float rs = 1.0f / sqrtf(ss * (1.0f / 128.0f) + NORM_EPS);
                const size_t m = tok0 + (size_t)c * 64 + row;
                const v2u gw2 = gld[k];
                const f32x4 hgv = *(const f32x4*)(hgain + col);
                const float g0 = bflo(gw2.x), g1 = bfhi(gw2.x), g2 = bflo(gw2.y), g3 = bfhi(gw2.y);
                v2u w; w.x = pk2(ov.x * rs * hgv.x * (g0 * sigmoidf_(g0)), ov.y * rs * hgv.y * (g1 * sigmoidf_(g1))); w.y = pk2(ov.z * rs * hgv.z * (g2 * sigmoidf_(g2)), ov.w * rs * hgv.w * (g3 * sigmoidf_(g3)));
                *(v2u*)(YCAT + m * D_MODEL + 1024 + h * 128 + col) = w; }
        }
    }
#undef HG_ISSUE
}

__device__ __forceinline__ void xcopy_rows(const float* xin, bf16r* HB, float* RS0, int gw, int ngw, int lane) {
    for (int m = gw; m < M_TOK; m += ngw) {
        const f32x4* xr = (const f32x4*)(xin + (size_t)m * D_MODEL) + lane;
        f32x4 v[16]; float ss = 0.f;
#pragma unroll
        for (int j = 0; j < 16; ++j) { v[j] = __builtin_nontemporal_load(xr + 64 * j); ss += (v[j].x * v[j].x + v[j].y * v[j].y) + (v[j].z * v[j].z + v[j].w * v[j].w); }
        ss = wave_sum(ss);
        v2u* o = (v2u*)(HB + (size_t)m * D_MODEL) + lane;
#pragma unroll
        for (int j = 0; j < 16; ++j) { v2u w; w.x = pk2(v[j].x, v[j].y); w.y = pk2(v[j].z, v[j].w); o[64 * j] = w; }
        if (lane == 0) RS0[m] = ss;
    }
}
#define RS_TABLE_OFF (RING_BYTES + 1024)
#define RS_TABLE_FILL(pssp, nparts, pm_) do { { const int r_ = tid & 255, hf_ = tid >> 8; float ss_ = 0.f;                                                                         \
        if ((nparts) == 1) { if (!hf_) ss_ = (pssp)[(pm_) * 256 + r_]; }                                                                                                           \
        else { _Pragma("unroll 16") for (int j_ = 0; j_ < 32; ++j_) ss_ += (pssp)[(size_t)(hf_ * 32 + j_) * M_TOK + (pm_) * 256 + r_]; }                                           \
        if (hf_) ((LAS float*)(ldsl + RS_TABLE_OFF))[256 + r_] = ss_;                                                                                                              \
        __syncthreads();                                                                                                                                                           \
        if (!hf_) ((LAS float*)(ldsl + RS_TABLE_OFF))[r_] = 1.0f / sqrtf((ss_ + ((LAS float*)(ldsl + RS_TABLE_OFF))[256 + r_]) * (1.0f / D_MODEL) + NORM_EPS); } __syncthreads(); } while (0)

constexpr int WC_IN = (D_MODEL / 64) * (IN_WIDTH / 32), WC_OUT = (D_MODEL / 64) * (D_MODEL / 32), WC_F1 = (D_MODEL / 64) * (D_FF / 32), WC_F2 = (D_FF / 64) * (D_MODEL / 32);
constexpr int WC_LAYER = WC_IN + WC_OUT + WC_F1 + WC_F2;
__device__ __forceinline__ void convert_weights(int it0, int it1, int w, int nw, LAS float* scr, int lane) {
    bf16r* const W_IN = WSP(bf16r, WS_WIN); bf16r* const W_OUT = WSP(bf16r, WS_WOUT); bf16r* const W_FF1 = WSP(bf16r, WS_WFF1); bf16r* const W_FF2 = WSP(bf16r, WS_WFF2);
    for (int it = it0 + w; it < it1; it += nw) {
        const int l = it / WC_LAYER; int r = it - l * WC_LAYER;
        if (r < WC_IN) { p0_transpose_item(karg_in(I_WIN) + (size_t)l * D_MODEL * IN_WIDTH, D_MODEL, IN_WIDTH, W_IN + (size_t)l * IN_WIDTH * D_MODEL, scr, r, lane, karg_in(I_LN1) + l * D_MODEL, D_MODEL); continue; } r -= WC_IN;
        if (r < WC_OUT) { p0_transpose_item(karg_in(I_WOUT) + (size_t)l * D_MODEL * D_MODEL, D_MODEL, D_MODEL, W_OUT + (size_t)l * D_MODEL * D_MODEL, scr, r, lane, nullptr, D_MODEL); continue; } r -= WC_OUT;
        if (r < WC_F1) { p0_transpose_item(karg_in(I_WFF1) + (size_t)l * D_MODEL * D_FF, D_MODEL, D_FF, W_FF1 + (size_t)l * D_FF * D_MODEL, scr, r, lane, karg_in(I_LN2) + l * D_MODEL, D_MODEL); continue; } r -= WC_F1;
        p0_transpose_item(karg_in(I_WFF2) + (size_t)l * D_FF * D_MODEL, D_FF, D_MODEL, W_FF2 + (size_t)l * D_MODEL * D_FF_LD, scr, r, lane, nullptr, D_FF_LD);
    }
}

__device__ __forceinline__ ab::BlockRef<__hip_bfloat16, __hip_bfloat16> attn_ref(const __hip_bfloat16* Qp, const __hip_bfloat16* Kp, const __hip_bfloat16* Vp, __hip_bfloat16* Op, int L, int pass) {
    const int bh = L >> 3, x = L & 7, qb = pass ? 15 - x : x;
    const int b = bh >> 5, hq = bh & 31, h = hq >> 2, c = (hq >> 1) & 1, vh = hq & 1;
    ab::BlockRef<__hip_bfloat16, __hip_bfloat16> r;
    r.Q = Qp + ((size_t)(b * 16 + h * 2 + c) * SEQ + (size_t)qb * 256) * 128;
    r.K = Kp + (size_t)(b * 16 + h * 2 + c) * SEQ * 128;
    r.V = Vp + (size_t)b * SEQ * IN_WIDTH + OFF_C_V + (h * 2 + vh) * 128;
    r.O = Op + ((size_t)(b * 32 + hq) * SEQ + (size_t)qb * 256) * 128;
    r.P0 = qb * 256;
    return r;
}

__device__ __forceinline__ ab::BlockRef<__hip_bfloat16, __hip_bfloat16> attn_ref_q(const __hip_bfloat16* Qp, const __hip_bfloat16* Kp, const __hip_bfloat16* Vp, __hip_bfloat16* Op, int J) {
    const int pr = (J >> 8) * 4 + (J & 3), i = (J & 255) >> 2;
    const int qb = 15 - (i >> 2), b = pr >> 3, h = pr & 7, c = (i >> 1) & 1, vh = i & 1, hq = h * 4 + c * 2 + vh;
    ab::BlockRef<__hip_bfloat16, __hip_bfloat16> r;
    r.Q = Qp + ((size_t)(b * 16 + h * 2 + c) * SEQ + (size_t)qb * 256) * 128;
    r.K = Kp + (size_t)(b * 16 + h * 2 + c) * SEQ * 128;
    r.V = Vp + (size_t)b * SEQ * IN_WIDTH + OFF_C_V + (h * 2 + vh) * 128;
    r.O = Op + ((size_t)(b * 32 + hq) * SEQ + (size_t)qb * 256) * 128;
    r.P0 = qb * 256;
    return r;
}

__device__ __forceinline__ void group4_barrier(unsigned* ctr, unsigned* ctr2, unsigned* bar) {
    asm volatile("s_waitcnt vmcnt(0)" ::: "memory");
    __syncthreads();
    if (threadIdx.x == 0) {
        __builtin_amdgcn_s_waitcnt(0);
        __builtin_amdgcn_fence(__ATOMIC_RELEASE, "agent");
        asm volatile("s_waitcnt vmcnt(0)" ::: "memory");
        (void)xb_add(ctr, 1u);
        XB_SPIN(xb_ld(ctr) < 4u, bar);
        if (ctr2) XB_SPIN(xb_ld(ctr2) < 4u, bar);
        __builtin_amdgcn_fence(__ATOMIC_ACQUIRE, "agent");
        asm volatile("s_waitcnt vmcnt(0)" ::: "memory");
    }
    __syncthreads();
}

constexpr int NQ_ALL = BATCH * 32 * 16, NQ_XCD = NQ_ALL / 8;
__device__ __forceinline__ int aq_take(unsigned* qbase, int x0, volatile LAS unsigned* st) {
    unsigned dx = *st;
    while (dx < 8u) {
        const unsigned q = ((unsigned)x0 + dx) & 7u;
        const unsigned v = __hip_atomic_fetch_add(qbase + 64 * q, 1u, __ATOMIC_RELAXED, __HIP_MEMORY_SCOPE_AGENT);
        if (v < (unsigned)NQ_XCD) { *st = dx; return (int)(q * NQ_XCD + v); }
        ++dx;
    }
    *st = 8u; return NQ_ALL;
}

__global__ void __launch_bounds__(NTHREADS, 2) hymba_fwd(Args args) {
    extern __shared__ __attribute__((aligned(16))) unsigned char lds[];
    LAS unsigned char* ldsl = (LAS unsigned char*)lds;
    const int G = gridDim.x;
    int bx = blockIdx.x;
    int vcu = (G % 8 == 0) ? (bx % 8) * (G / 8) + bx / 8 : bx;
    const int ngw = G * NWAVES;
    volatile LAS unsigned* MISC = (volatile LAS unsigned*)(ldsl + MISC_OFF);
    for (int u = threadIdx.x; u < (LDS_BYTES - RING_BYTES) / 4; u += NTHREADS) ((LAS unsigned*)(ldsl + RING_BYTES))[u] = 0u;
    __syncthreads();
#if MK_PER_PHASE
    const int lo = karg_int(0), hi = karg_int(1);
#else
    constexpr int lo = 0, hi = N_PHASES;
#endif
    const bool multi = (hi - lo) > 1;
    XcdBarrier bar; bar.bar = WSP(unsigned, WS_CTL) + CW_BAR; bar.x = 0; bar.st = nullptr;
    if (multi) bar = xcd_barrier_post(WSP(unsigned, WS_CTL) + CW_BAR, MISC + 8);
    if (multi && threadIdx.x == 0) MISC[18] = __hip_atomic_fetch_add(WSP(unsigned, WS_CTL) + 3072 + 64 * (xb_xcc_id() & 7u), 1u, __ATOMIC_RELAXED, __HIP_MEMORY_SCOPE_AGENT);
#ifndef EN_MASK
#define EN_MASK 0xFFFF
#endif
#define ENK(j) (((EN_MASK) >> (j)) & 1)
#ifndef DBG_TWICE_MASK
#define DBG_TWICE_MASK 0
#endif
#define REPS(j) ((((DBG_TWICE_MASK) >> (j)) & 1) ? 2 : 1)
#define IN(k) (lo <= (k) && (k) < hi)
#if defined(DBG_STAMP_MASK)
#define SEAM(k) do { if (IN((k) + 1)) { if (threadIdx.x == 0) WSP(unsigned long long, 12 * MiB)[((k) * 2 + 0) * 256 + blockIdx.x] = __builtin_amdgcn_s_memrealtime(); xcd_barrier(bar); \
    if (threadIdx.x == 0) WSP(unsigned long long, 12 * MiB)[((k) * 2 + 1) * 256 + blockIdx.x] = __builtin_amdgcn_s_memrealtime(); } } while (0)
#else
#define SEAM(k) do { if (IN((k) + 1)) xcd_barrier(bar); } while (0)
#endif
#define PANEL_PM ((bx & 7) * 8 + ((bx >> 3) & 7))
#define PANEL_R4 ((bx >> 6) & 3)
#define SEAM4(k, slot) do { if (IN((k) + 1)) group4_barrier(WSP(unsigned, WS_CTL) + 16384 + ((slot) * 64 + PANEL_PM) * 64, nullptr, bar.bar); } while (0)
#define SEAM4H(k, slot) do { if (IN((k) + 1)) group4_barrier(WSP(unsigned, WS_CTL) + 16384 + ((slot) * 64 + PANEL_PM) * 64, \
        (PANEL_R4 == 0 && (PANEL_PM & 15) != 0) ? WSP(unsigned, WS_CTL) + 16384 + ((slot) * 64 + PANEL_PM - 1) * 64 : (unsigned*)nullptr, bar.bar); } while (0)

    if (ENK(15) && IN(0)) {
        PHASE_IDS;
#pragma unroll 1
        for (int rep_ = 0; rep_ < REPS(15); ++rep_) {
        bf16r* const W_IN = WSP(bf16r, WS_WIN);
        bf16r* const W_OUT = WSP(bf16r, WS_WOUT);
        bf16r* const W_FF1 = WSP(bf16r, WS_WFF1);
        bf16r* const W_FF2 = WSP(bf16r, WS_WFF2);
        bf16r* const W_GATE = WSP(bf16r, WS_WGATE);
        float* const LB = WSP(float, WS_LB);
        float* const ROPE_COS = WSP(float, WS_ROPE); float* const ROPE_SIN = ROPE_COS + SEQ * 64;
        LAS float* scr = (LAS float*)(ldsl + wave * 16384);
        convert_weights(0, WC_IN, gw, ngw, scr, lane);
        for (int idx = gw * 64 + lane; idx < DEPTH * 2048 * 32; idx += ngw * 64) {
            const int l = idx / (2048 * 32), n = (idx / 32) % 2048, k0 = (idx % 32) * 8;
            const int pn = n >> 8, p = pn >> 1, g = pn & 1, hh = (n >> 7) & 1, j = n & 127;
            v4u o = {0u, 0u, 0u, 0u};
            if ((k0 >> 7) == hh) { const float* w = karg_in(g ? I_WI : I_WR) + (((size_t)l * 8 + 2 * p + hh) * 128 + (k0 & 127)) * 128 + j;
                o.x = pk2(w[0 * 128], w[1 * 128]); o.y = pk2(w[2 * 128], w[3 * 128]); o.z = pk2(w[4 * 128], w[5 * 128]); o.w = pk2(w[6 * 128], w[7 * 128]); }
            *(v4u*)(W_GATE + ((size_t)l * 2048 + n) * 256 + k0) = o;
        }
        for (int c = gw * 64 + lane; c < HG_W; c += ngw * 64) {
            const float b0 = karg_in(I_HLB)[c], b1 = karg_in(I_HLB)[HG_W + c]; const float mx = fmaxf(b0, b1);
            const float e0 = __expf(b0 - mx), e1 = __expf(b1 - mx);
            LB[c] = 0.f; LB[HG_W + c] = e1 / (e0 + e1);
        }
        for (int idx = gw * 64 + lane; idx < SEQ * 64; idx += ngw * 64) {
            const int t = idx >> 6, j = idx & 63;
            const float inv = exp2f(-(float)(2 * j) * (1.0f / 128.0f) * 13.287712379549449f);
            const float angf = (float)t * inv;
            double rev = (double)angf * 0.15915494309189535; rev -= floor(rev);
            const float rf = (float)rev;
            ROPE_COS[idx] = __builtin_amdgcn_cosf(rf); ROPE_SIN[idx] = __builtin_amdgcn_sinf(rf);
        }
        }
        xcopy_rows(karg_in(I_X), WSP(bf16r, WS_H), WSP(float, WS_RS0), gw, ngw, lane);
        SEAM(0);
    }
    if (multi && IN(0) && IN(1) && G % 8 == 0) {
        if (threadIdx.x == 0) {
            const unsigned x = xb_xcc_id() & 7u; unsigned before = 0u;
            for (unsigned j = 0; j < 8u; ++j) { const unsigned cj = __hip_atomic_load(WSP(unsigned, WS_CTL) + 3072 + 64 * j, __ATOMIC_RELAXED, __HIP_MEMORY_SCOPE_AGENT); before += (j < x) ? cj : 0u; }
            MISC[17] = before + MISC[18];
        }
        __syncthreads();
        const int lb = (int)MISC[17];
        if (lb >= 0 && lb < G) { vcu = lb; bx = (lb % (G / 8)) * 8 + lb / (G / 8); }
    }

#pragma unroll 1
    for (int l = 0; l < DEPTH; ++l) {
        const int pb = 1 + l * PH_PER_LAYER;

        if (ENK(1) && IN(pb + 1)) {
            PHASE_IDS;
#pragma unroll 1
            for (int rep_ = 0; rep_ < REPS(1); ++rep_) {
            bf16r* const HB = WSP(bf16r, WS_H);
            bf16r* const W_IN = WSP(bf16r, WS_WIN);
            bf16r* const Z = WSP(bf16r, WS_Z);
            pg8::Gemm g{HB, W_IN + (size_t)l * IN_WIDTH * D_MODEL, M_TOK, IN_WIDTH, D_MODEL}; pg8::StaticOrder S; S.init(M_TOK, IN_WIDTH, G, bx);
            { const float* pssp = (l == 0) ? WSP(float, WS_RS0) : WSP(float, WS_PSS) + (size_t)1 * 64 * M_TOK; const int nparts = (l == 0) ? 1 : 64;
              pg8::Unit u0; if (S.next(0, u0)) RS_TABLE_FILL(pssp, nparts, u0.pm); }
            pg8::EpiBf16X<0> E{Z, IN_WIDTH, nullptr, nullptr, 0, (const LAS float*)(ldsl + RS_TABLE_OFF)};
            pg8::gemm_phase<pg8::EpiBf16X<0>, pg8::StaticOrder, GEMM_ALIGN, GEMM_SP2>(ldsl, g, S, E);
            }
            SEAM4H(pb + 1, 8 * l + 2);
        }

        if (ENK(2) && IN(pb + 2)) {
            PHASE_IDS;
#pragma unroll 1
            for (int rep_ = 0; rep_ < REPS(2); ++rep_) {
            bf16r* const Z = WSP(bf16r, WS_Z);
            bf16r* const XA = WSP(bf16r, WS_XA);
            bf16r* const QH = WSP(bf16r, WS_QH);
            bf16r* const KH = WSP(bf16r, WS_KH);
            float* const LB = WSP(float, WS_LB);
            float* const ROPE_COS = WSP(float, WS_ROPE); float* const ROPE_SIN = ROPE_COS + SEQ * 64;
            const float* convw = karg_in(I_CONVW) + l * 4 * LRU_W; const float* convb = karg_in(I_CONVB) + l * LRU_W;
            const float* qg = karg_in(I_QNG) + l * 128; const float* kg = karg_in(I_KNG) + l * 128;
            for (int m = PANEL_PM * 256 + PANEL_R4 * 64 + wave; m < PANEL_PM * 256 + PANEL_R4 * 64 + 64; m += NWAVES) {
                const int t = m & (SEQ - 1), b = m >> 12;
                const bf16r* zr = Z + (size_t)m * IN_WIDTH;
#pragma unroll
                for (int it = 0; it < 2; ++it) {
                    const int c0 = it * 512 + lane * 8;
                    const f32x4 b0 = *(const f32x4*)(convb + c0), b1 = *(const f32x4*)(convb + c0 + 4);
                    float a0 = b0.x, a1 = b0.y, a2 = b0.z, a3 = b0.w, a4 = b1.x, a5 = b1.y, a6 = b1.z, a7 = b1.w;
#pragma unroll
                    for (int j = 0; j < 4; ++j) {
                        if (t - 3 + j >= 0) {
                            const v4u xv = *(const v4u*)(zr - (ptrdiff_t)(3 - j) * IN_WIDTH + OFF_A_X + c0);
                            const f32x4 w0 = *(const f32x4*)(convw + j * LRU_W + c0), w1 = *(const f32x4*)(convw + j * LRU_W + c0 + 4);
                            a0 += bflo(xv.x) * w0.x; a1 += bfhi(xv.x) * w0.y; a2 += bflo(xv.y) * w0.z; a3 += bfhi(xv.y) * w0.w;
                            a4 += bflo(xv.z) * w1.x; a5 += bfhi(xv.z) * w1.y; a6 += bflo(xv.w) * w1.z; a7 += bfhi(xv.w) * w1.w;
                        }
                    }
                    v4u o; o.x = pk2(a0, a1); o.y = pk2(a2, a3); o.z = pk2(a4, a5); o.w = pk2(a6, a7);
                    *(v4u*)(XA + ((size_t)(c0 >> 8) * M_TOK + m) * 256 + (c0 & 255)) = o;
                }
#pragma unroll
                for (int it = 0; it < 4; ++it) {
                    const int isk = it >> 1, vi = (it & 1) * 8 + (lane >> 3), sub = lane & 7;
                    const bf16r* src = zr + (isk ? OFF_C_K : OFF_C_Q) + vi * 128 + sub * 8;
                    const v4u av = __builtin_nontemporal_load((const v4u*)src), cv = __builtin_nontemporal_load((const v4u*)(src + 64));
                    float x1[8] = {bflo(av.x), bfhi(av.x), bflo(av.y), bfhi(av.y), bflo(av.z), bfhi(av.z), bflo(av.w), bfhi(av.w)};
                    float x2[8] = {bflo(cv.x), bfhi(cv.x), bflo(cv.y), bfhi(cv.y), bflo(cv.z), bfhi(cv.z), bflo(cv.w), bfhi(cv.w)};
                    float ss = 0.f;
#pragma unroll
                    for (int e = 0; e < 8; ++e) ss += x1[e] * x1[e] + x2[e] * x2[e];
                    ss += __shfl_xor(ss, 1); ss += __shfl_xor(ss, 2); ss += __shfl_xor(ss, 4);
                    const float rs = 1.0f / sqrtf(ss * (1.0f / 128.0f) + NORM_EPS);
                    const float* gp = (isk ? kg : qg) + sub * 8;
                    const f32x4 g1a = *(const f32x4*)gp, g1b = *(const f32x4*)(gp + 4), g2a = *(const f32x4*)(gp + 64), g2b = *(const f32x4*)(gp + 68);
                    const f32x4 ca = *(const f32x4*)(ROPE_COS + t * 64 + sub * 8), cb = *(const f32x4*)(ROPE_COS + t * 64 + sub * 8 + 4);
                    const f32x4 sa = *(const f32x4*)(ROPE_SIN + t * 64 + sub * 8), sb = *(const f32x4*)(ROPE_SIN + t * 64 + sub * 8 + 4);
                    const float g1[8] = {g1a.x, g1a.y, g1a.z, g1a.w, g1b.x, g1b.y, g1b.z, g1b.w}, g2[8] = {g2a.x, g2a.y, g2a.z, g2a.w, g2b.x, g2b.y, g2b.z, g2b.w};
                    const float cc[8] = {ca.x, ca.y, ca.z, ca.w, cb.x, cb.y, cb.z, cb.w}, sn[8] = {sa.x, sa.y, sa.z, sa.w, sb.x, sb.y, sb.z, sb.w};
                    float o1[8], o2[8];
#pragma unroll
                    for (int e = 0; e < 8; ++e) { const float y1 = x1[e] * rs * g1[e], y2 = x2[e] * rs * g2[e]; o1[e] = y1 * cc[e] - y2 * sn[e]; o2[e] = y2 * cc[e] + y1 * sn[e]; }
                    bf16r* dst = (isk ? KH : QH) + ((size_t)(b * 16 + vi) * SEQ + t) * 128 + sub * 8;
                    v4u w1, w2; w1.x = pk2(o1[0], o1[1]); w1.y = pk2(o1[2], o1[3]); w1.z = pk2(o1[4], o1[5]); w1.w = pk2(o1[6], o1[7]);
                    w2.x = pk2(o2[0], o2[1]); w2.y = pk2(o2[2], o2[3]); w2.z = pk2(o2[4], o2[5]); w2.w = pk2(o2[6], o2[7]);
                    *(v4u*)dst = w1; *(v4u*)(dst + 64) = w2;
                }
            }
            }
            SEAM4(pb + 2, 8 * l + 3);
        }

        if (ENK(3) && IN(pb + 3)) {
            PHASE_IDS;
#pragma unroll 1
            for (int rep_ = 0; rep_ < REPS(3); ++rep_) {
            bf16r* const XA = WSP(bf16r, WS_XA);
            bf16r* const W_GATE = WSP(bf16r, WS_WGATE);
            bf16r* const RI = WSP(bf16r, WS_RI);
            pg8::Gemm g{XA, W_GATE + (size_t)l * 2048 * 256, M_TOK, 2048, 256, (size_t)M_TOK * 256 * 2, 1}; pg8::StaticOrder S; S.init(M_TOK, 2048, G, bx);
            pg8::EpiBf16X<1> E{RI, 2048, karg_in(I_BR) + l * LRU_W, karg_in(I_BI) + l * LRU_W, 1024, nullptr};
            pg8::gemm_phase<pg8::EpiBf16X<1>, pg8::StaticOrder, GEMM_ALIGN, GEMM_SP2>(ldsl, g, S, E);
            }
            SEAM4(pb + 3, 8 * l + 4);
        }

        if ((ENK(4) || ENK(5)) && (IN(pb + 4) || IN(pb + 5))) {
            PHASE_IDS;
            bf16r* const XA = WSP(bf16r, WS_XA);
            bf16r* const RI = WSP(bf16r, WS_RI);
            float* const LSUM = WSP(float, WS_LSUM);
            bf16r* const Z = WSP(bf16r, WS_Z);
            const float* lam = karg_in(I_LAM) + l * LRU_W;
            const int c = tid * 2;
            const float sp0 = 8.0f * log1pf(__expf(-lam[c])), sp1 = 8.0f * log1pf(__expf(-lam[c + 1]));
            if (ENK(4) && IN(pb + 4)) {
#pragma unroll 1
                for (int rep_ = 0; rep_ < REPS(4); ++rep_)
                for (int u = PANEL_PM * 4 + PANEL_R4; u < BATCH * 64; u += BATCH * 64) {
                    const int b = u >> 6, s = u & 63;
                    float h0 = 0.f, h1 = 0.f, A0 = 0.f, A1 = 0.f;
#pragma unroll 4
                    for (int t = 0; t < 64; ++t) {
                        const size_t m = (size_t)b * SEQ + s * 64 + t;
                        const unsigned rr = *(const unsigned*)(RI + m * 2048 + (c >> 8) * 512 + (c & 255)), ii = *(const unsigned*)(RI + m * 2048 + (c >> 8) * 512 + 256 + (c & 255)), xx = *(const unsigned*)(XA + ((size_t)(c >> 8) * M_TOK + m) * 256 + (c & 255));
                        const bool first = (s == 0 && t == 0);
                        lru_step(bflo(rr), bflo(ii), bflo(xx), sp0, first, h0, A0);
                        lru_step(bfhi(rr), bfhi(ii), bfhi(xx), sp1, first, h1, A1);
                    }
                    *(f32x4*)(LSUM + ((size_t)u * LRU_W + c) * 2) = (f32x4){A0, h0, A1, h1};
                }
                SEAM(pb + 4);
            }
            if (ENK(5) && IN(pb + 5)) {
                constexpr int NHU = BATCH * 8, NCV = 64;
                const bool split = G >= 2 * (NHU + NCV);
                const int rid = bx;
                {
                    const int it0 = l * WC_LAYER + WC_IN, it1 = (l + 1 < DEPTH) ? (l + 1) * WC_LAYER + WC_IN : DEPTH * WC_LAYER;
                    LAS float* scr = (LAS float*)(ldsl + wave * 16384);
                    if (!split) convert_weights(it0, it1, gw, ngw, scr, lane);
                    else if (rid >= NHU && rid < NHU + NCV) convert_weights(it0, it1, (rid - NHU) * NWAVES + wave, NCV * NWAVES, scr, lane);
                }
                if (!split) __syncthreads();
                if (!split || rid >= NHU + NCV) {
                    const float* lg = karg_in(I_LRUG) + l * LRU_W; bf16r* const YCAT = WSP(bf16r, WS_YCAT);
                    for (int u = split ? rid - (NHU + NCV) : rid; u < BATCH * 64; u += split ? G - (NHU + NCV) : G) {
                        const int b = u >> 6, s = u & 63;
                        float h0 = 0.f, h1 = 0.f, A0 = 0.f, A1 = 0.f;
                        for (int sp = 0; sp < s; ++sp) {
                            const f32x4 v = *(const f32x4*)(LSUM + ((size_t)(b * 64 + sp) * LRU_W + c) * 2);
                            h0 = fast_exp(v.x) * h0 + v.y; h1 = fast_exp(v.z) * h1 + v.w;
                        }
#pragma unroll 1
                        for (int hb = 0; hb < 2; ++hb) {
#pragma unroll 4
                            for (int tt = 0; tt < 32; ++tt) {
                                const size_t m = (size_t)b * SEQ + s * 64 + hb * 32 + tt;
                                const unsigned rr = __builtin_nontemporal_load((const unsigned*)(RI + m * 2048 + (c >> 8) * 512 + (c & 255))), ii = __builtin_nontemporal_load((const unsigned*)(RI + m * 2048 + (c >> 8) * 512 + 256 + (c & 255))), xx = __builtin_nontemporal_load((const unsigned*)(XA + ((size_t)(c >> 8) * M_TOK + m) * 256 + (c & 255)));
                                const unsigned gg = __builtin_nontemporal_load((const unsigned*)(Z + m * IN_WIDTH + OFF_A_GATE + c));
                                const bool first = (s == 0 && hb == 0 && tt == 0);
                                lru_step(bflo(rr), bflo(ii), bflo(xx), sp0, first, h0, A0);
                                lru_step(bfhi(rr), bfhi(ii), bfhi(xx), sp1, first, h1, A1);
                                *(LAS f32x2*)(ldsl + ((size_t)tt * LRU_W + c) * 4) = (f32x2){h0 * gelu_tanh(bflo(gg)), h1 * gelu_tanh(bfhi(gg))};
                            }
                            __syncthreads();
#pragma unroll
                            for (int q = 0; q < 4; ++q) {
                                const int tt = wave * 4 + q; const size_t m = (size_t)b * SEQ + s * 64 + hb * 32 + tt;
                                f32x4 v[4]; float ss = 0.f;
#pragma unroll
                                for (int j = 0; j < 4; ++j) { v[j] = *(const LAS f32x4*)(ldsl + ((size_t)tt * LRU_W + 256 * j + 4 * lane) * 4); ss += (v[j].x * v[j].x + v[j].y * v[j].y) + (v[j].z * v[j].z + v[j].w * v[j].w); }
                                ss = wave_sum(ss);
                                const float rs = 1.0f / sqrtf(ss * (1.0f / LRU_W) + NORM_EPS);
#pragma unroll
                                for (int j = 0; j < 4; ++j) { const f32x4 g = *((const f32x4*)lg + lane + 64 * j); v2u w; w.x = pk2(v[j].x * rs * g.x, v[j].y * rs * g.y); w.y = pk2(v[j].z * rs * g.z, v[j].w * rs * g.w);
                                    *((v2u*)(YCAT + m * D_MODEL) + lane + 64 * j) = w; }
                            }
                            __syncthreads();
                        }
                    }
                }
                for (int ubh = rid; ubh < NHU; ubh += G) hgrn_chunked(ldsl, Z, WSP(float, WS_LB) + l * HG_W, karg_in(I_HNG) + l * 128, WSP(bf16r, WS_YCAT), ubh >> 3, ubh & 7, tid);
                __syncthreads();
                {
                    typedef __hip_bfloat16 abf;
                    const abf* Qp = (const abf*)WSP(bf16r, WS_QH); const abf* Kp = (const abf*)WSP(bf16r, WS_KH); const abf* Vp = (const abf*)WSP(bf16r, WS_Z); abf* Op = (abf*)WSP(bf16r, WS_OATT);
                    unsigned* qctr = WSP(unsigned, WS_CTL) + 2048 + 512 * l;
                    constexpr int NQ = NQ_ALL;
                    const int x0 = bx & 7;
                    if (tid == 0) MISC[20] = 0u;
#define AQ_FETCH(dst) do { if (tid == 0) MISC[16] = (unsigned)aq_take(qctr, x0, MISC + 20); __syncthreads(); dst = (int)MISC[16]; __syncthreads(); } while (0)
                    int cur, nxt;
                    if (wave >= 4) __builtin_amdgcn_s_setprio(1);
                    AQ_FETCH(cur);
                    if (cur < NQ) {
                        AQ_FETCH(nxt);
                        ab::BlockRef<abf, abf> cref = attn_ref_q(Qp, Kp, Vp, Op, cur);
                        ab::Seam<abf> Sm;
                        ab::causal_swa_prime<abf, abf>(cref, SEQ, (char*)lds, Sm);
                        for (;;) {
                            const bool more = nxt < NQ;
                            unsigned pend = 0u;
                            if (more && wave == 0) { unsigned p_ = 0u; if (lane == 0) p_ = (unsigned)aq_take(qctr, x0, MISC + 20); pend = (unsigned)__builtin_amdgcn_readfirstlane((int)p_); }
                            const ab::BlockRef<abf, abf> nref = more ? attn_ref_q(Qp, Kp, Vp, Op, nxt) : cref;
                            ab::causal_swa_block<abf, abf>(cref, nref, SEQ, SEQ, (char*)lds, Sm);
                            if (!more) break;
                            if (tid == 0) MISC[16] = pend;
                            __syncthreads();
                            cref = nref; nxt = (int)MISC[16];
                            __syncthreads();
                        }
                    }
                    __builtin_amdgcn_s_setprio(0);
#undef AQ_FETCH
                }
                SEAM(pb + 7);
            }
        }

        if (ENK(8) && IN(pb + 8)) {
            PHASE_IDS;
#pragma unroll 1
            for (int rep_ = 0; rep_ < REPS(8); ++rep_) {
            bf16r* const OATT = WSP(bf16r, WS_OATT);
            bf16r* const Z = WSP(bf16r, WS_Z);
            bf16r* const YCAT = WSP(bf16r, WS_YCAT);
            const float lam_init = 0.8f - 0.6f * __expf(-0.3f * (float)l);
            const float* dl = karg_in(I_DLAM) + l * 4 * 128;
            float d1 = dl[lane] * dl[128 + lane] + dl[64 + lane] * dl[128 + 64 + lane];
            float d2 = dl[256 + lane] * dl[384 + lane] + dl[256 + 64 + lane] * dl[384 + 64 + lane];
            d1 = wave_sum(d1); d2 = wave_sum(d2);
            const float lamv = __expf(d1) - __expf(d2) + lam_init;
            const float* sg = karg_in(I_SUBLN) + l * 256;
            for (int m = PANEL_PM * 256 + PANEL_R4 * 64 + wave; m < PANEL_PM * 256 + PANEL_R4 * 64 + 64; m += NWAVES) {
                const int t = m & (SEQ - 1), b = m >> 12;
                bf16r* yrow = YCAT + (size_t)m * D_MODEL;
#pragma unroll
                for (int it = 0; it < 4; ++it) {
                    const int e = it * 512 + lane * 8, h = e >> 8, vh = (e >> 7) & 1, d = e & 127;
                    const bf16r* o1p = OATT + ((size_t)(b * 32 + h * 4 + 0 + vh) * SEQ + t) * 128 + d;
                    const bf16r* o2p = OATT + ((size_t)(b * 32 + h * 4 + 2 + vh) * SEQ + t) * 128 + d;
                    const v4u a = __builtin_nontemporal_load((const v4u*)o1p), c2 = __builtin_nontemporal_load((const v4u*)o2p);
                    float oc[8] = {bflo(a.x) - lamv * bflo(c2.x), bfhi(a.x) - lamv * bfhi(c2.x), bflo(a.y) - lamv * bflo(c2.y), bfhi(a.y) - lamv * bfhi(c2.y),
                                   bflo(a.z) - lamv * bflo(c2.z), bfhi(a.z) - lamv * bfhi(c2.z), bflo(a.w) - lamv * bflo(c2.w), bfhi(a.w) - lamv * bfhi(c2.w)};
                    float ss = 0.f;
#pragma unroll
                    for (int j = 0; j < 8; ++j) ss += oc[j] * oc[j];
                    ss += __shfl_xor(ss, 1); ss += __shfl_xor(ss, 2); ss += __shfl_xor(ss, 4); ss += __shfl_xor(ss, 8); ss += __shfl_xor(ss, 16);
                    const float rs = (1.0f - lam_init) / sqrtf(ss * (1.0f / 256.0f) + NORM_EPS);
                    const f32x4 g0 = *(const f32x4*)(sg + (e & 255)), g1 = *(const f32x4*)(sg + (e & 255) + 4);
                    v4u w; w.x = pk2(oc[0] * rs * g0.x, oc[1] * rs * g0.y); w.y = pk2(oc[2] * rs * g0.z, oc[3] * rs * g0.w); w.z = pk2(oc[4] * rs * g1.x, oc[5] * rs * g1.y); w.w = pk2(oc[6] * rs * g1.z, oc[7] * rs * g1.w);
                    *(v4u*)(yrow + 2048 + e) = w;
                }
            }
            }
            SEAM4(pb + 8, 8 * l + 5);
        }

        if (ENK(9) && IN(pb + 9)) {
            PHASE_IDS;
#pragma unroll 1
            for (int rep_ = 0; rep_ < REPS(9); ++rep_) {
            bf16r* const YCAT = WSP(bf16r, WS_YCAT);
            bf16r* const W_OUT = WSP(bf16r, WS_WOUT);
            bf16r* const XB = WSP(bf16r, WS_H);
            pg8::Gemm g{YCAT, W_OUT + (size_t)l * D_MODEL * D_MODEL, M_TOK, D_MODEL, D_MODEL}; pg8::StaticOrder S; S.init(M_TOK, D_MODEL, G, bx);
            pg8::EpiResX E{(l == 0) ? karg_in(I_X) : (const float*)nullptr, XB, nullptr, XB, WSP(float, WS_PSS) + (size_t)(2 * l) * 64 * M_TOK, D_MODEL, M_TOK};
            pg8::gemm_phase<pg8::EpiResX, pg8::StaticOrder, GEMM_ALIGN, GEMM_SP2>(ldsl, g, S, E);
            }
            SEAM4(pb + 9, 8 * l + 0);
        }

        if (ENK(11) && IN(pb + 11)) {
            PHASE_IDS;
#pragma unroll 1
            for (int rep_ = 0; rep_ < REPS(11); ++rep_) {
            bf16r* const HB = WSP(bf16r, WS_H);
            bf16r* const W_FF1 = WSP(bf16r, WS_WFF1);
            bf16r* const HID = WSP(bf16r, WS_HID);
            pg8::Gemm g{HB, W_FF1 + (size_t)l * D_FF * D_MODEL, M_TOK, D_FF, D_MODEL}; pg8::StaticOrder S; S.init(M_TOK, D_FF, G, bx);
            { const float* pssp = WSP(float, WS_PSS) + (size_t)(2 * l) * 64 * M_TOK;
              pg8::Unit u0; if (S.next(0, u0)) RS_TABLE_FILL(pssp, 64, u0.pm); }
            pg8::EpiBf16X<2> E{HID, D_FF_LD, nullptr, nullptr, 0, (const LAS float*)(ldsl + RS_TABLE_OFF)};
            pg8::gemm_phase<pg8::EpiBf16X<2>, pg8::StaticOrder, GEMM_ALIGN, GEMM_SP2>(ldsl, g, S, E);
            }
            SEAM4(pb + 11, 8 * l + 1);
        }

        if (ENK(12) && IN(pb + 12)) {
            PHASE_IDS;
#pragma unroll 1
            for (int rep_ = 0; rep_ < REPS(12); ++rep_) {
            bf16r* const HID = WSP(bf16r, WS_HID);
            bf16r* const W_FF2 = WSP(bf16r, WS_WFF2);
            float* const OUT = karg_out();
            pg8::Gemm g{HID, W_FF2 + (size_t)l * D_MODEL * D_FF_LD, M_TOK, D_MODEL, D_FF, 0, 0, D_FF_LD}; pg8::StaticOrder S; S.init(M_TOK, D_MODEL, G, bx);
            bf16r* const XB = WSP(bf16r, WS_H);
            pg8::EpiResX E{nullptr, XB, (l + 1 == DEPTH) ? OUT : (float*)nullptr, XB, WSP(float, WS_PSS) + (size_t)1 * 64 * M_TOK, D_MODEL, M_TOK};
            pg8::gemm_phase<pg8::EpiResX, pg8::StaticOrder, GEMM_ALIGN, GEMM_SP2>(ldsl, g, S, E);
            }
            SEAM(pb + 12);
        }
    }
#if defined(DBG_STAMP_MASK)
    if (multi) {
        xcd_barrier(bar);
        if (blockIdx.x == 0 && threadIdx.x == 0) {
            const unsigned long long* st = WSP(unsigned long long, 12 * MiB);
            double idle = 0.0, lat = 0.0;
            for (int k = 0; k < N_PHASES - 1; ++k) {
                if (!((DBG_STAMP_MASK >> k) & 1)) continue;
                unsigned long long amax = 0, emax = 0; double asum = 0.0; bool any = false;
                for (int b2 = 0; b2 < G; ++b2) { const unsigned long long a = st[(k * 2 + 0) * 256 + b2], e = st[(k * 2 + 1) * 256 + b2]; if (a == 0xAAAAAAAAAAAAAAAAull) continue; any = true; amax = a > amax ? a : amax; emax = e > emax ? e : emax; asum += (double)a; }
                if (!any) continue;
                idle += (double)amax - asum / (double)G; lat += (double)emax - (double)amax;
            }
            karg_out()[0] = (float)(floor(idle * 0.01 / 200.0 + 0.5) * 200.0 * 1.0e4);
            karg_out()[1] = (float)(floor(lat * 0.01 / 100.0 + 0.5) * 100.0 * 1.0e4);
        }
    }
#endif
#undef IN
#undef SEAM
#undef SEAM4
#undef SEAM4H
}


#ifndef MK_PER_PHASE
#define MK_PER_PHASE 0
#endif
extern "C" void kernel_launch(void* const* d_in, const int* in_sizes, int n_in, void* d_out, int out_size, void* d_ws, size_t ws_size, hipStream_t stream) {
    static int grid = 0;
    if (grid == 0) {
        if (n_in != N_INPUTS || out_size != M_TOK * D_MODEL || ws_size < WS_END) { fprintf(stderr, "kernel_launch: unexpected shapes (n_in %d, out %d, ws %zu < %zu); nothing launched\n", n_in, out_size, ws_size, (size_t)WS_END); grid = -1; return; }
        int dev = 0, cus = 0;
        if (hipGetDevice(&dev) != hipSuccess || hipDeviceGetAttribute(&cus, hipDeviceAttributeMultiprocessorCount, dev) != hipSuccess || cus <= 0) { fprintf(stderr, "kernel_launch: device query failed\n"); grid = -1; return; }
        if (hipFuncSetAttribute((const void*)hymba_fwd, hipFuncAttributeMaxDynamicSharedMemorySize, LDS_BYTES) != hipSuccess) { fprintf(stderr, "kernel_launch: hipFuncSetAttribute failed\n"); grid = -1; return; }
        int per_cu = 0;
        if (hipOccupancyMaxActiveBlocksPerMultiprocessor(&per_cu, (const void*)hymba_fwd, NTHREADS, LDS_BYTES) != hipSuccess || per_cu < 1) fprintf(stderr, "kernel_launch: occupancy query reports %d blocks per CU\n", per_cu);
        (void)hipGetLastError();
        grid = cus;
        if (grid != 256) { fprintf(stderr, "kernel_launch: built for a 256-CU device (one row panel per workgroup in the z and ff1 GEMM phases); this device reports %d CUs; nothing launched\n", cus); grid = -1; return; }
    }
    if (grid < 0) return;
    (void)in_sizes;
    if (hipMemsetAsync((char*)d_ws + WS_CTL, 0, CTL_ZERO_BYTES, stream) != hipSuccess) { fprintf(stderr, "kernel_launch: memset failed\n"); return; }
    Args a{};
    for (int i = 0; i < N_INPUTS; ++i) a.in[i] = (const float*)d_in[i];
    a.out = (float*)d_out; a.ws = (unsigned char*)d_ws;
#if MK_PER_PHASE
    for (int p = 0; p < N_PHASES; ++p) { a.ph_lo = p; a.ph_hi = p + 1; hipLaunchKernelGGL(hymba_fwd, dim3(grid), dim3(NTHREADS), LDS_BYTES, stream, a); }
#else
    a.ph_lo = 0; a.ph_hi = N_PHASES;
    hipLaunchKernelGGL(hymba_fwd, dim3(grid), dim3(NTHREADS), LDS_BYTES, stream, a);
#endif
    const hipError_t le = hipPeekAtLastError();
    if (le != hipSuccess) fprintf(stderr, "kernel_launch: launch failed: %s\n", hipGetErrorName(le));
}
```

```cpp
#include <hip/hip_runtime.h>
#include <hip/hip_bf16.h>
#include <cstdio>
#include <cstdint>
__device__ __forceinline__ int tid_opaque() { int t = threadIdx.x; asm volatile("" : "+v"(t)); return t; }
typedef __bf16 hw_bf16x2 __attribute__((ext_vector_type(2)));
typedef float hw_f32x2 __attribute__((ext_vector_type(2)));
__device__ __forceinline__ unsigned pk_bf16_builtin(float lo, float hi) { hw_f32x2 f = {lo, hi}; hw_bf16x2 r = __builtin_convertvector(f, hw_bf16x2); return __builtin_bit_cast(unsigned, r); }
namespace pg8 {
#define PG8_LAS __attribute__((address_space(3)))
typedef unsigned short bf16_t;
typedef short bf16x8 __attribute__((ext_vector_type(8)));
typedef float f32x4 __attribute__((ext_vector_type(4)));
typedef unsigned u32x4 __attribute__((ext_vector_type(4)));
constexpr int BM = 256, BK = 64, HALF = 128, HTB = HALF * BK * 2  , STAGE_BYTES = 8 * HTB, NXCD = 8, WGM = 8;

__host__ __device__ __forceinline__ int lds_byte(int r, int c) { const int st = (r >> 4) * 2 + (c >> 5), rr = r & 15, cc = c & 31, ob = rr * 64 + cc * 2; return st * 1024 + (ob ^ (((ob >> 9) & 1) << 5)); }
__host__ __device__ __forceinline__ void stage_rc(int b, int& R, int& C) { const int st = b / 1024, sb = b % 1024, swz = sb ^ (((sb >> 9) & 1) << 5); R = (st >> 1) * 16 + swz / 64; C = (st & 1) * 32 + (swz % 64) / 2; }
__host__ __device__ __forceinline__ int perm32(int rho) { const int n = rho >> 4, i = rho & 15; return 8 * (i >> 2) + 4 * n + (i & 3); }

struct Unit { int pm, pn; };
struct Gemm { const bf16_t* A; const bf16_t* Bt; int M, N, K; size_t a_pn_stride = 0; int a_pn_shift = 0; int ld = 0;
    __device__ __forceinline__ size_t aoff(int pn) const { return (size_t)(pn >> a_pn_shift) * a_pn_stride; } };

struct StaticOrder {
    int nM, nN, nwg, G, c;
    __host__ __device__ void init(int M, int N, int G_, int c_) { nM = M / BM; nN = N / BM; nwg = nM * nN; G = G_; c = c_; }
    __host__ __device__ bool next(int i, Unit& u) const {
        const long L = (long)i * G + c; if (L >= nwg) return false;
        int wgid = (int)L; { const int q = nwg / NXCD, r = nwg % NXCD, xcd = wgid % NXCD, off = wgid / NXCD; wgid = (xcd < r ? xcd * (q + 1) : r * (q + 1) + (xcd - r) * q) + off; }
        const int nig = WGM * nN, gid = wgid / nig, fm = gid * WGM, gsz = (nM - fm) < WGM ? (nM - fm) : WGM;
        u.pm = fm + ((wgid % nig) % gsz); u.pn = (wgid % nig) / gsz; return true;
    }
    __device__ __forceinline__ void a_ready(const Unit&) const {}
    __device__ __forceinline__ void done(const Unit&) const {}
};

__device__ __forceinline__ unsigned cvt_pk_bf16(float lo, float hi) { return pk_bf16_builtin(lo, hi); }
typedef float f32x2 __attribute__((ext_vector_type(2)));
__device__ __forceinline__ f32x2 gelu_pk(f32x2 v) {
    const f32x2 av = __builtin_elementwise_abs(v), d = av * 0.2316418882f + 1.0f;
    f32x2 t; t.x = __builtin_amdgcn_rcpf(d.x); t.y = __builtin_amdgcn_rcpf(d.y);
    f32x2 q = t * 0.5307027145f + (-0.7265760135f); q = q * t + 0.7107068705f; q = q * t + (-0.142248368f); q = q * t + 0.127414796f; q = q * t;
    const f32x2 s = (v * v) * (-0.72134752044f);
    f32x2 e; e.x = __builtin_amdgcn_exp2f(s.x); e.y = __builtin_amdgcn_exp2f(s.y);
    const f32x2 m = v * (q * e), r = v - m;
    f32x2 o; o.x = v.x < 0.f ? m.x : r.x; o.y = v.y < 0.f ? m.y : r.y; return o;
}

template <int ACT> struct EpiBf16X {
    static constexpr bool PERM = true, AFTER_DRAIN = false;
    bf16_t* O; int ldc; const float* bias0; const float* bias1; int bias_split;
    const PG8_LAS float* rs_lds;
    __device__ __forceinline__ void operator()(const f32x4 (&acc)[2][2][4][2], const Unit& u, int wr, int wc, int fr, int fq) const {
        const int row0 = u.pm * BM + wr * 64 + fr; const int colt = u.pn * BM;
        const int col0 = colt + wc * 32 + 8 * fq;
        f32x4 bv[2][2];
#pragma unroll
        for (int bj = 0; bj < 2; ++bj)
#pragma unroll
            for (int n = 0; n < 2; ++n) {
                if (ACT == 1) { const float* bp = ((u.pn & 1) ? bias1 : bias0) + (u.pn >> 1) * BM + (col0 - colt); bv[bj][n] = *(const f32x4*)(bp + bj * HALF + 4 * n); }
                else bv[bj][n] = (f32x4){0.f, 0.f, 0.f, 0.f};
            }
#pragma unroll
        for (int ai = 0; ai < 2; ++ai)
#pragma unroll
            for (int m = 0; m < 4; ++m) { bf16_t* rowp = O + (size_t)(row0 + ai * HALF + m * 16) * ldc + col0;
                float rsc = 1.0f;
                if (rs_lds) rsc = rs_lds[wr * 64 + fr + ai * HALF + m * 16];
#pragma unroll
                for (int bj = 0; bj < 2; ++bj) { f32x4 v0 = (acc[ai][bj][m][0] + bv[bj][0]) * rsc, v1 = (acc[ai][bj][m][1] + bv[bj][1]) * rsc;
                    if (ACT == 1) {
#pragma unroll
                        for (int j = 0; j < 4; ++j) { v0[j] = __builtin_amdgcn_rcpf(1.0f + __builtin_amdgcn_exp2f(-1.4426950408889634f * v0[j])); v1[j] = __builtin_amdgcn_rcpf(1.0f + __builtin_amdgcn_exp2f(-1.4426950408889634f * v1[j])); } }
                    if (ACT == 2) {
#pragma unroll
                        for (int j = 0; j < 4; ++j) { const float a = fmaxf(v0[j], 0.f), b = fmaxf(v1[j], 0.f); v0[j] = a * a; v1[j] = b * b; } }
                    u32x4 w; w.x = cvt_pk_bf16(v0[0], v0[1]); w.y = cvt_pk_bf16(v0[2], v0[3]); w.z = cvt_pk_bf16(v1[0], v1[1]); w.w = cvt_pk_bf16(v1[2], v1[3]);
                    *(u32x4*)(rowp + bj * HALF) = w; } }
    }
};
struct EpiResX {
    static constexpr bool PERM = true, AFTER_DRAIN = false;
    const float* basef; const bf16_t* baseh; float* outf; bf16_t* outh; float* pss; int ldc, nrows;
    __device__ __forceinline__ void operator()(const f32x4 (&acc)[2][2][4][2], const Unit& u, int wr, int wc, int fr, int fq) const {
        const int row0 = u.pm * BM + wr * 64 + fr, col0 = u.pn * BM + wc * 32 + 8 * fq;
        float ssq[2][4];
#pragma unroll
        for (int ai = 0; ai < 2; ++ai)
#pragma unroll
            for (int m = 0; m < 4; ++m) { const size_t off = (size_t)(row0 + ai * HALF + m * 16) * ldc + col0;
                float sq = 0.f;
#pragma unroll
                for (int bj = 0; bj < 2; ++bj) {
                    f32x4 b0, b1;
                    if (basef) { b0 = *(const f32x4*)(basef + off + bj * HALF); b1 = *(const f32x4*)(basef + off + bj * HALF + 4); }
                    else { const u32x4 w = *(const u32x4*)(baseh + off + bj * HALF);
                        b0 = (f32x4){__uint_as_float(w.x << 16), __uint_as_float(w.x & 0xffff0000u), __uint_as_float(w.y << 16), __uint_as_float(w.y & 0xffff0000u)};
                        b1 = (f32x4){__uint_as_float(w.z << 16), __uint_as_float(w.z & 0xffff0000u), __uint_as_float(w.w << 16), __uint_as_float(w.w & 0xffff0000u)}; }
                    const f32x4 v0 = acc[ai][bj][m][0] + b0, v1 = acc[ai][bj][m][1] + b1;
                    if (outf) { *(f32x4*)(outf + off + bj * HALF) = v0; *(f32x4*)(outf + off + bj * HALF + 4) = v1; }
                    else { u32x4 w; w.x = cvt_pk_bf16(v0[0], v0[1]); w.y = cvt_pk_bf16(v0[2], v0[3]); w.z = cvt_pk_bf16(v1[0], v1[1]); w.w = cvt_pk_bf16(v1[2], v1[3]);
                        *(u32x4*)(outh + off + bj * HALF) = w;
                        sq += ((v0[0] * v0[0] + v0[1] * v0[1]) + (v0[2] * v0[2] + v0[3] * v0[3])) + ((v1[0] * v1[0] + v1[1] * v1[1]) + (v1[2] * v1[2] + v1[3] * v1[3])); } }
                ssq[ai][m] = sq;
                asm volatile("" ::: "memory"); }
        if (!outf) {
#pragma unroll
            for (int ai = 0; ai < 2; ++ai)
#pragma unroll
                for (int m = 0; m < 4; ++m) ssq[ai][m] += __shfl_xor(ssq[ai][m], 16);
#pragma unroll
            for (int ai = 0; ai < 2; ++ai)
#pragma unroll
                for (int m = 0; m < 4; ++m) ssq[ai][m] += __shfl_xor(ssq[ai][m], 32);
            if (fq == 0) {
#pragma unroll
                for (int ai = 0; ai < 2; ++ai)
#pragma unroll
                    for (int m = 0; m < 4; ++m) pss[(size_t)(u.pn * 4 + wc) * nrows + (row0 + ai * HALF + m * 16)] = ssq[ai][m];
            }
        }
    }
};
template <class Epi, class Sched, bool ALIGN_EPI = false, bool SP2 = false>
__device__ __forceinline__ void gemm_phase(PG8_LAS unsigned char* lds, const Gemm g, const Sched& S, const Epi& E) {
    const int tid = tid_opaque(), wid = __builtin_amdgcn_readfirstlane(tid >> 6), lane = tid & 63, wr = wid >> 2, wc = wid & 3, fr = lane & 15, fq = lane >> 4;
    const int K = g.K, nt = K / BK, LD = g.ld ? g.ld : K;
    unsigned voffA[2], voffB[2];
#pragma unroll
    for (int i = 0; i < 2; ++i) { int R, C; stage_rc(tid * 16 + i * 8192, R, C); const int Rb = Epi::PERM ? ((R & ~31) + perm32(R & 31)) : R;
        voffA[i] = (unsigned)(R * LD + C) * 2u; voffB[i] = (unsigned)(Rb * LD + C) * 2u; }
    const size_t kstep = (size_t)(BK * 2);
    const size_t hstep = (size_t)HALF * LD * 2;
    const size_t tstep = 2 * hstep;
    const unsigned ldsw = (unsigned)wid * 1024u;
    const int aoff = lds_byte(wr * 64 + fr, fq * 8), boff = lds_byte(wc * 32 + fr, fq * 8);
#define PG8_SA(b, h) (((b) * 2 + (h)) * HTB)
#define PG8_SB(b, h) ((4 + (b) * 2 + (h)) * HTB)
#define PG8_STAGE(bufoff, gbase, voff) do { _Pragma("unroll") for (int _i = 0; _i < 2; ++_i) \
        __builtin_amdgcn_global_load_lds((const unsigned*)((const char*)(gbase) + (voff)[_i]), (PG8_LAS unsigned*)(lds + (bufoff) + ldsw + _i * 8192), 16, 0, 0); } while (0)
#define PG8_LDA(dst, b, h) do { _Pragma("unroll") for (int m = 0; m < 4; ++m) _Pragma("unroll") for (int k = 0; k < 2; ++k) dst[m][k] = *(const PG8_LAS bf16x8*)(lds + PG8_SA(b, h) + aoff + m * 2048 + k * 1024); } while (0)
#define PG8_LDB(dst, b, h) do { _Pragma("unroll") for (int n = 0; n < 2; ++n) _Pragma("unroll") for (int k = 0; k < 2; ++k) dst[n][k] = *(const PG8_LAS bf16x8*)(lds + PG8_SB(b, h) + boff + n * 2048 + k * 1024); } while (0)
#define PG8_MMA(ai, bj, At, Bt) do { __builtin_amdgcn_s_setprio(1); _Pragma("unroll") for (int m = 0; m < 4; ++m) _Pragma("unroll") for (int n = 0; n < 2; ++n) _Pragma("unroll") for (int k = 0; k < 2; ++k) \
        acc[ai][bj][m][n] = __builtin_amdgcn_mfma_f32_16x16x32_bf16(Bt[n][k], At[m][k], acc[ai][bj][m][n], 0, 0, 0); __builtin_amdgcn_s_setprio(0); } while (0)
#define PG8_WAIT_V(n) asm volatile("s_waitcnt vmcnt(" #n ")" ::: "memory")
#define PG8_WAIT_L(n) asm volatile("s_waitcnt lgkmcnt(" #n ")" ::: "memory")
#define PG8_BAR __builtin_amdgcn_s_barrier()
#define PG8_SCHED __builtin_amdgcn_sched_barrier(0)
    Unit cur, nxt; int ui = 0;
    if (!S.next(0, cur)) return;
    f32x4 acc[2][2][4][2];
#pragma unroll
    for (int a = 0; a < 2; ++a)
#pragma unroll
        for (int b = 0; b < 2; ++b)
#pragma unroll
            for (int m = 0; m < 4; ++m)
#pragma unroll
                for (int n = 0; n < 2; ++n) acc[a][b][m][n] = (f32x4){0.f, 0.f, 0.f, 0.f};
    bf16x8 At[4][2], B0[2][2], B1[2][2];
    const char* cA = (const char*)g.A + (size_t)cur.pm * tstep + g.aoff(cur.pn); const char* cB = (const char*)g.Bt + (size_t)cur.pn * tstep;
    S.a_ready(cur);
    if constexpr (SP2) {
        PG8_STAGE(PG8_SB(0, 0), cB, voffB); PG8_STAGE(PG8_SB(0, 1), cB + hstep, voffB); PG8_STAGE(PG8_SA(0, 0), cA, voffA); PG8_STAGE(PG8_SA(0, 1), cA + hstep, voffA);
        if (wr == 1) PG8_BAR;
        PG8_WAIT_V(2); PG8_BAR;
        PG8_STAGE(PG8_SB(1, 0), cB + kstep, voffB); PG8_STAGE(PG8_SA(1, 0), cA + kstep, voffA); PG8_STAGE(PG8_SB(1, 1), cB + hstep + kstep, voffB);
        PG8_WAIT_V(6); PG8_BAR;
    } else {
        PG8_STAGE(PG8_SB(0, 0), cB, voffB); PG8_STAGE(PG8_SA(0, 0), cA, voffA); PG8_STAGE(PG8_SB(0, 1), cB + hstep, voffB); PG8_STAGE(PG8_SA(0, 1), cA + hstep, voffA);
        if (wr == 1) PG8_BAR;
        PG8_WAIT_V(4); PG8_BAR;
        PG8_STAGE(PG8_SB(1, 0), cB + kstep, voffB); PG8_STAGE(PG8_SA(1, 0), cA + kstep, voffA); PG8_STAGE(PG8_SB(1, 1), cB + hstep + kstep, voffB);
        PG8_WAIT_V(6); PG8_BAR;
    }
    for (;;) {
        const bool has_next = S.next(ui + 1, nxt);
        const char* nA = has_next ? (const char*)g.A + (size_t)nxt.pm * tstep + g.aoff(nxt.pn) : cA; const char* nB = has_next ? (const char*)g.Bt + (size_t)nxt.pn * tstep : cB;
        _Pragma("unroll 1")
        for (int t = 0; t < nt; t += 2) {
            const bool last = (t == nt - 2);
            const char* a1 = cA + (size_t)(t + 1) * kstep;
            const char* a2 = last ? nA : cA + (size_t)(t + 2) * kstep; const char* b2 = last ? nB : cB + (size_t)(t + 2) * kstep;
            const char* a3 = a2 + kstep; const char* b3 = b2 + kstep;
            if (last && has_next) S.a_ready(nxt);
            if constexpr (SP2) {
            PG8_LDB(B0, 0, 0); PG8_LDB(B1, 0, 1); PG8_SCHED; PG8_LDA(At, 0, 0); PG8_STAGE(PG8_SA(1, 1), a1 + hstep, voffA);
            PG8_WAIT_V(8); PG8_WAIT_L(0); PG8_BAR; PG8_MMA(0, 0, At, B0); PG8_MMA(0, 1, At, B1); PG8_BAR; PG8_SCHED;
            PG8_LDA(At, 0, 1); PG8_STAGE(PG8_SB(0, 0), b2, voffB); PG8_STAGE(PG8_SB(0, 1), b2 + hstep, voffB); PG8_STAGE(PG8_SA(0, 0), a2, voffA);
            PG8_WAIT_V(8); PG8_WAIT_L(0); PG8_BAR; PG8_MMA(1, 0, At, B0); PG8_MMA(1, 1, At, B1); PG8_BAR; PG8_SCHED;
            PG8_LDB(B0, 1, 0); PG8_LDB(B1, 1, 1); PG8_SCHED; PG8_LDA(At, 1, 0); PG8_STAGE(PG8_SA(0, 1), a2 + hstep, voffA);
            PG8_WAIT_V(8); PG8_WAIT_L(0); PG8_BAR; PG8_MMA(0, 0, At, B0); PG8_MMA(0, 1, At, B1); PG8_BAR; PG8_SCHED;
            PG8_LDA(At, 1, 1); PG8_STAGE(PG8_SB(1, 0), b3, voffB); PG8_STAGE(PG8_SB(1, 1), b3 + hstep, voffB); PG8_STAGE(PG8_SA(1, 0), a3, voffA);
            PG8_WAIT_V(8); PG8_WAIT_L(0); PG8_BAR; PG8_MMA(1, 0, At, B0); PG8_MMA(1, 1, At, B1); PG8_BAR; PG8_SCHED;
            } else {
            PG8_LDB(B0, 0, 0); PG8_SCHED; PG8_LDA(At, 0, 0); PG8_STAGE(PG8_SA(1, 1), a1 + hstep, voffA);
            PG8_WAIT_L(8); PG8_BAR; PG8_WAIT_L(0); PG8_MMA(0, 0, At, B0); PG8_BAR; PG8_SCHED;
            PG8_LDB(B1, 0, 1); PG8_STAGE(PG8_SB(0, 0), b2, voffB);
            PG8_BAR; PG8_WAIT_L(0); PG8_MMA(0, 1, At, B1); PG8_BAR;
            PG8_LDA(At, 0, 1); PG8_STAGE(PG8_SA(0, 0), a2, voffA);
            PG8_BAR; PG8_WAIT_L(0); PG8_MMA(1, 0, At, B0); PG8_BAR; PG8_SCHED;
            PG8_STAGE(PG8_SB(0, 1), b2 + hstep, voffB);
            PG8_WAIT_V(6); PG8_BAR; PG8_MMA(1, 1, At, B1); PG8_BAR;
            PG8_LDB(B0, 1, 0); PG8_SCHED; PG8_LDA(At, 1, 0); PG8_STAGE(PG8_SA(0, 1), a2 + hstep, voffA);
            PG8_WAIT_L(8); PG8_BAR; PG8_WAIT_L(0); PG8_MMA(0, 0, At, B0); PG8_BAR; PG8_SCHED;
            PG8_LDB(B1, 1, 1); PG8_STAGE(PG8_SB(1, 0), b3, voffB);
            PG8_BAR; PG8_WAIT_L(0); PG8_MMA(0, 1, At, B1); PG8_BAR;
            PG8_LDA(At, 1, 1); PG8_STAGE(PG8_SA(1, 0), a3, voffA);
            PG8_BAR; PG8_WAIT_L(0); PG8_MMA(1, 0, At, B0); PG8_BAR; PG8_SCHED;
            PG8_STAGE(PG8_SB(1, 1), b3 + hstep, voffB);
            PG8_WAIT_V(6); PG8_BAR; PG8_MMA(1, 1, At, B1); PG8_BAR;
            }
        }
        if constexpr (ALIGN_EPI) { if (wr == 0) PG8_BAR; }
        if constexpr (!Epi::AFTER_DRAIN) { E(acc, cur, wr, wc, fr, fq); S.done(cur); }
        if (!has_next) break;
#pragma unroll
        for (int a = 0; a < 2; ++a)
#pragma unroll
            for (int b = 0; b < 2; ++b)
#pragma unroll
                for (int m = 0; m < 4; ++m)
#pragma unroll
                    for (int n = 0; n < 2; ++n) acc[a][b][m][n] = (f32x4){0.f, 0.f, 0.f, 0.f};
        cur = nxt; cA = nA; cB = nB; ++ui;
        if constexpr (ALIGN_EPI) { if (wr == 1) PG8_BAR; }
    }
    PG8_WAIT_V(0);
    if constexpr (!ALIGN_EPI) { if (wr == 0) PG8_BAR; }
    PG8_BAR;
    if constexpr (Epi::AFTER_DRAIN) { E.fused(acc, cur, wr, wc, fr, fq, lds, wid, lane); S.done(cur); }
#undef PG8_SA
#undef PG8_SB
#undef PG8_STAGE
#undef PG8_LDA
#undef PG8_LDB
#undef PG8_MMA
#undef PG8_WAIT_V
#undef PG8_WAIT_L
#undef PG8_BAR
#undef PG8_SCHED
}
}

namespace ab {
enum { ORDER_NATURAL = 0, ORDER_REVERSED = 1, ORDER_PAIRED = 2, ORDER_XCD = 4 };
using TIN = __hip_bfloat16; using TOUT = __hip_bfloat16;
constexpr int B = 4, H = 32, HKV = 32, SQ = 4096, SKV = 4096, D = 128;
constexpr int QOFF = 0; constexpr int WINDOW = SKV; constexpr float THR = 8.f; constexpr int ORDER = ORDER_PAIRED; constexpr int GRID_WGS = 0; constexpr bool WSKIP = false;
constexpr float SCALE = 0.08838834764831845f;
constexpr int NW = 8, QBLK = 32, KVBLK = 64, QB = NW * QBLK;
constexpr int SHM_V = KVBLK * D * 2, SHM_K = KVBLK * D * 2;
constexpr int LDS_BYTES = 2 * SHM_V + 2 * SHM_K + NW * 64 * 4;
constexpr int V_ROW = 12288;
constexpr int O_STAGE = LDS_BYTES, O_STAGE_ROW = 272, O_STAGE_WAVE = 32 * O_STAGE_ROW;
using bf16 = __hip_bfloat16;
typedef short bf16x8 __attribute__((ext_vector_type(8)));
typedef short s16x4 __attribute__((ext_vector_type(4)));
typedef float f32x16 __attribute__((ext_vector_type(16)));
typedef float f32x4 __attribute__((ext_vector_type(4)));
typedef unsigned u32x4 __attribute__((ext_vector_type(4)));
template <class A, class Bt> struct same_t { static constexpr bool v = false; };
template <class A> struct same_t<A, A> { static constexpr bool v = true; };

#define KSWZ(row, colB) ((row) * 256 + ((colB) ^ (((row) & 7) << 4)))
#define SBAR() __builtin_amdgcn_sched_barrier(0)
__device__ __forceinline__ int v_st(int k, int c) { const int kk = (k & ~0xC) | ((k & 4) << 1) | ((k & 8) >> 1); return ((kk >> 3) * 4 + (c >> 5)) * 512 + ((kk & 7) * 32 + (c & 31)) * 2; }
__device__ __forceinline__ int v_rd_base(int lane) { return ((lane & 3) << 3) | (((lane >> 2) & 3) << 6) | (((lane >> 4) & 1) << 5) | (((lane >> 5) & 1) << 8); }
constexpr int v_rd_off(int d0, int ks, int half) { return d0 * 512 + ks * 4096 + half * 2048; }
__device__ __forceinline__ int crow(int r, int hi) { return (r & 3) + 8 * (r >> 2) + 4 * hi; }
__device__ __forceinline__ unsigned cvtpk(float lo, float hi) {
    return pk_bf16_builtin(lo, hi);
}
__device__ __forceinline__ bf16x8 pack8(f32x4 a, f32x4 b) {
    u32x4 w = {cvtpk(a[0], a[1]), cvtpk(a[2], a[3]), cvtpk(b[0], b[1]), cvtpk(b[2], b[3])};
    return *reinterpret_cast<bf16x8*>(&w);
}
template <class T> __device__ __forceinline__ bf16x8 load8(const T* p) {
    if constexpr (same_t<T, float>::v) { return pack8(*(const f32x4*)p, *(const f32x4*)(p + 4)); }
    else { return *reinterpret_cast<const bf16x8*>(p); }
}
__device__ __forceinline__ void mask_tile(f32x16& p0, f32x16& p1, int dq, unsigned W) {
    const float NEG = -__builtin_inff();
#pragma unroll
    for (int r = 0; r < 16; ++r) {
        const int c = (r & 3) + 8 * (r >> 2);
        if ((unsigned)(dq - c) >= W) p0[r] = NEG;
        if ((unsigned)(dq - c - 32) >= W) p1[r] = NEG;
    }
}
__device__ __forceinline__ void partialSM(f32x16& p0, f32x16& p1, float& m_reg, float& mn, float& alpha) {
    float pmax = p0[0]; for (int r = 1; r < 16; ++r) pmax = fmaxf(pmax, p0[r]); for (int r = 0; r < 16; ++r) pmax = fmaxf(pmax, p1[r]);
    { auto rr = __builtin_amdgcn_permlane32_swap(__float_as_uint(pmax), __float_as_uint(pmax), false, false);
      pmax = fmaxf(__uint_as_float(rr[0]), __uint_as_float(rr[1])); }
    constexpr float C2 = 1.4426950408889634f * SCALE;
    if (__builtin_expect(__all((pmax - m_reg) * SCALE <= THR), 1)) { mn = m_reg; alpha = 1.f; }
    else { mn = fmaxf(m_reg, pmax); alpha = __builtin_amdgcn_exp2f((m_reg - mn) * C2); m_reg = mn; }
    const float mnL = -mn * C2;
    for (int r = 0; r < 16; ++r) p0[r] = fmaf(p0[r], C2, mnL); for (int r = 0; r < 16; ++r) p1[r] = fmaf(p1[r], C2, mnL);
    for (int r = 0; r < 16; ++r) p0[r] = __builtin_amdgcn_exp2f(p0[r]);
}
__device__ __forceinline__ void finishSM(f32x16& p0, f32x16& p1, float alpha, float& l_reg, bf16x8& pa0, bf16x8& pa1, bf16x8& pa2, bf16x8& pa3) {
    for (int r = 0; r < 16; ++r) p1[r] = __builtin_amdgcn_exp2f(p1[r]);
    float ps = 0; for (int r = 0; r < 16; ++r) ps += p0[r]; for (int r = 0; r < 16; ++r) ps += p1[r];
    { auto rr = __builtin_amdgcn_permlane32_swap(__float_as_uint(ps), __float_as_uint(ps), false, false);
      ps = __uint_as_float(rr[0]) + __uint_as_float(rr[1]); }
    l_reg = l_reg * alpha + ps;
#define PK4(P, B_, OUT) do { unsigned a0 = cvtpk(P[B_+0], P[B_+1]), a1 = cvtpk(P[B_+2], P[B_+3]);                          \
        unsigned b0 = cvtpk(P[B_+4], P[B_+5]), b1 = cvtpk(P[B_+6], P[B_+7]);                                             \
        auto r0 = __builtin_amdgcn_permlane32_swap(a0, b0, false, false); auto r1 = __builtin_amdgcn_permlane32_swap(a1, b1, false, false); \
        u32x4 w = {r0[0], r1[0], r0[1], r1[1]}; OUT = *reinterpret_cast<bf16x8*>(&w); } while (0)
    PK4(p0, 0, pa0); PK4(p0, 8, pa1); PK4(p1, 0, pa2); PK4(p1, 8, pa3);
#undef PK4
}
template <int KB, bool SK>
__device__ __forceinline__ void qkt(f32x16& p0, f32x16& p1, const char* K_lds, int r32, int hi, const bf16x8* qr, bool act) {
    if (SK && !act) { const float NEG = -__builtin_inff();
#pragma unroll
        for (int r = 0; r < 16; ++r) { p0[r] = NEG; p1[r] = NEG; } return; }
    p0 = f32x16{}; p1 = f32x16{};
    const char* kb[4];
#pragma unroll
    for (int dd = 0; dd < 4; ++dd) kb[dd] = K_lds + KB * SHM_K + KSWZ(r32, (dd * 16 + hi * 8) * 2);
#pragma unroll
    for (int d0 = 0; d0 < 8; ++d0) { const char* a = kb[d0 & 3] + (d0 >> 2) * 128;
        bf16x8 b0 = *reinterpret_cast<const bf16x8*>(a);
        bf16x8 b1 = *reinterpret_cast<const bf16x8*>(a + 32 * 256);
        p0 = __builtin_amdgcn_mfma_f32_32x32x16_bf16(b0, qr[d0], p0, 0, 0, 0);
        p1 = __builtin_amdgcn_mfma_f32_32x32x16_bf16(b1, qr[d0], p1, 0, 0, 0); }
}
template <int VB, bool SK>
__device__ __forceinline__ void pv_tile(f32x16* o, int vb0, bf16x8 pa0, bf16x8 pa1, bf16x8 pa2, bf16x8 pa3, bool act) {
    if (SK && !act) return;
#define TRRD(dst, off) asm volatile("ds_read_b64_tr_b16 %0, %1 offset:%2" : "=&v"(dst) : "v"(vb0), "i"(off) : "memory")
#define PV_D0(d0) do { s16x4 l0, l1, l2, l3, h0, h1, h2, h3; constexpr int b_ = VB * SHM_V + v_rd_off(d0, 0, 0);     \
        TRRD(l0, b_); TRRD(h0, b_ + 2048); TRRD(l1, b_ + 4096); TRRD(h1, b_ + 6144); TRRD(l2, b_ + 8192); TRRD(h2, b_ + 10240); TRRD(l3, b_ + 12288); TRRD(h3, b_ + 14336); \
        asm volatile("s_waitcnt lgkmcnt(0)" ::: "memory"); SBAR();                 \
        o[d0] = __builtin_amdgcn_mfma_f32_32x32x16_bf16(pa0, (bf16x8){l0[0], l0[1], l0[2], l0[3], h0[0], h0[1], h0[2], h0[3]}, o[d0], 0, 0, 0);   \
        o[d0] = __builtin_amdgcn_mfma_f32_32x32x16_bf16(pa1, (bf16x8){l1[0], l1[1], l1[2], l1[3], h1[0], h1[1], h1[2], h1[3]}, o[d0], 0, 0, 0);   \
        o[d0] = __builtin_amdgcn_mfma_f32_32x32x16_bf16(pa2, (bf16x8){l2[0], l2[1], l2[2], l2[3], h2[0], h2[1], h2[2], h2[3]}, o[d0], 0, 0, 0);   \
        o[d0] = __builtin_amdgcn_mfma_f32_32x32x16_bf16(pa3, (bf16x8){l3[0], l3[1], l3[2], l3[3], h3[0], h3[1], h3[2], h3[3]}, o[d0], 0, 0, 0); } while (0)
    PV_D0(0); PV_D0(1); PV_D0(2); PV_D0(3);
#undef PV_D0
#undef TRRD
}

template <class TIn, class TOut> struct BlockRef { const TIn* Q; const TIn* K; const TIn* V; TOut* O; int P0; };
template <class TIn> struct Seam {
    bf16x8 qr[8];
    bf16x8 st_v0, st_v1, st_k0, st_k1; f32x4 sf0, sf1, sf2, sf3;
    f32x4 tq[16];
};
__device__ __forceinline__ int swa_jlo(int P0, int W) { const int lowk = P0 - W + 1; return lowk > 0 ? lowk / KVBLK : 0; }
#define ROW(p, k0, rr) ((p) + (size_t)((k0) + (rr)) * D + sc)
#define ROWV(p, k0, rr) ((p) + (size_t)((k0) + (rr)) * V_ROW + sc)
#define VMW() asm volatile("s_waitcnt vmcnt(0)" ::: "memory")
#define VMWN(n) asm volatile("s_waitcnt vmcnt(%0)" :: "i"(n) : "memory")
#define SLOAD_H(Kp, Vp, k0) do { S.st_v0 = load8<TIn>(ROWV(Vp, k0, sr)); S.st_v1 = load8<TIn>(ROWV(Vp, k0, 32 + sr));              \
                         S.st_k0 = load8<TIn>(ROW(Kp, k0, sr)); S.st_k1 = load8<TIn>(ROW(Kp, k0, 32 + sr)); } while (0)
#define SWRITE_HK(bf) do { *(bf16x8*)(K_lds + (bf) * SHM_K + kws) = S.st_k0; *(bf16x8*)(K_lds + (bf) * SHM_K + kws + 32 * 256) = S.st_k1; } while (0)
#define SWRITE_HV(bf) do { *(bf16x8*)(V_lds + (bf) * SHM_V + vst0) = S.st_v0; *(bf16x8*)(V_lds + (bf) * SHM_V + vst1) = S.st_v1; } while (0)
#define SWRITE_H(bf) do { SWRITE_HV(bf); SWRITE_HK(bf); } while (0)
#define SLOAD_F(p, k0) do { S.sf0 = *(const f32x4*)ROW(p, k0, sr); S.sf1 = *(const f32x4*)(ROW(p, k0, sr) + 4);                \
                            S.sf2 = *(const f32x4*)ROW(p, k0, 32 + sr); S.sf3 = *(const f32x4*)(ROW(p, k0, 32 + sr) + 4); } while (0)
#define SWRITE_KF(bf) do { *(bf16x8*)(K_lds + (bf) * SHM_K + kws) = pack8(S.sf0, S.sf1); *(bf16x8*)(K_lds + (bf) * SHM_K + kws + 32 * 256) = pack8(S.sf2, S.sf3); } while (0)
#define SWRITE_VF(bf) do { *(bf16x8*)(V_lds + (bf) * SHM_V + vst0) = pack8(S.sf0, S.sf1); *(bf16x8*)(V_lds + (bf) * SHM_V + vst1) = pack8(S.sf2, S.sf3); } while (0)
template <class TIn, class TOut>
__device__ __forceinline__ void causal_swa_prime(const BlockRef<TIn, TOut>& cur, int W, char* lds, Seam<TIn>& S) {
    constexpr bool F32 = same_t<TIn, float>::v;
    const int tid = tid_opaque(), wid = __builtin_amdgcn_readfirstlane(tid >> 6), lane = tid & 63, r32 = lane & 31, hi = lane >> 5;
    const int sr = tid >> 4, sc = (tid & 15) * 8, kws = KSWZ(sr, sc * 2); char* K_lds = lds + 2 * SHM_V;
    const int kb0 = swa_jlo(cur.P0, W) * KVBLK;
    for (int d0 = 0; d0 < 8; ++d0) S.qr[d0] = load8<TIn>(cur.Q + (size_t)(wid * QBLK + r32) * D + d0 * 16 + hi * 8);
    if constexpr (F32) { SLOAD_F((const float*)cur.K, kb0); VMW(); SWRITE_KF(0); SBAR(); SLOAD_F((const float*)cur.V, kb0); }
    else { SLOAD_H(cur.K, cur.V, kb0); VMW(); SWRITE_HK(0); }
    __syncthreads();
}
template <class TIn, class TOut>
__device__ __forceinline__ void causal_swa_block(const BlockRef<TIn, TOut>& cur, const BlockRef<TIn, TOut>& nxt, int skv, int W, char* lds, Seam<TIn>& S) {
    constexpr bool F32 = same_t<TIn, float>::v;
    const int tid = tid_opaque(), wid = __builtin_amdgcn_readfirstlane(tid >> 6), lane = tid & 63, r32 = lane & 31, hi = lane >> 5;
    const int j_lo = swa_jlo(cur.P0, W);
    int j_hi = (cur.P0 + QB - 1) / KVBLK + 1; if (j_hi > skv / KVBLK) j_hi = skv / KVBLK;
    const int NT = j_hi - j_lo;
    const int kbn = swa_jlo(nxt.P0, W) * KVBLK;
    const int qlo = cur.P0 + wid * QBLK, qm = qlo + r32 - 4 * hi;
    char* V_lds = lds; char* K_lds = lds + 2 * SHM_V;
    float* ws = (float*)(lds + 2 * SHM_V + 2 * SHM_K) + wid * 64; float* li_l = ws, * al_l = ws + 32;
    float m_reg = -1e30f, l_reg = 0; f32x16 o[4] = {};
    const int sr = tid >> 4, sc = (tid & 15) * 8, vst0 = v_st(sr, sc), vst1 = v_st(32 + sr, sc), kws = KSWZ(sr, sc * 2);
    const int vb0 = (int)(uintptr_t)V_lds + v_rd_base(lane);
    const TIn* Kh = cur.K; const TIn* Vh = cur.V;
#define RESC(a) do { if (__any((a) < 1.f)) { if (hi == 0) al_l[r32] = (a); asm volatile("s_waitcnt lgkmcnt(0)" ::: "memory");              \
                     for (int d_ = 0; d_ < 4; ++d_) for (int r = 0; r < 16; ++r) o[d_][r] *= al_l[crow(r, hi)]; } } while (0)
#define KBASE(t) ((j_lo + (t)) * KVBLK)
#define ACT(t) (KBASE(t) <= qlo + QBLK - 1 && KBASE(t) + KVBLK - 1 >= qlo - W + 1)
#define MASKT(P0_, P1_, t) do { const int kb_ = KBASE(t); if ((!SK || ACT(t)) && (kb_ + KVBLK - 1 > qlo || kb_ <= qlo + QBLK - 1 - W)) mask_tile(P0_, P1_, qm - kb_, (unsigned)W); } while (0)
    constexpr int NQL = F32 ? 16 : 8;
    constexpr bool SK = WSKIP && !F32;
#define SEAM_K0() do { VMWN(NQL); if constexpr (F32) { SWRITE_KF(0); SBAR(); SLOAD_F((const float*)nxt.V, kbn); } else { SWRITE_HK(0); } SBAR(); } while (0)
    f32x16 pA0, pA1, pB0, pB1; float mnA, mnB, alA, alB; bf16x8 pa0, pa1, pa2, pa3;
    if constexpr (F32) { VMW(); SWRITE_VF(0); SBAR(); } else { SWRITE_HV(0); SBAR(); }
    if (NT > 1) { if constexpr (F32) SLOAD_F((const float*)Kh, KBASE(1)); else SLOAD_H(Kh, Vh, KBASE(1)); }
    SBAR(); qkt<0, SK>(pA0, pA1, K_lds, r32, hi, S.qr, ACT(0));
    if constexpr (F32) { if (NT > 1) { VMW(); SWRITE_KF(1); SBAR(); SLOAD_F((const float*)Vh, KBASE(1)); } }
    MASKT(pA0, pA1, 0); partialSM(pA0, pA1, m_reg, mnA, alA);
    if (NT > 1) { VMW(); if constexpr (F32) { SWRITE_VF(1); SBAR(); if (NT > 2) SLOAD_F((const float*)Kh, KBASE(2)); } else SWRITE_H(1); }
    __syncthreads();
#define HALF_STEP(PX0, PX1, mnX, alX, PY0, PY1, alY, t, KB, VB, SB) do {                                                      \
        SBAR(); qkt<KB, SK>(PX0, PX1, K_lds, r32, hi, S.qr, ACT(t));                                             \
        finishSM(PY0, PY1, alY, l_reg, pa0, pa1, pa2, pa3); SBAR();                                                           \
        if ((t) + 1 < NT) { if constexpr (F32) { VMW(); SWRITE_KF(SB); SBAR(); SLOAD_F((const float*)Vh, KBASE((t) + 1)); }  \
                            else { SLOAD_H(Kh, Vh, KBASE((t) + 1)); } SBAR(); }                                               \
        pv_tile<VB, SK>(o, vb0, pa0, pa1, pa2, pa3, ACT((t) - 1)); MASKT(PX0, PX1, (t)); partialSM(PX0, PX1, m_reg, mnX, alX);                                        \
        __syncthreads();                                                                                                      \
        if ((t) + 1 < NT) { VMW(); if constexpr (F32) { SWRITE_VF(SB); SBAR(); if ((t) + 2 < NT) SLOAD_F((const float*)Kh, KBASE((t) + 2)); } \
                            else { SWRITE_H(SB); } }                                                                          \
        RESC(alX); __syncthreads(); } while (0)
    for (int t = 1; t + 1 < NT; t += 2) {
        HALF_STEP(pB0, pB1, mnB, alB, pA0, pA1, alA, t, 1, 0, 0);
        HALF_STEP(pA0, pA1, mnA, alA, pB0, pB1, alB, t + 1, 0, 1, 1);
    }
    const bool even = (NT & 1) == 0;
    if (even) { SBAR(); qkt<1, SK>(pB0, pB1, K_lds, r32, hi, S.qr, ACT(NT - 1)); SBAR(); }
#define QROW(e) (nxt.Q + (size_t)(wid * QBLK + r32) * D + ((e) >> 1) * 16 + hi * 8 + ((e) & 1) * 4)
    if constexpr (F32) { SLOAD_F((const float*)nxt.K, kbn); SBAR();
#pragma unroll
        for (int e = 0; e < 8; ++e) S.tq[e] = *(const f32x4*)QROW(e); }
    else { SLOAD_H(nxt.K, nxt.V, kbn); SBAR();
#pragma unroll
        for (int d0 = 0; d0 < 8; ++d0) S.qr[d0] = load8<TIn>(nxt.Q + (size_t)(wid * QBLK + r32) * D + d0 * 16 + hi * 8); }
    SBAR();
    finishSM(pA0, pA1, alA, l_reg, pa0, pa1, pa2, pa3); SBAR();
    if constexpr (F32) {
#pragma unroll
        for (int e = 8; e < 16; ++e) S.tq[e] = *(const f32x4*)QROW(e); SBAR(); }
#undef QROW
    pv_tile<0, SK>(o, vb0, pa0, pa1, pa2, pa3, ACT(even ? NT - 2 : NT - 1));
    if (even) { MASKT(pB0, pB1, NT - 1); partialSM(pB0, pB1, m_reg, mnB, alB); __syncthreads(); RESC(alB);
        finishSM(pB0, pB1, alB, l_reg, pa0, pa1, pa2, pa3); SBAR(); pv_tile<1, SK>(o, vb0, pa0, pa1, pa2, pa3, ACT(NT - 1)); }
    SBAR(); SEAM_K0();
    if (hi == 0) li_l[r32] = l_reg; asm volatile("s_waitcnt lgkmcnt(0)" ::: "memory");
    float rli[16];
#pragma unroll
    for (int r = 0; r < 16; ++r) rli[r] = __builtin_amdgcn_rcpf(li_l[crow(r, hi)]);
    TOut* Ow = cur.O + (size_t)(wid * QBLK) * D;
#pragma unroll
    for (int r = 0; r < 16; ++r) { const int orow = crow(r, hi);
#pragma unroll
        for (int d0 = 0; d0 < 4; ++d0) { const float v = o[d0][r] * rli[r];
            if constexpr (same_t<TOut, float>::v) { Ow[(size_t)orow * D + d0 * 32 + r32] = v; }
            else { *(unsigned short*)(lds + O_STAGE + wid * O_STAGE_WAVE + orow * O_STAGE_ROW + (d0 * 32 + r32) * 2) = (unsigned short)cvtpk(v, 0.f); } } }
    if constexpr (!same_t<TOut, float>::v) {
#pragma unroll
        for (int j = 0; j < 8; ++j) { const int ch = j * 64 + lane, orow = ch >> 4, c16 = ch & 15;
            __builtin_nontemporal_store(*(const u32x4*)(lds + O_STAGE + wid * O_STAGE_WAVE + orow * O_STAGE_ROW + c16 * 16), (u32x4*)((char*)(Ow + (size_t)orow * D) + c16 * 16)); } }
    if constexpr (F32) {
#pragma unroll
        for (int d0 = 0; d0 < 8; ++d0) S.qr[d0] = pack8(S.tq[2 * d0], S.tq[2 * d0 + 1]); }
    __syncthreads();
#undef RESC
#undef KBASE
#undef ACT
#undef MASKT
#undef SEAM_K0
#undef HALF_STEP
}
#undef ROW
#undef VMW
#undef VMWN
#undef SLOAD_H
#undef SWRITE_HK
#undef SWRITE_HV
#undef SWRITE_H
#undef SLOAD_F
#undef SWRITE_KF
#undef SWRITE_VF

}

#define XB_TMO      128
#define XB_XCNT(j)  (256  + 64 * (j))
#define XB_XSUB(j)  (1280 + 64 * (j))
#define XB_XGEN(j)  (2304 + 64 * (j))
#define XB_TOP      3328
#define XB_TOPGEN   3392
#define XCD_BAR_WORDS 3456
#define XB_SPIN_CAP (1u << 18)
#define LAS __attribute__((address_space(3)))

__device__ __forceinline__ unsigned xb_ld(unsigned* p)              { return __hip_atomic_load(p, __ATOMIC_RELAXED, __HIP_MEMORY_SCOPE_AGENT); }
__device__ __forceinline__ unsigned xb_add(unsigned* p, unsigned v) { return __hip_atomic_fetch_add(p, v, __ATOMIC_RELAXED, __HIP_MEMORY_SCOPE_AGENT); }
__device__ __forceinline__ unsigned xb_xcc_id() { return (unsigned)__builtin_amdgcn_s_getreg((3 << 11) | 20) & 0xFu; }
#define XB_SPIN(cond, bar) do { unsigned _sp = 0; while (cond) { __builtin_amdgcn_s_sleep(1); \
    if ((++_sp & 255u) == 0u) { if (xb_ld(&(bar)[XB_TMO])) break; if (_sp > XB_SPIN_CAP) { atomicAdd(&(bar)[XB_TMO], 1u); break; } } } } while (0)

struct XcdBarrier {
    unsigned* bar; unsigned x;
    volatile LAS unsigned* st;
};

__device__ __forceinline__ XcdBarrier xcd_barrier_post(unsigned* bar, volatile LAS unsigned* st) {
    XcdBarrier b; b.bar = bar; b.x = xb_xcc_id(); b.st = st;
    if (threadIdx.x == 0) (void)xb_add(&bar[XB_XCNT(b.x)], 1u);
    return b;
}
__device__ __forceinline__ void xcd_barrier_complete(unsigned* bar, unsigned x, unsigned& nloc, unsigned& nx) {
    const unsigned G = gridDim.x * gridDim.y * gridDim.z;
    unsigned sum, cnt, mine, sp = 0u;
    for (;;) {
        sum = 0u; cnt = 0u; mine = 0u;
#pragma unroll
        for (unsigned j = 0; j < 16; ++j) { const unsigned c = xb_ld(&bar[XB_XCNT(j)]); sum += c; cnt += (c > 0u) ? 1u : 0u; mine = (j == x) ? c : mine; }
        if (sum == G) break;
        __builtin_amdgcn_s_sleep(1);
        if ((++sp & 255u) == 0u) { if (xb_ld(&bar[XB_TMO])) break; if (sp > XB_SPIN_CAP) { atomicAdd(&bar[XB_TMO], 1u); break; } }
    }
    nloc = mine > 0u ? mine : 1u; nx = cnt > 0u ? cnt : 1u;
}

__device__ __forceinline__ void xcd_barrier(const XcdBarrier& b) {
    asm volatile("s_waitcnt vmcnt(0)" ::: "memory");
    __syncthreads();
    if (threadIdx.x == 0) {
        unsigned* bar = b.bar;
        __builtin_amdgcn_s_waitcnt(0);
        unsigned nloc = b.st[0], nx = b.st[1];
        if (nloc == 0u) { xcd_barrier_complete(bar, b.x, nloc, nx); b.st[0] = nloc; b.st[1] = nx; }
        const unsigned old = xb_add(&bar[XB_XSUB(b.x)], 1u);
        const unsigned gen = old / nloc;
        if (old + 1u == (gen + 1u) * nloc) {
            __builtin_amdgcn_fence(__ATOMIC_RELEASE, "agent");
            asm volatile("s_waitcnt vmcnt(0)" ::: "memory");
            const unsigned og = xb_add(&bar[XB_TOP], 1u);
            const unsigned tg = og / nx;
            if (og + 1u == (tg + 1u) * nx) xb_add(&bar[XB_TOPGEN], 1u);
            else XB_SPIN(xb_ld(&bar[XB_TOPGEN]) == tg, bar);
            __builtin_amdgcn_fence(__ATOMIC_ACQUIRE, "agent");
            xb_add(&bar[XB_XGEN(b.x)], 1u);
            asm volatile("s_waitcnt vmcnt(0)" ::: "memory");
        } else {
            XB_SPIN(xb_ld(&bar[XB_XGEN(b.x)]) == gen, bar);
            __builtin_amdgcn_fence(__ATOMIC_ACQUIRE, "agent");
            asm volatile("s_waitcnt vmcnt(0)" ::: "memory");
        }
    }
    __syncthreads();
}

constexpr int D_MODEL = 4096, BATCH = 4, SEQ = 4096, DEPTH = 2, M_TOK = BATCH * SEQ;
constexpr int D_FF_LD = 16384 + 128;
constexpr int IN_WIDTH = 12288, D_FF = 16384, LRU_W = 1024, HG_W = 1024, DIFF_W = 2048;
constexpr int OFF_A_GATE = 0, OFF_A_X = 1024, OFF_B_Q = 2048, OFF_B_F = 3072, OFF_B_I = 4096, OFF_B_G = 5120, OFF_C_Q = 6144, OFF_C_K = 8192, OFF_C_V = 10240;
constexpr float NORM_EPS = 1e-6f;
constexpr int NWAVES = 8, NTHREADS = NWAVES * 64;
constexpr int N_INPUTS = 21;
enum { I_X = 0, I_LN1, I_WIN, I_CONVW, I_CONVB, I_WR, I_BR, I_WI, I_BI, I_LAM, I_LRUG, I_HLB, I_HNG, I_QNG, I_KNG, I_DLAM, I_SUBLN, I_WOUT, I_LN2, I_WFF1, I_WFF2 };

constexpr size_t MiB = (size_t)1 << 20;
constexpr size_t WS_CTL = 0, CTL_ZERO_BYTES = 1 * MiB;
constexpr size_t WS_LB = 1 * MiB;
constexpr size_t WS_ROPE = 2 * MiB;
constexpr size_t WS_WGATE = 4 * MiB;
constexpr size_t WS_WIN = 16 * MiB;
constexpr size_t WS_WOUT = 208 * MiB;
constexpr size_t WS_WFF1 = 272 * MiB;
constexpr size_t WS_WFF2 = 528 * MiB;
constexpr size_t WS_H = 1904 * MiB;
constexpr size_t WS_YCAT = 912 * MiB;
constexpr size_t WS_Z = 1040 * MiB;
constexpr size_t WS_XA = 1424 * MiB;
constexpr size_t WS_RI = 1456 * MiB;
constexpr size_t WS_PSS = 1712 * MiB;
constexpr size_t WS_RS0 = 1724 * MiB;
constexpr size_t WS_QH = 1584 * MiB, WS_KH = 1648 * MiB;
constexpr size_t WS_OATT = 1776 * MiB;
constexpr size_t WS_LSUM = 2032 * MiB;
constexpr size_t WS_HID = 1040 * MiB;
constexpr size_t WS_END = 2034 * MiB;
constexpr int CW_BAR = 4096;

constexpr int RING_BYTES = 131072, LDS_BYTES = 147456, MISC_OFF = LDS_BYTES - 512;
static_assert(ab::O_STAGE + 8 * ab::O_STAGE_WAVE <= MISC_OFF, "attention LDS (tiles + output stage) must stay below the control words");

#define GAS __attribute__((address_space(1)))
typedef unsigned short bf16r;
typedef unsigned v4u __attribute__((ext_vector_type(4)));
typedef unsigned v2u __attribute__((ext_vector_type(2)));
typedef float f32x4 __attribute__((ext_vector_type(4)));
typedef float f32x2 __attribute__((ext_vector_type(2)));
#define LDS_WAIT() asm volatile("s_waitcnt lgkmcnt(0)" ::: "memory")
__device__ __forceinline__ float bflo(unsigned w) { return __uint_as_float(w << 16); }
__device__ __forceinline__ float bfhi(unsigned w) { return __uint_as_float(w & 0xffff0000u); }
__device__ __forceinline__ float bf1(bf16r b) { return __uint_as_float((unsigned)b << 16); }
__device__ __forceinline__ unsigned pk2(float lo, float hi) { return pk_bf16_builtin(lo, hi); }
__device__ __forceinline__ float wave_sum(float v) {
#pragma unroll
    for (int o = 1; o < 64; o <<= 1) v += __shfl_xor(v, o);
    return v;
}
__device__ __forceinline__ float fast_exp(float x) { return __builtin_amdgcn_exp2f(x * 1.4426950408889634f); }
__device__ __forceinline__ float sigmoidf_(float x) { return __builtin_amdgcn_rcpf(1.0f + fast_exp(-x)); }

__device__ __forceinline__ void p0_transpose_item(const float* W, int K, int N, bf16r* WT, LAS float* scr, int item, int lane, const float* kgain, int ldw) {
    const int nblk = N / 32, kb = item / nblk, nb = item % nblk, k0 = 64 * kb, n0 = 32 * nb;
    {
        const int l8 = lane & 7, lr = lane >> 3; f32x4 v[8];
#pragma unroll
        for (int i = 0; i < 8; ++i) v[i] = __builtin_nontemporal_load((const f32x4*)(W + (size_t)(k0 + 8 * i + lr) * N + n0 + 4 * l8));
#pragma unroll
        for (int i = 0; i < 8; ++i) { LAS float* d = scr + (8 * i + lr) * 33 + 4 * l8; d[0] = v[i].x; d[1] = v[i].y; d[2] = v[i].z; d[3] = v[i].w; }
    }
    LDS_WAIT(); asm volatile("" ::: "memory");
    const int c = lane & 7;
    f32x4 g0 = (f32x4){1.f, 1.f, 1.f, 1.f}, g1 = g0;
    if (kgain) { g0 = *(const f32x4*)(kgain + k0 + 8 * c); g1 = *(const f32x4*)(kgain + k0 + 8 * c + 4); }
#pragma unroll
    for (int j = 0; j < 4; ++j) { const int n = (lane >> 3) + 8 * j; const LAS float* s = scr + (8 * c) * 33 + n;
        v4u o; o.x = pk2(s[0 * 33] * g0.x, s[1 * 33] * g0.y); o.y = pk2(s[2 * 33] * g0.z, s[3 * 33] * g0.w); o.z = pk2(s[4 * 33] * g1.x, s[5 * 33] * g1.y); o.w = pk2(s[6 * 33] * g1.z, s[7 * 33] * g1.w);
        *(v4u*)(WT + (size_t)(n0 + n) * ldw + k0 + 8 * c) = o; }
    LDS_WAIT(); asm volatile("" ::: "memory");
}

struct Args { const float* in[N_INPUTS]; float* out; unsigned char* ws; int ph_lo, ph_hi; };

#ifndef GEMM_ALIGN
#define GEMM_ALIGN true
#endif
#ifndef GEMM_SP2
#define GEMM_SP2 true
#endif
constexpr int PH_PER_LAYER = 13, N_PHASES = 1 + DEPTH * PH_PER_LAYER;

__device__ __forceinline__ float neg_expm1(float x) {
    if (x > -0.3f) { float p = 1.0f + x * (1.0f / 7.0f); p = 1.0f + x * (1.0f / 6.0f) * p; p = 1.0f + x * 0.2f * p; p = 1.0f + x * 0.25f * p; p = 1.0f + x * (1.0f / 3.0f) * p; p = 1.0f + x * 0.5f * p; return -x * p; }
    return 1.0f - fast_exp(x);
}
__device__ __forceinline__ void lru_step(float r, float ig, float x, float sp8, bool first, float& h, float& A) {
    const float la = -r * sp8; const float a = fast_exp(la);
    const float mult = first ? 1.0f : sqrtf(neg_expm1(2.0f * la));
    h = a * h + mult * (ig * x); A += la;
}
__device__ __forceinline__ float gelu_tanh(float x) { const float y = 1.5957691216057308f * (x + 0.044715f * x * x * x); return x * __builtin_amdgcn_rcpf(1.0f + fast_exp(-y)); }

typedef const __attribute__((address_space(4))) unsigned char* kargp_t;
__device__ __forceinline__ kargp_t karg_base() { kargp_t kp = (kargp_t)__builtin_amdgcn_kernarg_segment_ptr(); asm volatile("" : "+s"(kp)); return kp; }
__device__ __forceinline__ const float* karg_in(int i) { return *(const float* const __attribute__((address_space(4)))*)(karg_base() + 8 * i); }
__device__ __forceinline__ float* karg_out() { return *(float* const __attribute__((address_space(4)))*)(karg_base() + 8 * N_INPUTS); }
__device__ __forceinline__ unsigned char* karg_ws() { return *(unsigned char* const __attribute__((address_space(4)))*)(karg_base() + 8 * N_INPUTS + 8); }
__device__ __forceinline__ int karg_int(int i) { return *(const int __attribute__((address_space(4)))*)(karg_base() + 8 * N_INPUTS + 16 + 4 * i); }
#define WSP(T, off) ((T*)(karg_ws() + (off)))
#define PHASE_IDS const int tid = tid_opaque(), lane = tid & 63, wave = __builtin_amdgcn_readfirstlane(tid >> 6), gw = vcu * NWAVES + wave; (void)tid; (void)lane; (void)wave; (void)gw

typedef short hg_bf16x8 __attribute__((ext_vector_type(8)));
#define HG_MFMA(a, b, c) __builtin_amdgcn_mfma_f32_16x16x32_bf16((a), (b), (c), 0, 0, 0)
#define HG_BAR() do { asm volatile("s_waitcnt vmcnt(0) lgkmcnt(0)" ::: "memory"); __builtin_amdgcn_s_barrier(); asm volatile("" ::: "memory"); } while (0)
#define HG_BARL() do { asm volatile("s_waitcnt lgkmcnt(0)" ::: "memory"); __builtin_amdgcn_s_barrier(); asm volatile("" ::: "memory"); } while (0)
__device__ __forceinline__ void hgrn_chunked(LAS unsigned char* L, const bf16r* Z, const float* lbp, const float* hgain, bf16r* YCAT, int b, int h, int tid) {
    constexpr int QS = 0, KS = 17408, KT = 34816, VT = 53248, STO = 71680, PS = 106496, SP = 115712, DM = 123904, DH = 124416;
    constexpr int RS = 272, TS = 144;
    const int lane = tid & 63, wave = __builtin_amdgcn_readfirstlane(tid >> 6), lr = lane & 15, lq = lane >> 4;
    const int u = tid & 255, j8 = (u & 15) * 8, seg = u >> 4;
    const bool scaler = wave < 4;
    const bool backward = wave < 2;
    const size_t tok0 = (size_t)b * SEQ;
    f32x4 stm[8];
#pragma unroll
    for (int n = 0; n < 8; ++n) stm[n] = (f32x4){0.f, 0.f, 0.f, 0.f};
    constexpr int LBS = 124928;
    if (tid < 128) *(LAS float*)(L + LBS + tid * 4) = 1.0f - lbp[h * 128 + tid];
    HG_BARL();
    v4u ldA[4], ldB[4];
#define HG_ISSUE(c) do { const size_t m_ = tok0 + (size_t)(c) * 64 + 4 * seg; \
        if (scaler) { _Pragma("unroll") for (int r = 0; r < 4; ++r) { ldA[r] = __builtin_nontemporal_load((const v4u*)(Z + (m_ + r) * IN_WIDTH + OFF_B_F + h * 128 + j8)); ldB[r] = __builtin_nontemporal_load((const v4u*)(Z + (m_ + r) * IN_WIDTH + OFF_B_Q + h * 128 + j8)); } } \
        else { _Pragma("unroll") for (int r = 0; r < 4; ++r) ldA[r] = __builtin_nontemporal_load((const v4u*)(Z + (m_ + r) * IN_WIDTH + OFF_B_I + h * 128 + j8)); } } while (0)
    HG_ISSUE(0);
#pragma unroll 1
    for (int c = 0; c < SEQ / 64; ++c) {
        float loc[4][8], Lp[8];
        if (scaler) {
            asm volatile("s_waitcnt vmcnt(0)" ::: "memory");
#pragma unroll
            for (int r = 0; r < 4; ++r) {
                const unsigned zw[4] = {ldA[r].x, ldA[r].y, ldA[r].z, ldA[r].w}; unsigned kwp[4];
                const f32x4 om0 = *(const LAS f32x4*)(L + LBS + j8 * 4), om1 = *(const LAS f32x4*)(L + LBS + j8 * 4 + 16);
                const float oml[8] = {om0.x, om0.y, om0.z, om0.w, om1.x, om1.y, om1.z, om1.w};
#pragma unroll
                for (int e2 = 0; e2 < 4; ++e2) { const float k0_ = oml[2 * e2] * __builtin_amdgcn_rcpf(1.0f + fast_exp(bflo(zw[e2]))), k1_ = oml[2 * e2 + 1] * __builtin_amdgcn_rcpf(1.0f + fast_exp(bfhi(zw[e2]))); kwp[e2] = pk2(k0_, k1_); }
                ldA[r] = (v4u){kwp[0], kwp[1], kwp[2], kwp[3]};
            }
            const unsigned kw0[4] = {ldA[0].x, ldA[0].y, ldA[0].z, ldA[0].w}, kw1[4] = {ldA[1].x, ldA[1].y, ldA[1].z, ldA[1].w}, kw2[4] = {ldA[2].x, ldA[2].y, ldA[2].z, ldA[2].w}, kw3[4] = {ldA[3].x, ldA[3].y, ldA[3].z, ldA[3].w};
#pragma unroll
            for (int e = 0; e < 8; ++e) {
                const float f0 = 1.0f - ((e & 1) ? bfhi(kw0[e >> 1]) : bflo(kw0[e >> 1])), f1 = 1.0f - ((e & 1) ? bfhi(kw1[e >> 1]) : bflo(kw1[e >> 1]));
                const float f2 = 1.0f - ((e & 1) ? bfhi(kw2[e >> 1]) : bflo(kw2[e >> 1])), f3 = 1.0f - ((e & 1) ? bfhi(kw3[e >> 1]) : bflo(kw3[e >> 1]));
                if (backward) { loc[3][e] = 1.0f; loc[2][e] = f3; loc[1][e] = f3 * f2; loc[0][e] = f3 * f2 * f1; Lp[e] = loc[0][e] * f0; }
                else { loc[0][e] = f0; loc[1][e] = f0 * f1; loc[2][e] = loc[1][e] * f2; loc[3][e] = loc[2][e] * f3; Lp[e] = loc[3][e]; }
            }
            *(LAS f32x4*)(L + SP + (seg * 128 + j8) * 4) = (f32x4){Lp[0], Lp[1], Lp[2], Lp[3]};
            *(LAS f32x4*)(L + SP + (seg * 128 + j8) * 4 + 16) = (f32x4){Lp[4], Lp[5], Lp[6], Lp[7]};
        }
        HG_BAR();
        if (scaler) {
            float X[8];
#pragma unroll
            for (int e = 0; e < 8; ++e) X[e] = 1.0f;
#pragma unroll
            for (int k = 0; k < 7; ++k) {
                const int sp = backward ? (1 + k) : (8 + k);
                const bool use = backward ? (sp > seg) : (sp < seg);
                const f32x4 a = *(const LAS f32x4*)(L + SP + (sp * 128 + j8) * 4), b4 = *(const LAS f32x4*)(L + SP + (sp * 128 + j8) * 4 + 16);
                X[0] *= use ? a.x : 1.0f; X[1] *= use ? a.y : 1.0f; X[2] *= use ? a.z : 1.0f; X[3] *= use ? a.w : 1.0f;
                X[4] *= use ? b4.x : 1.0f; X[5] *= use ? b4.y : 1.0f; X[6] *= use ? b4.z : 1.0f; X[7] *= use ? b4.w : 1.0f;
            }
            if (seg == 0) { *(LAS f32x4*)(L + DM + j8 * 4) = (f32x4){Lp[0] * X[0], Lp[1] * X[1], Lp[2] * X[2], Lp[3] * X[3]}; *(LAS f32x4*)(L + DM + j8 * 4 + 16) = (f32x4){Lp[4] * X[4], Lp[5] * X[5], Lp[6] * X[6], Lp[7] * X[7]}; }
            if (seg == 15) { *(LAS f32x4*)(L + DH + j8 * 4) = (f32x4){Lp[0] * X[0], Lp[1] * X[1], Lp[2] * X[2], Lp[3] * X[3]}; *(LAS f32x4*)(L + DH + j8 * 4 + 16) = (f32x4){Lp[4] * X[4], Lp[5] * X[5], Lp[6] * X[6], Lp[7] * X[7]}; }
            unsigned kt[8][2];
#pragma unroll
            for (int r = 0; r < 4; ++r) {
                float qs[8], ks[8];
                const unsigned kwr[4] = {ldA[r].x, ldA[r].y, ldA[r].z, ldA[r].w}, qwr[4] = {ldB[r].x, ldB[r].y, ldB[r].z, ldB[r].w};
#pragma unroll
                for (int e = 0; e < 8; ++e) {
                    float E, IE;
                    if (backward) { IE = fmaxf(loc[r][e] * X[e], 1.0e-30f); E = __builtin_amdgcn_rcpf(IE); }
                    else { E = fmaxf(loc[r][e] * X[e], 1.0e-30f); IE = __builtin_amdgcn_rcpf(E); }
                    { const float zq_ = (e & 1) ? bfhi(qwr[e >> 1]) : bflo(qwr[e >> 1]); qs[e] = zq_ * sigmoidf_(zq_) * 0.08838834764831845f * E; } ks[e] = ((e & 1) ? bfhi(kwr[e >> 1]) : bflo(kwr[e >> 1])) * IE;
                }
                v4u wq, wk; wq.x = pk2(qs[0], qs[1]); wq.y = pk2(qs[2], qs[3]); wq.z = pk2(qs[4], qs[5]); wq.w = pk2(qs[6], qs[7]);
                wk.x = pk2(ks[0], ks[1]); wk.y = pk2(ks[2], ks[3]); wk.z = pk2(ks[4], ks[5]); wk.w = pk2(ks[6], ks[7]);
                *(LAS v4u*)(L + QS + (4 * seg + r) * RS + j8 * 2) = wq; *(LAS v4u*)(L + KS + (4 * seg + r) * RS + j8 * 2) = wk;
                const unsigned kw[4] = {wk.x, wk.y, wk.z, wk.w};
#pragma unroll
                for (int e = 0; e < 8; ++e) { const unsigned hv = (e & 1) ? (kw[e >> 1] >> 16) : (kw[e >> 1] & 0xffffu);
                    if (r == 0) kt[e][0] = hv; else if (r == 1) kt[e][0] |= hv << 16; else if (r == 2) kt[e][1] = hv; else kt[e][1] |= hv << 16; }
            }
#pragma unroll
            for (int e = 0; e < 8; ++e) *(LAS v2u*)(L + KT + (j8 + e) * TS + (4 * seg) * 2) = (v2u){kt[e][0], kt[e][1]};
        } else {
            asm volatile("s_waitcnt vmcnt(0)" ::: "memory");
            const unsigned vw[4][4] = {{ldA[0].x, ldA[0].y, ldA[0].z, ldA[0].w}, {ldA[1].x, ldA[1].y, ldA[1].z, ldA[1].w}, {ldA[2].x, ldA[2].y, ldA[2].z, ldA[2].w}, {ldA[3].x, ldA[3].y, ldA[3].z, ldA[3].w}};
#pragma unroll
            for (int e = 0; e < 8; ++e) {
                unsigned h0, h1, h2, h3;
                if (e & 1) { h0 = vw[0][e >> 1] >> 16; h1 = vw[1][e >> 1] >> 16; h2 = vw[2][e >> 1] >> 16; h3 = vw[3][e >> 1] >> 16; }
                else { h0 = vw[0][e >> 1] & 0xffffu; h1 = vw[1][e >> 1] & 0xffffu; h2 = vw[2][e >> 1] & 0xffffu; h3 = vw[3][e >> 1] & 0xffffu; }
                *(LAS v2u*)(L + VT + (j8 + e) * TS + (4 * seg) * 2) = (v2u){h0 | (h1 << 16), h2 | (h3 << 16)};
            }
        }
        HG_BARL();
#pragma unroll
        for (int n = 0; n < 8; ++n) {
            const f32x4 dm = *(const LAS f32x4*)(L + DM + (16 * n + 4 * lq) * 4); const f32x4 sv = stm[n] * dm;
            *(LAS v2u*)(L + STO + (16 * wave + lr) * RS + (16 * n + 4 * lq) * 2) = (v2u){pk2(sv.x, sv.y), pk2(sv.z, sv.w)};
        }
        {
            const int ti = wave >> 1;
#pragma unroll
            for (int jj = 0; jj < 2; ++jj) {
                const int sj = 2 * (wave & 1) + jj;
                f32x4 acc = (f32x4){0.f, 0.f, 0.f, 0.f};
#pragma unroll
                for (int ks = 0; ks < 4; ++ks) {
                    const hg_bf16x8 a = *(const LAS hg_bf16x8*)(L + KS + (16 * sj + lr) * RS + (ks * 32 + 8 * lq) * 2);
                    const hg_bf16x8 bq = *(const LAS hg_bf16x8*)(L + QS + (16 * ti + lr) * RS + (ks * 32 + 8 * lq) * 2);
                    acc = HG_MFMA(a, bq, acc);
                }
                {
                    const int s0 = 16 * sj + 4 * lq, tt = 16 * ti + lr;
                    acc.x = (s0 + 0 <= tt) ? acc.x : 0.f; acc.y = (s0 + 1 <= tt) ? acc.y : 0.f; acc.z = (s0 + 2 <= tt) ? acc.z : 0.f; acc.w = (s0 + 3 <= tt) ? acc.w : 0.f;
                }
                *(LAS v2u*)(L + PS + (16 * ti + lr) * TS + (16 * sj + 4 * lq) * 2) = (v2u){pk2(acc.x, acc.y), pk2(acc.z, acc.w)};
            }
        }
        if (c + 1 < SEQ / 64) HG_ISSUE(c + 1);
        v2u gld[4];
        int tG = tid; asm volatile("" : "+v"(tG));
#pragma unroll
        for (int k = 0; k < 4; ++k) { const int pc = tG + 512 * k; gld[k] = __builtin_nontemporal_load((const v2u*)(Z + (tok0 + (size_t)c * 64 + (pc >> 5)) * IN_WIDTH + OFF_B_G + h * 128 + (pc & 31) * 4)); }
        HG_BARL();
        f32x4 o[4];
        {
#pragma unroll
            for (int i = 0; i < 4; ++i) o[i] = (f32x4){0.f, 0.f, 0.f, 0.f};
            hg_bf16x8 bs[4];
#pragma unroll
            for (int ks = 0; ks < 4; ++ks) bs[ks] = *(const LAS hg_bf16x8*)(L + STO + (16 * wave + lr) * RS + (ks * 32 + 8 * lq) * 2);
#pragma unroll
            for (int i = 0; i < 4; ++i)
#pragma unroll
                for (int ks = 0; ks < 4; ++ks) { const hg_bf16x8 a = *(const LAS hg_bf16x8*)(L + QS + (16 * i + lr) * RS + (ks * 32 + 8 * lq) * 2); o[i] = HG_MFMA(a, bs[ks], o[i]); }
            hg_bf16x8 bv[2];
#pragma unroll
            for (int ks = 0; ks < 2; ++ks) bv[ks] = *(const LAS hg_bf16x8*)(L + VT + (16 * wave + lr) * TS + (ks * 32 + 8 * lq) * 2);
#pragma unroll
            for (int i = 0; i < 4; ++i)
#pragma unroll
                for (int ks = 0; ks < 2; ++ks) { if (ks == 1 && i < 2) continue; const hg_bf16x8 a = *(const LAS hg_bf16x8*)(L + PS + (16 * i + lr) * TS + (ks * 32 + 8 * lq) * 2); o[i] = HG_MFMA(a, bv[ks], o[i]); }
#pragma unroll
            for (int n = 0; n < 8; ++n) {
                f32x4 U = (f32x4){0.f, 0.f, 0.f, 0.f};
#pragma unroll
                for (int ks = 0; ks < 2; ++ks) { const hg_bf16x8 a = *(const LAS hg_bf16x8*)(L + KT + (16 * n + lr) * TS + (ks * 32 + 8 * lq) * 2); U = HG_MFMA(a, bv[ks], U); }
                const f32x4 dm = *(const LAS f32x4*)(L + DM + (16 * n + 4 * lq) * 4), dh = *(const LAS f32x4*)(L + DH + (16 * n + 4 * lq) * 4);
                stm[n] = stm[n] * (dm * dh) + dh * U;
            }
        }
        HG_BARL();
#pragma unroll
        for (int i = 0; i < 4; ++i) {
            *(LAS float*)(L + (16 * i + 4 * lq + 0) * 528 + (16 * wave + lr) * 4) = o[i].x; *(LAS float*)(L + (16 * i + 4 * lq + 1) * 528 + (16 * wave + lr) * 4) = o[i].y;
            *(LAS float*)(L + (16 * i + 4 * lq + 2) * 528 + (16 * wave + lr) * 4) = o[i].z; *(LAS float*)(L + (16 * i + 4 * lq + 3) * 528 + (16 * wave + lr) * 4) = o[i].w;
        }
        HG_BARL();
        {
            int tE = tid; asm volatile("" : "+v"(tE));
#pragma unroll
            for (int k = 0; k < 4; ++k) { const int pc = tE + 512 * k, row = pc >> 5, col = (pc & 31) * 4;
                const f32x4 ov = *(const LAS f32x4*)(L + row * 528 + col * 4);
                float ss = (ov.x * ov.x + ov.y * ov.y) + (ov.z * ov.z + ov.w * ov.w);
                ss += __shfl_xor(ss, 1); ss += __shfl_xor(ss, 2); ss += __shfl_xor(ss, 4); ss += __shfl_xor(ss, 8); ss += __shfl_xor(ss, 16);
                const float rs = 1.0f / sqrtf(ss * (1.0f / 128.0f) + NORM_EPS);
                const size_t m = tok0 + (size_t)c * 64 + row;
                const v2u gw2 = gld[k];
                const f32x4 hgv = *(const f32x4*)(hgain + col);
                const float g0 = bflo(gw2.x), g1 = bfhi(gw2.x), g2 = bflo(gw2.y), g3 = bfhi(gw2.y);
                v2u w; w.x = pk2(ov.x * rs * hgv.x * (g0 * sigmoidf_(g0)), ov.y * rs * hgv.y * (g1 * sigmoidf_(g1))); w.y = pk2(ov.z * rs * hgv.z * (g2 * sigmoidf_(g2)), ov.w * rs * hgv.w * (g3 * sigmoidf_(g3)));
                *(v2u*)(YCAT + m * D_MODEL + 1024 + h * 128 + col) = w; }
        }
    }
#undef HG_ISSUE
}

__device__ __forceinline__ void xcopy_rows(const float* xin, bf16r* HB, float* RS0, int gw, int ngw, int lane) {
    for (int m = gw; m < M_TOK; m += ngw) {
        const f32x4* xr = (const f32x4*)(xin + (size_t)m * D_MODEL) + lane;
        f32x4 v[16]; float ss = 0.f;
#pragma unroll
        for (int j = 0; j < 16; ++j) { v[j] = __builtin_nontemporal_load(xr + 64 * j); ss += (v[j].x * v[j].x + v[j].y * v[j].y) + (v[j].z * v[j].z + v[j].w * v[j].w); }
        ss = wave_sum(ss);
        v2u* o = (v2u*)(HB + (size_t)m * D_MODEL) + lane;
#pragma unroll
        for (int j = 0; j < 16; ++j) { v2u w; w.x = pk2(v[j].x, v[j].y); w.y = pk2(v[j].z, v[j].w); o[64 * j] = w; }
        if (lane == 0) RS0[m] = ss;
    }
}
#define RS_TABLE_OFF (RING_BYTES + 1024)
#define RS_TABLE_FILL(pssp, nparts, pm_) do { { const int r_ = tid & 255, hf_ = tid >> 8; float ss_ = 0.f;                                                                         \
        if ((nparts) == 1) { if (!hf_) ss_ = (pssp)[(pm_) * 256 + r_]; }                                                                                                           \
        else { _Pragma("unroll 16") for (int j_ = 0; j_ < 32; ++j_) ss_ += (pssp)[(size_t)(hf_ * 32 + j_) * M_TOK + (pm_) * 256 + r_]; }                                           \
        if (hf_) ((LAS float*)(ldsl + RS_TABLE_OFF))[256 + r_] = ss_;                                                                                                              \
        __syncthreads();                                                                                                                                                           \
        if (!hf_) ((LAS float*)(ldsl + RS_TABLE_OFF))[r_] = 1.0f / sqrtf((ss_ + ((LAS float*)(ldsl + RS_TABLE_OFF))[256 + r_]) * (1.0f / D_MODEL) + NORM_EPS); } __syncthreads(); } while (0)

constexpr int WC_IN = (D_MODEL / 64) * (IN_WIDTH / 32), WC_OUT = (D_MODEL / 64) * (D_MODEL / 32), WC_F1 = (D_MODEL / 64) * (D_FF / 32), WC_F2 = (D_FF / 64) * (D_MODEL / 32);
constexpr int WC_LAYER = WC_IN + WC_OUT + WC_F1 + WC_F2;
__device__ __forceinline__ void convert_weights(int it0, int it1, int w, int nw, LAS float* scr, int lane) {
    bf16r* const W_IN = WSP(bf16r, WS_WIN); bf16r* const W_OUT = WSP(bf16r, WS_WOUT); bf16r* const W_FF1 = WSP(bf16r, WS_WFF1); bf16r* const W_FF2 = WSP(bf16r, WS_WFF2);
    for (int it = it0 + w; it < it1; it += nw) {
        const int l = it / WC_LAYER; int r = it - l * WC_LAYER;
        if (r < WC_IN) { p0_transpose_item(karg_in(I_WIN) + (size_t)l * D_MODEL * IN_WIDTH, D_MODEL, IN_WIDTH, W_IN + (size_t)l * IN_WIDTH * D_MODEL, scr, r, lane, karg_in(I_LN1) + l * D_MODEL, D_MODEL); continue; } r -= WC_IN;
        if (r < WC_OUT) { p0_transpose_item(karg_in(I_WOUT) + (size_t)l * D_MODEL * D_MODEL, D_MODEL, D_MODEL, W_OUT + (size_t)l * D_MODEL * D_MODEL, scr, r, lane, nullptr, D_MODEL); continue; } r -= WC_OUT;
        if (r < WC_F1) { p0_transpose_item(karg_in(I_WFF1) + (size_t)l * D_MODEL * D_FF, D_MODEL, D_FF, W_FF1 + (size_t)l * D_FF * D_MODEL, scr, r, lane, karg_in(I_LN2) + l * D_MODEL, D_MODEL); continue; } r -= WC_F1;
        p0_transpose_item(karg_in(I_WFF2) + (size_t)l * D_FF * D_MODEL, D_FF, D_MODEL, W_FF2 + (size_t)l * D_MODEL * D_FF_LD, scr, r, lane, nullptr, D_FF_LD);
    }
}

__device__ __forceinline__ ab::BlockRef<__hip_bfloat16, __hip_bfloat16> attn_ref(const __hip_bfloat16* Qp, const __hip_bfloat16* Kp, const __hip_bfloat16* Vp, __hip_bfloat16* Op, int L, int pass) {
    const int bh = L >> 3, x = L & 7, qb = pass ? 15 - x : x;
    const int b = bh >> 5, hq = bh & 31, h = hq >> 2, c = (hq >> 1) & 1, vh = hq & 1;
    ab::BlockRef<__hip_bfloat16, __hip_bfloat16> r;
    r.Q = Qp + ((size_t)(b * 16 + h * 2 + c) * SEQ + (size_t)qb * 256) * 128;
    r.K = Kp + (size_t)(b * 16 + h * 2 + c) * SEQ * 128;
    r.V = Vp + (size_t)b * SEQ * IN_WIDTH + OFF_C_V + (h * 2 + vh) * 128;
    r.O = Op + ((size_t)(b * 32 + hq) * SEQ + (size_t)qb * 256) * 128;
    r.P0 = qb * 256;
    return r;
}

__device__ __forceinline__ ab::BlockRef<__hip_bfloat16, __hip_bfloat16> attn_ref_q(const __hip_bfloat16* Qp, const __hip_bfloat16* Kp, const __hip_bfloat16* Vp, __hip_bfloat16* Op, int J) {
    const int pr = (J >> 8) * 4 + (J & 3), i = (J & 255) >> 2;
    const int qb = 15 - (i >> 2), b = pr >> 3, h = pr & 7, c = (i >> 1) & 1, vh = i & 1, hq = h * 4 + c * 2 + vh;
    ab::BlockRef<__hip_bfloat16, __hip_bfloat16> r;
    r.Q = Qp + ((size_t)(b * 16 + h * 2 + c) * SEQ + (size_t)qb * 256) * 128;
    r.K = Kp + (size_t)(b * 16 + h * 2 + c) * SEQ * 128;
    r.V = Vp + (size_t)b * SEQ * IN_WIDTH + OFF_C_V + (h * 2 + vh) * 128;
    r.O = Op + ((size_t)(b * 32 + hq) * SEQ + (size_t)qb * 256) * 128;
    r.P0 = qb * 256;
    return r;
}

__device__ __forceinline__ void group4_barrier(unsigned* ctr, unsigned* ctr2, unsigned* bar) {
    asm volatile("s_waitcnt vmcnt(0)" ::: "memory");
    __syncthreads();
    if (threadIdx.x == 0) {
        __builtin_amdgcn_s_waitcnt(0);
        __builtin_amdgcn_fence(__ATOMIC_RELEASE, "agent");
        asm volatile("s_waitcnt vmcnt(0)" ::: "memory");
        (void)xb_add(ctr, 1u);
        XB_SPIN(xb_ld(ctr) < 4u, bar);
        if (ctr2) XB_SPIN(xb_ld(ctr2) < 4u, bar);
        __builtin_amdgcn_fence(__ATOMIC_ACQUIRE, "agent");
        asm volatile("s_waitcnt vmcnt(0)" ::: "memory");
    }
    __syncthreads();
}

constexpr int NQ_ALL = BATCH * 32 * 16, NQ_XCD = NQ_ALL / 8;
__device__ __forceinline__ int aq_take(unsigned* qbase, int x0, volatile LAS unsigned* st) {
    unsigned dx = *st;
    while (dx < 8u) {
        const unsigned q = ((unsigned)x0 + dx) & 7u;
        const unsigned v = __hip_atomic_fetch_add(qbase + 64 * q, 1u, __ATOMIC_RELAXED, __HIP_MEMORY_SCOPE_AGENT);
        if (v < (unsigned)NQ_XCD) { *st = dx; return (int)(q * NQ_XCD + v); }
        ++dx;
    }
    *st = 8u; return NQ_ALL;
}

__global__ void __launch_bounds__(NTHREADS, 2) hymba_fwd(Args args) {
    extern __shared__ __attribute__((aligned(16))) unsigned char lds[];
    LAS unsigned char* ldsl = (LAS unsigned char*)lds;
    const int G = gridDim.x;
    int bx = blockIdx.x;
    int vcu = (G % 8 == 0) ? (bx % 8) * (G / 8) + bx / 8 : bx;
    const int ngw = G * NWAVES;
    volatile LAS unsigned* MISC = (volatile LAS unsigned*)(ldsl + MISC_OFF);
    for (int u = threadIdx.x; u < (LDS_BYTES - RING_BYTES) / 4; u += NTHREADS) ((LAS unsigned*)(ldsl + RING_BYTES))[u] = 0u;
    __syncthreads();
#if MK_PER_PHASE
    const int lo = karg_int(0), hi = karg_int(1);
#else
    constexpr int lo = 0, hi = N_PHASES;
#endif
    const bool multi = (hi - lo) > 1;
    XcdBarrier bar; bar.bar = WSP(unsigned, WS_CTL) + CW_BAR; bar.x = 0; bar.st = nullptr;
    if (multi) bar = xcd_barrier_post(WSP(unsigned, WS_CTL) + CW_BAR, MISC + 8);
    if (multi && threadIdx.x == 0) MISC[18] = __hip_atomic_fetch_add(WSP(unsigned, WS_CTL) + 3072 + 64 * (xb_xcc_id() & 7u), 1u, __ATOMIC_RELAXED, __HIP_MEMORY_SCOPE_AGENT);
#ifndef EN_MASK
#define EN_MASK 0xFFFF
#endif
#define ENK(j) (((EN_MASK) >> (j)) & 1)
#ifndef DBG_TWICE_MASK
#define DBG_TWICE_MASK 0
#endif
#define REPS(j) ((((DBG_TWICE_MASK) >> (j)) & 1) ? 2 : 1)
#define IN(k) (lo <= (k) && (k) < hi)
#if defined(DBG_STAMP_MASK)
#define SEAM(k) do { if (IN((k) + 1)) { if (threadIdx.x == 0) WSP(unsigned long long, 12 * MiB)[((k) * 2 + 0) * 256 + blockIdx.x] = __builtin_amdgcn_s_memrealtime(); xcd_barrier(bar); \
    if (threadIdx.x == 0) WSP(unsigned long long, 12 * MiB)[((k) * 2 + 1) * 256 + blockIdx.x] = __builtin_amdgcn_s_memrealtime(); } } while (0)
#else
#define SEAM(k) do { if (IN((k) + 1)) xcd_barrier(bar); } while (0)
#endif
#define PANEL_PM ((bx & 7) * 8 + ((bx >> 3) & 7))
#define PANEL_R4 ((bx >> 6) & 3)
#define SEAM4(k, slot) do { if (IN((k) + 1)) group4_barrier(WSP(unsigned, WS_CTL) + 16384 + ((slot) * 64 + PANEL_PM) * 64, nullptr, bar.bar); } while (0)
#define SEAM4H(k, slot) do { if (IN((k) + 1)) group4_barrier(WSP(unsigned, WS_CTL) + 16384 + ((slot) * 64 + PANEL_PM) * 64, \
        (PANEL_R4 == 0 && (PANEL_PM & 15) != 0) ? WSP(unsigned, WS_CTL) + 16384 + ((slot) * 64 + PANEL_PM - 1) * 64 : (unsigned*)nullptr, bar.bar); } while (0)

    if (ENK(15) && IN(0)) {
        PHASE_IDS;
#pragma unroll 1
        for (int rep_ = 0; rep_ < REPS(15); ++rep_) {
        bf16r* const W_IN = WSP(bf16r, WS_WIN);
        bf16r* const W_OUT = WSP(bf16r, WS_WOUT);
        bf16r* const W_FF1 = WSP(bf16r, WS_WFF1);
        bf16r* const W_FF2 = WSP(bf16r, WS_WFF2);
        bf16r* const W_GATE = WSP(bf16r, WS_WGATE);
        float* const LB = WSP(float, WS_LB);
        float* const ROPE_COS = WSP(float, WS_ROPE); float* const ROPE_SIN = ROPE_COS + SEQ * 64;
        LAS float* scr = (LAS float*)(ldsl + wave * 16384);
        convert_weights(0, WC_IN, gw, ngw, scr, lane);
        for (int idx = gw * 64 + lane; idx < DEPTH * 2048 * 32; idx += ngw * 64) {
            const int l = idx / (2048 * 32), n = (idx / 32) % 2048, k0 = (idx % 32) * 8;
            const int pn = n >> 8, p = pn >> 1, g = pn & 1, hh = (n >> 7) & 1, j = n & 127;
            v4u o = {0u, 0u, 0u, 0u};
            if ((k0 >> 7) == hh) { const float* w = karg_in(g ? I_WI : I_WR) + (((size_t)l * 8 + 2 * p + hh) * 128 + (k0 & 127)) * 128 + j;
                o.x = pk2(w[0 * 128], w[1 * 128]); o.y = pk2(w[2 * 128], w[3 * 128]); o.z = pk2(w[4 * 128], w[5 * 128]); o.w = pk2(w[6 * 128], w[7 * 128]); }
            *(v4u*)(W_GATE + ((size_t)l * 2048 + n) * 256 + k0) = o;
        }
        for (int c = gw * 64 + lane; c < HG_W; c += ngw * 64) {
            const float b0 = karg_in(I_HLB)[c], b1 = karg_in(I_HLB)[HG_W + c]; const float mx = fmaxf(b0, b1);
            const float e0 = __expf(b0 - mx), e1 = __expf(b1 - mx);
            LB[c] = 0.f; LB[HG_W + c] = e1 / (e0 + e1);
        }
        for (int idx = gw * 64 + lane; idx < SEQ * 64; idx += ngw * 64) {
            const int t = idx >> 6, j = idx & 63;
            const float inv = exp2f(-(float)(2 * j) * (1.0f / 128.0f) * 13.287712379549449f);
            const float angf = (float)t * inv;
            double rev = (double)angf * 0.15915494309189535; rev -= floor(rev);
            const float rf = (float)rev;
            ROPE_COS[idx] = __builtin_amdgcn_cosf(rf); ROPE_SIN[idx] = __builtin_amdgcn_sinf(rf);
        }
        }
        xcopy_rows(karg_in(I_X), WSP(bf16r, WS_H), WSP(float, WS_RS0), gw, ngw, lane);
        SEAM(0);
    }
    if (multi && IN(0) && IN(1) && G % 8 == 0) {
        if (threadIdx.x == 0) {
            const unsigned x = xb_xcc_id() & 7u; unsigned before = 0u;
            for (unsigned j = 0; j < 8u; ++j) { const unsigned cj = __hip_atomic_load(WSP(unsigned, WS_CTL) + 3072 + 64 * j, __ATOMIC_RELAXED, __HIP_MEMORY_SCOPE_AGENT); before += (j < x) ? cj : 0u; }
            MISC[17] = before + MISC[18];
        }
        __syncthreads();
        const int lb = (int)MISC[17];
        if (lb >= 0 && lb < G) { vcu = lb; bx = (lb % (G / 8)) * 8 + lb / (G / 8); }
    }

#pragma unroll 1
    for (int l = 0; l < DEPTH; ++l) {
        const int pb = 1 + l * PH_PER_LAYER;

        if (ENK(1) && IN(pb + 1)) {
            PHASE_IDS;
#pragma unroll 1
            for (int rep_ = 0; rep_ < REPS(1); ++rep_) {
            bf16r* const HB = WSP(bf16r, WS_H);
            bf16r* const W_IN = WSP(bf16r, WS_WIN);
            bf16r* const Z = WSP(bf16r, WS_Z);
            pg8::Gemm g{HB, W_IN + (size_t)l * IN_WIDTH * D_MODEL, M_TOK, IN_WIDTH, D_MODEL}; pg8::StaticOrder S; S.init(M_TOK, IN_WIDTH, G, bx);
            { const float* pssp = (l == 0) ? WSP(float, WS_RS0) : WSP(float, WS_PSS) + (size_t)1 * 64 * M_TOK; const int nparts = (l == 0) ? 1 : 64;
              pg8::Unit u0; if (S.next(0, u0)) RS_TABLE_FILL(pssp, nparts, u0.pm); }
            pg8::EpiBf16X<0> E{Z, IN_WIDTH, nullptr, nullptr, 0, (const LAS float*)(ldsl + RS_TABLE_OFF)};
            pg8::gemm_phase<pg8::EpiBf16X<0>, pg8::StaticOrder, GEMM_ALIGN, GEMM_SP2>(ldsl, g, S, E);
            }
            SEAM4H(pb + 1, 8 * l + 2);
        }

        if (ENK(2) && IN(pb + 2)) {
            PHASE_IDS;
#pragma unroll 1
            for (int rep_ = 0; rep_ < REPS(2); ++rep_) {
            bf16r* const Z = WSP(bf16r, WS_Z);
            bf16r* const XA = WSP(bf16r, WS_XA);
            bf16r* const QH = WSP(bf16r, WS_QH);
            bf16r* const KH = WSP(bf16r, WS_KH);
            float* const LB = WSP(float, WS_LB);
            float* const ROPE_COS = WSP(float, WS_ROPE); float* const ROPE_SIN = ROPE_COS + SEQ * 64;
            const float* convw = karg_in(I_CONVW) + l * 4 * LRU_W; const float* convb = karg_in(I_CONVB) + l * LRU_W;
            const float* qg = karg_in(I_QNG) + l * 128; const float* kg = karg_in(I_KNG) + l * 128;
            for (int m = PANEL_PM * 256 + PANEL_R4 * 64 + wave; m < PANEL_PM * 256 + PANEL_R4 * 64 + 64; m += NWAVES) {
                const int t = m & (SEQ - 1), b = m >> 12;
                const bf16r* zr = Z + (size_t)m * IN_WIDTH;
#pragma unroll
                for (int it = 0; it < 2; ++it) {
                    const int c0 = it * 512 + lane * 8;
                    const f32x4 b0 = *(const f32x4*)(convb + c0), b1 = *(const f32x4*)(convb + c0 + 4);
                    float a0 = b0.x, a1 = b0.y, a2 = b0.z, a3 = b0.w, a4 = b1.x, a5 = b1.y, a6 = b1.z, a7 = b1.w;
#pragma unroll
                    for (int j = 0; j < 4; ++j) {
                        if (t - 3 + j >= 0) {
                            const v4u xv = *(const v4u*)(zr - (ptrdiff_t)(3 - j) * IN_WIDTH + OFF_A_X + c0);
                            const f32x4 w0 = *(const f32x4*)(convw + j * LRU_W + c0), w1 = *(const f32x4*)(convw + j * LRU_W + c0 + 4);
                            a0 += bflo(xv.x) * w0.x; a1 += bfhi(xv.x) * w0.y; a2 += bflo(xv.y) * w0.z; a3 += bfhi(xv.y) * w0.w;
                            a4 += bflo(xv.z) * w1.x; a5 += bfhi(xv.z) * w1.y; a6 += bflo(xv.w) * w1.z; a7 += bfhi(xv.w) * w1.w;
                        }
                    }
                    v4u o; o.x = pk2(a0, a1); o.y = pk2(a2, a3); o.z = pk2(a4, a5); o.w = pk2(a6, a7);
                    *(v4u*)(XA + ((size_t)(c0 >> 8) * M_TOK + m) * 256 + (c0 & 255)) = o;
                }
#pragma unroll
                for (int it = 0; it < 4; ++it) {
                    const int isk = it >> 1, vi = (it & 1) * 8 + (lane >> 3), sub = lane & 7;
                    const bf16r* src = zr + (isk ? OFF_C_K : OFF_C_Q) + vi * 128 + sub * 8;
                    const v4u av = __builtin_nontemporal_load((const v4u*)src), cv = __builtin_nontemporal_load((const v4u*)(src + 64));
                    float x1[8] = {bflo(av.x), bfhi(av.x), bflo(av.y), bfhi(av.y), bflo(av.z), bfhi(av.z), bflo(av.w), bfhi(av.w)};
                    float x2[8] = {bflo(cv.x), bfhi(cv.x), bflo(cv.y), bfhi(cv.y), bflo(cv.z), bfhi(cv.z), bflo(cv.w), bfhi(cv.w)};
                    float ss = 0.f;
#pragma unroll
                    for (int e = 0; e < 8; ++e) ss += x1[e] * x1[e] + x2[e] * x2[e];
                    ss += __shfl_xor(ss, 1); ss += __shfl_xor(ss, 2); ss += __shfl_xor(ss, 4);
                    const float rs = 1.0f / sqrtf(ss * (1.0f / 128.0f) + NORM_EPS);
                    const float* gp = (isk ? kg : qg) + sub * 8;
                    const f32x4 g1a = *(const f32x4*)gp, g1b = *(const f32x4*)(gp + 4), g2a = *(const f32x4*)(gp + 64), g2b = *(const f32x4*)(gp + 68);
                    const f32x4 ca = *(const f32x4*)(ROPE_COS + t * 64 + sub * 8), cb = *(const f32x4*)(ROPE_COS + t * 64 + sub * 8 + 4);
                    const f32x4 sa = *(const f32x4*)(ROPE_SIN + t * 64 + sub * 8), sb = *(const f32x4*)(ROPE_SIN + t * 64 + sub * 8 + 4);
                    const float g1[8] = {g1a.x, g1a.y, g1a.z, g1a.w, g1b.x, g1b.y, g1b.z, g1b.w}, g2[8] = {g2a.x, g2a.y, g2a.z, g2a.w, g2b.x, g2b.y, g2b.z, g2b.w};
                    const float cc[8] = {ca.x, ca.y, ca.z, ca.w, cb.x, cb.y, cb.z, cb.w}, sn[8] = {sa.x, sa.y, sa.z, sa.w, sb.x, sb.y, sb.z, sb.w};
                    float o1[8], o2[8];
#pragma unroll
                    for (int e = 0; e < 8; ++e) { const float y1 = x1[e] * rs * g1[e], y2 = x2[e] * rs * g2[e]; o1[e] = y1 * cc[e] - y2 * sn[e]; o2[e] = y2 * cc[e] + y1 * sn[e]; }
                    bf16r* dst = (isk ? KH : QH) + ((size_t)(b * 16 + vi) * SEQ + t) * 128 + sub * 8;
                    v4u w1, w2; w1.x = pk2(o1[0], o1[1]); w1.y = pk2(o1[2], o1[3]); w1.z = pk2(o1[4], o1[5]); w1.w = pk2(o1[6], o1[7]);
                    w2.x = pk2(o2[0], o2[1]); w2.y = pk2(o2[2], o2[3]); w2.z = pk2(o2[4], o2[5]); w2.w = pk2(o2[6], o2[7]);
                    *(v4u*)dst = w1; *(v4u*)(dst + 64) = w2;
                }
            }
            }
            SEAM4(pb + 2, 8 * l + 3);
        }

        if (ENK(3) && IN(pb + 3)) {
            PHASE_IDS;
#pragma unroll 1
            for (int rep_ = 0; rep_ < REPS(3); ++rep_) {
            bf16r* const XA = WSP(bf16r, WS_XA);
            bf16r* const W_GATE = WSP(bf16r, WS_WGATE);
            bf16r* const RI = WSP(bf16r, WS_RI);
            pg8::Gemm g{XA, W_GATE + (size_t)l * 2048 * 256, M_TOK, 2048, 256, (size_t)M_TOK * 256 * 2, 1}; pg8::StaticOrder S; S.init(M_TOK, 2048, G, bx);
            pg8::EpiBf16X<1> E{RI, 2048, karg_in(I_BR) + l * LRU_W, karg_in(I_BI) + l * LRU_W, 1024, nullptr};
            pg8::gemm_phase<pg8::EpiBf16X<1>, pg8::StaticOrder, GEMM_ALIGN, GEMM_SP2>(ldsl, g, S, E);
            }
            SEAM4(pb + 3, 8 * l + 4);
        }

        if ((ENK(4) || ENK(5)) && (IN(pb + 4) || IN(pb + 5))) {
            PHASE_IDS;
            bf16r* const XA = WSP(bf16r, WS_XA);
            bf16r* const RI = WSP(bf16r, WS_RI);
            float* const LSUM = WSP(float, WS_LSUM);
            bf16r* const Z = WSP(bf16r, WS_Z);
            const float* lam = karg_in(I_LAM) + l * LRU_W;
            const int c = tid * 2;
            const float sp0 = 8.0f * log1pf(__expf(-lam[c])), sp1 = 8.0f * log1pf(__expf(-lam[c + 1]));
            if (ENK(4) && IN(pb + 4)) {
#pragma unroll 1
                for (int rep_ = 0; rep_ < REPS(4); ++rep_)
                for (int u = PANEL_PM * 4 + PANEL_R4; u < BATCH * 64; u += BATCH * 64) {
                    const int b = u >> 6, s = u & 63;
                    float h0 = 0.f, h1 = 0.f, A0 = 0.f, A1 = 0.f;
#pragma unroll 4
                    for (int t = 0; t < 64; ++t) {
                        const size_t m = (size_t)b * SEQ + s * 64 + t;
                        const unsigned rr = *(const unsigned*)(RI + m * 2048 + (c >> 8) * 512 + (c & 255)), ii = *(const unsigned*)(RI + m * 2048 + (c >> 8) * 512 + 256 + (c & 255)), xx = *(const unsigned*)(XA + ((size_t)(c >> 8) * M_TOK + m) * 256 + (c & 255));
                        const bool first = (s == 0 && t == 0);
                        lru_step(bflo(rr), bflo(ii), bflo(xx), sp0, first, h0, A0);
                        lru_step(bfhi(rr), bfhi(ii), bfhi(xx), sp1, first, h1, A1);
                    }
                    *(f32x4*)(LSUM + ((size_t)u * LRU_W + c) * 2) = (f32x4){A0, h0, A1, h1};
                }
                SEAM(pb + 4);
            }
            if (ENK(5) && IN(pb + 5)) {
                constexpr int NHU = BATCH * 8, NCV = 64;
                const bool split = G >= 2 * (NHU + NCV);
                const int rid = bx;
                {
                    const int it0 = l * WC_LAYER + WC_IN, it1 = (l + 1 < DEPTH) ? (l + 1) * WC_LAYER + WC_IN : DEPTH * WC_LAYER;
                    LAS float* scr = (LAS float*)(ldsl + wave * 16384);
                    if (!split) convert_weights(it0, it1, gw, ngw, scr, lane);
                    else if (rid >= NHU && rid < NHU + NCV) convert_weights(it0, it1, (rid - NHU) * NWAVES + wave, NCV * NWAVES, scr, lane);
                }
                if (!split) __syncthreads();
                if (!split || rid >= NHU + NCV) {
                    const float* lg = karg_in(I_LRUG) + l * LRU_W; bf16r* const YCAT = WSP(bf16r, WS_YCAT);
                    for (int u = split ? rid - (NHU + NCV) : rid; u < BATCH * 64; u += split ? G - (NHU + NCV) : G) {
                        const int b = u >> 6, s = u & 63;
                        float h0 = 0.f, h1 = 0.f, A0 = 0.f, A1 = 0.f;
                        for (int sp = 0; sp < s; ++sp) {
                            const f32x4 v = *(const f32x4*)(LSUM + ((size_t)(b * 64 + sp) * LRU_W + c) * 2);
                            h0 = fast_exp(v.x) * h0 + v.y; h1 = fast_exp(v.z) * h1 + v.w;
                        }
#pragma unroll 1
                        for (int hb = 0; hb < 2; ++hb) {
#pragma unroll 4
                            for (int tt = 0; tt < 32; ++tt) {
                                const size_t m = (size_t)b * SEQ + s * 64 + hb * 32 + tt;
                                const unsigned rr = __builtin_nontemporal_load((const unsigned*)(RI + m * 2048 + (c >> 8) * 512 + (c & 255))), ii = __builtin_nontemporal_load((const unsigned*)(RI + m * 2048 + (c >> 8) * 512 + 256 + (c & 255))), xx = __builtin_nontemporal_load((const unsigned*)(XA + ((size_t)(c >> 8) * M_TOK + m) * 256 + (c & 255)));
                                const unsigned gg = __builtin_nontemporal_load((const unsigned*)(Z + m * IN_WIDTH + OFF_A_GATE + c));
                                const bool first = (s == 0 && hb == 0 && tt == 0);
                                lru_step(bflo(rr), bflo(ii), bflo(xx), sp0, first, h0, A0);
                                lru_step(bfhi(rr), bfhi(ii), bfhi(xx), sp1, first, h1, A1);
                                *(LAS f32x2*)(ldsl + ((size_t)tt * LRU_W + c) * 4) = (f32x2){h0 * gelu_tanh(bflo(gg)), h1 * gelu_tanh(bfhi(gg))};
                            }
                            __syncthreads();
#pragma unroll
                            for (int q = 0; q < 4; ++q) {
                                const int tt = wave * 4 + q; const size_t m = (size_t)b * SEQ + s * 64 + hb * 32 + tt;
                                f32x4 v[4]; float ss = 0.f;
#pragma unroll
                                for (int j = 0; j < 4; ++j) { v[j] = *(const LAS f32x4*)(ldsl + ((size_t)tt * LRU_W + 256 * j + 4 * lane) * 4); ss += (v[j].x * v[j].x + v[j].y * v[j].y) + (v[j].z * v[j].z + v[j].w * v[j].w); }
                                ss = wave_sum(ss);
                                const float rs = 1.0f / sqrtf(ss * (1.0f / LRU_W) + NORM_EPS);
#pragma unroll
                                for (int j = 0; j < 4; ++j) { const f32x4 g = *((const f32x4*)lg + lane + 64 * j); v2u w; w.x = pk2(v[j].x * rs * g.x, v[j].y * rs * g.y); w.y = pk2(v[j].z * rs * g.z, v[j].w * rs * g.w);
                                    *((v2u*)(YCAT + m * D_MODEL) + lane + 64 * j) = w; }
                            }
                            __syncthreads();
                        }
                    }
                }
                for (int ubh = rid; ubh < NHU; ubh += G) hgrn_chunked(ldsl, Z, WSP(float, WS_LB) + l * HG_W, karg_in(I_HNG) + l * 128, WSP(bf16r, WS_YCAT), ubh >> 3, ubh & 7, tid);
                __syncthreads();
                {
                    typedef __hip_bfloat16 abf;
                    const abf* Qp = (const abf*)WSP(bf16r, WS_QH); const abf* Kp = (const abf*)WSP(bf16r, WS_KH); const abf* Vp = (const abf*)WSP(bf16r, WS_Z); abf* Op = (abf*)WSP(bf16r, WS_OATT);
                    unsigned* qctr = WSP(unsigned, WS_CTL) + 2048 + 512 * l;
                    constexpr int NQ = NQ_ALL;
                    const int x0 = bx & 7;
                    if (tid == 0) MISC[20] = 0u;
#define AQ_FETCH(dst) do { if (tid == 0) MISC[16] = (unsigned)aq_take(qctr, x0, MISC + 20); __syncthreads(); dst = (int)MISC[16]; __syncthreads(); } while (0)
                    int cur, nxt;
                    if (wave >= 4) __builtin_amdgcn_s_setprio(1);
                    AQ_FETCH(cur);
                    if (cur < NQ) {
                        AQ_FETCH(nxt);
                        ab::BlockRef<abf, abf> cref = attn_ref_q(Qp, Kp, Vp, Op, cur);
                        ab::Seam<abf> Sm;
                        ab::causal_swa_prime<abf, abf>(cref, SEQ, (char*)lds, Sm);
                        for (;;) {
                            const bool more = nxt < NQ;
                            unsigned pend = 0u;
                            if (more && wave == 0) { unsigned p_ = 0u; if (lane == 0) p_ = (unsigned)aq_take(qctr, x0, MISC + 20); pend = (unsigned)__builtin_amdgcn_readfirstlane((int)p_); }
                            const ab::BlockRef<abf, abf> nref = more ? attn_ref_q(Qp, Kp, Vp, Op, nxt) : cref;
                            ab::causal_swa_block<abf, abf>(cref, nref, SEQ, SEQ, (char*)lds, Sm);
                            if (!more) break;
                            if (tid == 0) MISC[16] = pend;
                            __syncthreads();
                            cref = nref; nxt = (int)MISC[16];
                            __syncthreads();
                        }
                    }
                    __builtin_amdgcn_s_setprio(0);
#undef AQ_FETCH
                }
                SEAM(pb + 7);
            }
        }

        if (ENK(8) && IN(pb + 8)) {
            PHASE_IDS;
#pragma unroll 1
            for (int rep_ = 0; rep_ < REPS(8); ++rep_) {
            bf16r* const OATT = WSP(bf16r, WS_OATT);
            bf16r* const Z = WSP(bf16r, WS_Z);
            bf16r* const YCAT = WSP(bf16r, WS_YCAT);
            const float lam_init = 0.8f - 0.6f * __expf(-0.3f * (float)l);
            const float* dl = karg_in(I_DLAM) + l * 4 * 128;
            float d1 = dl[lane] * dl[128 + lane] + dl[64 + lane] * dl[128 + 64 + lane];
            float d2 = dl[256 + lane] * dl[384 + lane] + dl[256 + 64 + lane] * dl[384 + 64 + lane];
            d1 = wave_sum(d1); d2 = wave_sum(d2);
            const float lamv = __expf(d1) - __expf(d2) + lam_init;
            const float* sg = karg_in(I_SUBLN) + l * 256;
            for (int m = PANEL_PM * 256 + PANEL_R4 * 64 + wave; m < PANEL_PM * 256 + PANEL_R4 * 64 + 64; m += NWAVES) {
                const int t = m & (SEQ - 1), b = m >> 12;
                bf16r* yrow = YCAT + (size_t)m * D_MODEL;
#pragma unroll
                for (int it = 0; it < 4; ++it) {
                    const int e = it * 512 + lane * 8, h = e >> 8, vh = (e >> 7) & 1, d = e & 127;
                    const bf16r* o1p = OATT + ((size_t)(b * 32 + h * 4 + 0 + vh) * SEQ + t) * 128 + d;
                    const bf16r* o2p = OATT + ((size_t)(b * 32 + h * 4 + 2 + vh) * SEQ + t) * 128 + d;
                    const v4u a = __builtin_nontemporal_load((const v4u*)o1p), c2 = __builtin_nontemporal_load((const v4u*)o2p);
                    float oc[8] = {bflo(a.x) - lamv * bflo(c2.x), bfhi(a.x) - lamv * bfhi(c2.x), bflo(a.y) - lamv * bflo(c2.y), bfhi(a.y) - lamv * bfhi(c2.y),
                                   bflo(a.z) - lamv * bflo(c2.z), bfhi(a.z) - lamv * bfhi(c2.z), bflo(a.w) - lamv * bflo(c2.w), bfhi(a.w) - lamv * bfhi(c2.w)};
                    float ss = 0.f;
#pragma unroll
                    for (int j = 0; j < 8; ++j) ss += oc[j] * oc[j];
                    ss += __shfl_xor(ss, 1); ss += __shfl_xor(ss, 2); ss += __shfl_xor(ss, 4); ss += __shfl_xor(ss, 8); ss += __shfl_xor(ss, 16);
                    const float rs = (1.0f - lam_init) / sqrtf(ss * (1.0f / 256.0f) + NORM_EPS);
                    const f32x4 g0 = *(const f32x4*)(sg + (e & 255)), g1 = *(const f32x4*)(sg + (e & 255) + 4);
                    v4u w; w.x = pk2(oc[0] * rs * g0.x, oc[1] * rs * g0.y); w.y = pk2(oc[2] * rs * g0.z, oc[3] * rs * g0.w); w.z = pk2(oc[4] * rs * g1.x, oc[5] * rs * g1.y); w.w = pk2(oc[6] * rs * g1.z, oc[7] * rs * g1.w);
                    *(v4u*)(yrow + 2048 + e) = w;
                }
            }
            }
            SEAM4(pb + 8, 8 * l + 5);
        }

        if (ENK(9) && IN(pb + 9)) {
            PHASE_IDS;
#pragma unroll 1
            for (int rep_ = 0; rep_ < REPS(9); ++rep_) {
            bf16r* const YCAT = WSP(bf16r, WS_YCAT);
            bf16r* const W_OUT = WSP(bf16r, WS_WOUT);
            bf16r* const XB = WSP(bf16r, WS_H);
            pg8::Gemm g{YCAT, W_OUT + (size_t)l * D_MODEL * D_MODEL, M_TOK, D_MODEL, D_MODEL}; pg8::StaticOrder S; S.init(M_TOK, D_MODEL, G, bx);
            pg8::EpiResX E{(l == 0) ? karg_in(I_X) : (const float*)nullptr, XB, nullptr, XB, WSP(float, WS_PSS) + (size_t)(2 * l) * 64 * M_TOK, D_MODEL, M_TOK};
            pg8::gemm_phase<pg8::EpiResX, pg8::StaticOrder, GEMM_ALIGN, GEMM_SP2>(ldsl, g, S, E);
            }
            SEAM4(pb + 9, 8 * l + 0);
        }

        if (ENK(11) && IN(pb + 11)) {
            PHASE_IDS;
#pragma unroll 1
            for (int rep_ = 0; rep_ < REPS(11); ++rep_) {
            bf16r* const HB = WSP(bf16r, WS_H);
            bf16r* const W_FF1 = WSP(bf16r, WS_WFF1);
            bf16r* const HID = WSP(bf16r, WS_HID);
            pg8::Gemm g{HB, W_FF1 + (size_t)l * D_FF * D_MODEL, M_TOK, D_FF, D_MODEL}; pg8::StaticOrder S; S.init(M_TOK, D_FF, G, bx);
            { const float* pssp = WSP(float, WS_PSS) + (size_t)(2 * l) * 64 * M_TOK;
              pg8::Unit u0; if (S.next(0, u0)) RS_TABLE_FILL(pssp, 64, u0.pm); }
            pg8::EpiBf16X<2> E{HID, D_FF_LD, nullptr, nullptr, 0, (const LAS float*)(ldsl + RS_TABLE_OFF)};
            pg8::gemm_phase<pg8::EpiBf16X<2>, pg8::StaticOrder, GEMM_ALIGN, GEMM_SP2>(ldsl, g, S, E);
            }
            SEAM4(pb + 11, 8 * l + 1);
        }

        if (ENK(12) && IN(pb + 12)) {
            PHASE_IDS;
#pragma unroll 1
            for (int rep_ = 0; rep_ < REPS(12); ++rep_) {
            bf16r* const HID = WSP(bf16r, WS_HID);
            bf16r* const W_FF2 = WSP(bf16r, WS_WFF2);
            float* const OUT = karg_out();
            pg8::Gemm g{HID, W_FF2 + (size_t)l * D_MODEL * D_FF_LD, M_TOK, D_MODEL, D_FF, 0, 0, D_FF_LD}; pg8::StaticOrder S; S.init(M_TOK, D_MODEL, G, bx);
            bf16r* const XB = WSP(bf16r, WS_H);
            pg8::EpiResX E{nullptr, XB, (l + 1 == DEPTH) ? OUT : (float*)nullptr, XB, WSP(float, WS_PSS) + (size_t)1 * 64 * M_TOK, D_MODEL, M_TOK};
            pg8::gemm_phase<pg8::EpiResX, pg8::StaticOrder, GEMM_ALIGN, GEMM_SP2>(ldsl, g, S, E);
            }
            SEAM(pb + 12);
        }
    }
#if defined(DBG_STAMP_MASK)
    if (multi) {
        xcd_barrier(bar);
        if (blockIdx.x == 0 && threadIdx.x == 0) {
            const unsigned long long* st = WSP(unsigned long long, 12 * MiB);
            double idle = 0.0, lat = 0.0;
            for (int k = 0; k < N_PHASES - 1; ++k) {
                if (!((DBG_STAMP_MASK >> k) & 1)) continue;
                unsigned long long amax = 0, emax = 0; double asum = 0.0; bool any = false;
                for (int b2 = 0; b2 < G; ++b2) { const unsigned long long a = st[(k * 2 + 0) * 256 + b2], e = st[(k * 2 + 1) * 256 + b2]; if (a == 0xAAAAAAAAAAAAAAAAull) continue; any = true; amax = a > amax ? a : amax; emax = e > emax ? e : emax; asum += (double)a; }
                if (!any) continue;
                idle += (double)amax - asum / (double)G; lat += (double)emax - (double)amax;
            }
            karg_out()[0] = (float)(floor(idle * 0.01 / 200.0 + 0.5) * 200.0 * 1.0e4);
            karg_out()[1] = (float)(floor(lat * 0.01 / 100.0 + 0.5) * 100.0 * 1.0e4);
        }
    }
#endif
#undef IN
#undef SEAM
#undef SEAM4
#undef SEAM4H
}


#ifndef MK_PER_PHASE
#define MK_PER_PHASE 0
#endif
extern "C" void kernel_launch(void* const* d_in, const int* in_sizes, int n_in, void* d_out, int out_size, void* d_ws, size_t ws_size, hipStream_t stream) {
    static int grid = 0;
    if (grid == 0) {
        if (n_in != N_INPUTS || out_size != M_TOK * D_MODEL || ws_size < WS_END) { fprintf(stderr, "kernel_launch: unexpected shapes (n_in %d, out %d, ws %zu < %zu); nothing launched\n", n_in, out_size, ws_size, (size_t)WS_END); grid = -1; return; }
        int dev = 0, cus = 0;
        if (hipGetDevice(&dev) != hipSuccess || hipDeviceGetAttribute(&cus, hipDeviceAttributeMultiprocessorCount, dev) != hipSuccess || cus <= 0) { fprintf(stderr, "kernel_launch: device query failed\n"); grid = -1; return; }
        if (hipFuncSetAttribute((const void*)hymba_fwd, hipFuncAttributeMaxDynamicSharedMemorySize, LDS_BYTES) != hipSuccess) { fprintf(stderr, "kernel_launch: hipFuncSetAttribute failed\n"); grid = -1; return; }
        int per_cu = 0;
        if (hipOccupancyMaxActiveBlocksPerMultiprocessor(&per_cu, (const void*)hymba_fwd, NTHREADS, LDS_BYTES) != hipSuccess || per_cu < 1) fprintf(stderr, "kernel_launch: occupancy query reports %d blocks per CU\n", per_cu);
        (void)hipGetLastError();
        grid = cus;
        if (grid != 256) { fprintf(stderr, "kernel_launch: built for a 256-CU device (one row panel per workgroup in the z and ff1 GEMM phases); this device reports %d CUs; nothing launched\n", cus); grid = -1; return; }
    }
    if (grid < 0) return;
    (void)in_sizes;
    if (hipMemsetAsync((char*)d_ws + WS_CTL, 0, CTL_ZERO_BYTES, stream) != hipSuccess) { fprintf(stderr, "kernel_launch: memset failed\n"); return; }
    Args a{};
    for (int i = 0; i < N_INPUTS; ++i) a.in[i] = (const float*)d_in[i];
    a.out = (float*)d_out; a.ws = (unsigned char*)d_ws;
#if MK_PER_PHASE
    for (int p = 0; p < N_PHASES; ++p) { a.ph_lo = p; a.ph_hi = p + 1; hipLaunchKernelGGL(hymba_fwd, dim3(grid), dim3(NTHREADS), LDS_BYTES, stream, a); }
#else
    a.ph_lo = 0; a.ph_hi = N_PHASES;
    hipLaunchKernelGGL(hymba_fwd, dim3(grid), dim3(NTHREADS), LDS_BYTES, stream, a);
#endif
    const hipError_t le = hipPeekAtLastError();
    if (le != hipSuccess) fprintf(stderr, "kernel_launch: launch failed: %s\n", hipGetErrorName(le));
}
```

```cpp
#include <hip/hip_runtime.h>
#include <hip/hip_bf16.h>
#include <cstdio>
#include <cstdint>
__device__ __forceinline__ int tid_opaque() { int t = threadIdx.x; asm volatile("" : "+v"(t)); return t; }
typedef __bf16 hw_bf16x2 __attribute__((ext_vector_type(2)));
typedef float hw_f32x2 __attribute__((ext_vector_type(2)));
__device__ __forceinline__ unsigned pk_bf16_builtin(float lo, float hi) { hw_f32x2 f = {lo, hi}; hw_bf16x2 r = __builtin_convertvector(f, hw_bf16x2); return __builtin_bit_cast(unsigned, r); }
namespace pg8 {
#define PG8_LAS __attribute__((address_space(3)))
typedef unsigned short bf16_t;
typedef short bf16x8 __attribute__((ext_vector_type(8)));
typedef float f32x4 __attribute__((ext_vector_type(4)));
typedef unsigned u32x4 __attribute__((ext_vector_type(4)));
constexpr int BM = 256, BK = 64, HALF = 128, HTB = HALF * BK * 2  , STAGE_BYTES = 8 * HTB, NXCD = 8, WGM = 8;

__host__ __device__ __forceinline__ int lds_byte(int r, int c) { const int st = (r >> 4) * 2 + (c >> 5), rr = r & 15, cc = c & 31, ob = rr * 64 + cc * 2; return st * 1024 + (ob ^ (((ob >> 9) & 1) << 5)); }
__host__ __device__ __forceinline__ void stage_rc(int b, int& R, int& C) { const int st = b / 1024, sb = b % 1024, swz = sb ^ (((sb >> 9) & 1) << 5); R = (st >> 1) * 16 + swz / 64; C = (st & 1) * 32 + (swz % 64) / 2; }
__host__ __device__ __forceinline__ int perm32(int rho) { const int n = rho >> 4, i = rho & 15; return 8 * (i >> 2) + 4 * n + (i & 3); }

struct Unit { int pm, pn; };
struct Gemm { const bf16_t* A; const bf16_t* Bt; int M, N, K; size_t a_pn_stride = 0; int a_pn_shift = 0; int ld = 0;
    __device__ __forceinline__ size_t aoff(int pn) const { return (size_t)(pn >> a_pn_shift) * a_pn_stride; } };

struct StaticOrder {
    int nM, nN, nwg, G, c;
    __host__ __device__ void init(int M, int N, int G_, int c_) { nM = M / BM; nN = N / BM; nwg = nM * nN; G = G_; c = c_; }
    __host__ __device__ bool next(int i, Unit& u) const {
        const long L = (long)i * G + c; if (L >= nwg) return false;
        int wgid = (int)L; { const int q = nwg / NXCD, r = nwg % NXCD, xcd = wgid % NXCD, off = wgid / NXCD; wgid = (xcd < r ? xcd * (q + 1) : r * (q + 1) + (xcd - r) * q) + off; }
        const int nig = WGM * nN, gid = wgid / nig, fm = gid * WGM, gsz = (nM - fm) < WGM ? (nM - fm) : WGM;
        u.pm = fm + ((wgid % nig) % gsz); u.pn = (wgid % nig) / gsz; return true;
    }
    __device__ __forceinline__ void a_ready(const Unit&) const {}
    __device__ __forceinline__ void done(const Unit&) const {}
};

__device__ __forceinline__ unsigned cvt_pk_bf16(float lo, float hi) { return pk_bf16_builtin(lo, hi); }
typedef float f32x2 __attribute__((ext_vector_type(2)));
__device__ __forceinline__ f32x2 gelu_pk(f32x2 v) {
    const f32x2 av = __builtin_elementwise_abs(v), d = av * 0.2316418882f + 1.0f;
    f32x2 t; t.x = __builtin_amdgcn_rcpf(d.x); t.y = __builtin_amdgcn_rcpf(d.y);
    f32x2 q = t * 0.5307027145f + (-0.7265760135f); q = q * t + 0.7107068705f; q = q * t + (-0.142248368f); q = q * t + 0.127414796f; q = q * t;
    const f32x2 s = (v * v) * (-0.72134752044f);
    f32x2 e; e.x = __builtin_amdgcn_exp2f(s.x); e.y = __builtin_amdgcn_exp2f(s.y);
    const f32x2 m = v * (q * e), r = v - m;
    f32x2 o; o.x = v.x < 0.f ? m.x : r.x; o.y = v.y < 0.f ? m.y : r.y; return o;
}

template <int ACT> struct EpiBf16X {
    static constexpr bool PERM = true, AFTER_DRAIN = false;
    bf16_t* O; int ldc; const float* bias0; const float* bias1; int bias_split;
    const PG8_LAS float* rs_lds;
    __device__ __forceinline__ void operator()(const f32x4 (&acc)[2][2][4][2], const Unit& u, int wr, int wc, int fr, int fq) const {
        const int row0 = u.pm * BM + wr * 64 + fr; const int colt = u.pn * BM;
        const int col0 = colt + wc * 32 + 8 * fq;
        f32x4 bv[2][2];
#pragma unroll
        for (int bj = 0; bj < 2; ++bj)
#pragma unroll
            for (int n = 0; n < 2; ++n) {
                if (ACT == 1) { const float* bp = ((u.pn & 1) ? bias1 : bias0) + (u.pn >> 1) * BM + (col0 - colt); bv[bj][n] = *(const f32x4*)(bp + bj * HALF + 4 * n); }
                else bv[bj][n] = (f32x4){0.f, 0.f, 0.f, 0.f};
            }
#pragma unroll
        for (int ai = 0; ai < 2; ++ai)
#pragma unroll
            for (int m = 0; m < 4; ++m) { bf16_t* rowp = O + (size_t)(row0 + ai * HALF + m * 16) * ldc + col0;
                float rsc = 1.0f;
                if (rs_lds) rsc = rs_lds[wr * 64 + fr + ai * HALF + m * 16];
#pragma unroll
                for (int bj = 0; bj < 2; ++bj) { f32x4 v0 = (acc[ai][bj][m][0] + bv[bj][0]) * rsc, v1 = (acc[ai][bj][m][1] + bv[bj][1]) * rsc;
                    if (ACT == 1) {
#pragma unroll
                        for (int j = 0; j < 4; ++j) { v0[j] = __builtin_amdgcn_rcpf(1.0f + __builtin_amdgcn_exp2f(-1.4426950408889634f * v0[j])); v1[j] = __builtin_amdgcn_rcpf(1.0f + __builtin_amdgcn_exp2f(-1.4426950408889634f * v1[j])); } }
                    if (ACT == 2) {
#pragma unroll
                        for (int j = 0; j < 4; ++j) { const float a = fmaxf(v0[j], 0.f), b = fmaxf(v1[j], 0.f); v0[j] = a * a; v1[j] = b * b; } }
                    u32x4 w; w.x = cvt_pk_bf16(v0[0], v0[1]); w.y = cvt_pk_bf16(v0[2], v0[3]); w.z = cvt_pk_bf16(v1[0], v1[1]); w.w = cvt_pk_bf16(v1[2], v1[3]);
                    *(u32x4*)(rowp + bj * HALF) = w; } }
    }
};
struct EpiResX {
    static constexpr bool PERM = true, AFTER_DRAIN = false;
    const float* basef; const bf16_t* baseh; float* outf; bf16_t* outh; float* pss; int ldc, nrows;
    __device__ __forceinline__ void operator()(const f32x4 (&acc)[2][2][4][2], const Unit& u, int wr, int wc, int fr, int fq) const {
        const int row0 = u.pm * BM + wr * 64 + fr, col0 = u.pn * BM + wc * 32 + 8 * fq;
        float ssq[2][4];
#pragma unroll
        for (int ai = 0; ai < 2; ++ai)
#pragma unroll
            for (int m = 0; m < 4; ++m) { const size_t off = (size_t)(row0 + ai * HALF + m * 16) * ldc + col0;
                float sq = 0.f;
#pragma unroll
                for (int bj = 0; bj < 2; ++bj) {
                    f32x4 b0, b1;
                    if (basef) { b0 = *(const f32x4*)(basef + off + bj * HALF); b1 = *(const f32x4*)(basef + off + bj * HALF + 4); }
                    else { const u32x4 w = *(const u32x4*)(baseh + off + bj * HALF);
                        b0 = (f32x4){__uint_as_float(w.x << 16), __uint_as_float(w.x & 0xffff0000u), __uint_as_float(w.y << 16), __uint_as_float(w.y & 0xffff0000u)};
                        b1 = (f32x4){__uint_as_float(w.z << 16), __uint_as_float(w.z & 0xffff0000u), __uint_as_float(w.w << 16), __uint_as_float(w.w & 0xffff0000u)}; }
                    const f32x4 v0 = acc[ai][bj][m][0] + b0, v1 = acc[ai][bj][m][1] + b1;
                    if (outf) { *(f32x4*)(outf + off + bj * HALF) = v0; *(f32x4*)(outf + off + bj * HALF + 4) = v1; }
                    else { u32x4 w; w.x = cvt_pk_bf16(v0[0], v0[1]); w.y = cvt_pk_bf16(v0[2], v0[3]); w.z = cvt_pk_bf16(v1[0], v1[1]); w.w = cvt_pk_bf16(v1[2], v1[3]);
                        *(u32x4*)(outh + off + bj * HALF) = w;
                        sq += ((v0[0] * v0[0] + v0[1] * v0[1]) + (v0[2] * v0[2] + v0[3] * v0[3])) + ((v1[0] * v1[0] + v1[1] * v1[1]) + (v1[2] * v1[2] + v1[3] * v1[3])); } }
                ssq[ai][m] = sq;
                asm volatile("" ::: "memory"); }
        if (!outf) {
#pragma unroll
            for (int ai = 0; ai < 2; ++ai)
#pragma unroll
                for (int m = 0; m < 4; ++m) ssq[ai][m] += __shfl_xor(ssq[ai][m], 16);
#pragma unroll
            for (int ai = 0; ai < 2; ++ai)
#pragma unroll
                for (int m = 0; m < 4; ++m) ssq[ai][m] += __shfl_xor(ssq[ai][m], 32);
            if (fq == 0) {
#pragma unroll
                for (int ai = 0; ai < 2; ++ai)
#pragma unroll
                    for (int m = 0; m < 4; ++m) pss[(size_t)(u.pn * 4 + wc) * nrows + (row0 + ai * HALF + m * 16)] = ssq[ai][m];
            }
        }
    }
};
template <class Epi, class Sched, bool ALIGN_EPI = false, bool SP2 = false>
__device__ __forceinline__ void gemm_phase(PG8_LAS unsigned char* lds, const Gemm g, const Sched& S, const Epi& E) {
    const int tid = tid_opaque(), wid = __builtin_amdgcn_readfirstlane(tid >> 6), lane = tid & 63, wr = wid >> 2, wc = wid & 3, fr = lane & 15, fq = lane >> 4;
    const int K = g.K, nt = K / BK, LD = g.ld ? g.ld : K;
    unsigned voffA[2], voffB[2];
#pragma unroll
    for (int i = 0; i < 2; ++i) { int R, C; stage_rc(tid * 16 + i * 8192, R, C); const int Rb = Epi::PERM ? ((R & ~31) + perm32(R & 31)) : R;
        voffA[i] = (unsigned)(R * LD + C) * 2u; voffB[i] = (unsigned)(Rb * LD + C) * 2u; }
    const size_t kstep = (size_t)(BK * 2);
    const size_t hstep = (size_t)HALF * LD * 2;
    const size_t tstep = 2 * hstep;
    const unsigned ldsw = (unsigned)wid * 1024u;
    const int aoff = lds_byte(wr * 64 + fr, fq * 8), boff = lds_byte(wc * 32 + fr, fq * 8);
#define PG8_SA(b, h) (((b) * 2 + (h)) * HTB)
#define PG8_SB(b, h) ((4 + (b) * 2 + (h)) * HTB)
#define PG8_STAGE(bufoff, gbase, voff) do { _Pragma("unroll") for (int _i = 0; _i < 2; ++_i) \
        __builtin_amdgcn_global_load_lds((const unsigned*)((const char*)(gbase) + (voff)[_i]), (PG8_LAS unsigned*)(lds + (bufoff) + ldsw + _i * 8192), 16, 0, 0); } while (0)
#define PG8_LDA(dst, b, h) do { _Pragma("unroll") for (int m = 0; m < 4; ++m) _Pragma("unroll") for (int k = 0; k < 2; ++k) dst[m][k] = *(const PG8_LAS bf16x8*)(lds + PG8_SA(b, h) + aoff + m * 2048 + k * 1024); } while (0)
#define PG8_LDB(dst, b, h) do { _Pragma("unroll") for (int n = 0; n < 2; ++n) _Pragma("unroll") for (int k = 0; k < 2; ++k) dst[n][k] = *(const PG8_LAS bf16x8*)(lds + PG8_SB(b, h) + boff + n * 2048 + k * 1024); } while (0)
#define PG8_MMA(ai, bj, At, Bt) do { __builtin_amdgcn_s_setprio(1); _Pragma("unroll") for (int m = 0; m < 4; ++m) _Pragma("unroll") for (int n = 0; n < 2; ++n) _Pragma("unroll") for (int k = 0; k < 2; ++k) \
        acc[ai][bj][m][n] = __builtin_amdgcn_mfma_f32_16x16x32_bf16(Bt[n][k], At[m][k], acc[ai][bj][m][n], 0, 0, 0); __builtin_amdgcn_s_setprio(0); } while (0)
#define PG8_WAIT_V(n) asm volatile("s_waitcnt vmcnt(" #n ")" ::: "memory")
#define PG8_WAIT_L(n) asm volatile("s_waitcnt lgkmcnt(" #n ")" ::: "memory")
#define PG8_BAR __builtin_amdgcn_s_barrier()
#define PG8_SCHED __builtin_amdgcn_sched_barrier(0)
    Unit cur, nxt; int ui = 0;
    if (!S.next(0, cur)) return;
    f32x4 acc[2][2][4][2];
#pragma unroll
    for (int a = 0; a < 2; ++a)
#pragma unroll
        for (int b = 0; b < 2; ++b)
#pragma unroll
            for (int m = 0; m < 4; ++m)
#pragma unroll
                for (int n = 0; n < 2; ++n) acc[a][b][m][n] = (f32x4){0.f, 0.f, 0.f, 0.f};
    bf16x8 At[4][2], B0[2][2], B1[2][2];
    const char* cA = (const char*)g.A + (size_t)cur.pm * tstep + g.aoff(cur.pn); const char* cB = (const char*)g.Bt + (size_t)cur.pn * tstep;
    S.a_ready(cur);
    if constexpr (SP2) {
        PG8_STAGE(PG8_SB(0, 0), cB, voffB); PG8_STAGE(PG8_SB(0, 1), cB + hstep, voffB); PG8_STAGE(PG8_SA(0, 0), cA, voffA); PG8_STAGE(PG8_SA(0, 1), cA + hstep, voffA);
        if (wr == 1) PG8_BAR;
        PG8_WAIT_V(2); PG8_BAR;
        PG8_STAGE(PG8_SB(1, 0), cB + kstep, voffB); PG8_STAGE(PG8_SA(1, 0), cA + kstep, voffA); PG8_STAGE(PG8_SB(1, 1), cB + hstep + kstep, voffB);
        PG8_WAIT_V(6); PG8_BAR;
    } else {
        PG8_STAGE(PG8_SB(0, 0), cB, voffB); PG8_STAGE(PG8_SA(0, 0), cA, voffA); PG8_STAGE(PG8_SB(0, 1), cB + hstep, voffB); PG8_STAGE(PG8_SA(0, 1), cA + hstep, voffA);
        if (wr == 1) PG8_BAR;
        PG8_WAIT_V(4); PG8_BAR;
        PG8_STAGE(PG8_SB(1, 0), cB + kstep, voffB); PG8_STAGE(PG8_SA(1, 0), cA + kstep, voffA); PG8_STAGE(PG8_SB(1, 1), cB + hstep + kstep, voffB);
        PG8_WAIT_V(6); PG8_BAR;
    }
    for (;;) {
        const bool has_next = S.next(ui + 1, nxt);
        const char* nA = has_next ? (const char*)g.A + (size_t)nxt.pm * tstep + g.aoff(nxt.pn) : cA; const char* nB = has_next ? (const char*)g.Bt + (size_t)nxt.pn * tstep : cB;
        _Pragma("unroll 1")
        for (int t = 0; t < nt; t += 2) {
            const bool last = (t == nt - 2);
            const char* a1 = cA + (size_t)(t + 1) * kstep;
            const char* a2 = last ? nA : cA + (size_t)(t + 2) * kstep; const char* b2 = last ? nB : cB + (size_t)(t + 2) * kstep;
            const char* a3 = a2 + kstep; const char* b3 = b2 + kstep;
            if (last && has_next) S.a_ready(nxt);
            if constexpr (SP2) {
            PG8_LDB(B0, 0, 0); PG8_LDB(B1, 0, 1); PG8_SCHED; PG8_LDA(At, 0, 0); PG8_STAGE(PG8_SA(1, 1), a1 + hstep, voffA);
            PG8_WAIT_V(8); PG8_WAIT_L(0); PG8_BAR; PG8_MMA(0, 0, At, B0); PG8_MMA(0, 1, At, B1); PG8_BAR; PG8_SCHED;
            PG8_LDA(At, 0, 1); PG8_STAGE(PG8_SB(0, 0), b2, voffB); PG8_STAGE(PG8_SB(0, 1), b2 + hstep, voffB); PG8_STAGE(PG8_SA(0, 0), a2, voffA);
            PG8_WAIT_V(8); PG8_WAIT_L(0); PG8_BAR; PG8_MMA(1, 0, At, B0); PG8_MMA(1, 1, At, B1); PG8_BAR; PG8_SCHED;
            PG8_LDB(B0, 1, 0); PG8_LDB(B1, 1, 1); PG8_SCHED; PG8_LDA(At, 1, 0); PG8_STAGE(PG8_SA(0, 1), a2 + hstep, voffA);
            PG8_WAIT_V(8); PG8_WAIT_L(0); PG8_BAR; PG8_MMA(0, 0, At, B0); PG8_MMA(0, 1, At, B1); PG8_BAR; PG8_SCHED;
            PG8_LDA(At, 1, 1); PG8_STAGE(PG8_SB(1, 0), b3, voffB); PG8_STAGE(PG8_SB(1, 1), b3 + hstep, voffB); PG8_STAGE(PG8_SA(1, 0), a3, voffA);
            PG8_WAIT_V(8); PG8_WAIT_L(0); PG8_BAR; PG8_MMA(1, 0, At, B0); PG8_MMA(1, 1, At, B1); PG8_BAR; PG8_SCHED;
            } else {
            PG8_LDB(B0, 0, 0); PG8_SCHED; PG8_LDA(At, 0, 0); PG8_STAGE(PG8_SA(1, 1), a1 + hstep, voffA);
            PG8_WAIT_L(8); PG8_BAR; PG8_WAIT_L(0); PG8_MMA(0, 0, At, B0); PG8_BAR; PG8_SCHED;
            PG8_LDB(B1, 0, 1); PG8_STAGE(PG8_SB(0, 0), b2, voffB);
            PG8_BAR; PG8_WAIT_L(0); PG8_MMA(0, 1, At, B1); PG8_BAR;
            PG8_LDA(At, 0, 1); PG8_STAGE(PG8_SA(0, 0), a2, voffA);
            PG8_BAR; PG8_WAIT_L(0); PG8_MMA(1, 0, At, B0); PG8_BAR; PG8_SCHED;
            PG8_STAGE(PG8_SB(0, 1), b2 + hstep, voffB);
            PG8_WAIT_V(6); PG8_BAR; PG8_MMA(1, 1, At, B1); PG8_BAR;
            PG8_LDB(B0, 1, 0); PG8_SCHED; PG8_LDA(At, 1, 0); PG8_STAGE(PG8_SA(0, 1), a2 + hstep, voffA);
            PG8_WAIT_L(8); PG8_BAR; PG8_WAIT_L(0); PG8_MMA(0, 0, At, B0); PG8_BAR; PG8_SCHED;
            PG8_LDB(B1, 1, 1); PG8_STAGE(PG8_SB(1, 0), b3, voffB);
            PG8_BAR; PG8_WAIT_L(0); PG8_MMA(0, 1, At, B1); PG8_BAR;
            PG8_LDA(At, 1, 1); PG8_STAGE(PG8_SA(1, 0), a3, voffA);
            PG8_BAR; PG8_WAIT_L(0); PG8_MMA(1, 0, At, B0); PG8_BAR; PG8_SCHED;
            PG8_STAGE(PG8_SB(1, 1), b3 + hstep, voffB);
            PG8_WAIT_V(6); PG8_BAR; PG8_MMA(1, 1, At, B1); PG8_BAR;
            }
        }
        if constexpr (ALIGN_EPI) { if (wr == 0) PG8_BAR; }
        if constexpr (!Epi::AFTER_DRAIN) { E(acc, cur, wr, wc, fr, fq); S.done(cur); }
        if (!has_next) break;
#pragma unroll
        for (int a = 0; a < 2; ++a)
#pragma unroll
            for (int b = 0; b < 2; ++b)
#pragma unroll
                for (int m = 0; m < 4; ++m)
#pragma unroll
                    for (int n = 0; n < 2; ++n) acc[a][b][m][n] = (f32x4){0.f, 0.f, 0.f, 0.f};
        cur = nxt; cA = nA; cB = nB; ++ui;
        if constexpr (ALIGN_EPI) { if (wr == 1) PG8_BAR; }
    }
    PG8_WAIT_V(0);
    if constexpr (!ALIGN_EPI) { if (wr == 0) PG8_BAR; }
    PG8_BAR;
    if constexpr (Epi::AFTER_DRAIN) { E.fused(acc, cur, wr, wc, fr, fq, lds, wid, lane); S.done(cur); }
#undef PG8_SA
#undef PG8_SB
#undef PG8_STAGE
#undef PG8_LDA
#undef PG8_LDB
#undef PG8_MMA
#undef PG8_WAIT_V
#undef PG8_WAIT_L
#undef PG8_BAR
#undef PG8_SCHED
}
}

namespace ab {
enum { ORDER_NATURAL = 0, ORDER_REVERSED = 1, ORDER_PAIRED = 2, ORDER_XCD = 4 };
using TIN = __hip_bfloat16; using TOUT = __hip_bfloat16;
constexpr int B = 4, H = 32, HKV = 32, SQ = 4096, SKV = 4096, D = 128;
constexpr int QOFF = 0; constexpr int WINDOW = SKV; constexpr float THR = 8.f; constexpr int ORDER = ORDER_PAIRED; constexpr int GRID_WGS = 0; constexpr bool WSKIP = false;
constexpr float SCALE = 0.08838834764831845f;
constexpr int NW = 8, QBLK = 32, KVBLK = 64, QB = NW * QBLK;
constexpr int SHM_V = KVBLK * D * 2, SHM_K = KVBLK * D * 2;
constexpr int LDS_BYTES = 2 * SHM_V + 2 * SHM_K + NW * 64 * 4;
constexpr int V_ROW = 12288;
constexpr int O_STAGE = LDS_BYTES, O_STAGE_ROW = 272, O_STAGE_WAVE = 32 * O_STAGE_ROW;
using bf16 = __hip_bfloat16;
typedef short bf16x8 __attribute__((ext_vector_type(8)));
typedef short s16x4 __attribute__((ext_vector_type(4)));
typedef float f32x16 __attribute__((ext_vector_type(16)));
typedef float f32x4 __attribute__((ext_vector_type(4)));
typedef unsigned u32x4 __attribute__((ext_vector_type(4)));
template <class A, class Bt> struct same_t { static constexpr bool v = false; };
template <class A> struct same_t<A, A> { static constexpr bool v = true; };

#define KSWZ(row, colB) ((row) * 256 + ((colB) ^ (((row) & 7) << 4)))
#define SBAR() __builtin_amdgcn_sched_barrier(0)
__device__ __forceinline__ int v_st(int k, int c) { const int kk = (k & ~0xC) | ((k & 4) << 1) | ((k & 8) >> 1); return ((kk >> 3) * 4 + (c >> 5)) * 512 + ((kk & 7) * 32 + (c & 31)) * 2; }
__device__ __forceinline__ int v_rd_base(int lane) { return ((lane & 3) << 3) | (((lane >> 2) & 3) << 6) | (((lane >> 4) & 1) << 5) | (((lane >> 5) & 1) << 8); }
constexpr int v_rd_off(int d0, int ks, int half) { return d0 * 512 + ks * 4096 + half * 2048; }
__device__ __forceinline__ int crow(int r, int hi) { return (r & 3) + 8 * (r >> 2) + 4 * hi; }
__device__ __forceinline__ unsigned cvtpk(float lo, float hi) {
    return pk_bf16_builtin(lo, hi);
}
__device__ __forceinline__ bf16x8 pack8(f32x4 a, f32x4 b) {
    u32x4 w = {cvtpk(a[0], a[1]), cvtpk(a[2], a[3]), cvtpk(b[0], b[1]), cvtpk(b[2], b[3])};
    return *reinterpret_cast<bf16x8*>(&w);
}
template <class T> __device__ __forceinline__ bf16x8 load8(const T* p) {
    if constexpr (same_t<T, float>::v) { return pack8(*(const f32x4*)p, *(const f32x4*)(p + 4)); }
    else { return *reinterpret_cast<const bf16x8*>(p); }
}
__device__ __forceinline__ void mask_tile(f32x16& p0, f32x16& p1, int dq, unsigned W) {
    const float NEG = -__builtin_inff();
#pragma unroll
    for (int r = 0; r < 16; ++r) {
        const int c = (r & 3) + 8 * (r >> 2);
        if ((unsigned)(dq - c) >= W) p0[r] = NEG;
        if ((unsigned)(dq - c - 32) >= W) p1[r] = NEG;
    }
}
__device__ __forceinline__ void partialSM(f32x16& p0, f32x16& p1, float& m_reg, float& mn, float& alpha) {
    float pmax = p0[0]; for (int r = 1; r < 16; ++r) pmax = fmaxf(pmax, p0[r]); for (int r = 0; r < 16; ++r) pmax = fmaxf(pmax, p1[r]);
    { auto rr = __builtin_amdgcn_permlane32_swap(__float_as_uint(pmax), __float_as_uint(pmax), false, false);
      pmax = fmaxf(__uint_as_float(rr[0]), __uint_as_float(rr[1])); }
    constexpr float C2 = 1.4426950408889634f * SCALE;
    if (__builtin_expect(__all((pmax - m_reg) * SCALE <= THR), 1)) { mn = m_reg; alpha = 1.f; }
    else { mn = fmaxf(m_reg, pmax); alpha = __builtin_amdgcn_exp2f((m_reg - mn) * C2); m_reg = mn; }
    const float mnL = -mn * C2;
    for (int r = 0; r < 16; ++r) p0[r] = fmaf(p0[r], C2, mnL); for (int r = 0; r < 16; ++r) p1[r] = fmaf(p1[r], C2, mnL);
    for (int r = 0; r < 16; ++r) p0[r] = __builtin_amdgcn_exp2f(p0[r]);
}
__device__ __forceinline__ void finishSM(f32x16& p0, f32x16& p1, float alpha, float& l_reg, bf16x8& pa0, bf16x8& pa1, bf16x8& pa2, bf16x8& pa3) {
    for (int r = 0; r < 16; ++r) p1[r] = __builtin_amdgcn_exp2f(p1[r]);
    float ps = 0; for (int r = 0; r < 16; ++r) ps += p0[r]; for (int r = 0; r < 16; ++r) ps += p1[r];
    { auto rr = __builtin_amdgcn_permlane32_swap(__float_as_uint(ps), __float_as_uint(ps), false, false);
      ps = __uint_as_float(rr[0]) + __uint_as_float(rr[1]); }
    l_reg = l_reg * alpha + ps;
#define PK4(P, B_, OUT) do { unsigned a0 = cvtpk(P[B_+0], P[B_+1]), a1 = cvtpk(P[B_+2], P[B_+3]);                          \
        unsigned b0 = cvtpk(P[B_+4], P[B_+5]), b1 = cvtpk(P[B_+6], P[B_+7]);                                             \
        auto r0 = __builtin_amdgcn_permlane32_swap(a0, b0, false, false); auto r1 = __builtin_amdgcn_permlane32_swap(a1, b1, false, false); \
        u32x4 w = {r0[0], r1[0], r0[1], r1[1]}; OUT = *reinterpret_cast<bf16x8*>(&w); } while (0)
    PK4(p0, 0, pa0); PK4(p0, 8, pa1); PK4(p1, 0, pa2); PK4(p1, 8, pa3);
#undef PK4
}
template <int KB, bool SK>
__device__ __forceinline__ void qkt(f32x16& p0, f32x16& p1, const char* K_lds, int r32, int hi, const bf16x8* qr, bool act) {
    if (SK && !act) { const float NEG = -__builtin_inff();
#pragma unroll
        for (int r = 0; r < 16; ++r) { p0[r] = NEG; p1[r] = NEG; } return; }
    p0 = f32x16{}; p1 = f32x16{};
    const char* kb[4];
#pragma unroll
    for (int dd = 0; dd < 4; ++dd) kb[dd] = K_lds + KB * SHM_K + KSWZ(r32, (dd * 16 + hi * 8) * 2);
#pragma unroll
    for (int d0 = 0; d0 < 8; ++d0) { const char* a = kb[d0 & 3] + (d0 >> 2) * 128;
        bf16x8 b0 = *reinterpret_cast<const bf16x8*>(a);
        bf16x8 b1 = *reinterpret_cast<const bf16x8*>(a + 32 * 256);
        p0 = __builtin_amdgcn_mfma_f32_32x32x16_bf16(b0, qr[d0], p0, 0, 0, 0);
        p1 = __builtin_amdgcn_mfma_f32_32x32x16_bf16(b1, qr[d0], p1, 0, 0, 0); }
}
template <int VB, bool SK>
__device__ __forceinline__ void pv_tile(f32x16* o, int vb0, bf16x8 pa0, bf16x8 pa1, bf16x8 pa2, bf16x8 pa3, bool act) {
    if (SK && !act) return;
#define TRRD(dst, off) asm volatile("ds_read_b64_tr_b16 %0, %1 offset:%2" : "=&v"(dst) : "v"(vb0), "i"(off) : "memory")
#define PV_D0(d0) do { s16x4 l0, l1, l2, l3, h0, h1, h2, h3; constexpr int b_ = VB * SHM_V + v_rd_off(d0, 0, 0);     \
        TRRD(l0, b_); TRRD(h0, b_ + 2048); TRRD(l1, b_ + 4096); TRRD(h1, b_ + 6144); TRRD(l2, b_ + 8192); TRRD(h2, b_ + 10240); TRRD(l3, b_ + 12288); TRRD(h3, b_ + 14336); \
        asm volatile("s_waitcnt lgkmcnt(0)" ::: "memory"); SBAR();                 \
        o[d0] = __builtin_amdgcn_mfma_f32_32x32x16_bf16(pa0, (bf16x8){l0[0], l0[1], l0[2], l0[3], h0[0], h0[1], h0[2], h0[3]}, o[d0], 0, 0, 0);   \
        o[d0] = __builtin_amdgcn_mfma_f32_32x32x16_bf16(pa1, (bf16x8){l1[0], l1[1], l1[2], l1[3], h1[0], h1[1], h1[2], h1[3]}, o[d0], 0, 0, 0);   \
        o[d0] = __builtin_amdgcn_mfma_f32_32x32x16_bf16(pa2, (bf16x8){l2[0], l2[1], l2[2], l2[3], h2[0], h2[1], h2[2], h2[3]}, o[d0], 0, 0, 0);   \
        o[d0] = __builtin_amdgcn_mfma_f32_32x32x16_bf16(pa3, (bf16x8){l3[0], l3[1], l3[2], l3[3], h3[0], h3[1], h3[2], h3[3]}, o[d0], 0, 0, 0); } while (0)
    PV_D0(0); PV_D0(1); PV_D0(2); PV_D0(3);
#undef PV_D0
#undef TRRD
}

template <class TIn, class TOut> struct BlockRef { const TIn* Q; const TIn* K; const TIn* V; TOut* O; int P0; };
template <class TIn> struct Seam {
    bf16x8 qr[8];
    bf16x8 st_v0, st_v1, st_k0, st_k1; f32x4 sf0, sf1, sf2, sf3;
    f32x4 tq[16];
};
__device__ __forceinline__ int swa_jlo(int P0, int W) { const int lowk = P0 - W + 1; return lowk > 0 ? lowk / KVBLK : 0; }
#define ROW(p, k0, rr) ((p) + (size_t)((k0) + (rr)) * D + sc)
#define ROWV(p, k0, rr) ((p) + (size_t)((k0) + (rr)) * V_ROW + sc)
#define VMW() asm volatile("s_waitcnt vmcnt(0)" ::: "memory")
#define VMWN(n) asm volatile("s_waitcnt vmcnt(%0)" :: "i"(n) : "memory")
#define SLOAD_H(Kp, Vp, k0) do { S.st_v0 = load8<TIn>(ROWV(Vp, k0, sr)); S.st_v1 = load8<TIn>(ROWV(Vp, k0, 32 + sr));              \
                         S.st_k0 = load8<TIn>(ROW(Kp, k0, sr)); S.st_k1 = load8<TIn>(ROW(Kp, k0, 32 + sr)); } while (0)
#define SWRITE_HK(bf) do { *(bf16x8*)(K_lds + (bf) * SHM_K + kws) = S.st_k0; *(bf16x8*)(K_lds + (bf) * SHM_K + kws + 32 * 256) = S.st_k1; } while (0)
#define SWRITE_HV(bf) do { *(bf16x8*)(V_lds + (bf) * SHM_V + vst0) = S.st_v0; *(bf16x8*)(V_lds + (bf) * SHM_V + vst1) = S.st_v1; } while (0)
#define SWRITE_H(bf) do { SWRITE_HV(bf); SWRITE_HK(bf); } while (0)
#define SLOAD_F(p, k0) do { S.sf0 = *(const f32x4*)ROW(p, k0, sr); S.sf1 = *(const f32x4*)(ROW(p, k0, sr) + 4);                \
                            S.sf2 = *(const f32x4*)ROW(p, k0, 32 + sr); S.sf3 = *(const f32x4*)(ROW(p, k0, 32 + sr) + 4); } while (0)
#define SWRITE_KF(bf) do { *(bf16x8*)(K_lds + (bf) * SHM_K + kws) = pack8(S.sf0, S.sf1); *(bf16x8*)(K_lds + (bf) * SHM_K + kws + 32 * 256) = pack8(S.sf2, S.sf3); } while (0)
#define SWRITE_VF(bf) do { *(bf16x8*)(V_lds + (bf) * SHM_V + vst0) = pack8(S.sf0, S.sf1); *(bf16x8*)(V_lds + (bf) * SHM_V + vst1) = pack8(S.sf2, S.sf3); } while (0)
template <class TIn, class TOut>
__device__ __forceinline__ void causal_swa_prime(const BlockRef<TIn, TOut>& cur, int W, char* lds, Seam<TIn>& S) {
    constexpr bool F32 = same_t<TIn, float>::v;
    const int tid = tid_opaque(), wid = __builtin_amdgcn_readfirstlane(tid >> 6), lane = tid & 63, r32 = lane & 31, hi = lane >> 5;
    const int sr = tid >> 4, sc = (tid & 15) * 8, kws = KSWZ(sr, sc * 2); char* K_lds = lds + 2 * SHM_V;
    const int kb0 = swa_jlo(cur.P0, W) * KVBLK;
    for (int d0 = 0; d0 < 8; ++d0) S.qr[d0] = load8<TIn>(cur.Q + (size_t)(wid * QBLK + r32) * D + d0 * 16 + hi * 8);
    if constexpr (F32) { SLOAD_F((const float*)cur.K, kb0); VMW(); SWRITE_KF(0); SBAR(); SLOAD_F((const float*)cur.V, kb0); }
    else { SLOAD_H(cur.K, cur.V, kb0); VMW(); SWRITE_HK(0); }
    __syncthreads();
}
template <class TIn, class TOut>
__device__ __forceinline__ void causal_swa_block(const BlockRef<TIn, TOut>& cur, const BlockRef<TIn, TOut>& nxt, int skv, int W, char* lds, Seam<TIn>& S) {
    constexpr bool F32 = same_t<TIn, float>::v;
    const int tid = tid_opaque(), wid = __builtin_amdgcn_readfirstlane(tid >> 6), lane = tid & 63, r32 = lane & 31, hi = lane >> 5;
    const int j_lo = swa_jlo(cur.P0, W);
    int j_hi = (cur.P0 + QB - 1) / KVBLK + 1; if (j_hi > skv / KVBLK) j_hi = skv / KVBLK;
    const int NT = j_hi - j_lo;
    const int kbn = swa_jlo(nxt.P0, W) * KVBLK;
    const int qlo = cur.P0 + wid * QBLK, qm = qlo + r32 - 4 * hi;
    char* V_lds = lds; char* K_lds = lds + 2 * SHM_V;
    float* ws = (float*)(lds + 2 * SHM_V + 2 * SHM_K) + wid * 64; float* li_l = ws, * al_l = ws + 32;
    float m_reg = -1e30f, l_reg = 0; f32x16 o[4] = {};
    const int sr = tid >> 4, sc = (tid & 15) * 8, vst0 = v_st(sr, sc), vst1 = v_st(32 + sr, sc), kws = KSWZ(sr, sc * 2);
    const int vb0 = (int)(uintptr_t)V_lds + v_rd_base(lane);
    const TIn* Kh = cur.K; const TIn* Vh = cur.V;
#define RESC(a) do { if (__any((a) < 1.f)) { if (hi == 0) al_l[r32] = (a); asm volatile("s_waitcnt lgkmcnt(0)" ::: "memory");              \
                     for (int d_ = 0; d_ < 4; ++d_) for (int r = 0; r < 16; ++r) o[d_][r] *= al_l[crow(r, hi)]; } } while (0)
#define KBASE(t) ((j_lo + (t)) * KVBLK)
#define ACT(t) (KBASE(t) <= qlo + QBLK - 1 && KBASE(t) + KVBLK - 1 >= qlo - W + 1)
#define MASKT(P0_, P1_, t) do { const int kb_ = KBASE(t); if ((!SK || ACT(t)) && (kb_ + KVBLK - 1 > qlo || kb_ <= qlo + QBLK - 1 - W)) mask_tile(P0_, P1_, qm - kb_, (unsigned)W); } while (0)
    constexpr int NQL = F32 ? 16 : 8;
    constexpr bool SK = WSKIP && !F32;
#define SEAM_K0() do { VMWN(NQL); if constexpr (F32) { SWRITE_KF(0); SBAR(); SLOAD_F((const float*)nxt.V, kbn); } else { SWRITE_HK(0); } SBAR(); } while (0)
    f32x16 pA0, pA1, pB0, pB1; float mnA, mnB, alA, alB; bf16x8 pa0, pa1, pa2, pa3;
    if constexpr (F32) { VMW(); SWRITE_VF(0); SBAR(); } else { SWRITE_HV(0); SBAR(); }
    if (NT > 1) { if constexpr (F32) SLOAD_F((const float*)Kh, KBASE(1)); else SLOAD_H(Kh, Vh, KBASE(1)); }
    SBAR(); qkt<0, SK>(pA0, pA1, K_lds, r32, hi, S.qr, ACT(0));
    if constexpr (F32) { if (NT > 1) { VMW(); SWRITE_KF(1); SBAR(); SLOAD_F((const float*)Vh, KBASE(1)); } }
    MASKT(pA0, pA1, 0); partialSM(pA0, pA1, m_reg, mnA, alA);
    if (NT > 1) { VMW(); if constexpr (F32) { SWRITE_VF(1); SBAR(); if (NT > 2) SLOAD_F((const float*)Kh, KBASE(2)); } else SWRITE_H(1); }
    __syncthreads();
#define HALF_STEP(PX0, PX1, mnX, alX, PY0, PY1, alY, t, KB, VB, SB) do {                                                      \
        SBAR(); qkt<KB, SK>(PX0, PX1, K_lds, r32, hi, S.qr, ACT(t));                                             \
        finishSM(PY0, PY1, alY, l_reg, pa0, pa1, pa2, pa3); SBAR();                                                           \
        if ((t) + 1 < NT) { if constexpr (F32) { VMW(); SWRITE_KF(SB); SBAR(); SLOAD_F((const float*)Vh, KBASE((t) + 1)); }  \
                            else { SLOAD_H(Kh, Vh, KBASE((t) + 1)); } SBAR(); }                                               \
        pv_tile<VB, SK>(o, vb0, pa0, pa1, pa2, pa3, ACT((t) - 1)); MASKT(PX0, PX1, (t)); partialSM(PX0, PX1, m_reg, mnX, alX);                                        \
        __syncthreads();                                                                                                      \
        if ((t) + 1 < NT) { VMW(); if constexpr (F32) { SWRITE_VF(SB); SBAR(); if ((t) + 2 < NT) SLOAD_F((const float*)Kh, KBASE((t) + 2)); } \
                            else { SWRITE_H(SB); } }                                                                          \
        RESC(alX); __syncthreads(); } while (0)
    for (int t = 1; t + 1 < NT; t += 2) {
        HALF_STEP(pB0, pB1, mnB, alB, pA0, pA1, alA, t, 1, 0, 0);
        HALF_STEP(pA0, pA1, mnA, alA, pB0, pB1, alB, t + 1, 0, 1, 1);
    }
    const bool even = (NT & 1) == 0;
    if (even) { SBAR(); qkt<1, SK>(pB0, pB1, K_lds, r32, hi, S.qr, ACT(NT - 1)); SBAR(); }
#define QROW(e) (nxt.Q + (size_t)(wid * QBLK + r32) * D + ((e) >> 1) * 16 + hi * 8 + ((e) & 1) * 4)
    if constexpr (F32) { SLOAD_F((const float*)nxt.K, kbn); SBAR();
#pragma unroll
        for (int e = 0; e < 8; ++e) S.tq[e] = *(const f32x4*)QROW(e); }
    else { SLOAD_H(nxt.K, nxt.V, kbn); SBAR();
#pragma unroll
        for (int d0 = 0; d0 < 8; ++d0) S.qr[d0] = load8<TIn>(nxt.Q + (size_t)(wid * QBLK + r32) * D + d0 * 16 + hi * 8); }
    SBAR();
    finishSM(pA0, pA1, alA, l_reg, pa0, pa1, pa2, pa3); SBAR();
    if constexpr (F32) {
#pragma unroll
        for (int e = 8; e < 16; ++e) S.tq[e] = *(const f32x4*)QROW(e); SBAR(); }
#undef QROW
    pv_tile<0, SK>(o, vb0, pa0, pa1, pa2, pa3, ACT(even ? NT - 2 : NT - 1));
    if (even) { MASKT(pB0, pB1, NT - 1); partialSM(pB0, pB1, m_reg, mnB, alB); __syncthreads(); RESC(alB);
        finishSM(pB0, pB1, alB, l_reg, pa0, pa1, pa2, pa3); SBAR(); pv_tile<1, SK>(o, vb0, pa0, pa1, pa2, pa3, ACT(NT - 1)); }
    SBAR(); SEAM_K0();
    if (hi == 0) li_l[r32] = l_reg; asm volatile("s_waitcnt lgkmcnt(0)" ::: "memory");
    float rli[16];
#pragma unroll
    for (int r = 0; r < 16; ++r) rli[r] = __builtin_amdgcn_rcpf(li_l[crow(r, hi)]);
    TOut* Ow = cur.O + (size_t)(wid * QBLK) * D;
#pragma unroll
    for (int r = 0; r < 16; ++r) { const int orow = crow(r, hi);
#pragma unroll
        for (int d0 = 0; d0 < 4; ++d0) { const float v = o[d0][r] * rli[r];
            if constexpr (same_t<TOut, float>::v) { Ow[(size_t)orow * D + d0 * 32 + r32] = v; }
            else { *(unsigned short*)(lds + O_STAGE + wid * O_STAGE_WAVE + orow * O_STAGE_ROW + (d0 * 32 + r32) * 2) = (unsigned short)cvtpk(v, 0.f); } } }
    if constexpr (!same_t<TOut, float>::v) {
#pragma unroll
        for (int j = 0; j < 8; ++j) { const int ch = j * 64 + lane, orow = ch >> 4, c16 = ch & 15;
            __builtin_nontemporal_store(*(const u32x4*)(lds + O_STAGE + wid * O_STAGE_WAVE + orow * O_STAGE_ROW + c16 * 16), (u32x4*)((char*)(Ow + (size_t)orow * D) + c16 * 16)); } }
    if constexpr (F32) {
#pragma unroll
        for (int d0 = 0; d0 < 8; ++d0) S.qr[d0] = pack8(S.tq[2 * d0], S.tq[2 * d0 + 1]); }
    __syncthreads();
#undef RESC
#undef KBASE
#undef ACT
#undef MASKT
#undef SEAM_K0
#undef HALF_STEP
}
#undef ROW
#undef VMW
#undef VMWN
#undef SLOAD_H
#undef SWRITE_HK
#undef SWRITE_HV
#undef SWRITE_H
#undef SLOAD_F
#undef SWRITE_KF
#undef SWRITE_VF

}

#define XB_TMO      128
#define XB_XCNT(j)  (256  + 64 * (j))
#define XB_XSUB(j)  (1280 + 64 * (j))
#define XB_XGEN(j)  (2304 + 64 * (j))
#define XB_TOP      3328
#define XB_TOPGEN   3392
#define XCD_BAR_WORDS 3456
#define XB_SPIN_CAP (1u << 18)
#define LAS __attribute__((address_space(3)))

__device__ __forceinline__ unsigned xb_ld(unsigned* p)              { return __hip_atomic_load(p, __ATOMIC_RELAXED, __HIP_MEMORY_SCOPE_AGENT); }
__device__ __forceinline__ unsigned xb_add(unsigned* p, unsigned v) { return __hip_atomic_fetch_add(p, v, __ATOMIC_RELAXED, __HIP_MEMORY_SCOPE_AGENT); }
__device__ __forceinline__ unsigned xb_xcc_id() { return (unsigned)__builtin_amdgcn_s_getreg((3 << 11) | 20) & 0xFu; }
#define XB_SPIN(cond, bar) do { unsigned _sp = 0; while (cond) { __builtin_amdgcn_s_sleep(1); \
    if ((++_sp & 255u) == 0u) { if (xb_ld(&(bar)[XB_TMO])) break; if (_sp > XB_SPIN_CAP) { atomicAdd(&(bar)[XB_TMO], 1u); break; } } } } while (0)

struct XcdBarrier {
    unsigned* bar; unsigned x;
    volatile LAS unsigned* st;
};

__device__ __forceinline__ XcdBarrier xcd_barrier_post(unsigned* bar, volatile LAS unsigned* st) {
    XcdBarrier b; b.bar = bar; b.x = xb_xcc_id(); b.st = st;
    if (threadIdx.x == 0) (void)xb_add(&bar[XB_XCNT(b.x)], 1u);
    return b;
}
__device__ __forceinline__ void xcd_barrier_complete(unsigned* bar, unsigned x, unsigned& nloc, unsigned& nx) {
    const unsigned G = gridDim.x * gridDim.y * gridDim.z;
    unsigned sum, cnt, mine, sp = 0u;
    for (;;) {
        sum = 0u; cnt = 0u; mine = 0u;
#pragma unroll
        for (unsigned j = 0; j < 16; ++j) { const unsigned c = xb_ld(&bar[XB_XCNT(j)]); sum += c; cnt += (c > 0u) ? 1u : 0u; mine = (j == x) ? c : mine; }
        if (sum == G) break;
        __builtin_amdgcn_s_sleep(1);
        if ((++sp & 255u) == 0u) { if (xb_ld(&bar[XB_TMO])) break; if (sp > XB_SPIN_CAP) { atomicAdd(&bar[XB_TMO], 1u); break; } }
    }
    nloc = mine > 0u ? mine : 1u; nx = cnt > 0u ? cnt : 1u;
}

__device__ __forceinline__ void xcd_barrier(const XcdBarrier& b) {
    asm volatile("s_waitcnt vmcnt(0)" ::: "memory");
    __syncthreads();
    if (threadIdx.x == 0) {
        unsigned* bar = b.bar;
        __builtin_amdgcn_s_waitcnt(0);
        unsigned nloc = b.st[0], nx = b.st[1];
        if (nloc == 0u) { xcd_barrier_complete(bar, b.x, nloc, nx); b.st[0] = nloc; b.st[1] = nx; }
        const unsigned old = xb_add(&bar[XB_XSUB(b.x)], 1u);
        const unsigned gen = old / nloc;
        if (old + 1u == (gen + 1u) * nloc) {
            __builtin_amdgcn_fence(__ATOMIC_RELEASE, "agent");
            asm volatile("s_waitcnt vmcnt(0)" ::: "memory");
            const unsigned og = xb_add(&bar[XB_TOP], 1u);
            const unsigned tg = og / nx;
            if (og + 1u == (tg + 1u) * nx) xb_add(&bar[XB_TOPGEN], 1u);
            else XB_SPIN(xb_ld(&bar[XB_TOPGEN]) == tg, bar);
            __builtin_amdgcn_fence(__ATOMIC_ACQUIRE, "agent");
            xb_add(&bar[XB_XGEN(b.x)], 1u);
            asm volatile("s_waitcnt vmcnt(0)" ::: "memory");
        } else {
            XB_SPIN(xb_ld(&bar[XB_XGEN(b.x)]) == gen, bar);
            __builtin_amdgcn_fence(__ATOMIC_ACQUIRE, "agent");
            asm volatile("s_waitcnt vmcnt(0)" ::: "memory");
        }
    }
    __syncthreads();
}

constexpr int D_MODEL = 4096, BATCH = 4, SEQ = 4096, DEPTH = 2, M_TOK = BATCH * SEQ;
constexpr int D_FF_LD = 16384 + 128;
constexpr int IN_WIDTH = 12288, D_FF = 16384, LRU_W = 1024, HG_W = 1024, DIFF_W = 2048;
constexpr int OFF_A_GATE = 0, OFF_A_X = 1024, OFF_B_Q = 2048, OFF_B_F = 3072, OFF_B_I = 4096, OFF_B_G = 5120, OFF_C_Q = 6144, OFF_C_K = 8192, OFF_C_V = 10240;
constexpr float NORM_EPS = 1e-6f;
constexpr int NWAVES = 8, NTHREADS = NWAVES * 64;
constexpr int N_INPUTS = 21;
enum { I_X = 0, I_LN1, I_WIN, I_CONVW, I_CONVB, I_WR, I_BR, I_WI, I_BI, I_LAM, I_LRUG, I_HLB, I_HNG, I_QNG, I_KNG, I_DLAM, I_SUBLN, I_WOUT, I_LN2, I_WFF1, I_WFF2 };

constexpr size_t MiB = (size_t)1 << 20;
constexpr size_t WS_CTL = 0, CTL_ZERO_BYTES = 1 * MiB;
constexpr size_t WS_LB = 1 * MiB;
constexpr size_t WS_ROPE = 2 * MiB;
constexpr size_t WS_WGATE = 4 * MiB;
constexpr size_t WS_WIN = 16 * MiB;
constexpr size_t WS_WOUT = 208 * MiB;
constexpr size_t WS_WFF1 = 272 * MiB;
constexpr size_t WS_WFF2 = 528 * MiB;
constexpr size_t WS_H = 1904 * MiB;
constexpr size_t WS_YCAT = 912 * MiB;
constexpr size_t WS_Z = 1040 * MiB;
constexpr size_t WS_XA = 1424 * MiB;
constexpr size_t WS_RI = 1456 * MiB;
constexpr size_t WS_PSS = 1712 * MiB;
constexpr size_t WS_RS0 = 1724 * MiB;
constexpr size_t WS_QH = 1584 * MiB, WS_KH = 1648 * MiB;
constexpr size_t WS_OATT = 1776 * MiB;
constexpr size_t WS_LSUM = 2032 * MiB;
constexpr size_t WS_HID = 1040 * MiB;
constexpr size_t WS_END = 2034 * MiB;
constexpr int CW_BAR = 4096;

constexpr int RING_BYTES = 131072, LDS_BYTES = 147456, MISC_OFF = LDS_BYTES - 512;
static_assert(ab::O_STAGE + 8 * ab::O_STAGE_WAVE <= MISC_OFF, "attention LDS (tiles + output stage) must stay below the control words");

#define GAS __attribute__((address_space(1)))
typedef unsigned short bf16r;
typedef unsigned v4u __attribute__((ext_vector_type(4)));
typedef unsigned v2u __attribute__((ext_vector_type(2)));
typedef float f32x4 __attribute__((ext_vector_type(4)));
typedef float f32x2 __attribute__((ext_vector_type(2)));
#define LDS_WAIT() asm volatile("s_waitcnt lgkmcnt(0)" ::: "memory")
__device__ __forceinline__ float bflo(unsigned w) { return __uint_as_float(w << 16); }
__device__ __forceinline__ float bfhi(unsigned w) { return __uint_as_float(w & 0xffff0000u); }
__device__ __forceinline__ float bf1(bf16r b) { return __uint_as_float((unsigned)b << 16); }
__device__ __forceinline__ unsigned pk2(float lo, float hi) { return pk_bf16_builtin(lo, hi); }
__device__ __forceinline__ float wave_sum(float v) {
#pragma unroll
    for (int o = 1; o < 64; o <<= 1) v += __shfl_xor(v, o);
    return v;
}
__device__ __forceinline__ float fast_exp(float x) { return __builtin_amdgcn_exp2f(x * 1.4426950408889634f); }
__device__ __forceinline__ float sigmoidf_(float x) { return __builtin_amdgcn_rcpf(1.0f + fast_exp(-x)); }

__device__ __forceinline__ void p0_transpose_item(const float* W, int K, int N, bf16r* WT, LAS float* scr, int item, int lane, const float* kgain, int ldw) {
    const int nblk = N / 32, kb = item / nblk, nb = item % nblk, k0 = 64 * kb, n0 = 32 * nb;
    {
        const int l8 = lane & 7, lr = lane >> 3; f32x4 v[8];
#pragma unroll
        for (int i = 0; i < 8; ++i) v[i] = __builtin_nontemporal_load((const f32x4*)(W + (size_t)(k0 + 8 * i + lr) * N + n0 + 4 * l8));
#pragma unroll
        for (int i = 0; i < 8; ++i) { LAS float* d = scr + (8 * i + lr) * 33 + 4 * l8; d[0] = v[i].x; d[1] = v[i].y; d[2] = v[i].z; d[3] = v[i].w; }
    }
    LDS_WAIT(); asm volatile("" ::: "memory");
    const int c = lane & 7;
    f32x4 g0 = (f32x4){1.f, 1.f, 1.f, 1.f}, g1 = g0;
    if (kgain) { g0 = *(const f32x4*)(kgain + k0 + 8 * c); g1 = *(const f32x4*)(kgain + k0 + 8 * c + 4); }
#pragma unroll
    for (int j = 0; j < 4; ++j) { const int n = (lane >> 3) + 8 * j; const LAS float* s = scr + (8 * c) * 33 + n;
        v4u o; o.x = pk2(s[0 * 33] * g0.x, s[1 * 33] * g0.y); o.y = pk2(s[2 * 33] * g0.z, s[3 * 33] * g0.w); o.z = pk2(s[4 * 33] * g1.x, s[5 * 33] * g1.y); o.w = pk2(s[6 * 33] * g1.z, s[7 * 33] * g1.w);
        *(v4u*)(WT + (size_t)(n0 + n) * ldw + k0 + 8 * c) = o; }
    LDS_WAIT(); asm volatile("" ::: "memory");
}

struct Args { const float* in[N_INPUTS]; float* out; unsigned char* ws; int ph_lo, ph_hi; };

#ifndef GEMM_ALIGN
#define GEMM_ALIGN true
#endif
#ifndef GEMM_SP2
#define GEMM_SP2 true
#endif
constexpr int PH_PER_LAYER = 13, N_PHASES = 1 + DEPTH * PH_PER_LAYER;

__device__ __forceinline__ float neg_expm1(float x) {
    if (x > -0.3f) { float p = 1.0f + x * (1.0f / 7.0f); p = 1.0f + x * (1.0f / 6.0f) * p; p = 1.0f + x * 0.2f * p; p = 1.0f + x * 0.25f * p; p = 1.0f + x * (1.0f / 3.0f) * p; p = 1.0f + x * 0.5f * p; return -x * p; }
    return 1.0f - fast_exp(x);
}
__device__ __forceinline__ void lru_step(float r, float ig, float x, float sp8, bool first, float& h, float& A) {
    const float la = -r * sp8; const float a = fast_exp(la);
    const float mult = first ? 1.0f : sqrtf(neg_expm1(2.0f * la));
    h = a * h + mult * (ig * x); A += la;
}
__device__ __forceinline__ float gelu_tanh(float x) { const float y = 1.5957691216057308f * (x + 0.044715f * x * x * x); return x * __builtin_amdgcn_rcpf(1.0f + fast_exp(-y)); }

typedef const __attribute__((address_space(4))) unsigned char* kargp_t;
__device__ __forceinline__ kargp_t karg_base() { kargp_t kp = (kargp_t)__builtin_amdgcn_kernarg_segment_ptr(); asm volatile("" : "+s"(kp)); return kp; }
__device__ __forceinline__ const float* karg_in(int i) { return *(const float* const __attribute__((address_space(4)))*)(karg_base() + 8 * i); }
__device__ __forceinline__ float* karg_out() { return *(float* const __attribute__((address_space(4)))*)(karg_base() + 8 * N_INPUTS); }
__device__ __forceinline__ unsigned char* karg_ws() { return *(unsigned char* const __attribute__((address_space(4)))*)(karg_base() + 8 * N_INPUTS + 8); }
__device__ __forceinline__ int karg_int(int i) { return *(const int __attribute__((address_space(4)))*)(karg_base() + 8 * N_INPUTS + 16 + 4 * i); }
#define WSP(T, off) ((T*)(karg_ws() + (off)))
#define PHASE_IDS const int tid = tid_opaque(), lane = tid & 63, wave = __builtin_amdgcn_readfirstlane(tid >> 6), gw = vcu * NWAVES + wave; (void)tid; (void)lane; (void)wave; (void)gw

typedef short hg_bf16x8 __attribute__((ext_vector_type(8)));
#define HG_MFMA(a, b, c) __builtin_amdgcn_mfma_f32_16x16x32_bf16((a), (b), (c), 0, 0, 0)
#define HG_BAR() do { asm volatile("s_waitcnt vmcnt(0) lgkmcnt(0)" ::: "memory"); __builtin_amdgcn_s_barrier(); asm volatile("" ::: "memory"); } while (0)
#define HG_BARL() do { asm volatile("s_waitcnt lgkmcnt(0)" ::: "memory"); __builtin_amdgcn_s_barrier(); asm volatile("" ::: "memory"); } while (0)
__device__ __forceinline__ void hgrn_chunked(LAS unsigned char* L, const bf16r* Z, const float* lbp, const float* hgain, bf16r* YCAT, int b, int h, int tid) {
    constexpr int QS = 0, KS = 17408, KT = 34816, VT = 53248, STO = 71680, PS = 106496, SP = 115712, DM = 123904, DH = 124416;
    constexpr int RS = 272, TS = 144;
    const int lane = tid & 63, wave = __builtin_amdgcn_readfirstlane(tid >> 6), lr = lane & 15, lq = lane >> 4;
    const int u = tid & 255, j8 = (u & 15) * 8, seg = u >> 4;
    const bool scaler = wave < 4;
    const bool backward = wave < 2;
    const size_t tok0 = (size_t)b * SEQ;
    f32x4 stm[8];
#pragma unroll
    for (int n = 0; n < 8; ++n) stm[n] = (f32x4){0.f, 0.f, 0.f, 0.f};
    constexpr int LBS = 124928;
    if (tid < 128) *(LAS float*)(L + LBS + tid * 4) = 1.0f - lbp[h * 128 + tid];
    HG_BARL();
    v4u ldA[4], ldB[4];
#define HG_ISSUE(c) do { const size_t m_ = tok0 + (size_t)(c) * 64 + 4 * seg; \
        if (scaler) { _Pragma("unroll") for (int r = 0; r < 4; ++r) { ldA[r] = __builtin_nontemporal_load((const v4u*)(Z + (m_ + r) * IN_WIDTH + OFF_B_F + h * 128 + j8)); ldB[r] = __builtin_nontemporal_load((const v4u*)(Z + (m_ + r) * IN_WIDTH + OFF_B_Q + h * 128 + j8)); } } \
        else { _Pragma("unroll") for (int r = 0; r < 4; ++r) ldA[r] = __builtin_nontemporal_load((const v4u*)(Z + (m_ + r) * IN_WIDTH + OFF_B_I + h * 128 + j8)); } } while (0)
    HG_ISSUE(0);
#pragma unroll 1
    for (int c = 0; c < SEQ / 64; ++c) {
        float loc[4][8], Lp[8];
        if (scaler) {
            asm volatile("s_waitcnt vmcnt(0)" ::: "memory");
#pragma unroll
            for (int r = 0; r < 4; ++r) {
                const unsigned zw[4] = {ldA[r].x, ldA[r].y, ldA[r].z, ldA[r].w}; unsigned kwp[4];
                const f32x4 om0 = *(const LAS f32x4*)(L + LBS + j8 * 4), om1 = *(const LAS f32x4*)(L + LBS + j8 * 4 + 16);
                const float oml[8] = {om0.x, om0.y, om0.z, om0.w, om1.x, om1.y, om1.z, om1.w};
#pragma unroll
                for (int e2 = 0; e2 < 4; ++e2) { const float k0_ = oml[2 * e2] * __builtin_amdgcn_rcpf(1.0f + fast_exp(bflo(zw[e2]))), k1_ = oml[2 * e2 + 1] * __builtin_amdgcn_rcpf(1.0f + fast_exp(bfhi(zw[e2]))); kwp[e2] = pk2(k0_, k1_); }
                ldA[r] = (v4u){kwp[0], kwp[1], kwp[2], kwp[3]};
            }
            const unsigned kw0[4] = {ldA[0].x, ldA[0].y, ldA[0].z, ldA[0].w}, kw1[4] = {ldA[1].x, ldA[1].y, ldA[1].z, ldA[1].w}, kw2[4] = {ldA[2].x, ldA[2].y, ldA[2].z, ldA[2].w}, kw3[4] = {ldA[3].x, ldA[3].y, ldA[3].z, ldA[3].w};
#pragma unroll
            for (int e = 0; e < 8; ++e) {
                const float f0 = 1.0f - ((e & 1) ? bfhi(kw0[e >> 1]) : bflo(kw0[e >> 1])), f1 = 1.0f - ((e & 1) ? bfhi(kw1[e >> 1]) : bflo(kw1[e >> 1]));
                const float f2 = 1.0f - ((e & 1) ? bfhi(kw2[e >> 1]) : bflo(kw2[e >> 1])), f3 = 1.0f - ((e & 1) ? bfhi(kw3[e >> 1]) : bflo(kw3[e >> 1]));
                if (backward) { loc[3][e] = 1.0f; loc[2][e] = f3; loc[1][e] = f3 * f2; loc[0][e] = f3 * f2 * f1; Lp[e] = loc[0][e] * f0; }
                else { loc[0][e] = f0; loc[1][e] = f0 * f1; loc[2][e] = loc[1][e] * f2; loc[3][e] = loc[2][e] * f3; Lp[e] = loc[3][e]; }
            }
            *(LAS f32x4*)(L + SP + (seg * 128 + j8) * 4) = (f32x4){Lp[0], Lp[1], Lp[2], Lp[3]};
            *(LAS f32x4*)(L + SP + (seg * 128 + j8) * 4 + 16) = (f32x4){Lp[4], Lp[5], Lp[6], Lp[7]};
        }
        HG_BAR();
        if (scaler) {
            float X[8];
#pragma unroll
            for (int e = 0; e < 8; ++e) X[e] = 1.0f;
#pragma unroll
            for (int k = 0; k < 7; ++k) {
                const int sp = backward ? (1 + k) : (8 + k);
                const bool use = backward ? (sp > seg) : (sp < seg);
                const f32x4 a = *(const LAS f32x4*)(L + SP + (sp * 128 + j8) * 4), b4 = *(const LAS f32x4*)(L + SP + (sp * 128 + j8) * 4 + 16);
                X[0] *= use ? a.x : 1.0f; X[1] *= use ? a.y : 1.0f; X[2] *= use ? a.z : 1.0f; X[3] *= use ? a.w : 1.0f;
                X[4] *= use ? b4.x : 1.0f; X[5] *= use ? b4.y : 1.0f; X[6] *= use ? b4.z : 1.0f; X[7] *= use ? b4.w : 1.0f;
            }
            if (seg == 0) { *(LAS f32x4*)(L + DM + j8 * 4) = (f32x4){Lp[0] * X[0], Lp[1] * X[1], Lp[2] * X[2], Lp[3] * X[3]}; *(LAS f32x4*)(L + DM + j8 * 4 + 16) = (f32x4){Lp[4] * X[4], Lp[5] * X[5], Lp[6] * X[6], Lp[7] * X[7]}; }
            if (seg == 15) { *(LAS f32x4*)(L + DH + j8 * 4) = (f32x4){Lp[0] * X[0], Lp[1] * X[1], Lp[2] * X[2], Lp[3] * X[3]}; *(LAS f32x4*)(L + DH + j8 * 4 + 16) = (f32x4){Lp[4] * X[4], Lp[5] * X[5], Lp[6] * X[6], Lp[7] * X[7]}; }
            unsigned kt[8][2];
#pragma unroll
            for (int r = 0; r < 4; ++r) {
                float qs[8], ks[8];
                const unsigned kwr[4] = {ldA[r].x, ldA[r].y, ldA[r].z, ldA[r].w}, qwr[4] = {ldB[r].x, ldB[r].y, ldB[r].z, ldB[r].w};
#pragma unroll
                for (int e = 0; e < 8; ++e) {
                    float E, IE;
                    if (backward) { IE = fmaxf(loc[r][e] * X[e], 1.0e-30f); E = __builtin_amdgcn_rcpf(IE); }
                    else { E = fmaxf(loc[r][e] * X[e], 1.0e-30f); IE = __builtin_amdgcn_rcpf(E); }
                    { const float zq_ = (e & 1) ? bfhi(qwr[e >> 1]) : bflo(qwr[e >> 1]); qs[e] = zq_ * sigmoidf_(zq_) * 0.08838834764831845f * E; } ks[e] = ((e & 1) ? bfhi(kwr[e >> 1]) : bflo(kwr[e >> 1])) * IE;
                }
                v4u wq, wk; wq.x = pk2(qs[0], qs[1]); wq.y = pk2(qs[2], qs[3]); wq.z = pk2(qs[4], qs[5]); wq.w = pk2(qs[6], qs[7]);
                wk.x = pk2(ks[0], ks[1]); wk.y = pk2(ks[2], ks[3]); wk.z = pk2(ks[4], ks[5]); wk.w = pk2(ks[6], ks[7]);
                *(LAS v4u*)(L + QS + (4 * seg + r) * RS + j8 * 2) = wq; *(LAS v4u*)(L + KS + (4 * seg + r) * RS + j8 * 2) = wk;
                const unsigned kw[4] = {wk.x, wk.y, wk.z, wk.w};
#pragma unroll
                for (int e = 0; e < 8; ++e) { const unsigned hv = (e & 1) ? (kw[e >> 1] >> 16) : (kw[e >> 1] & 0xffffu);
                    if (r == 0) kt[e][0] = hv; else if (r == 1) kt[e][0] |= hv << 16; else if (r == 2) kt[e][1] = hv; else kt[e][1] |= hv << 16; }
            }
#pragma unroll
            for (int e = 0; e < 8; ++e) *(LAS v2u*)(L + KT + (j8 + e) * TS + (4 * seg) * 2) = (v2u){kt[e][0], kt[e][1]};
        } else {
            asm volatile("s_waitcnt vmcnt(0)" ::: "memory");
            const unsigned vw[4][4] = {{ldA[0].x, ldA[0].y, ldA[0].z, ldA[0].w}, {ldA[1].x, ldA[1].y, ldA[1].z, ldA[1].w}, {ldA[2].x, ldA[2].y, ldA[2].z, ldA[2].w}, {ldA[3].x, ldA[3].y, ldA[3].z, ldA[3].w}};
#pragma unroll
            for (int e = 0; e < 8; ++e) {
                unsigned h0, h1, h2, h3;
                if (e & 1) { h0 = vw[0][e >> 1] >> 16; h1 = vw[1][e >> 1] >> 16; h2 = vw[2][e >> 1] >> 16; h3 = vw[3][e >> 1] >> 16; }
                else { h0 = vw[0][e >> 1] & 0xffffu; h1 = vw[1][e >> 1] & 0xffffu; h2 = vw[2][e >> 1] & 0xffffu; h3 = vw[3][e >> 1] & 0xffffu; }
                *(LAS v2u*)(L + VT + (j8 + e) * TS + (4 * seg) * 2) = (v2u){h0 | (h1 << 16), h2 | (h3 << 16)};
            }
        }
        HG_BARL();
#pragma unroll
        for (int n = 0; n < 8; ++n) {
            const f32x4 dm = *(const LAS f32x4*)(L + DM + (16 * n + 4 * lq) * 4); const f32x4 sv = stm[n] * dm;
            *(LAS v2u*)(L + STO + (16 * wave + lr) * RS + (16 * n + 4 * lq) * 2) = (v2u){pk2(sv.x, sv.y), pk2(sv.z, sv.w)};
        }
        {
            const int ti = wave >> 1;
#pragma unroll
            for (int jj = 0; jj < 2; ++jj) {
                const int sj = 2 * (wave & 1) + jj;
                f32x4 acc = (f32x4){0.f, 0.f, 0.f, 0.f};
#pragma unroll
                for (int ks = 0; ks < 4; ++ks) {
                    const hg_bf16x8 a = *(const LAS hg_bf16x8*)(L + KS + (16 * sj + lr) * RS + (ks * 32 + 8 * lq) * 2);
                    const hg_bf16x8 bq = *(const LAS hg_bf16x8*)(L + QS + (16 * ti + lr) * RS + (ks * 32 + 8 * lq) * 2);
                    acc = HG_MFMA(a, bq, acc);
                }
                {
                    const int s0 = 16 * sj + 4 * lq, tt = 16 * ti + lr;
                    acc.x = (s0 + 0 <= tt) ? acc.x : 0.f; acc.y = (s0 + 1 <= tt) ? acc.y : 0.f; acc.z = (s0 + 2 <= tt) ? acc.z : 0.f; acc.w = (s0 + 3 <= tt) ? acc.w : 0.f;
                }
                *(LAS v2u*)(L + PS + (16 * ti + lr) * TS + (16 * sj + 4 * lq) * 2) = (v2u){pk2(acc.x, acc.y), pk2(acc.z, acc.w)};
            }
        }
        if (c + 1 < SEQ / 64) HG_ISSUE(c + 1);
        v2u gld[4];
        int tG = tid; asm volatile("" : "+v"(tG));
#pragma unroll
        for (int k = 0; k < 4; ++k) { const int pc = tG + 512 * k; gld[k] = __builtin_nontemporal_load((const v2u*)(Z + (tok0 + (size_t)c * 64 + (pc >> 5)) * IN_WIDTH + OFF_B_G + h * 128 + (pc & 31) * 4)); }
        HG_BARL();
        f32x4 o[4];
        {
#pragma unroll
            for (int i = 0; i < 4; ++i) o[i] = (f32x4){0.f, 0.f, 0.f, 0.f};
            hg_bf16x8 bs[4];
#pragma unroll
            for (int ks = 0; ks < 4; ++ks) bs[ks] = *(const LAS hg_bf16x8*)(L + STO + (16 * wave + lr) * RS + (ks * 32 + 8 * lq) * 2);
#pragma unroll
            for (int i = 0; i < 4; ++i)
#pragma unroll
                for (int ks = 0; ks < 4; ++ks) { const hg_bf16x8 a = *(const LAS hg_bf16x8*)(L + QS + (16 * i + lr) * RS + (ks * 32 + 8 * lq) * 2); o[i] = HG_MFMA(a, bs[ks], o[i]); }
            hg_bf16x8 bv[2];
#pragma unroll
            for (int ks = 0; ks < 2; ++ks) bv[ks] = *(const LAS hg_bf16x8*)(L + VT + (16 * wave + lr) * TS + (ks * 32 + 8 * lq) * 2);
#pragma unroll
            for (int i = 0; i < 4; ++i)
#pragma unroll
                for (int ks = 0; ks < 2; ++ks) { if (ks == 1 && i < 2) continue; const hg_bf16x8 a = *(const LAS hg_bf16x8*)(L + PS + (16 * i + lr) * TS + (ks * 32 + 8 * lq) * 2); o[i] = HG_MFMA(a, bv[ks], o[i]); }
#pragma unroll
            for (int n = 0; n < 8; ++n) {
                f32x4 U = (f32x4){0.f, 0.f, 0.f, 0.f};
#pragma unroll
                for (int ks = 0; ks < 2; ++ks) { const hg_bf16x8 a = *(const LAS hg_bf16x8*)(L + KT + (16 * n + lr) * TS + (ks * 32 + 8 * lq) * 2); U = HG_MFMA(a, bv[ks], U); }
                const f32x4 dm = *(const LAS f32x4*)(L + DM + (16 * n + 4 * lq) * 4), dh = *(const LAS f32x4*)(L + DH + (16 * n + 4 * lq) * 4);
                stm[n] = stm[n] * (dm * dh) + dh * U;
            }
        }
        HG_BARL();
#pragma unroll
        for (int i = 0; i < 4; ++i) {
            *(LAS float*)(L + (16 * i + 4 * lq + 0) * 528 + (16 * wave + lr) * 4) = o[i].x; *(LAS float*)(L + (16 * i + 4 * lq + 1) * 528 + (16 * wave + lr) * 4) = o[i].y;
            *(LAS float*)(L + (16 * i + 4 * lq + 2) * 528 + (16 * wave + lr) * 4) = o[i].z; *(LAS float*)(L + (16 * i + 4 * lq + 3) * 528 + (16 * wave + lr) * 4) = o[i].w;
        }
        HG_BARL();
        {
            int tE = tid; asm volatile("" : "+v"(tE));
#pragma unroll
            for (int k = 0; k < 4; ++k) { const int pc = tE + 512 * k, row = pc >> 5, col = (pc & 31) * 4;
                const f32x4 ov = *(const LAS f32x4*)(L + row * 528 + col * 4);
                float ss = (ov.x * ov.x + ov.y * ov.y) + (ov.z * ov.z + ov.w * ov.w);
                ss += __shfl_xor(ss, 1); ss += __shfl_xor(ss, 2); ss += __shfl_xor(ss, 4); ss += __shfl_xor(ss, 8); ss += __shfl_xor(ss, 16);
                const float rs = 1.0f / sqrtf(ss * (1.0f / 128.0f) + NORM_EPS);
                const size_t m = tok0 + (size_t)c * 64 + row;
                const v2u gw2 = gld[k];
                const f32x4 hgv = *(const f32x4*)(hgain + col);
                const float g0 = bflo(gw2.x), g1 = bfhi(gw2.x), g2 = bflo(gw2.y), g3 = bfhi(gw2.y);
                v2u w; w.x = pk2(ov.x * rs * hgv.x * (g0 * sigmoidf_(g0)), ov.y * rs * hgv.y * (g1 * sigmoidf_(g1))); w.y = pk2(ov.z * rs * hgv.z * (g2 * sigmoidf_(g2)), ov.w * rs * hgv.w * (g3 * sigmoidf_(g3)));
                *(v2u*)(YCAT + m * D_MODEL + 1024 + h * 128 + col) = w; }
        }
    }
#undef HG_ISSUE
}

__device__ __forceinline__ void xcopy_rows(const float* xin, bf16r* HB, float* RS0, int gw, int ngw, int lane) {
    for (int m = gw; m < M_TOK; m += ngw) {
        const f32x4* xr = (const f32x4*)(xin + (size_t)m * D_MODEL) + lane;
        f32x4 v[16]; float ss = 0.f;
#pragma unroll
        for (int j = 0; j < 16; ++j) { v[j] = __builtin_nontemporal_load(xr + 64 * j); ss += (v[j].x * v[j].x + v[j].y * v[j].y) + (v[j].z * v[j].z + v[j].w * v[j].w); }
        ss = wave_sum(ss);
        v2u* o = (v2u*)(HB + (size_t)m * D_MODEL) + lane;
#pragma unroll
        for (int j = 0; j < 16; ++j) { v2u w; w.x = pk2(v[j].x, v[j].y); w.y = pk2(v[j].z, v[j].w); o[64 * j] = w; }
        if (lane == 0) RS0[m] = ss;
    }
}
#define RS_TABLE_OFF (RING_BYTES + 1024)
#define RS_TABLE_FILL(pssp, nparts, pm_) do { { const int r_ = tid & 255, hf_ = tid >> 8; float ss_ = 0.f;                                                                         \
        if ((nparts) == 1) { if (!hf_) ss_ = (pssp)[(pm_) * 256 + r_]; }                                                                                                           \
        else { _Pragma("unroll 16") for (int j_ = 0; j_ < 32; ++j_) ss_ += (pssp)[(size_t)(hf_ * 32 + j_) * M_TOK + (pm_) * 256 + r_]; }                                           \
        if (hf_) ((LAS float*)(ldsl + RS_TABLE_OFF))[256 + r_] = ss_;                                                                                                              \
        __syncthreads();                                                                                                                                                           \
        if (!hf_) ((LAS float*)(ldsl + RS_TABLE_OFF))[r_] = 1.0f / sqrtf((ss_ + ((LAS float*)(ldsl + RS_TABLE_OFF))[256 + r_]) * (1.0f / D_MODEL) + NORM_EPS); } __syncthreads(); } while (0)

constexpr int WC_IN = (D_MODEL / 64) * (IN_WIDTH / 32), WC_OUT = (D_MODEL / 64) * (D_MODEL / 32), WC_F1 = (D_MODEL / 64) * (D_FF / 32), WC_F2 = (D_FF / 64) * (D_MODEL / 32);
constexpr int WC_LAYER = WC_IN + WC_OUT + WC_F1 + WC_F2;
__device__ __forceinline__ void convert_weights(int it0, int it1, int w, int nw, LAS float* scr, int lane) {
    bf16r* const W_IN = WSP(bf16r, WS_WIN); bf16r* const W_OUT = WSP(bf16r, WS_WOUT); bf16r* const W_FF1 = WSP(bf16r, WS_WFF1); bf16r* const W_FF2 = WSP(bf16r, WS_WFF2);
    for (int it = it0 + w; it < it1; it += nw) {
        const int l = it / WC_LAYER; int r = it - l * WC_LAYER;
        if (r < WC_IN) { p0_transpose_item(karg_in(I_WIN) + (size_t)l * D_MODEL * IN_WIDTH, D_MODEL, IN_WIDTH, W_IN + (size_t)l * IN_WIDTH * D_MODEL, scr, r, lane, karg_in(I_LN1) + l * D_MODEL, D_MODEL); continue; } r -= WC_IN;
        if (r < WC_OUT) { p0_transpose_item(karg_in(I_WOUT) + (size_t)l * D_MODEL * D_MODEL, D_MODEL, D_MODEL, W_OUT + (size_t)l * D_MODEL * D_MODEL, scr, r, lane, nullptr, D_MODEL); continue; } r -= WC_OUT;
        if (r < WC_F1) { p0_transpose_item(karg_in(I_WFF1) + (size_t)l * D_MODEL * D_FF, D_MODEL, D_FF, W_FF1 + (size_t)l * D_FF * D_MODEL, scr, r, lane, karg_in(I_LN2) + l * D_MODEL, D_MODEL); continue; } r -= WC_F1;
        p0_transpose_item(karg_in(I_WFF2) + (size_t)l * D_FF * D_MODEL, D_FF, D_MODEL, W_FF2 + (size_t)l * D_MODEL * D_FF_LD, scr, r, lane, nullptr, D_FF_LD);
    }
}

__device__ __forceinline__ ab::BlockRef<__hip_bfloat16, __hip_bfloat16> attn_ref(const __hip_bfloat16* Qp, const __hip_bfloat16* Kp, const __hip_bfloat16* Vp, __hip_bfloat16* Op, int L, int pass) {
    const int bh = L >> 3, x = L & 7, qb = pass ? 15 - x : x;
    const int b = bh >> 5, hq = bh & 31, h = hq >> 2, c = (hq >> 1) & 1, vh = hq & 1;
    ab::BlockRef<__hip_bfloat16, __hip_bfloat16> r;
    r.Q = Qp + ((size_t)(b * 16 + h * 2 + c) * SEQ + (size_t)qb * 256) * 128;
    r.K = Kp + (size_t)(b * 16 + h * 2 + c) * SEQ * 128;
    r.V = Vp + (size_t)b * SEQ * IN_WIDTH + OFF_C_V + (h * 2 + vh) * 128;
    r.O = Op + ((size_t)(b * 32 + hq) * SEQ + (size_t)qb * 256) * 128;
    r.P0 = qb * 256;
    return r;
}

__device__ __forceinline__ ab::BlockRef<__hip_bfloat16, __hip_bfloat16> attn_ref_q(const __hip_bfloat16* Qp, const __hip_bfloat16* Kp, const __hip_bfloat16* Vp, __hip_bfloat16* Op, int J) {
    const int pr = (J >> 8) * 4 + (J & 3), i = (J & 255) >> 2;
    const int qb = 15 - (i >> 2), b = pr >> 3, h = pr & 7, c = (i >> 1) & 1, vh = i & 1, hq = h * 4 + c * 2 + vh;
    ab::BlockRef<__hip_bfloat16, __hip_bfloat16> r;
    r.Q = Qp + ((size_t)(b * 16 + h * 2 + c) * SEQ + (size_t)qb * 256) * 128;
    r.K = Kp + (size_t)(b * 16 + h * 2 + c) * SEQ * 128;
    r.V = Vp + (size_t)b * SEQ * IN_WIDTH + OFF_C_V + (h * 2 + vh) * 128;
    r.O = Op + ((size_t)(b * 32 + hq) * SEQ + (size_t)qb * 256) * 128;
    r.P0 = qb * 256;
    return r;
}

__device__ __forceinline__ void group4_barrier(unsigned* ctr, unsigned* ctr2, unsigned* bar) {
    asm volatile("s_waitcnt vmcnt(0)" ::: "memory");
    __syncthreads();
    if (threadIdx.x == 0) {
        __builtin_amdgcn_s_waitcnt(0);
        __builtin_amdgcn_fence(__ATOMIC_RELEASE, "agent");
        asm volatile("s_waitcnt vmcnt(0)" ::: "memory");
        (void)xb_add(ctr, 1u);
        XB_SPIN(xb_ld(ctr) < 4u, bar);
        if (ctr2) XB_SPIN(xb_ld(ctr2) < 4u, bar);
        __builtin_amdgcn_fence(__ATOMIC_ACQUIRE, "agent");
        asm volatile("s_waitcnt vmcnt(0)" ::: "memory");
    }
    __syncthreads();
}

constexpr int NQ_ALL = BATCH * 32 * 16, NQ_XCD = NQ_ALL / 8;
__device__ __forceinline__ int aq_take(unsigned* qbase, int x0, volatile LAS unsigned* st) {
    unsigned dx = *st;
    while (dx < 8u) {
        const unsigned q = ((unsigned)x0 + dx) & 7u;
        const unsigned v = __hip_atomic_fetch_add(qbase + 64 * q, 1u, __ATOMIC_RELAXED, __HIP_MEMORY_SCOPE_AGENT);
        if (v < (unsigned)NQ_XCD) { *st = dx; return (int)(q * NQ_XCD + v); }
        ++dx;
    }
    *st = 8u; return NQ_ALL;
}

__global__ void __launch_bounds__(NTHREADS, 2) hymba_fwd(Args args) {
    extern __shared__ __attribute__((aligned(16))) unsigned char lds[];
    LAS unsigned char* ldsl = (LAS unsigned char*)lds;
    const int G = gridDim.x;
    int bx = blockIdx.x;
    int vcu = (G % 8 == 0) ? (bx % 8) * (G / 8) + bx / 8 : bx;
    const int ngw = G * NWAVES;
    volatile LAS unsigned* MISC = (volatile LAS unsigned*)(ldsl + MISC_OFF);
    for (int u = threadIdx.x; u < (LDS_BYTES - RING_BYTES) / 4; u += NTHREADS) ((LAS unsigned*)(ldsl + RING_BYTES))[u] = 0u;
    __syncthreads();
#if MK_PER_PHASE
    const int lo = karg_int(0), hi = karg_int(1);
#else
    constexpr int lo = 0, hi = N_PHASES;
#endif
    const bool multi = (hi - lo) > 1;
    XcdBarrier bar; bar.bar = WSP(unsigned, WS_CTL) + CW_BAR; bar.x = 0; bar.st = nullptr;
    if (multi) bar = xcd_barrier_post(WSP(unsigned, WS_CTL) + CW_BAR, MISC + 8);
    if (multi && threadIdx.x == 0) MISC[18] = __hip_atomic_fetch_add(WSP(unsigned, WS_CTL) + 3072 + 64 * (xb_xcc_id() & 7u), 1u, __ATOMIC_RELAXED, __HIP_MEMORY_SCOPE_AGENT);
#ifndef EN_MASK
#define EN_MASK 0xFFFF
#endif
#define ENK(j) (((EN_MASK) >> (j)) & 1)
#ifndef DBG_TWICE_MASK
#define DBG_TWICE_MASK 0
#endif
#define REPS(j) ((((DBG_TWICE_MASK) >> (j)) & 1) ? 2 : 1)
#define IN(k) (lo <= (k) && (k) < hi)
#if defined(DBG_STAMP_MASK)
#define SEAM(k) do { if (IN((k) + 1)) { if (threadIdx.x == 0) WSP(unsigned long long, 12 * MiB)[((k) * 2 + 0) * 256 + blockIdx.x] = __builtin_amdgcn_s_memrealtime(); xcd_barrier(bar); \
    if (threadIdx.x == 0) WSP(unsigned long long, 12 * MiB)[((k) * 2 + 1) * 256 + blockIdx.x] = __builtin_amdgcn_s_memrealtime(); } } while (0)
#else
#define SEAM(k) do { if (IN((k) + 1)) xcd_barrier(bar); } while (0)
#endif
#define PANEL_PM ((bx & 7) * 8 + ((bx >> 3) & 7))
#define PANEL_R4 ((bx >> 6) & 3)
#define SEAM4(k, slot) do { if (IN((k) + 1)) group4_barrier(WSP(unsigned, WS_CTL) + 16384 + ((slot) * 64 + PANEL_PM) * 64, nullptr, bar.bar); } while (0)
#define SEAM4H(k, slot) do { if (IN((k) + 1)) group4_barrier(WSP(unsigned, WS_CTL) + 16384 + ((slot) * 64 + PANEL_PM) * 64, \
        (PANEL_R4 == 0 && (PANEL_PM & 15) != 0) ? WSP(unsigned, WS_CTL) + 16384 + ((slot) * 64 + PANEL_PM - 1) * 64 : (unsigned*)nullptr, bar.bar); } while (0)

    if (ENK(15) && IN(0)) {
        PHASE_IDS;
#pragma unroll 1
        for (int rep_ = 0; rep_ < REPS(15); ++rep_) {
        bf16r* const W_IN = WSP(bf16r, WS_WIN);
        bf16r* const W_OUT = WSP(bf16r, WS_WOUT);
        bf16r* const W_FF1 = WSP(bf16r, WS_WFF1);
        bf16r* const W_FF2 = WSP(bf16r, WS_WFF2);
        bf16r* const W_GATE = WSP(bf16r, WS_WGATE);
        float* const LB = WSP(float, WS_LB);
        float* const ROPE_COS = WSP(float, WS_ROPE); float* const ROPE_SIN = ROPE_COS + SEQ * 64;
        LAS float* scr = (LAS float*)(ldsl + wave * 16384);
        convert_weights(0, WC_IN, gw, ngw, scr, lane);
        for (int idx = gw * 64 + lane; idx < DEPTH * 2048 * 32; idx += ngw * 64) {
            const int l = idx / (2048 * 32), n = (idx / 32) % 2048, k0 = (idx % 32) * 8;
            const int pn = n >> 8, p = pn >> 1, g = pn & 1, hh = (n >> 7) & 1, j = n & 127;
            v4u o = {0u, 0u, 0u, 0u};
            if ((k0 >> 7) == hh) { const float* w = karg_in(g ? I_WI : I_WR) + (((size_t)l * 8 + 2 * p + hh) * 128 + (k0 & 127)) * 128 + j;
                o.x = pk2(w[0 * 128], w[1 * 128]); o.y = pk2(w[2 * 128], w[3 * 128]); o.z = pk2(w[4 * 128], w[5 * 128]); o.w = pk2(w[6 * 128], w[7 * 128]); }
            *(v4u*)(W_GATE + ((size_t)l * 2048 + n) * 256 + k0) = o;
        }
        for (int c = gw * 64 + lane; c < HG_W; c += ngw * 64) {
            const float b0 = karg_in(I_HLB)[c], b1 = karg_in(I_HLB)[HG_W + c]; const float mx = fmaxf(b0, b1);
            const float e0 = __expf(b0 - mx), e1 = __expf(b1 - mx);
            LB[c] = 0.f; LB[HG_W + c] = e1 / (e0 + e1);
        }
        for (int idx = gw * 64 + lane; idx < SEQ * 64; idx += ngw * 64) {
            const int t = idx >> 6, j = idx & 63;
            const float inv = exp2f(-(float)(2 * j) * (1.0f / 128.0f) * 13.287712379549449f);
            const float angf = (float)t * inv;
            double rev = (double)angf * 0.15915494309189535; rev -= floor(rev);
            const float rf = (float)rev;
            ROPE_COS[idx] = __builtin_amdgcn_cosf(rf); ROPE_SIN[idx] = __builtin_amdgcn_sinf(rf);
        }
        }
        xcopy_rows(karg_in(I_X), WSP(bf16r, WS_H), WSP(float, WS_RS0), gw, ngw, lane);
        SEAM(0);
    }
    if (multi && IN(0) && IN(1) && G % 8 == 0) {
        if (threadIdx.x == 0) {
            const unsigned x = xb_xcc_id() & 7u; unsigned before = 0u;
            for (unsigned j = 0; j < 8u; ++j) { const unsigned cj = __hip_atomic_load(WSP(unsigned, WS_CTL) + 3072 + 64 * j, __ATOMIC_RELAXED, __HIP_MEMORY_SCOPE_AGENT); before += (j < x) ? cj : 0u; }
            MISC[17] = before + MISC[18];
        }
        __syncthreads();
        const int lb = (int)MISC[17];
        if (lb >= 0 && lb < G) { vcu = lb; bx = (lb % (G / 8)) * 8 + lb / (G / 8); }
    }

#pragma unroll 1
    for (int l = 0; l < DEPTH; ++l) {
        const int pb = 1 + l * PH_PER_LAYER;

        if (ENK(1) && IN(pb + 1)) {
            PHASE_IDS;
#pragma unroll 1
            for (int rep_ = 0; rep_ < REPS(1); ++rep_) {
            bf16r* const HB = WSP(bf16r, WS_H);
            bf16r* const W_IN = WSP(bf16r, WS_WIN);
            bf16r* const Z = WSP(bf16r, WS_Z);
            pg8::Gemm g{HB, W_IN + (size_t)l * IN_WIDTH * D_MODEL, M_TOK, IN_WIDTH, D_MODEL}; pg8::StaticOrder S; S.init(M_TOK, IN_WIDTH, G, bx);
            { const float* pssp = (l == 0) ? WSP(float, WS_RS0) : WSP(float, WS_PSS) + (size_t)1 * 64 * M_TOK; const int nparts = (l == 0) ? 1 : 64;
              pg8::Unit u0; if (S.next(0, u0)) RS_TABLE_FILL(pssp, nparts, u0.pm); }
            pg8::EpiBf16X<0> E{Z, IN_WIDTH, nullptr, nullptr, 0, (const LAS float*)(ldsl + RS_TABLE_OFF)};
            pg8::gemm_phase<pg8::EpiBf16X<0>, pg8::StaticOrder, GEMM_ALIGN, GEMM_SP2>(ldsl, g, S, E);
            }
            SEAM4H(pb + 1, 8 * l + 2);
        }

        if (ENK(2) && IN(pb + 2)) {
            PHASE_IDS;
#pragma unroll 1
            for (int rep_ = 0; rep_ < REPS(2); ++rep_) {
            bf16r* const Z = WSP(bf16r, WS_Z);
            bf16r* const XA = WSP(bf16r, WS_XA);
            bf16r* const QH = WSP(bf16r, WS_QH);
            bf16r* const KH = WSP(bf16r, WS_KH);
            float* const LB = WSP(float, WS_LB);
            float* const ROPE_COS = WSP(float, WS_ROPE); float* const ROPE_SIN = ROPE_COS + SEQ * 64;
            const float* convw = karg_in(I_CONVW) + l * 4 * LRU_W; const float* convb = karg_in(I_CONVB) + l * LRU_W;
            const float* qg = karg_in(I_QNG) + l * 128; const float* kg = karg_in(I_KNG) + l * 128;
            for (int m = PANEL_PM * 256 + PANEL_R4 * 64 + wave; m < PANEL_PM * 256 + PANEL_R4 * 64 + 64; m += NWAVES) {
                const int t = m & (SEQ - 1), b = m >> 12;
                const bf16r* zr = Z + (size_t)m * IN_WIDTH;
                v4u xv[2][4], av[4], cv[4];
#pragma unroll
                for (int it = 0; it < 2; ++it)
#pragma unroll
                    for (int j = 0; j < 4; ++j) { xv[it][j] = (v4u){0u, 0u, 0u, 0u}; if (t - 3 + j >= 0) xv[it][j] = *(const v4u*)(zr - (ptrdiff_t)(3 - j) * IN_WIDTH + OFF_A_X + it * 512 + lane * 8); }
#pragma unroll
                for (int it = 0; it < 4; ++it) { const bf16r* src = zr + ((it >> 1) ? OFF_C_K : OFF_C_Q) + ((it & 1) * 8 + (lane >> 3)) * 128 + (lane & 7) * 8;
                    av[it] = __builtin_nontemporal_load((const v4u*)src); cv[it] = __builtin_nontemporal_load((const v4u*)(src + 64)); }
                const f32x4 ca = *(const f32x4*)(ROPE_COS + t * 64 + (lane & 7) * 8), cb = *(const f32x4*)(ROPE_COS + t * 64 + (lane & 7) * 8 + 4);
                const f32x4 sa = *(const f32x4*)(ROPE_SIN + t * 64 + (lane & 7) * 8), sb = *(const f32x4*)(ROPE_SIN + t * 64 + (lane & 7) * 8 + 4);
#pragma unroll
                for (int it = 0; it < 2; ++it) {
                    const int c0 = it * 512 + lane * 8;
                    const f32x4 b0 = *(const f32x4*)(convb + c0), b1 = *(const f32x4*)(convb + c0 + 4);
                    float a0 = b0.x, a1 = b0.y, a2 = b0.z, a3 = b0.w, a4 = b1.x, a5 = b1.y, a6 = b1.z, a7 = b1.w;
#pragma unroll
                    for (int j = 0; j < 4; ++j) {
                        const v4u x4 = xv[it][j];
                        const f32x4 w0 = *(const f32x4*)(convw + j * LRU_W + c0), w1 = *(const f32x4*)(convw + j * LRU_W + c0 + 4);
                        a0 += bflo(x4.x) * w0.x; a1 += bfhi(x4.x) * w0.y; a2 += bflo(x4.y) * w0.z; a3 += bfhi(x4.y) * w0.w;
                        a4 += bflo(x4.z) * w1.x; a5 += bfhi(x4.z) * w1.y; a6 += bflo(x4.w) * w1.z; a7 += bfhi(x4.w) * w1.w;
                    }
                    v4u o; o.x = pk2(a0, a1); o.y = pk2(a2, a3); o.z = pk2(a4, a5); o.w = pk2(a6, a7);
                    *(v4u*)(XA + ((size_t)(c0 >> 8) * M_TOK + m) * 256 + (c0 & 255)) = o;
                }
#pragma unroll
                for (int it = 0; it < 4; ++it) {
                    const int isk = it >> 1, vi = (it & 1) * 8 + (lane >> 3), sub = lane & 7;
                    const v4u a4 = av[it], c4 = cv[it];
                    float x1[8] = {bflo(a4.x), bfhi(a4.x), bflo(a4.y), bfhi(a4.y), bflo(a4.z), bfhi(a4.z), bflo(a4.w), bfhi(a4.w)};
                    float x2[8] = {bflo(c4.x), bfhi(c4.x), bflo(c4.y), bfhi(c4.y), bflo(c4.z), bfhi(c4.z), bflo(c4.w), bfhi(c4.w)};
                    float ss = 0.f;
#pragma unroll
                    for (int e = 0; e < 8; ++e) ss += x1[e] * x1[e] + x2[e] * x2[e];
                    ss += __shfl_xor(ss, 1); ss += __shfl_xor(ss, 2); ss += __shfl_xor(ss, 4);
                    const float rs = 1.0f / sqrtf(ss * (1.0f / 128.0f) + NORM_EPS);
                    const float* gp = (isk ? kg : qg) + sub * 8;
                    const f32x4 g1a = *(const f32x4*)gp, g1b = *(const f32x4*)(gp + 4), g2a = *(const f32x4*)(gp + 64), g2b = *(const f32x4*)(gp + 68);
                    const float g1[8] = {g1a.x, g1a.y, g1a.z, g1a.w, g1b.x, g1b.y, g1b.z, g1b.w}, g2[8] = {g2a.x, g2a.y, g2a.z, g2a.w, g2b.x, g2b.y, g2b.z, g2b.w};
                    const float cc[8] = {ca.x, ca.y, ca.z, ca.w, cb.x, cb.y, cb.z, cb.w}, sn[8] = {sa.x, sa.y, sa.z, sa.w, sb.x, sb.y, sb.z, sb.w};
                    float o1[8], o2[8];
#pragma unroll
                    for (int e = 0; e < 8; ++e) { const float y1 = x1[e] * rs * g1[e], y2 = x2[e] * rs * g2[e]; o1[e] = y1 * cc[e] - y2 * sn[e]; o2[e] = y2 * cc[e] + y1 * sn[e]; }
                    bf16r* dst = (isk ? KH : QH) + ((size_t)(b * 16 + vi) * SEQ + t) * 128 + sub * 8;
                    v4u w1, w2; w1.x = pk2(o1[0], o1[1]); w1.y = pk2(o1[2], o1[3]); w1.z = pk2(o1[4], o1[5]); w1.w = pk2(o1[6], o1[7]);
                    w2.x = pk2(o2[0], o2[1]); w2.y = pk2(o2[2], o2[3]); w2.z = pk2(o2[4], o2[5]); w2.w = pk2(o2[6], o2[7]);
                    *(v4u*)dst = w1; *(v4u*)(dst + 64) = w2;
                }
            }
            }
            SEAM4(pb + 2, 8 * l + 3);
        }

        if (ENK(3) && IN(pb + 3)) {
            PHASE_IDS;
#pragma unroll 1
            for (int rep_ = 0; rep_ < REPS(3); ++rep_) {
            bf16r* const XA = WSP(bf16r, WS_XA);
            bf16r* const W_GATE = WSP(bf16r, WS_WGATE);
            bf16r* const RI = WSP(bf16r, WS_RI);
            pg8::Gemm g{XA, W_GATE + (size_t)l * 2048 * 256, M_TOK, 2048, 256, (size_t)M_TOK * 256 * 2, 1}; pg8::StaticOrder S; S.init(M_TOK, 2048, G, bx);
            pg8::EpiBf16X<1> E{RI, 2048, karg_in(I_BR) + l * LRU_W, karg_in(I_BI) + l * LRU_W, 1024, nullptr};
            pg8::gemm_phase<pg8::EpiBf16X<1>, pg8::StaticOrder, GEMM_ALIGN, GEMM_SP2>(ldsl, g, S, E);
            }
            SEAM4(pb + 3, 8 * l + 4);
        }

        if ((ENK(4) || ENK(5)) && (IN(pb + 4) || IN(pb + 5))) {
            PHASE_IDS;
            bf16r* const XA = WSP(bf16r, WS_XA);
            bf16r* const RI = WSP(bf16r, WS_RI);
            float* const LSUM = WSP(float, WS_LSUM);
            bf16r* const Z = WSP(bf16r, WS_Z);
            const float* lam = karg_in(I_LAM) + l * LRU_W;
            const int c = tid * 2;
            const float sp0 = 8.0f * log1pf(__expf(-lam[c])), sp1 = 8.0f * log1pf(__expf(-lam[c + 1]));
            if (ENK(4) && IN(pb + 4)) {
#pragma unroll 1
                for (int rep_ = 0; rep_ < REPS(4); ++rep_)
                for (int u = PANEL_PM * 4 + PANEL_R4; u < BATCH * 64; u += BATCH * 64) {
                    const int b = u >> 6, s = u & 63;
                    float h0 = 0.f, h1 = 0.f, A0 = 0.f, A1 = 0.f;
#pragma unroll 4
                    for (int t = 0; t < 64; ++t) {
                        const size_t m = (size_t)b * SEQ + s * 64 + t;
                        const unsigned rr = *(const unsigned*)(RI + m * 2048 + (c >> 8) * 512 + (c & 255)), ii = *(const unsigned*)(RI + m * 2048 + (c >> 8) * 512 + 256 + (c & 255)), xx = *(const unsigned*)(XA + ((size_t)(c >> 8) * M_TOK + m) * 256 + (c & 255));
                        const bool first = (s == 0 && t == 0);
                        lru_step(bflo(rr), bflo(ii), bflo(xx), sp0, first, h0, A0);
                        lru_step(bfhi(rr), bfhi(ii), bfhi(xx), sp1, first, h1, A1);
                    }
                    *(f32x4*)(LSUM + ((size_t)u * LRU_W + c) * 2) = (f32x4){A0, h0, A1, h1};
                }
                SEAM(pb + 4);
            }
            if (ENK(5) && IN(pb + 5)) {
                constexpr int NHU = BATCH * 8, NCV = 64;
                const bool split = G >= 2 * (NHU + NCV);
                const int rid = bx;
                {
                    const int it0 = l * WC_LAYER + WC_IN, it1 = (l + 1 < DEPTH) ? (l + 1) * WC_LAYER + WC_IN : DEPTH * WC_LAYER;
                    LAS float* scr = (LAS float*)(ldsl + wave * 16384);
                    if (!split) convert_weights(it0, it1, gw, ngw, scr, lane);
                    else if (rid >= NHU && rid < NHU + NCV) convert_weights(it0, it1, (rid - NHU) * NWAVES + wave, NCV * NWAVES, scr, lane);
                }
                if (!split) __syncthreads();
                if (!split || rid >= NHU + NCV) {
                    const float* lg = karg_in(I_LRUG) + l * LRU_W; bf16r* const YCAT = WSP(bf16r, WS_YCAT);
                    for (int u = split ? rid - (NHU + NCV) : rid; u < BATCH * 64; u += split ? G - (NHU + NCV) : G) {
                        const int b = u >> 6, s = u & 63;
                        float h0 = 0.f, h1 = 0.f, A0 = 0.f, A1 = 0.f;
                        for (int sp = 0; sp < s; ++sp) {
                            const f32x4 v = *(const f32x4*)(LSUM + ((size_t)(b * 64 + sp) * LRU_W + c) * 2);
                            h0 = fast_exp(v.x) * h0 + v.y; h1 = fast_exp(v.z) * h1 + v.w;
                        }
#pragma unroll 1
                        for (int hb = 0; hb < 2; ++hb) {
#pragma unroll 4
                            for (int tt = 0; tt < 32; ++tt) {
                                const size_t m = (size_t)b * SEQ + s * 64 + hb * 32 + tt;
                                const unsigned rr = __builtin_nontemporal_load((const unsigned*)(RI + m * 2048 + (c >> 8) * 512 + (c & 255))), ii = __builtin_nontemporal_load((const unsigned*)(RI + m * 2048 + (c >> 8) * 512 + 256 + (c & 255))), xx = __builtin_nontemporal_load((const unsigned*)(XA + ((size_t)(c >> 8) * M_TOK + m) * 256 + (c & 255)));
                                const unsigned gg = __builtin_nontemporal_load((const unsigned*)(Z + m * IN_WIDTH + OFF_A_GATE + c));
                                const bool first = (s == 0 && hb == 0 && tt == 0);
                                lru_step(bflo(rr), bflo(ii), bflo(xx), sp0, first, h0, A0);
                                lru_step(bfhi(rr), bfhi(ii), bfhi(xx), sp1, first, h1, A1);
                                *(LAS f32x2*)(ldsl + ((size_t)tt * LRU_W + c) * 4) = (f32x2){h0 * gelu_tanh(bflo(gg)), h1 * gelu_tanh(bfhi(gg))};
                            }
                            __syncthreads();
#pragma unroll
                            for (int q = 0; q < 4; ++q) {
                                const int tt = wave * 4 + q; const size_t m = (size_t)b * SEQ + s * 64 + hb * 32 + tt;
                                f32x4 v[4]; float ss = 0.f;
#pragma unroll
                                for (int j = 0; j < 4; ++j) { v[j] = *(const LAS f32x4*)(ldsl + ((size_t)tt * LRU_W + 256 * j + 4 * lane) * 4); ss += (v[j].x * v[j].x + v[j].y * v[j].y) + (v[j].z * v[j].z + v[j].w * v[j].w); }
                                ss = wave_sum(ss);
                                const float rs = 1.0f / sqrtf(ss * (1.0f / LRU_W) + NORM_EPS);
#pragma unroll
                                for (int j = 0; j < 4; ++j) { const f32x4 g = *((const f32x4*)lg + lane + 64 * j); v2u w; w.x = pk2(v[j].x * rs * g.x, v[j].y * rs * g.y); w.y = pk2(v[j].z * rs * g.z, v[j].w * rs * g.w);
                                    *((v2u*)(YCAT + m * D_MODEL) + lane + 64 * j) = w; }
                            }
                            __syncthreads();
                        }
                    }
                }
                for (int ubh = rid; ubh < NHU; ubh += G) hgrn_chunked(ldsl, Z, WSP(float, WS_LB) + l * HG_W, karg_in(I_HNG) + l * 128, WSP(bf16r, WS_YCAT), ubh >> 3, ubh & 7, tid);
                __syncthreads();
                {
                    typedef __hip_bfloat16 abf;
                    const abf* Qp = (const abf*)WSP(bf16r, WS_QH); const abf* Kp = (const abf*)WSP(bf16r, WS_KH); const abf* Vp = (const abf*)WSP(bf16r, WS_Z); abf* Op = (abf*)WSP(bf16r, WS_OATT);
                    unsigned* qctr = WSP(unsigned, WS_CTL) + 2048 + 512 * l;
                    constexpr int NQ = NQ_ALL;
                    const int x0 = bx & 7;
                    if (tid == 0) MISC[20] = 0u;
#define AQ_FETCH(dst) do { if (tid == 0) MISC[16] = (unsigned)aq_take(qctr, x0, MISC + 20); __syncthreads(); dst = (int)MISC[16]; __syncthreads(); } while (0)
                    int cur, nxt;
                    if (wave >= 4) __builtin_amdgcn_s_setprio(1);
                    AQ_FETCH(cur);
                    if (cur < NQ) {
                        AQ_FETCH(nxt);
                        ab::BlockRef<abf, abf> cref = attn_ref_q(Qp, Kp, Vp, Op, cur);
                        ab::Seam<abf> Sm;
                        ab::causal_swa_prime<abf, abf>(cref, SEQ, (char*)lds, Sm);
                        for (;;) {
                            const bool more = nxt < NQ;
                            unsigned pend = 0u;
                            if (more && wave == 0) { unsigned p_ = 0u; if (lane == 0) p_ = (unsigned)aq_take(qctr, x0, MISC + 20); pend = (unsigned)__builtin_amdgcn_readfirstlane((int)p_); }
                            const ab::BlockRef<abf, abf> nref = more ? attn_ref_q(Qp, Kp, Vp, Op, nxt) : cref;
                            ab::causal_swa_block<abf, abf>(cref, nref, SEQ, SEQ, (char*)lds, Sm);
                            if (!more) break;
                            if (tid == 0) MISC[16] = pend;
                            __syncthreads();
                            cref = nref; nxt = (int)MISC[16];
                            __syncthreads();
                        }
                    }
                    __builtin_amdgcn_s_setprio(0);
#undef AQ_FETCH
                }
                SEAM(pb + 7);
            }
        }

        if (ENK(8) && IN(pb + 8)) {
            PHASE_IDS;
#pragma unroll 1
            for (int rep_ = 0; rep_ < REPS(8); ++rep_) {
            bf16r* const OATT = WSP(bf16r, WS_OATT);
            bf16r* const Z = WSP(bf16r, WS_Z);
            bf16r* const YCAT = WSP(bf16r, WS_YCAT);
            const float lam_init = 0.8f - 0.6f * __expf(-0.3f * (float)l);
            const float* dl = karg_in(I_DLAM) + l * 4 * 128;
            float d1 = dl[lane] * dl[128 + lane] + dl[64 + lane] * dl[128 + 64 + lane];
            float d2 = dl[256 + lane] * dl[384 + lane] + dl[256 + 64 + lane] * dl[384 + 64 + lane];
            d1 = wave_sum(d1); d2 = wave_sum(d2);
            const float lamv = __expf(d1) - __expf(d2) + lam_init;
            const float* sg = karg_in(I_SUBLN) + l * 256;
            for (int m = PANEL_PM * 256 + PANEL_R4 * 64 + wave; m < PANEL_PM * 256 + PANEL_R4 * 64 + 64; m += NWAVES) {
                const int t = m & (SEQ - 1), b = m >> 12;
                bf16r* yrow = YCAT + (size_t)m * D_MODEL;
                v4u oa[4], ob[4];
#pragma unroll
                for (int it = 0; it < 4; ++it) {
                    const int e = it * 512 + lane * 8, h = e >> 8, vh = (e >> 7) & 1, d = e & 127;
                    oa[it] = __builtin_nontemporal_load((const v4u*)(OATT + ((size_t)(b * 32 + h * 4 + 0 + vh) * SEQ + t) * 128 + d));
                    ob[it] = __builtin_nontemporal_load((const v4u*)(OATT + ((size_t)(b * 32 + h * 4 + 2 + vh) * SEQ + t) * 128 + d));
                }
#pragma unroll
                for (int it = 0; it < 4; ++it) {
                    const int e = it * 512 + lane * 8;
                    const v4u a = oa[it], c2 = ob[it];
                    float oc[8] = {bflo(a.x) - lamv * bflo(c2.x), bfhi(a.x) - lamv * bfhi(c2.x), bflo(a.y) - lamv * bflo(c2.y), bfhi(a.y) - lamv * bfhi(c2.y),
                                   bflo(a.z) - lamv * bflo(c2.z), bfhi(a.z) - lamv * bfhi(c2.z), bflo(a.w) - lamv * bflo(c2.w), bfhi(a.w) - lamv * bfhi(c2.w)};
                    float ss = 0.f;
#pragma unroll
                    for (int j = 0; j < 8; ++j) ss += oc[j] * oc[j];
                    ss += __shfl_xor(ss, 1); ss += __shfl_xor(ss, 2); ss += __shfl_xor(ss, 4); ss += __shfl_xor(ss, 8); ss += __shfl_xor(ss, 16);
                    const float rs = (1.0f - lam_init) / sqrtf(ss * (1.0f / 256.0f) + NORM_EPS);
                    const f32x4 g0 = *(const f32x4*)(sg + (e & 255)), g1 = *(const f32x4*)(sg + (e & 255) + 4);
                    v4u w; w.x = pk2(oc[0] * rs * g0.x, oc[1] * rs * g0.y); w.y = pk2(oc[2] * rs * g0.z, oc[3] * rs * g0.w); w.z = pk2(oc[4] * rs * g1.x, oc[5] * rs * g1.y); w.w = pk2(oc[6] * rs * g1.z, oc[7] * rs * g1.w);
                    *(v4u*)(yrow + 2048 + e) = w;
                }
            }
            }
            SEAM4(pb + 8, 8 * l + 5);
        }

        if (ENK(9) && IN(pb + 9)) {
            PHASE_IDS;
#pragma unroll 1
            for (int rep_ = 0; rep_ < REPS(9); ++rep_) {
            bf16r* const YCAT = WSP(bf16r, WS_YCAT);
            bf16r* const W_OUT = WSP(bf16r, WS_WOUT);
            bf16r* const XB = WSP(bf16r, WS_H);
            pg8::Gemm g{YCAT, W_OUT + (size_t)l * D_MODEL * D_MODEL, M_TOK, D_MODEL, D_MODEL}; pg8::StaticOrder S; S.init(M_TOK, D_MODEL, G, bx);
            pg8::EpiResX E{(l == 0) ? karg_in(I_X) : (const float*)nullptr, XB, nullptr, XB, WSP(float, WS_PSS) + (size_t)(2 * l) * 64 * M_TOK, D_MODEL, M_TOK};
            pg8::gemm_phase<pg8::EpiResX, pg8::StaticOrder, GEMM_ALIGN, GEMM_SP2>(ldsl, g, S, E);
            }
            SEAM4(pb + 9, 8 * l + 0);
        }

        if (ENK(11) && IN(pb + 11)) {
            PHASE_IDS;
#pragma unroll 1
            for (int rep_ = 0; rep_ < REPS(11); ++rep_) {
            bf16r* const HB = WSP(bf16r, WS_H);
            bf16r* const W_FF1 = WSP(bf16r, WS_WFF1);
            bf16r* const HID = WSP(bf16r, WS_HID);
            pg8::Gemm g{HB, W_FF1 + (size_t)l * D_FF * D_MODEL, M_TOK, D_FF, D_MODEL}; pg8::StaticOrder S; S.init(M_TOK, D_FF, G, bx);
            { const float* pssp = WSP(float, WS_PSS) + (size_t)(2 * l) * 64 * M_TOK;
              pg8::Unit u0; if (S.next(0, u0)) RS_TABLE_FILL(pssp, 64, u0.pm); }
            pg8::EpiBf16X<2> E{HID, D_FF_LD, nullptr, nullptr, 0, (const LAS float*)(ldsl + RS_TABLE_OFF)};
            pg8::gemm_phase<pg8::EpiBf16X<2>, pg8::StaticOrder, GEMM_ALIGN, GEMM_SP2>(ldsl, g, S, E);
            }
            SEAM4(pb + 11, 8 * l + 1);
        }

        if (ENK(12) && IN(pb + 12)) {
            PHASE_IDS;
#pragma unroll 1
            for (int rep_ = 0; rep_ < REPS(12); ++rep_) {
            bf16r* const HID = WSP(bf16r, WS_HID);
            bf16r* const W_FF2 = WSP(bf16r, WS_WFF2);
            float* const OUT = karg_out();
            pg8::Gemm g{HID, W_FF2 + (size_t)l * D_MODEL * D_FF_LD, M_TOK, D_MODEL, D_FF, 0, 0, D_FF_LD}; pg8::StaticOrder S; S.init(M_TOK, D_MODEL, G, bx);
            bf16r* const XB = WSP(bf16r, WS_H);
            pg8::EpiResX E{nullptr, XB, (l + 1 == DEPTH) ? OUT : (float*)nullptr, XB, WSP(float, WS_PSS) + (size_t)1 * 64 * M_TOK, D_MODEL, M_TOK};
            pg8::gemm_phase<pg8::EpiResX, pg8::StaticOrder, GEMM_ALIGN, GEMM_SP2>(ldsl, g, S, E);
            }
            SEAM(pb + 12);
        }
    }
#if defined(DBG_STAMP_MASK)
    if (multi) {
        xcd_barrier(bar);
        if (blockIdx.x == 0 && threadIdx.x == 0) {
            const unsigned long long* st = WSP(unsigned long long, 12 * MiB);
            double idle = 0.0, lat = 0.0;
            for (int k = 0; k < N_PHASES - 1; ++k) {
                if (!((DBG_STAMP_MASK >> k) & 1)) continue;
                unsigned long long amax = 0, emax = 0; double asum = 0.0; bool any = false;
                for (int b2 = 0; b2 < G; ++b2) { const unsigned long long a = st[(k * 2 + 0) * 256 + b2], e = st[(k * 2 + 1) * 256 + b2]; if (a == 0xAAAAAAAAAAAAAAAAull) continue; any = true; amax = a > amax ? a : amax; emax = e > emax ? e : emax; asum += (double)a; }
                if (!any) continue;
                idle += (double)amax - asum / (double)G; lat += (double)emax - (double)amax;
            }
            karg_out()[0] = (float)(floor(idle * 0.01 / 200.0 + 0.5) * 200.0 * 1.0e4);
            karg_out()[1] = (float)(floor(lat * 0.01 / 100.0 + 0.5) * 100.0 * 1.0e4);
        }
    }
#endif
#undef IN
#undef SEAM
#undef SEAM4
#undef SEAM4H
}


#ifndef MK_PER_PHASE
#define MK_PER_PHASE 0
#endif
extern "C" void kernel_launch(void* const* d_in, const int* in_sizes, int n_in, void* d_out, int out_size, void* d_ws, size_t ws_size, hipStream_t stream) {
    static int grid = 0;
    if (grid == 0) {
        if (n_in != N_INPUTS || out_size != M_TOK * D_MODEL || ws_size < WS_END) { fprintf(stderr, "kernel_launch: unexpected shapes (n_in %d, out %d, ws %zu < %zu); nothing launched\n", n_in, out_size, ws_size, (size_t)WS_END); grid = -1; return; }
        int dev = 0, cus = 0;
        if (hipGetDevice(&dev) != hipSuccess || hipDeviceGetAttribute(&cus, hipDeviceAttributeMultiprocessorCount, dev) != hipSuccess || cus <= 0) { fprintf(stderr, "kernel_launch: device query failed\n"); grid = -1; return; }
        if (hipFuncSetAttribute((const void*)hymba_fwd, hipFuncAttributeMaxDynamicSharedMemorySize, LDS_BYTES) != hipSuccess) { fprintf(stderr, "kernel_launch: hipFuncSetAttribute failed\n"); grid = -1; return; }
        int per_cu = 0;
        if (hipOccupancyMaxActiveBlocksPerMultiprocessor(&per_cu, (const void*)hymba_fwd, NTHREADS, LDS_BYTES) != hipSuccess || per_cu < 1) fprintf(stderr, "kernel_launch: occupancy query reports %d blocks per CU\n", per_cu);
        (void)hipGetLastError();
        grid = cus;
        if (grid != 256) { fprintf(stderr, "kernel_launch: built for a 256-CU device (one row panel per workgroup in the z and ff1 GEMM phases); this device reports %d CUs; nothing launched\n", cus); grid = -1; return; }
    }
    if (grid < 0) return;
    (void)in_sizes;
    if (hipMemsetAsync((char*)d_ws + WS_CTL, 0, CTL_ZERO_BYTES, stream) != hipSuccess) { fprintf(stderr, "kernel_launch: memset failed\n"); return; }
    Args a{};
    for (int i = 0; i < N_INPUTS; ++i) a.in[i] = (const float*)d_in[i];
    a.out = (float*)d_out; a.ws = (unsigned char*)d_ws;
#if MK_PER_PHASE
    for (int p = 0; p < N_PHASES; ++p) { a.ph_lo = p; a.ph_hi = p + 1; hipLaunchKernelGGL(hymba_fwd, dim3(grid), dim3(NTHREADS), LDS_BYTES, stream, a); }
#else
    a.ph_lo = 0; a.ph_hi = N_PHASES;
    hipLaunchKernelGGL(hymba_fwd, dim3(grid), dim3(NTHREADS), LDS_BYTES, stream, a);
#endif
    const hipError_t le = hipPeekAtLastError();
    if (le != hipSuccess) fprintf(stderr, "kernel_launch: launch failed: %s\n", hipGetErrorName(le));
}
```
